# Optimizing an MI355X kernel written in HIP

```python
import math
import jax
import jax.numpy as jnp
from jax import lax
import numpy as np

D_MODEL = 1024
BATCH = 8
SEQ = 2048
DEPTH = 1

GRID_W = 64
CTX_LEN = 256
D_MIX = D_MODEL
HY_WIDTH = D_MIX // 2
RET_WIDTH = D_MIX - HY_WIDTH
RET_HEADS = 4
RET_HEAD_DIM = RET_WIDTH // RET_HEADS
RET_CHUNK = 128
RET_DECAY_OFFSET_F = 5.0
RET_DECAY_OFFSET_B = 5.5
ROPE_AXIS_DIM = RET_HEAD_DIM // 4
ROPE_BASE = 10000.0
HY_EMB_DIM = 33
HY_FILTER_HIDDEN = 64
HY_DECAY_TARGET = 1e-2
HY_FAST_PCT = 0.3
HY_SLOW_PCT = 1.5
HY_DECAY_SHIFT = 0.05
PROJ_COLS = 3 * HY_WIDTH + 4 * RET_WIDTH
N_GROUPS = 4
EXPERTS_PER_GROUP = 4
TOP_K_WITHIN = 2
EXPERT_HIDDEN = D_MODEL // 2
N_MOD = 6
EPS = 1e-6
F32 = jnp.float32

kernel_name = 'hybrid_hyena_retention_hmoe_dit'


def rmsnorm(x, w):
    xf = x.astype(F32)
    y = xf * lax.rsqrt(jnp.mean(xf * xf, axis=-1, keepdims=True) + EPS)
    return (y * w.astype(F32)).astype(x.dtype)


def modulate(h, shift, scale):
    return h * (1.0 + scale) + shift


def short_conv3(u, w, b):
    up = jnp.pad(u, ((0, 0), (1, 1), (0, 0)))
    return up[:, :-2] * w[0] + up[:, 1:-1] * w[1] + up[:, 2:] * w[2] + b


def hyena_filters(n_tok, lp):
    t = jnp.linspace(0.0, 1.0, n_tok, dtype=F32)[:, None]
    n_bands = (HY_EMB_DIM - 1) // 2
    bands = jnp.linspace(1e-4, n_bands - 1, n_bands, dtype=F32)
    ang = (2.0 * math.pi / n_tok) * jnp.arange(n_tok, dtype=F32)[:, None] * bands[None, :]
    z = jnp.concatenate([t, jnp.cos(ang), -jnp.sin(ang)], axis=-1)
    freq = lp['hy_f_freq'].astype(F32)
    h = jnp.sin(freq * (z @ lp['hy_f_w1'].astype(F32) + lp['hy_f_b1'].astype(F32)))
    h = jnp.sin(freq * (h @ lp['hy_f_w2'].astype(F32) + lp['hy_f_b2'].astype(F32)))
    h = jnp.sin(freq * (h @ lp['hy_f_w3'].astype(F32) + lp['hy_f_b3'].astype(F32)))
    h = h @ lp['hy_f_wout'].astype(F32)
    max_decay = math.log(HY_DECAY_TARGET) / HY_FAST_PCT
    min_decay = math.log(HY_DECAY_TARGET) / HY_SLOW_PCT
    deltas = jnp.abs(jnp.linspace(min_decay, max_decay, HY_WIDTH, dtype=F32))
    window = jnp.exp(-t * deltas[None, :]) + HY_DECAY_SHIFT
    h = h.reshape(n_tok, 2, HY_WIDTH) * window[:, None, :]
    return h[:, 0], h[:, 1]


def bidir_long_conv(u, h_fwd, h_bwd, skip):
    n_tok = u.shape[1]
    n_fft = 2 * n_tok
    filt = jnp.concatenate([h_fwd, jnp.zeros_like(h_fwd[:1]), h_bwd[:0:-1]], axis=0)
    uf = u.astype(F32)
    y = jnp.fft.irfft(jnp.fft.rfft(uf, n=n_fft, axis=1) * jnp.fft.rfft(filt, n=n_fft, axis=0)[None],
                      n=n_fft, axis=1)[:, :n_tok]
    return (y + uf * skip.astype(F32)).astype(u.dtype)


def hyena_mixer(p_hy, lp):
    u = short_conv3(p_hy, lp['hy_conv_w'], lp['hy_conv_b'])
    x0, x1, v = jnp.split(u, 3, axis=-1)
    h_fwd, h_bwd = hyena_filters(u.shape[1], lp)
    y = x0 * bidir_long_conv(v * x1, h_fwd, h_bwd, lp['hy_skip'])
    return rmsnorm(y, lp['hy_out_norm'])


def split_heads(t):
    b, n_tok, _ = t.shape
    return t.reshape(b, n_tok, RET_HEADS, RET_HEAD_DIM).transpose(0, 2, 1, 3)


def grid_positions(n_tok):
    ROWS = n_tok // GRID_W
    rows = jnp.repeat(jnp.arange(ROWS, dtype=F32), GRID_W)
    cols = jnp.tile(jnp.arange(GRID_W, dtype=F32), ROWS)
    return rows, cols


def axial_rope(t, rows, cols):
    n_freq = ROPE_AXIS_DIM // 2
    freqs = ROPE_BASE ** (-jnp.arange(n_freq, dtype=F32) / n_freq)

    def rot(seg, pos):
        ang = pos[:, None] * freqs[None, :]
        cs, sn = jnp.cos(ang), jnp.sin(ang)
        a, b = seg[..., :n_freq], seg[..., n_freq:]
        return jnp.concatenate([a * cs - b * sn, a * sn + b * cs], axis=-1)

    return jnp.concatenate([rot(t[..., :ROPE_AXIS_DIM], rows),
                            rot(t[..., ROPE_AXIS_DIM:2 * ROPE_AXIS_DIM], cols),
                            t[..., 2 * ROPE_AXIS_DIM:]], axis=-1)


def log_gammas(offset):
    return jnp.log1p(-jnp.exp2(-(offset + jnp.arange(RET_HEADS, dtype=F32))))


def decay_tables(log_gamma):
    i = jnp.arange(RET_CHUNK, dtype=F32)
    diff = i[:, None] - i[None, :]
    d_intra = jnp.where(diff >= 0, jnp.exp(jnp.maximum(diff, 0.0)[None] * log_gamma[:, None, None]), 0.0)
    xi = jnp.exp((i + 1.0)[None, :] * log_gamma[:, None])
    zeta = jnp.exp((RET_CHUNK - 1.0 - i)[None, :] * log_gamma[:, None])
    g_chunk = jnp.exp(RET_CHUNK * log_gamma)
    return d_intra, xi, zeta, g_chunk


def retention_scan(q, k, v, log_gamma, s0):
    b, nh, n_tok, dh = q.shape
    n_chunks = n_tok // RET_CHUNK
    d_intra, xi, zeta, g_chunk = decay_tables(log_gamma)

    def chunks(t):
        return t.reshape(b, nh, n_chunks, RET_CHUNK, dh).transpose(2, 0, 1, 3, 4)

    def step(s, qkv):
        qc, kc, vc = qkv
        scores = jnp.einsum('bhid,bhjd->bhij', qc, kc) * d_intra[None]
        inner = jnp.einsum('bhij,bhjd->bhid', scores, vc)
        cross = jnp.einsum('bhid,bhde->bhie', qc, s) * xi[None, :, :, None]
        s_new = s * g_chunk[None, :, None, None] + jnp.einsum('bhjd,bhje->bhde', kc * zeta[None, :, :, None], vc)
        return s_new, inner + cross

    s_fin, o = lax.scan(step, s0, (chunks(q), chunks(k), chunks(v)))
    return o.transpose(1, 2, 0, 3, 4).reshape(b, nh, n_tok, dh), s_fin


def decayed_state(k, v, log_gamma):
    n_tok = k.shape[2]
    w = jnp.exp((n_tok - 1.0 - jnp.arange(n_tok, dtype=F32))[None, :] * log_gamma[:, None])
    return jnp.einsum('hl,bhld,bhle->bhde', w, k, v)


def head_group_norm(o, w):
    mu = jnp.mean(o, axis=-1, keepdims=True)
    var = jnp.mean(jnp.square(o - mu), axis=-1, keepdims=True)
    on = (o - mu) * lax.rsqrt(var + EPS)
    b, nh, n_tok, dh = o.shape
    return on.transpose(0, 2, 1, 3).reshape(b, n_tok, nh * dh) * w.astype(F32)


def token_mixer(h, lp, s0_f, s0_b, on_grid):
    proj = h @ lp['w_in']
    y_hy = hyena_mixer(proj[..., :3 * HY_WIDTH], lp)
    q, k, v, g = jnp.split(proj[..., 3 * HY_WIDTH:], 4, axis=-1)
    q, k, v = (split_heads(t).astype(F32) for t in (q, k, v))
    k = k * RET_HEAD_DIM ** -0.5
    if on_grid:
        rows, cols = grid_positions(h.shape[1])
        q = axial_rope(q, rows, cols)
        k = axial_rope(k, rows, cols)
    o_f, s_f = retention_scan(q, k, v, log_gammas(RET_DECAY_OFFSET_F), s0_f)
    o_b, s_b = retention_scan(q[:, :, ::-1], k[:, :, ::-1], v[:, :, ::-1], log_gammas(RET_DECAY_OFFSET_B), s0_b)
    o = o_f + o_b[:, :, ::-1]
    y_ret = (jax.nn.silu(g.astype(F32)) * head_group_norm(o, lp['ret_gn_w'])).astype(h.dtype)
    y = jnp.concatenate([y_hy, y_ret], axis=-1) @ lp['w_out']
    return y, s_f, s_b


def context_states(hc, lp):
    w_in = lp['w_in']
    k0 = 3 * HY_WIDTH + RET_WIDTH
    k = split_heads(hc @ w_in[:, k0:k0 + RET_WIDTH]).astype(F32) * RET_HEAD_DIM ** -0.5
    v = split_heads(hc @ w_in[:, k0 + RET_WIDTH:k0 + 2 * RET_WIDTH]).astype(F32)
    s_f = decayed_state(k, v, log_gammas(RET_DECAY_OFFSET_F))
    s_b = decayed_state(k[:, :, ::-1], v[:, :, ::-1], log_gammas(RET_DECAY_OFFSET_B))
    return s_f, s_b


def hier_moe(h, lp):
    b, n_tok, d = h.shape
    t = h.reshape(-1, d)
    tf = t.astype(F32)
    lg = tf @ lp['router_g_w'].astype(F32) + lp['router_g_b'].astype(F32)
    pg = jax.nn.softmax(lg, axis=-1)
    onehot_g = jax.nn.one_hot(jnp.argmax(lg, axis=-1), N_GROUPS, dtype=F32)
    p_sel = jnp.sum(pg * onehot_g, axis=-1)
    le = (tf @ lp['router_e_w'].astype(F32) + lp['router_e_b'].astype(F32)).reshape(-1, N_GROUPS, EXPERTS_PER_GROUP)
    pe = jax.nn.softmax(jnp.einsum('tg,tge->te', onehot_g, le), axis=-1)
    top_v, top_i = lax.top_k(pe, TOP_K_WITHIN)
    top_v = top_v / jnp.sum(top_v, axis=-1, keepdims=True)
    w_within = jnp.einsum('tk,tke->te', top_v, jax.nn.one_hot(top_i, EXPERTS_PER_GROUP, dtype=F32))
    combine = (onehot_g[:, :, None] * (p_sel[:, None] * w_within)[:, None, :]).astype(t.dtype)
    y = jnp.zeros_like(t)
    for gi in range(N_GROUPS):
        a = jnp.einsum('td,edh->teh', t, lp['exp_w1'][gi])
        u = jnp.einsum('td,edh->teh', t, lp['exp_w3'][gi])
        hid = jax.nn.silu(a) * u * combine[:, gi, :, None]
        y = y + jnp.einsum('teh,ehd->td', hid, lp['exp_w2'][gi])
    return y.reshape(b, n_tok, d)


def setup_inputs(seed: int = 0) -> dict:
    key = jax.random.key(seed)
    ks = jax.random.split(key, 32)
    D = D_MODEL

    def nrm(k, shape, scale):
        return scale * jax.random.normal(k, shape, F32)

    return {
        'x': nrm(ks[0], (BATCH, SEQ, D), 1.0),
        'c': nrm(ks[1], (BATCH, D), 1.0),
        'ctx': nrm(ks[2], (BATCH, CTX_LEN, D), 1.0),
        'c_ctx': nrm(ks[3], (D,), 1.0),
        'ada_w': nrm(ks[4], (DEPTH, D, N_MOD * D), 0.5 * D ** -0.5),
        'ada_b': nrm(ks[5], (DEPTH, N_MOD * D), 0.02),
        'norm1_w': 1.0 + nrm(ks[6], (DEPTH, D), 0.05),
        'w_in': nrm(ks[7], (DEPTH, D, PROJ_COLS), D ** -0.5),
        'hy_conv_w': nrm(ks[8], (DEPTH, 3, 3 * HY_WIDTH), 3 ** -0.5),
        'hy_conv_b': nrm(ks[9], (DEPTH, 3 * HY_WIDTH), 0.02),
        'hy_f_w1': nrm(ks[10], (DEPTH, HY_EMB_DIM, HY_FILTER_HIDDEN), HY_EMB_DIM ** -0.5),
        'hy_f_b1': nrm(ks[11], (DEPTH, HY_FILTER_HIDDEN), 0.1),
        'hy_f_w2': nrm(ks[12], (DEPTH, HY_FILTER_HIDDEN, HY_FILTER_HIDDEN), HY_FILTER_HIDDEN ** -0.5),
        'hy_f_b2': nrm(ks[13], (DEPTH, HY_FILTER_HIDDEN), 0.1),
        'hy_f_w3': nrm(ks[14], (DEPTH, HY_FILTER_HIDDEN, HY_FILTER_HIDDEN), HY_FILTER_HIDDEN ** -0.5),
        'hy_f_b3': nrm(ks[15], (DEPTH, HY_FILTER_HIDDEN), 0.1),
        'hy_f_wout': nrm(ks[16], (DEPTH, HY_FILTER_HIDDEN, 2 * HY_WIDTH), HY_FILTER_HIDDEN ** -0.5),
        'hy_f_freq': 1.0 + nrm(ks[17], (DEPTH, HY_FILTER_HIDDEN), 0.1),
        'hy_skip': nrm(ks[18], (DEPTH, HY_WIDTH), 0.5),
        'hy_out_norm': 1.0 + nrm(ks[19], (DEPTH, HY_WIDTH), 0.05),
        'ret_gn_w': 1.0 + nrm(ks[20], (DEPTH, RET_WIDTH), 0.05),
        'w_out': nrm(ks[21], (DEPTH, D_MIX, D), D_MIX ** -0.5),
        'norm2_w': 1.0 + nrm(ks[22], (DEPTH, D), 0.05),
        'router_g_w': nrm(ks[23], (DEPTH, D, N_GROUPS), D ** -0.5),
        'router_g_b': nrm(ks[24], (DEPTH, N_GROUPS), 0.01),
        'router_e_w': nrm(ks[25], (DEPTH, D, N_GROUPS * EXPERTS_PER_GROUP), D ** -0.5),
        'router_e_b': nrm(ks[26], (DEPTH, N_GROUPS * EXPERTS_PER_GROUP), 0.01),
        'exp_w1': nrm(ks[27], (DEPTH, N_GROUPS, EXPERTS_PER_GROUP, D, EXPERT_HIDDEN), D ** -0.5),
        'exp_w3': nrm(ks[28], (DEPTH, N_GROUPS, EXPERTS_PER_GROUP, D, EXPERT_HIDDEN), D ** -0.5),
        'exp_w2': nrm(ks[29], (DEPTH, N_GROUPS, EXPERTS_PER_GROUP, EXPERT_HIDDEN, D), EXPERT_HIDDEN ** -0.5),
        'final_norm_w': 1.0 + nrm(ks[30], (D,), 0.05),
    }


def reference(x, c, ctx, c_ctx, ada_w, ada_b, norm1_w, w_in, hy_conv_w, hy_conv_b, hy_f_w1, hy_f_b1,
              hy_f_w2, hy_f_b2, hy_f_w3, hy_f_b3, hy_f_wout, hy_f_freq, hy_skip, hy_out_norm, ret_gn_w,
              w_out, norm2_w, router_g_w, router_g_b, router_e_w, router_e_b, exp_w1, exp_w3, exp_w2,
              final_norm_w):
    b = x.shape[0]
    for i in range(DEPTH):
        last = i == DEPTH - 1
        lp = {
            'w_in': w_in[i], 'hy_conv_w': hy_conv_w[i], 'hy_conv_b': hy_conv_b[i],
            'hy_f_w1': hy_f_w1[i], 'hy_f_b1': hy_f_b1[i], 'hy_f_w2': hy_f_w2[i], 'hy_f_b2': hy_f_b2[i],
            'hy_f_w3': hy_f_w3[i], 'hy_f_b3': hy_f_b3[i], 'hy_f_wout': hy_f_wout[i], 'hy_f_freq': hy_f_freq[i],
            'hy_skip': hy_skip[i], 'hy_out_norm': hy_out_norm[i], 'ret_gn_w': ret_gn_w[i], 'w_out': w_out[i],
            'router_g_w': router_g_w[i], 'router_g_b': router_g_b[i], 'router_e_w': router_e_w[i],
            'router_e_b': router_e_b[i], 'exp_w1': exp_w1[i], 'exp_w3': exp_w3[i], 'exp_w2': exp_w2[i],
        }
        mod = jax.nn.silu(c) @ ada_w[i] + ada_b[i]
        sh1, sc1, g1, sh2, sc2, g2 = [m[:, None, :] for m in jnp.split(mod, N_MOD, axis=-1)]
        mod_c = jax.nn.silu(c_ctx) @ ada_w[i] + ada_b[i]
        csh1, csc1, cg1, csh2, csc2, cg2 = jnp.split(mod_c, N_MOD, axis=-1)

        hc = modulate(rmsnorm(ctx, norm1_w[i]), csh1, csc1)
        if last:
            s_f, s_b = context_states(hc, lp)
        else:
            zero_state = jnp.zeros((b, RET_HEADS, RET_HEAD_DIM, RET_HEAD_DIM), F32)
            yc, s_f, s_b = token_mixer(hc, lp, zero_state, zero_state, False)
            ctx = ctx + cg1 * yc
            ctx = ctx + cg2 * hier_moe(modulate(rmsnorm(ctx, norm2_w[i]), csh2, csc2), lp)

        h = modulate(rmsnorm(x, norm1_w[i]), sh1, sc1)
        y, _, _ = token_mixer(h, lp, s_f, s_b, True)
        x = x + g1 * y
        x = x + g2 * hier_moe(modulate(rmsnorm(x, norm2_w[i]), sh2, sc2), lp)
    return rmsnorm(x, final_norm_w)
```

```cpp
#ifdef CPU_EMU
#include "emu.h"
#else
#include <hip/hip_runtime.h>
#include <hip/hip_cooperative_groups.h>
#include <cstdio>
namespace cg = cooperative_groups;
#endif
#include <stdint.h>
#include <string.h>
#include <math.h>

#ifndef CFG_BATCH
#define CFG_BATCH 8
#endif
#ifndef CFG_SEQ
#define CFG_SEQ 2048
#endif
#ifndef CFG_CTX
#define CFG_CTX 256
#endif

#ifdef CPU_EMU
#define OPAQUE(x)
#else
#define OPAQUE(x) asm volatile("" : "+v"(x))
#endif
#define DEV __device__ __forceinline__

typedef unsigned short bf16_t;
typedef short bf16x8 __attribute__((ext_vector_type(8)));
typedef float f32x4 __attribute__((ext_vector_type(4)));
typedef unsigned short us4 __attribute__((ext_vector_type(4)));

constexpr int NB = CFG_BATCH, L = CFG_SEQ, LC = CFG_CTX;
constexpr int D = 1024, T = NB * L, TC = NB * LC, TA = T + TC;
constexpr int HW = 512, NH = 4, DH = 128, CH = 128, PC = 3584, NMODC = 6 * D;
constexpr int NCH = L / CH, NCC = LC / CH, NCT = NCH + NCC;
constexpr int NEXP = 16, EH = 512;
constexpr int UP = L + 64;
constexpr int NTHR = 256;
constexpr int SMEM_BYTES = 77824;
constexpr int MAXTILES = T * 2 / 128 + NEXP;

struct Params {
    const float *x, *c, *ctx, *c_ctx, *ada_w, *ada_b, *norm1_w, *w_in, *hy_conv_w, *hy_conv_b, *f_w1, *f_b1, *f_w2, *f_b2, *f_w3, *f_b3,
        *f_wout, *f_freq, *hy_skip, *hy_out_norm, *ret_gn_w, *w_out, *norm2_w, *rg_w, *rg_b, *re_w, *re_b, *exp_w1, *exp_w3, *exp_w2, *final_w;
    float* out;
    float* mod;
    bf16_t* w_in_t;
    bf16_t* w_out_t;
    bf16_t* w13_t;
    bf16_t* w2_t;
    bf16_t* gtap;
    float* rope;
    bf16_t* hbuf;
    float* RP;
    float* cb;
    bf16_t* pT;
    bf16_t* qn;
    bf16_t* kn;
    bf16_t* kT;
    bf16_t* vT;
    bf16_t* ckT;
    bf16_t* cvT;
    bf16_t* gbuf;
    float* Kst;
    bf16_t* Sst;
    bf16_t* yhyT;
    bf16_t* ycat;
    bf16_t* Pscr;
    float* x1;
    bf16_t* h2;
    int* cnt;
    int* elist;
    float* ewt;
    int* tok_e;
    int* tok_pos;
    bf16_t* hid;
    bf16_t* ymoe;
};

DEV uint32_t f_as_u(float f) { return __builtin_bit_cast(uint32_t, f); }
DEV float u_as_f(uint32_t u) { return __builtin_bit_cast(float, u); }
DEV float bf2f(bf16_t v) { return u_as_f(((uint32_t)v) << 16); }
DEV bf16_t f2bf(float f) { uint32_t u = f_as_u(f); u += 0x7fffu + ((u >> 16) & 1u); return (bf16_t)(u >> 16); }
DEV us4 pack4(float a, float b, float c, float d) { us4 r; r[0] = f2bf(a); r[1] = f2bf(b); r[2] = f2bf(c); r[3] = f2bf(d); return r; }
DEV float silu_f(float v) { return v / (1.f + expf(-v)); }
DEV float wave_sum(float v) { v += __shfl_xor(v, 1); v += __shfl_xor(v, 2); v += __shfl_xor(v, 4); v += __shfl_xor(v, 8); v += __shfl_xor(v, 16); v += __shfl_xor(v, 32); return v; }
DEV float lg2_gamma(int h, bool bwd) { return log2f(1.f - exp2f(-((bwd ? 5.5f : 5.0f) + (float)h))); }

struct LdPlain {
    const bf16_t* rp[4];
    DEV LdPlain(const bf16_t* base, size_t row0, size_t ld) { const int lrow = threadIdx.x >> 3, lc = threadIdx.x & 7;
#pragma unroll
        for (int i = 0; i < 4; ++i) rp[i] = base + (row0 + lrow + 32 * i) * ld + lc * 8; }
    DEV bf16x8 ld(int i, int kt) const { return *(const bf16x8*)(rp[i] + kt * 64); }
};
struct LdGather {
    const bf16_t* rp[4];
    DEV bf16x8 ld(int i, int kt) const { return *(const bf16x8*)(rp[i] + kt * 64); }
};
struct LdKScale {
    const bf16_t* rp[4]; float a, b;
    DEV LdKScale(const bf16_t* base, size_t row0, size_t ld, float a_, float b_) : a(a_), b(b_) { const int lrow = threadIdx.x >> 3, lc = threadIdx.x & 7;
#pragma unroll
        for (int i = 0; i < 4; ++i) rp[i] = base + (row0 + lrow + 32 * i) * ld + lc * 8; }
    DEV bf16x8 ld(int i, int kt) const { bf16x8 v = *(const bf16x8*)(rp[i] + kt * 64); const int k0 = kt * 64 + (threadIdx.x & 7) * 8; bf16x8 o;
#pragma unroll
        for (int e = 0; e < 8; ++e) o[e] = (short)f2bf(bf2f((bf16_t)v[e]) * exp2f(a + b * (float)(k0 + e)));
        return o; }
};
struct LdRowScale {
    const bf16_t* rp[4]; float sc[4];
    DEV LdRowScale(const bf16_t* base, size_t row0, size_t ld, float a, float b) { const int lrow = threadIdx.x >> 3, lc = threadIdx.x & 7;
#pragma unroll
        for (int i = 0; i < 4; ++i) { rp[i] = base + (row0 + lrow + 32 * i) * ld + lc * 8; sc[i] = exp2f(a + b * (float)(lrow + 32 * i)); } }
    DEV bf16x8 ld(int i, int kt) const { bf16x8 v = *(const bf16x8*)(rp[i] + kt * 64); bf16x8 o;
#pragma unroll
        for (int e = 0; e < 8; ++e) o[e] = (short)f2bf(bf2f((bf16_t)v[e]) * sc[i]);
        return o; }
};

template <class LX, class LY>
DEV void gemm_tile(f32x4 (&acc)[4][4], const LX& lx, const LY& ly, int nk, char* smem) {
    int tid = threadIdx.x; OPAQUE(tid);
    const int lane = tid & 63, wid = tid >> 6, wr = wid >> 1, wc = wid & 1;
    const int lrow = tid >> 3, lc = tid & 7, fr = lane & 15, quad = lane >> 4;
    bf16x8 rx[4], ry[4];
    int soff[4];
#pragma unroll
    for (int i = 0; i < 4; ++i) { const int row = lrow + 32 * i; soff[i] = row * 128 + ((lc ^ ((row >> 1) & 7)) << 4); }
#pragma unroll
    for (int i = 0; i < 4; ++i) { rx[i] = lx.ld(i, 0); ry[i] = ly.ld(i, 0); }
#pragma unroll
    for (int i = 0; i < 4; ++i) { *(bf16x8*)(smem + soff[i]) = rx[i]; *(bf16x8*)(smem + 32768 + soff[i]) = ry[i]; }
    __syncthreads();
    const int sw = fr >> 1;
    for (int kt = 0; kt < nk; ++kt) {
        const char* bx = smem + (kt & 1) * 16384; const char* by = smem + 32768 + (kt & 1) * 16384;
        if (kt + 1 < nk) {
#pragma unroll
            for (int i = 0; i < 4; ++i) { rx[i] = lx.ld(i, kt + 1); ry[i] = ly.ld(i, kt + 1); }
        }
#pragma unroll
        for (int kk = 0; kk < 2; ++kk) {
            bf16x8 xf[4], yf[4];
            const int ch = ((kk * 4 + quad) ^ sw) << 4;
#pragma unroll
            for (int mi = 0; mi < 4; ++mi) xf[mi] = *(const bf16x8*)(bx + (wr * 64 + mi * 16 + fr) * 128 + ch);
#pragma unroll
            for (int ni = 0; ni < 4; ++ni) yf[ni] = *(const bf16x8*)(by + (wc * 64 + ni * 16 + fr) * 128 + ch);
#pragma unroll
            for (int mi = 0; mi < 4; ++mi)
#pragma unroll
                for (int ni = 0; ni < 4; ++ni) acc[mi][ni] = __builtin_amdgcn_mfma_f32_16x16x32_bf16(xf[mi], yf[ni], acc[mi][ni], 0, 0, 0);
        }
        if (kt + 1 < nk) {
            char* nx = smem + ((kt + 1) & 1) * 16384;
#pragma unroll
            for (int i = 0; i < 4; ++i) { *(bf16x8*)(nx + soff[i]) = rx[i]; *(bf16x8*)(nx + 32768 + soff[i]) = ry[i]; }
        }
        __syncthreads();
    }
}
DEV void zero_acc(f32x4 (&acc)[4][4]) {
#pragma unroll
    for (int i = 0; i < 4; ++i)
#pragma unroll
        for (int j = 0; j < 4; ++j) acc[i][j] = (f32x4){0.f, 0.f, 0.f, 0.f};
}

DEV void task_ada(const Params& p, char* smem, int task) {
    float* sl = (float*)smem;
    float* red = sl + (NB + 1) * D;
    const int tid = threadIdx.x;
    for (int i = tid; i < (NB + 1) * D; i += NTHR) { const int r = i / D, k = i % D; const float v = r < NB ? p.c[r * D + k] : p.c_ctx[k]; sl[i] = silu_f(v); }
    __syncthreads();
    const int col = tid & 31, kq = tid >> 5, j = task * 32 + col;
    float acc[NB + 1];
#pragma unroll
    for (int r = 0; r <= NB; ++r) acc[r] = 0.f;
    for (int k = kq; k < D; k += 8) { const float w = p.ada_w[(size_t)k * NMODC + j];
#pragma unroll
        for (int r = 0; r <= NB; ++r) acc[r] += sl[r * D + k] * w; }
#pragma unroll
    for (int r = 0; r <= NB; ++r) red[(kq * (NB + 1) + r) * 32 + col] = acc[r];
    __syncthreads();
    for (int i = tid; i < (NB + 1) * 32; i += NTHR) { const int r = i / 32, cc = i % 32; float s = p.ada_b[task * 32 + cc];
        for (int q = 0; q < 8; ++q) s += red[(q * (NB + 1) + r) * 32 + cc];
        p.mod[r * NMODC + task * 32 + cc] = s; }
    __syncthreads();
}

DEV void transpose_tile(const float* src, int ldn, int k0, int n0, bf16_t* dst, size_t ldk, int mapmode, int which, const float* sc, int scsplit, const float* sc2, char* smem) {
    float* t = (float*)smem;
    const int tid = threadIdx.x;
    { const int r = tid >> 4, c4 = tid & 15;
#pragma unroll
      for (int i = 0; i < 4; ++i) { const int k = r + 16 * i; const f32x4 v = *(const f32x4*)(src + (size_t)(k0 + k) * ldn + n0 + c4 * 4);
          float s = 1.f; if (sc) { const int kk = k0 + k; s = kk < scsplit ? sc[kk] : sc2[kk - scsplit]; }
          t[k * 65 + c4 * 4 + 0] = v[0] * s; t[k * 65 + c4 * 4 + 1] = v[1] * s; t[k * 65 + c4 * 4 + 2] = v[2] * s; t[k * 65 + c4 * 4 + 3] = v[3] * s; } }
    __syncthreads();
    { const int n = tid >> 2, kc = tid & 3; const int nn = n0 + n;
      const int drow = mapmode == 0 ? nn : ((nn >> 6) * 128 + ((nn >> 5) & 1) * 64 + which * 32 + (nn & 31));
#pragma unroll
      for (int h = 0; h < 2; ++h) { bf16x8 o;
#pragma unroll
          for (int e = 0; e < 8; ++e) o[e] = (short)f2bf(t[(kc * 16 + h * 8 + e) * 65 + n]);
          *(bf16x8*)(dst + (size_t)drow * ldk + k0 + kc * 16 + h * 8) = o; } }
    __syncthreads();
}

DEV void task_filt(const Params& p, char* smem, int task) {
    float* z = (float*)smem;
    float* ha = z + 16 * 36;
    float* hb = ha + 16 * 64;
    const int tid = threadIdx.x, i0 = task * 16;
    for (int i = tid; i < 16 * 33; i += NTHR) { const int pp = i / 33, f = i % 33, pos = i0 + pp; float v;
        if (f == 0) v = (float)pos / (float)(L - 1);
        else { const int bnd = (f - 1) & 15; const float band = 1e-4f + (float)bnd * ((15.f - 1e-4f) / 15.f);
               const float ang = (6.283185307179586f / (float)L) * (float)pos * band; v = f <= 16 ? cosf(ang) : -sinf(ang); }
        z[pp * 36 + f] = v; }
    __syncthreads();
    const int pp = tid >> 4, jq = tid & 15;
#pragma unroll 1
    for (int m = 0; m < 4; ++m) { const int j = jq + 16 * m; float s = p.f_b1[j];
#pragma unroll 3
        for (int k = 0; k < 33; ++k) s += z[pp * 36 + k] * p.f_w1[k * 64 + j];
        ha[pp * 64 + j] = sinf(p.f_freq[j] * s); }
    __syncthreads();
#pragma unroll 1
    for (int m = 0; m < 4; ++m) { const int j = jq + 16 * m; float s = p.f_b2[j];
#pragma unroll 4
        for (int k = 0; k < 64; ++k) s += ha[pp * 64 + k] * p.f_w2[k * 64 + j];
        hb[pp * 64 + j] = sinf(p.f_freq[j] * s); }
    __syncthreads();
#pragma unroll 1
    for (int m = 0; m < 4; ++m) { const int j = jq + 16 * m; float s = p.f_b3[j];
#pragma unroll 4
        for (int k = 0; k < 64; ++k) s += hb[pp * 64 + k] * p.f_w3[k * 64 + j];
        ha[pp * 64 + j] = sinf(p.f_freq[j] * s); }
    __syncthreads();
    const float max_decay = logf(1e-2f) / 0.3f, min_decay = logf(1e-2f) / 1.5f;
#pragma unroll 1
    for (int m = 0; m < 4; ++m) { const int cc = tid + 256 * m; float acc[16];
#pragma unroll
        for (int q = 0; q < 16; ++q) acc[q] = 0.f;
#pragma unroll 2
        for (int k = 0; k < 64; ++k) { const float w = p.f_wout[k * 1024 + cc];
#pragma unroll
            for (int q = 0; q < 16; ++q) acc[q] += ha[q * 64 + k] * w; }
        const int c = cc & 511; const bool isb = cc >= 512;
        const float delta = fabsf(min_decay + (float)c * ((max_decay - min_decay) / 511.f));
#pragma unroll
        for (int q = 0; q < 16; ++q) { const int pos = i0 + q; const float tt = (float)pos / (float)(L - 1); const float win = expf(-tt * delta) + 0.05f; float val = acc[q] * win;
            if (!isb) { if (pos == 0) val += p.hy_skip[c]; p.gtap[(size_t)c * (2 * L) + (L - pos)] = f2bf(val); }
            else { if (pos == 0) p.gtap[(size_t)c * (2 * L)] = 0; else p.gtap[(size_t)c * (2 * L) + (L + pos)] = f2bf(val); } } }
    __syncthreads();
}

constexpr int NT_ADA = NMODC / 32;
constexpr int NT_WIN = 16 * 56, NT_WOUT = 16 * 16, NT_W13 = 16 * 2 * 16 * 8, NT_W2 = 16 * 8 * 16;
constexpr int NT_FILT = L / 16;
constexpr int NT_P0 = NT_ADA + NT_FILT + 1 + NT_WIN + NT_WOUT;

DEV void ph_prep(const Params& p, char* smem) {
    for (int task = blockIdx.x; task < NT_P0; task += gridDim.x) {
        int t = task;
        if (t < NT_ADA) { task_ada(p, smem, t); continue; } t -= NT_ADA;
        if (t < NT_FILT) { task_filt(p, smem, t); continue; } t -= NT_FILT;
        if (t < 1) {
            for (int i = threadIdx.x; i < 64 * 16; i += NTHR) { const int pos = i >> 4, f = i & 15; const float fr = powf(10000.f, -(float)f / 16.f); const float a = (float)pos * fr;
                p.rope[i * 2] = cosf(a); p.rope[i * 2 + 1] = sinf(a); }
            if (threadIdx.x < 32) p.cnt[threadIdx.x] = 0;
            continue; } t -= 1;
        if (t < NT_WIN) { const int kt = t / 56, nt = t % 56; transpose_tile(p.w_in, PC, kt * 64, nt * 64, p.w_in_t, 1024, 0, 0, nullptr, 0, nullptr, smem); continue; } t -= NT_WIN;
        { const int kt = t / 16, nt = t % 16; transpose_tile(p.w_out, D, kt * 64, nt * 64, p.w_out_t, 1024, 0, 0, p.hy_out_norm, 512, p.ret_gn_w, smem); }
    }
}
DEV void expert_conv_task(const Params& p, char* smem, int t) {
    if (t < NT_W13) { const int e = t / 256, r = t % 256, which = r / 128, r2 = r % 128, kt = r2 / 8, nt = r2 % 8;
        transpose_tile((which ? p.exp_w3 : p.exp_w1) + (size_t)e * D * EH, EH, kt * 64, nt * 64, p.w13_t + (size_t)e * 1024 * 1024, 1024, 1, which, nullptr, 0, nullptr, smem); return; }
    t -= NT_W13;
    { const int e = t / 128, r = t % 128, kt = r / 16, nt = r % 16;
        transpose_tile(p.exp_w2 + (size_t)e * EH * D, D, kt * 64, nt * 64, p.w2_t + (size_t)e * 1024 * EH, EH, 0, 0, nullptr, 0, nullptr, smem); }
}

DEV void ph_norm1(const Params& p, char* smem) {
    const int tid = threadIdx.x, lane = tid & 63, wid = tid >> 6;
    for (int row = blockIdx.x * 4 + wid; row < TA; row += gridDim.x * 4) {
        const float* src = row < T ? p.x + (size_t)row * D : p.ctx + (size_t)(row - T) * D;
        const int mb = row < T ? row / L : NB;
        const float* sh = p.mod + (size_t)mb * NMODC; const float* sc = sh + D;
        f32x4 v[4]; float ss = 0.f;
#pragma unroll
        for (int i = 0; i < 4; ++i) { v[i] = *(const f32x4*)(src + i * 256 + lane * 4); ss += v[i][0] * v[i][0] + v[i][1] * v[i][1] + v[i][2] * v[i][2] + v[i][3] * v[i][3]; }
        ss = wave_sum(ss);
        const float rstd = rsqrtf(ss * (1.f / D) + 1e-6f);
#pragma unroll
        for (int i = 0; i < 4; ++i) { const int k = i * 256 + lane * 4; const f32x4 w = *(const f32x4*)(p.norm1_w + k), s1 = *(const f32x4*)(sc + k), s0 = *(const f32x4*)(sh + k);
            *(us4*)(p.hbuf + (size_t)row * D + k) = pack4(v[i][0] * rstd * w[0] * (1.f + s1[0]) + s0[0], v[i][1] * rstd * w[1] * (1.f + s1[1]) + s0[1],
                                                          v[i][2] * rstd * w[2] * (1.f + s1[2]) + s0[2], v[i][3] * rstd * w[3] * (1.f + s1[3]) + s0[3]); }
    }
    const int gtid = blockIdx.x * NTHR + tid, gn = gridDim.x * NTHR;
    for (int i = gtid; i < NB * D * 32; i += gn) { const int ii = i & 3, j = (i >> 2) & 31, k4 = (i >> 7) & 255, b = i >> 15; const int k = k4 * 4 + ii;
        const float r = j < 4 ? p.rg_w[k * 4 + j] : (j < 20 ? p.re_w[k * 16 + (j - 4)] : 0.f);
        p.RP[i] = p.norm2_w[k] * (1.f + p.mod[(size_t)b * NMODC + 4 * D + k]) * r; }
    for (int wt = blockIdx.x * 4 + wid; wt < NB * 32; wt += gridDim.x * 4) { const int b = wt >> 5, j = wt & 31; float s = 0.f;
        if (j < 20) for (int k = lane; k < D; k += 64) { const float r = j < 4 ? p.rg_w[k * 4 + j] : p.re_w[k * 16 + (j - 4)]; s += p.mod[(size_t)b * NMODC + 3 * D + k] * r; }
        s = wave_sum(s);
        if (lane == 0) p.cb[wt] = j < 4 ? s + p.rg_b[j] : (j < 20 ? s + p.re_b[j - 4] : 0.f); }
}

constexpr int NT_INP = (T / 128) * 28 + (TC / 128) * 8;
DEV void inproj_tile(const Params& p, char* smem, int mt, int nt) {
    int tid = threadIdx.x; OPAQUE(tid);
    const int lane = tid & 63, wid = tid >> 6, wr = wid >> 1, wc = wid & 1, fr = lane & 15, quad = lane >> 4;
    const size_t row0 = (size_t)mt * 128;
    const bool is_ctx = mt >= T / 128;
    const bool actX = (nt < 12) || (nt >= 16 && nt < 24);
    f32x4 acc[4][4]; zero_acc(acc);
    LdPlain la(p.hbuf, row0, D), lw(p.w_in_t, (size_t)nt * 128, D);
    if (actX) gemm_tile(acc, la, lw, D / 64, smem); else gemm_tile(acc, lw, la, D / 64, smem);
    if (nt < 12) {
#pragma unroll
        for (int mi = 0; mi < 4; ++mi)
#pragma unroll
            for (int ni = 0; ni < 4; ++ni) { const size_t tok = row0 + wr * 64 + mi * 16 + quad * 4; const int c = nt * 128 + wc * 64 + ni * 16 + fr;
                *(us4*)(p.pT + (size_t)c * T + tok) = pack4(acc[mi][ni][0], acc[mi][ni][1], acc[mi][ni][2], acc[mi][ni][3]); }
    } else if (nt >= 16 && nt < 24) {
        const bool isk = nt < 20; const int h = (nt - 16) & 3;
        if (!is_ctx) {
            const int b = (int)(row0 / L), tl0 = (int)(row0 % L);
            if (isk) {
                if (wc == 0) {
#pragma unroll
                    for (int mi = 0; mi < 4; ++mi)
#pragma unroll
                        for (int r = 0; r < 4; ++r) { const int tl = tl0 + wr * 64 + mi * 16 + quad * 4 + r;
                            { const float* cs = p.rope + ((tl >> 6) * 16 + fr) * 2; const float a = acc[mi][0][r], bq = acc[mi][1][r]; acc[mi][0][r] = a * cs[0] - bq * cs[1]; acc[mi][1][r] = a * cs[1] + bq * cs[0]; }
                            { const float* cs = p.rope + ((tl & 63) * 16 + fr) * 2; const float a = acc[mi][2][r], bq = acc[mi][3][r]; acc[mi][2][r] = a * cs[0] - bq * cs[1]; acc[mi][3][r] = a * cs[1] + bq * cs[0]; } }
                }
                const float scl = 0.08838834764831845f;
#pragma unroll
                for (int mi = 0; mi < 4; ++mi)
#pragma unroll
                    for (int ni = 0; ni < 4; ++ni) { const int tl = tl0 + wr * 64 + mi * 16 + quad * 4, d = wc * 64 + ni * 16 + fr; const size_t bh = (size_t)b * NH + h;
                        const us4 o = pack4(acc[mi][ni][0] * scl, acc[mi][ni][1] * scl, acc[mi][ni][2] * scl, acc[mi][ni][3] * scl);
                        *(us4*)(p.kT + (bh * 128 + d) * L + tl) = o;
#pragma unroll
                        for (int r = 0; r < 4; ++r) p.kn[(bh * L + tl + r) * 128 + d] = o[r]; }
            } else {
#pragma unroll
                for (int mi = 0; mi < 4; ++mi)
#pragma unroll
                    for (int ni = 0; ni < 4; ++ni) { const int tl = tl0 + wr * 64 + mi * 16 + quad * 4, d = wc * 64 + ni * 16 + fr; const size_t bh = (size_t)b * NH + h;
                        *(us4*)(p.vT + (bh * 128 + d) * L + tl) = pack4(acc[mi][ni][0], acc[mi][ni][1], acc[mi][ni][2], acc[mi][ni][3]); }
            }
        } else {
            const size_t cr0 = row0 - T; const int b = (int)(cr0 / LC), tl0 = (int)(cr0 % LC); const float scl = isk ? 0.08838834764831845f : 1.f;
            bf16_t* dst = isk ? p.ckT : p.cvT;
#pragma unroll
            for (int mi = 0; mi < 4; ++mi)
#pragma unroll
                for (int ni = 0; ni < 4; ++ni) { const int tl = tl0 + wr * 64 + mi * 16 + quad * 4, d = wc * 64 + ni * 16 + fr; const size_t bh = (size_t)b * NH + h;
                    *(us4*)(dst + (bh * 128 + d) * LC + tl) = pack4(acc[mi][ni][0] * scl, acc[mi][ni][1] * scl, acc[mi][ni][2] * scl, acc[mi][ni][3] * scl); }
        }
    } else if (nt < 16) {
        const int h = nt - 12; const int b = (int)(row0 / L), tl0 = (int)(row0 % L);
        if (wr == 0) {
#pragma unroll
            for (int ni = 0; ni < 4; ++ni) { const int tl = tl0 + wc * 64 + ni * 16 + fr;
#pragma unroll
                for (int r = 0; r < 4; ++r) { const int j = quad * 4 + r;
                    { const float* cs = p.rope + ((tl >> 6) * 16 + j) * 2; const float a = acc[0][ni][r], bq = acc[1][ni][r]; acc[0][ni][r] = a * cs[0] - bq * cs[1]; acc[1][ni][r] = a * cs[1] + bq * cs[0]; }
                    { const float* cs = p.rope + ((tl & 63) * 16 + j) * 2; const float a = acc[2][ni][r], bq = acc[3][ni][r]; acc[2][ni][r] = a * cs[0] - bq * cs[1]; acc[3][ni][r] = a * cs[1] + bq * cs[0]; } } }
        }
#pragma unroll
        for (int mi = 0; mi < 4; ++mi)
#pragma unroll
            for (int ni = 0; ni < 4; ++ni) { const int tl = tl0 + wc * 64 + ni * 16 + fr, d = wr * 64 + mi * 16 + quad * 4; const size_t bh = (size_t)b * NH + h;
                *(us4*)(p.qn + (bh * L + tl) * 128 + d) = pack4(acc[mi][ni][0], acc[mi][ni][1], acc[mi][ni][2], acc[mi][ni][3]); }
    } else {
#pragma unroll
        for (int mi = 0; mi < 4; ++mi)
#pragma unroll
            for (int ni = 0; ni < 4; ++ni) { const size_t tok = row0 + wc * 64 + ni * 16 + fr; const int d = (nt - 24) * 128 + wr * 64 + mi * 16 + quad * 4;
                *(us4*)(p.gbuf + tok * 512 + d) = pack4(acc[mi][ni][0], acc[mi][ni][1], acc[mi][ni][2], acc[mi][ni][3]); }
    }
}
DEV void ph_inproj(const Params& p, char* smem) {
    for (int task = blockIdx.x; task < NT_INP; task += gridDim.x) {
        if (task < (T / 128) * 28) inproj_tile(p, smem, task / 28, task % 28);
        else { const int t = task - (T / 128) * 28; inproj_tile(p, smem, T / 128 + t / 8, 16 + t % 8); }
    }
}

constexpr int NU = L / 64, UPW = NU / 4;
DEV bf16x8 conv_afrag(const bf16_t* taps, int m0) { bf16x8 a;
#pragma unroll
    for (int e = 0; e < 8; ++e) a[e] = (short)taps[m0 + e];
    return a; }
DEV void conv3_w(const Params& p, int ch, float& w0, float& w1, float& w2, float& bs) { w0 = p.hy_conv_w[ch]; w1 = p.hy_conv_w[1536 + ch]; w2 = p.hy_conv_w[3072 + ch]; bs = p.hy_conv_b[ch]; }

DEV void conv_task(const Params& p, char* smem, int c) {
    bf16_t* taps = (bf16_t*)smem;
    bf16_t* U = taps + 2 * L + 8;
    const int tid = threadIdx.x, lane = tid & 63, w = tid >> 6, fr = lane & 15, quad = lane >> 4;
    for (int i = tid; i < 2 * L / 8; i += NTHR) *(bf16x8*)(taps + i * 8) = *(const bf16x8*)(p.gtap + (size_t)c * 2 * L + i * 8);
    for (int i = tid; i < 8 * UP / 8; i += NTHR) *(bf16x8*)(U + i * 8) = (bf16x8){0, 0, 0, 0, 0, 0, 0, 0};
    __syncthreads();
    { float a0, a1, a2, ab, v0, v1, v2, vb; conv3_w(p, 512 + c, a0, a1, a2, ab); conv3_w(p, 1024 + c, v0, v1, v2, vb);
      for (int g = tid; g < NB * (L / 8); g += NTHR) { const int b = g / (L / 8), t8 = (g % (L / 8)) * 8;
          const bf16_t* r1 = p.pT + (size_t)(512 + c) * T + (size_t)b * L + t8; const bf16_t* rv = p.pT + (size_t)(1024 + c) * T + (size_t)b * L + t8;
          const bf16x8 x1v = *(const bf16x8*)r1, vv = *(const bf16x8*)rv;
          float px[10], pv[10];
          px[0] = t8 > 0 ? bf2f(r1[-1]) : 0.f; pv[0] = t8 > 0 ? bf2f(rv[-1]) : 0.f;
          px[9] = t8 + 8 < L ? bf2f(r1[8]) : 0.f; pv[9] = t8 + 8 < L ? bf2f(rv[8]) : 0.f;
#pragma unroll
          for (int e = 0; e < 8; ++e) { px[e + 1] = bf2f((bf16_t)x1v[e]); pv[e + 1] = bf2f((bf16_t)vv[e]); }
          bf16x8 o;
#pragma unroll
          for (int e = 0; e < 8; ++e) { const float x1 = a0 * px[e] + a1 * px[e + 1] + a2 * px[e + 2] + ab; const float vq = v0 * pv[e] + v1 * pv[e + 1] + v2 * pv[e + 2] + vb; o[e] = (short)f2bf(x1 * vq); }
          *(bf16x8*)(U + b * UP + 32 + t8) = o; } }
    __syncthreads();
    f32x4 acc[2][UPW];
#pragma unroll
    for (int tp = 0; tp < 2; ++tp)
#pragma unroll
        for (int ui = 0; ui < UPW; ++ui) acc[tp][ui] = (f32x4){0.f, 0.f, 0.f, 0.f};
    const int bcol = fr & 7, i2 = fr >> 3;
    const bf16_t* Ub = U + bcol * UP + 32 + 32 * i2 + 8 * quad;
    const int mbase = L - fr + 8 * quad - 64 * (UPW * w);
#pragma unroll 1
    for (int jp = 1; jp >= 0; --jp) {
        bf16x8 af[2][UPW];
        int J0 = jp ? -1 : 0;
        if (jp) {
            const bf16x8 bfr = *(const bf16x8*)(Ub + 32 * J0);
#pragma unroll
            for (int tp = 0; tp < 2; ++tp)
#pragma unroll
                for (int ui = 0; ui < UPW; ++ui) { const bf16x8 a = conv_afrag(taps, mbase - 64 * ui - 16 * tp + 32 * J0); acc[tp][ui] = __builtin_amdgcn_mfma_f32_16x16x32_bf16(a, bfr, acc[tp][ui], 0, 0, 0); }
            J0 = 1;
        }
#pragma unroll
        for (int tp = 0; tp < 2; ++tp)
#pragma unroll
            for (int ui = 0; ui < UPW; ++ui) af[tp][ui] = conv_afrag(taps, mbase - 64 * ui - 16 * tp + 32 * J0);
#pragma unroll 1
        for (int grp = 0; grp < 4; ++grp) {
#pragma unroll
            for (int s = 0; s < UPW; ++s) {
                const bf16x8 bfr = *(const bf16x8*)(Ub + 32 * J0);
#pragma unroll
                for (int tp = 0; tp < 2; ++tp)
#pragma unroll
                    for (int ui = 0; ui < UPW; ++ui) acc[tp][ui] = __builtin_amdgcn_mfma_f32_16x16x32_bf16(af[tp][(ui - s + UPW) % UPW], bfr, acc[tp][ui], 0, 0, 0);
                J0 += 2;
                if (grp < 3 || s < UPW - 1) {
#pragma unroll
                    for (int tp = 0; tp < 2; ++tp) af[tp][(UPW - 1 - s) % UPW] = conv_afrag(taps, mbase - 16 * tp + 32 * J0);
                }
            }
        }
    }
    float w0, w1, w2, wb; conv3_w(p, c, w0, w1, w2, wb);
    if (bcol < NB) {
#pragma unroll
        for (int tp = 0; tp < 2; ++tp)
#pragma unroll
            for (int ui = 0; ui < UPW; ++ui) { const int I0 = 4 * (UPW * w + ui) + tp; const int t = 16 * (I0 + 2 * i2) + 4 * quad;
                const bf16_t* r0 = p.pT + (size_t)c * T + (size_t)bcol * L + t; const us4 cv = *(const us4*)r0;
                float pq[6]; pq[0] = t > 0 ? bf2f(r0[-1]) : 0.f; pq[5] = t + 4 < L ? bf2f(r0[4]) : 0.f;
#pragma unroll
                for (int e = 0; e < 4; ++e) pq[e + 1] = bf2f(cv[e]);
                float y[4];
#pragma unroll
                for (int e = 0; e < 4; ++e) y[e] = (w0 * pq[e] + w1 * pq[e + 1] + w2 * pq[e + 2] + wb) * acc[tp][ui][e];
                *(us4*)(p.yhyT + (size_t)c * T + (size_t)bcol * L + t) = pack4(y[0], y[1], y[2], y[3]); }
    }
    __syncthreads();
}

DEV void rstate_task(const Params& p, char* smem, int task) {
    const int bh = task / NCT, J = task % NCT, h = bh % NH;
    const int lane = threadIdx.x & 63, wid = threadIdx.x >> 6, wr = wid >> 1, wc = wid & 1, fr = lane & 15, quad = lane >> 4;
    const bf16_t *kb, *vb; size_t ld; int col0;
    if (J < NCC) { kb = p.ckT + (size_t)bh * 128 * LC; vb = p.cvT + (size_t)bh * 128 * LC; ld = LC; col0 = J * 128; }
    else { kb = p.kT + (size_t)bh * 128 * L; vb = p.vT + (size_t)bh * 128 * L; ld = L; col0 = (J - NCC) * 128; }
#pragma unroll 1
    for (int dir = 0; dir < 2; ++dir) {
        const float lg = lg2_gamma(h, dir == 1);
        f32x4 acc[4][4]; zero_acc(acc);
        LdKScale lk(kb + col0, 0, ld, dir == 0 ? 127.f * lg : 0.f, dir == 0 ? -lg : lg);
        LdPlain lv(vb + col0, 0, ld);
        gemm_tile(acc, lk, lv, 2, smem);
        float* dst = p.Kst + (((size_t)dir * NB * NH + bh) * NCT + J) * 16384;
#pragma unroll
        for (int mi = 0; mi < 4; ++mi)
#pragma unroll
            for (int ni = 0; ni < 4; ++ni) { const int d = wr * 64 + mi * 16 + quad * 4, e = wc * 64 + ni * 16 + fr; *(f32x4*)(dst + e * 128 + d) = acc[mi][ni]; }
    }
}
constexpr int NT_RST = NB * NH * NCT;
DEV void ph_conv_rstate(const Params& p, char* smem) {
    for (int task = blockIdx.x; task < HW + NT_RST; task += gridDim.x) {
        if (task < HW) conv_task(p, smem, task); else rstate_task(p, smem, task - HW);
    }
}

DEV void hynorm_task(const Params& p, char* smem, int task) {
    bf16_t* tl = (bf16_t*)smem;
    const int tid = threadIdx.x; const size_t pos0 = (size_t)task * 64;
    for (int half = 0; half < 2; ++half) { const int c = tid + 256 * half; const bf16_t* src = p.yhyT + (size_t)c * T + pos0;
#pragma unroll
        for (int q = 0; q < 8; ++q) { const bf16x8 v = *(const bf16x8*)(src + q * 8);
#pragma unroll
            for (int e = 0; e < 8; ++e) tl[(q * 8 + e) * 520 + c] = (bf16_t)v[e]; } }
    __syncthreads();
    const int pos = tid >> 2, part = tid & 3;
    float ss = 0.f;
    for (int q = 0; q < 16; ++q) { const bf16x8 v = *(const bf16x8*)(tl + pos * 520 + part * 128 + q * 8);
#pragma unroll
        for (int e = 0; e < 8; ++e) { const float f = bf2f((bf16_t)v[e]); ss += f * f; } }
    ss += __shfl_xor(ss, 1); ss += __shfl_xor(ss, 2);
    const float rstd = rsqrtf(ss * (1.f / 512.f) + 1e-6f);
    for (int q = 0; q < 16; ++q) { const bf16x8 v = *(const bf16x8*)(tl + pos * 520 + part * 128 + q * 8); bf16x8 o;
#pragma unroll
        for (int e = 0; e < 8; ++e) o[e] = (short)f2bf(bf2f((bf16_t)v[e]) * rstd);
        *(bf16x8*)(p.ycat + (pos0 + pos) * 1024 + part * 128 + q * 8) = o; }
    __syncthreads();
}
DEV void ph_scan_hynorm(const Params& p, char* smem) {
    const size_t gtid = (size_t)blockIdx.x * NTHR + threadIdx.x, gn = (size_t)gridDim.x * NTHR;
    for (size_t i = gtid; i < (size_t)2 * NB * NH * 16384; i += gn) {
        const int ed = (int)(i & 16383); const int bh = (int)((i >> 14) % (NB * NH)); const int dir = (int)(i / ((size_t)NB * NH * 16384));
        const float gch = exp2f(128.f * lg2_gamma(bh % NH, dir == 1));
        const float* ks = p.Kst + (((size_t)dir * NB * NH + bh) * NCT) * 16384 + ed;
        bf16_t* so = p.Sst + (((size_t)dir * NB * NH + bh) * NCH) * 16384 + ed;
        float s = 0.f;
        if (dir == 0) { for (int J = 0; J < NCC; ++J) s = s * gch + ks[(size_t)J * 16384];
            for (int I = 0; I < NCH; ++I) { so[(size_t)I * 16384] = f2bf(s); s = s * gch + ks[(size_t)(NCC + I) * 16384]; } }
        else { for (int J = NCC - 1; J >= 0; --J) s = s * gch + ks[(size_t)J * 16384];
            for (int I = NCH - 1; I >= 0; --I) { so[(size_t)I * 16384] = f2bf(s); s = s * gch + ks[(size_t)(NCC + I) * 16384]; } }
    }
    for (int task = blockIdx.x; task < T / 64; task += gridDim.x) hynorm_task(p, smem, task);
}

DEV void rout_task(const Params& p, char* smem, int task) {
    const int bh = task / NCH, I = task % NCH, h = bh % NH, b = bh / NH;
    int tid = threadIdx.x; OPAQUE(tid);
    const int lane = tid & 63, wid = tid >> 6, wr = wid >> 1, wc = wid & 1, fr = lane & 15, quad = lane >> 4;
    const float lgf = lg2_gamma(h, false), lgb = lg2_gamma(h, true);
    bf16_t* P = p.Pscr + (size_t)blockIdx.x * 16384;
    const bf16_t* qb = p.qn + ((size_t)bh * L + I * 128) * 128; const bf16_t* kb = p.kn + ((size_t)bh * L + I * 128) * 128;
    {
        f32x4 acc[4][4]; zero_acc(acc);
        LdPlain lk(kb, 0, 128), lq(qb, 0, 128);
        gemm_tile(acc, lk, lq, 2, smem);
#pragma unroll
        for (int mi = 0; mi < 4; ++mi)
#pragma unroll
            for (int ni = 0; ni < 4; ++ni) { const int i = wc * 64 + ni * 16 + fr, j0 = wr * 64 + mi * 16 + quad * 4; float v[4];
#pragma unroll
                for (int r = 0; r < 4; ++r) { const int j = j0 + r; const float dcy = i > j ? exp2f(lgf * (float)(i - j)) : (i == j ? 2.f : exp2f(lgb * (float)(j - i))); v[r] = acc[mi][ni][r] * dcy; }
                *(us4*)(P + i * 128 + j0) = pack4(v[0], v[1], v[2], v[3]); }
    }
    __syncthreads();
    f32x4 acc[4][4]; zero_acc(acc);
    {
        LdPlain lv(p.vT + (size_t)bh * 128 * L + I * 128, 0, L), lp(P, 0, 128);
        gemm_tile(acc, lv, lp, 2, smem);
    }
    {
        LdPlain ls(p.Sst + (((size_t)0 * NB * NH + bh) * NCH + I) * 16384, 0, 128); LdRowScale lq(qb, 0, 128, lgf, lgf);
        gemm_tile(acc, ls, lq, 2, smem);
    }
    {
        LdPlain ls(p.Sst + (((size_t)1 * NB * NH + bh) * NCH + I) * 16384, 0, 128); LdRowScale lq(qb, 0, 128, 128.f * lgb, -lgb);
        gemm_tile(acc, ls, lq, 2, smem);
    }
    float* red = (float*)smem;
    float mean[4], rstd[4];
#pragma unroll
    for (int ni = 0; ni < 4; ++ni) { float s = 0.f, ss = 0.f;
#pragma unroll
        for (int mi = 0; mi < 4; ++mi)
#pragma unroll
            for (int r = 0; r < 4; ++r) { const float v = acc[mi][ni][r]; s += v; ss += v * v; }
        s += __shfl_xor(s, 16); s += __shfl_xor(s, 32); ss += __shfl_xor(ss, 16); ss += __shfl_xor(ss, 32);
        if (quad == 0) { const int i = wc * 64 + ni * 16 + fr; red[(wr * 128 + i) * 2] = s; red[(wr * 128 + i) * 2 + 1] = ss; } }
    __syncthreads();
#pragma unroll
    for (int ni = 0; ni < 4; ++ni) { const int i = wc * 64 + ni * 16 + fr; const float s = red[i * 2] + red[(128 + i) * 2], ss = red[i * 2 + 1] + red[(128 + i) * 2 + 1];
        mean[ni] = s * (1.f / 128.f); const float var = ss * (1.f / 128.f) - mean[ni] * mean[ni]; rstd[ni] = rsqrtf(fmaxf(var, 0.f) + 1e-6f); }
#pragma unroll
    for (int mi = 0; mi < 4; ++mi)
#pragma unroll
        for (int ni = 0; ni < 4; ++ni) { const int i = wc * 64 + ni * 16 + fr, e = wr * 64 + mi * 16 + quad * 4; const size_t tok = (size_t)b * L + I * 128 + i;
            const us4 gv = *(const us4*)(p.gbuf + tok * 512 + h * 128 + e); float y[4];
#pragma unroll
            for (int r = 0; r < 4; ++r) y[r] = (acc[mi][ni][r] - mean[ni]) * rstd[ni] * silu_f(bf2f(gv[r]));
            *(us4*)(p.ycat + tok * 1024 + 512 + h * 128 + e) = pack4(y[0], y[1], y[2], y[3]); }
    __syncthreads();
}
DEV void ph_rout(const Params& p, char* smem) {
#pragma unroll 1
    for (int task = blockIdx.x; task < NB * NH * NCH; task += gridDim.x) rout_task(p, smem, task); }

DEV void ph_outproj(const Params& p, char* smem) {
    const int lane = threadIdx.x & 63, wid = threadIdx.x >> 6, wr = wid >> 1, wc = wid & 1, fr = lane & 15, quad = lane >> 4;
    for (int task = blockIdx.x; task < (T / 128) * 8 + NT_W13 + NT_W2; task += gridDim.x) {
        if (task >= (T / 128) * 8) { expert_conv_task(p, smem, task - (T / 128) * 8); continue; }
        const int mt = task / 8, nt = task % 8;
        f32x4 acc[4][4]; zero_acc(acc);
        LdPlain lw(p.w_out_t, (size_t)nt * 128, D), la(p.ycat, (size_t)mt * 128, D);
        gemm_tile(acc, lw, la, D / 64, smem);
        const int b = (mt * 128) / L; const float* g1 = p.mod + (size_t)b * NMODC + 2 * D;
#pragma unroll
        for (int mi = 0; mi < 4; ++mi)
#pragma unroll
            for (int ni = 0; ni < 4; ++ni) { const size_t tok = (size_t)mt * 128 + wc * 64 + ni * 16 + fr; const int col = nt * 128 + wr * 64 + mi * 16 + quad * 4;
                const f32x4 xv = *(const f32x4*)(p.x + tok * D + col), gv = *(const f32x4*)(g1 + col);
                *(f32x4*)(p.x1 + tok * D + col) = xv + gv * acc[mi][ni]; }
    }
}

DEV void ph_norm2_router(const Params& p, char* smem) {
    const int tid = threadIdx.x, lane = tid & 63, wid = tid >> 6, fr = lane & 15, quad = lane >> 4;
    float* lgs = (float*)smem + wid * (16 * 33);
    float* rs = (float*)smem + 4 * 16 * 33 + wid * 16;
    for (int wt = blockIdx.x * 4 + wid; wt < T / 16; wt += gridDim.x * 4) {
        const size_t row0 = (size_t)wt * 16; const int b = (int)(row0 / L);
        const float* xr = p.x1 + (row0 + fr) * D + quad * 4;
        const float* rp = p.RP + (size_t)b * D * 32;
        f32x4 a0 = {0.f, 0.f, 0.f, 0.f}, a1 = a0; float ss = 0.f;
        for (int k0 = 0; k0 < D; k0 += 16) {
            const f32x4 xv = *(const f32x4*)(xr + k0);
            const f32x4 b0 = *(const f32x4*)(rp + ((size_t)(k0 / 4 + quad) * 32 + fr) * 4), b1 = *(const f32x4*)(rp + ((size_t)(k0 / 4 + quad) * 32 + 16 + fr) * 4);
            ss += xv[0] * xv[0] + xv[1] * xv[1] + xv[2] * xv[2] + xv[3] * xv[3];
#pragma unroll
            for (int i = 0; i < 4; ++i) { a0 = __builtin_amdgcn_mfma_f32_16x16x4f32(xv[i], b0[i], a0, 0, 0, 0); a1 = __builtin_amdgcn_mfma_f32_16x16x4f32(xv[i], b1[i], a1, 0, 0, 0); }
        }
        ss += __shfl_xor(ss, 16); ss += __shfl_xor(ss, 32);
        const float rstd = rsqrtf(ss * (1.f / D) + 1e-6f);
        if (quad == 0) rs[fr] = rstd;
#pragma unroll
        for (int r = 0; r < 4; ++r) { lgs[(quad * 4 + r) * 33 + fr] = a0[r]; lgs[(quad * 4 + r) * 33 + 16 + fr] = a1[r]; }
        __syncthreads();
        if (lane < 16) {
            const size_t tok = row0 + lane; const float rsd = rs[lane]; float lg[20];
#pragma unroll
            for (int j = 0; j < 20; ++j) lg[j] = lgs[lane * 33 + j] * rsd + p.cb[b * 32 + j];
            int g = 0; float gm = lg[0];
#pragma unroll
            for (int j = 1; j < 4; ++j) if (lg[j] > gm) { gm = lg[j]; g = j; }
            float den = 0.f;
#pragma unroll
            for (int j = 0; j < 4; ++j) den += expf(lg[j] - gm);
            const float psel = 1.f / den;
            float le[4];
#pragma unroll
            for (int j = 0; j < 4; ++j) le[j] = g == 0 ? lg[4 + j] : (g == 1 ? lg[8 + j] : (g == 2 ? lg[12 + j] : lg[16 + j]));
            int i0 = 0; float m0 = le[0];
#pragma unroll
            for (int j = 1; j < 4; ++j) if (le[j] > m0) { m0 = le[j]; i0 = j; }
            int i1 = -1; float m1 = -3.0e38f;
#pragma unroll
            for (int j = 0; j < 4; ++j) if (j != i0 && le[j] > m1) { m1 = le[j]; i1 = j; }
            const float ex = expf(m1 - m0); const float w0 = psel / (1.f + ex), w1 = psel * ex / (1.f + ex);
            const int e0 = g * 4 + i0, e1 = g * 4 + i1;
            const int p0 = atomicAdd(p.cnt + e0, 1), p1 = atomicAdd(p.cnt + e1, 1);
            p.elist[(size_t)e0 * T + p0] = (int)tok * 2; p.ewt[(size_t)e0 * T + p0] = w0;
            p.elist[(size_t)e1 * T + p1] = (int)tok * 2 + 1; p.ewt[(size_t)e1 * T + p1] = w1;
            p.tok_e[tok * 2] = e0; p.tok_e[tok * 2 + 1] = e1; p.tok_pos[tok * 2] = p0; p.tok_pos[tok * 2 + 1] = p1;
        }
        const float* sh = p.mod + (size_t)b * NMODC + 3 * D; const float* sc = sh + D;
        for (int r = 0; r < 16; ++r) { const float rsd = rs[r]; const float* src = p.x1 + (row0 + r) * D;
#pragma unroll
            for (int i = 0; i < 4; ++i) { const int k = i * 256 + lane * 4; const f32x4 v = *(const f32x4*)(src + k), w = *(const f32x4*)(p.norm2_w + k), s1 = *(const f32x4*)(sc + k), s0 = *(const f32x4*)(sh + k);
                *(us4*)(p.h2 + (row0 + r) * D + k) = pack4(v[0] * rsd * w[0] * (1.f + s1[0]) + s0[0], v[1] * rsd * w[1] * (1.f + s1[1]) + s0[1],
                                                           v[2] * rsd * w[2] * (1.f + s1[2]) + s0[2], v[3] * rsd * w[3] * (1.f + s1[3]) + s0[3]); } }
        __syncthreads();
    }
}

DEV bool moe_find_tile(const Params& p, int mtile, int& e, int& lt, int& rowoff, int& cnt) {
    int acc = 0;
    for (int q = 0; q < NEXP; ++q) { const int c = p.cnt[q]; const int nt = (c + 127) >> 7; if (mtile < acc + nt) { e = q; lt = mtile - acc; rowoff = acc * 128; cnt = c; return true; } acc += nt; }
    return false;
}
DEV void ph_moe_up(const Params& p, char* smem) {
    const int tid = threadIdx.x, lane = tid & 63, wid = tid >> 6, wr = wid >> 1, wc = wid & 1, fr = lane & 15, quad = lane >> 4;
    for (int task = blockIdx.x; task < MAXTILES * 8; task += gridDim.x) { const int mtile = task >> 3, nt = task & 7;
        int e, lt, rowoff, cnt; if (!moe_find_tile(p, mtile, e, lt, rowoff, cnt)) break;
        LdGather la; const int lrow = tid >> 3, lc = tid & 7;
#pragma unroll
        for (int i = 0; i < 4; ++i) { int li = lt * 128 + lrow + 32 * i; if (li >= cnt) li = cnt - 1; const int tok = p.elist[(size_t)e * T + li] >> 1; la.rp[i] = p.h2 + (size_t)tok * D + lc * 8; }
        LdPlain lw(p.w13_t + (size_t)e * 1024 * 1024, (size_t)nt * 128, D);
        f32x4 acc[4][4]; zero_acc(acc);
        gemm_tile(acc, lw, la, D / 64, smem);
#pragma unroll
        for (int ni = 0; ni < 4; ++ni) { int li = lt * 128 + wc * 64 + ni * 16 + fr; const bool valid = li < cnt; if (!valid) li = cnt - 1; const float cw = p.ewt[(size_t)e * T + li];
#pragma unroll
            for (int mi = 0; mi < 2; ++mi) { float hv[4];
#pragma unroll
                for (int r = 0; r < 4; ++r) hv[r] = silu_f(acc[mi][ni][r]) * acc[mi + 2][ni][r] * cw;
                const int hidx = nt * 64 + wr * 32 + mi * 16 + quad * 4;
                if (valid) *(us4*)(p.hid + (size_t)(rowoff + lt * 128 + wc * 64 + ni * 16 + fr) * EH + hidx) = pack4(hv[0], hv[1], hv[2], hv[3]); } }
    }
}
DEV void ph_moe_down(const Params& p, char* smem) {
    const int tid = threadIdx.x, lane = tid & 63, wid = tid >> 6, wr = wid >> 1, wc = wid & 1, fr = lane & 15, quad = lane >> 4;
    for (int task = blockIdx.x; task < MAXTILES * 8; task += gridDim.x) { const int mtile = task >> 3, nt = task & 7;
        int e, lt, rowoff, cnt; if (!moe_find_tile(p, mtile, e, lt, rowoff, cnt)) break;
        LdGather la; const int lrow = tid >> 3, lc = tid & 7;
#pragma unroll
        for (int i = 0; i < 4; ++i) { int li = lt * 128 + lrow + 32 * i; if (li >= cnt) li = cnt - 1; la.rp[i] = p.hid + (size_t)(rowoff + li) * EH + lc * 8; }
        LdPlain lw(p.w2_t + (size_t)e * 1024 * EH, (size_t)nt * 128, EH);
        f32x4 acc[4][4]; zero_acc(acc);
        gemm_tile(acc, lw, la, EH / 64, smem);
#pragma unroll
        for (int ni = 0; ni < 4; ++ni) { const int li = lt * 128 + wc * 64 + ni * 16 + fr; if (li < cnt) { const int ts = p.elist[(size_t)e * T + li];
#pragma unroll
            for (int mi = 0; mi < 4; ++mi) *(us4*)(p.ymoe + (size_t)ts * D + nt * 128 + wr * 64 + mi * 16 + quad * 4) = pack4(acc[mi][ni][0], acc[mi][ni][1], acc[mi][ni][2], acc[mi][ni][3]); } }
    }
}
DEV void ph_final(const Params& p, char* smem) {
    const int lane = threadIdx.x & 63, wid = threadIdx.x >> 6;
    for (int row = blockIdx.x * 4 + wid; row < T; row += gridDim.x * 4) { const int b = row / L; const float* g2 = p.mod + (size_t)b * NMODC + 5 * D;
        f32x4 v[4]; float ss = 0.f;
#pragma unroll
        for (int i = 0; i < 4; ++i) { const int k = i * 256 + lane * 4; const f32x4 xv = *(const f32x4*)(p.x1 + (size_t)row * D + k), gv = *(const f32x4*)(g2 + k);
            const us4 y0 = *(const us4*)(p.ymoe + ((size_t)row * 2) * D + k), y1 = *(const us4*)(p.ymoe + ((size_t)row * 2 + 1) * D + k);
#pragma unroll
            for (int e = 0; e < 4; ++e) { v[i][e] = xv[e] + gv[e] * (bf2f(y0[e]) + bf2f(y1[e])); ss += v[i][e] * v[i][e]; } }
        ss = wave_sum(ss); const float rstd = rsqrtf(ss * (1.f / D) + 1e-6f);
#pragma unroll
        for (int i = 0; i < 4; ++i) { const int k = i * 256 + lane * 4; const f32x4 w = *(const f32x4*)(p.final_w + k); *(f32x4*)(p.out + (size_t)row * D + k) = v[i] * rstd * w; }
    }
}

#define PHASE_LIST(X) X(ph_prep) X(ph_norm1) X(ph_inproj) X(ph_conv_rstate) X(ph_scan_hynorm) X(ph_rout) X(ph_outproj) X(ph_norm2_router) X(ph_moe_up) X(ph_moe_down)

struct WsBuf { size_t size, off; int p0, p1; };
static size_t fill_params(Params& p, void* const* d_in, void* d_out, void* d_ws, int grid) {
    const float** in = (const float**)d_in;
    p.x = in[0]; p.c = in[1]; p.ctx = in[2]; p.c_ctx = in[3]; p.ada_w = in[4]; p.ada_b = in[5]; p.norm1_w = in[6]; p.w_in = in[7]; p.hy_conv_w = in[8]; p.hy_conv_b = in[9];
    p.f_w1 = in[10]; p.f_b1 = in[11]; p.f_w2 = in[12]; p.f_b2 = in[13]; p.f_w3 = in[14]; p.f_b3 = in[15]; p.f_wout = in[16]; p.f_freq = in[17]; p.hy_skip = in[18]; p.hy_out_norm = in[19];
    p.ret_gn_w = in[20]; p.w_out = in[21]; p.norm2_w = in[22]; p.rg_w = in[23]; p.rg_b = in[24]; p.re_w = in[25]; p.re_b = in[26]; p.exp_w1 = in[27]; p.exp_w3 = in[28]; p.exp_w2 = in[29]; p.final_w = in[30];
    p.out = (float*)d_out;
    char* ws = (char*)d_ws; WsBuf bufs[48]; void** slots[48]; int nb = 0; size_t total = 0;
#define WS(field, type, count, p0, p1) { slots[nb] = (void**)&p.field; bufs[nb] = WsBuf{((sizeof(type) * (size_t)(count)) + 255) & ~(size_t)255, 0, p0, p1}; ++nb; }
    WS(mod, float, (NB + 1) * NMODC, 0, 10); WS(cnt, int, 64, 0, 10); WS(rope, float, 64 * 16 * 2, 0, 2); WS(w_in_t, bf16_t, PC * D, 0, 2); WS(w_out_t, bf16_t, D * D, 0, 6);
    WS(gtap, bf16_t, (size_t)HW * 2 * L, 0, 3);
    WS(hbuf, bf16_t, (size_t)TA * D, 1, 2); WS(RP, float, (size_t)NB * D * 32, 1, 7); WS(cb, float, NB * 32, 1, 7);
    WS(pT, bf16_t, (size_t)1536 * T, 2, 3); WS(qn, bf16_t, (size_t)T * 512, 2, 5); WS(kn, bf16_t, (size_t)T * 512, 2, 5); WS(kT, bf16_t, (size_t)T * 512, 2, 3); WS(vT, bf16_t, (size_t)T * 512, 2, 5);
    WS(ckT, bf16_t, (size_t)TC * 512, 2, 3); WS(cvT, bf16_t, (size_t)TC * 512, 2, 3); WS(gbuf, bf16_t, (size_t)T * 512, 2, 5);
    WS(Kst, float, (size_t)2 * NB * NH * NCT * 16384, 3, 4); WS(yhyT, bf16_t, (size_t)HW * T, 3, 4);
    WS(Sst, bf16_t, (size_t)2 * NB * NH * NCH * 16384, 4, 5); WS(ycat, bf16_t, (size_t)T * D, 4, 6);
    WS(Pscr, bf16_t, (size_t)grid * 16384, 5, 5);
    WS(x1, float, (size_t)T * D, 6, 10); WS(w13_t, bf16_t, (size_t)NEXP * 1024 * 1024, 6, 8); WS(w2_t, bf16_t, (size_t)NEXP * 1024 * EH, 6, 9);
    WS(h2, bf16_t, (size_t)T * D, 7, 8); WS(elist, int, (size_t)NEXP * T, 7, 10); WS(ewt, float, (size_t)NEXP * T, 7, 10); WS(tok_e, int, (size_t)T * 2, 7, 10); WS(tok_pos, int, (size_t)T * 2, 7, 10);
    WS(hid, bf16_t, (size_t)(2 * T + NEXP * 128) * EH, 8, 9); WS(ymoe, bf16_t, (size_t)2 * T * D, 9, 10);
#undef WS
    int order[48]; for (int i = 0; i < nb; ++i) order[i] = i;
    for (int i = 1; i < nb; ++i) { const int v = order[i]; int j = i - 1; while (j >= 0 && bufs[order[j]].size < bufs[v].size) { order[j + 1] = order[j]; --j; } order[j + 1] = v; }
    bool placed[48]; for (int i = 0; i < nb; ++i) placed[i] = false;
    for (int oi = 0; oi < nb; ++oi) { WsBuf& nbuf = bufs[order[oi]]; size_t off = 0;
        for (bool moved = true; moved;) { moved = false;
            for (int i = 0; i < nb; ++i) { if (!placed[i]) continue; const WsBuf& b = bufs[i];
                if (b.p1 < nbuf.p0 || b.p0 > nbuf.p1) continue;
                if (off < b.off + b.size && b.off < off + nbuf.size) { off = b.off + b.size; moved = true; } } }
        nbuf.off = off; placed[order[oi]] = true; *slots[order[oi]] = (void*)(ws + off); if (off + nbuf.size > total) total = off + nbuf.size; }
    return total;
}

#ifndef CPU_EMU
__global__ void __launch_bounds__(NTHR, 2) mega_kernel(Params p) {
    extern __shared__ __attribute__((aligned(16))) char smem[];
    cg::grid_group grid = cg::this_grid();
#define X(f) f(p, smem); grid.sync();
    PHASE_LIST(X)
#undef X
    ph_final(p, smem);
}

extern "C" void kernel_launch(void* const* d_in, const int* in_sizes, int n_in, void* d_out, int out_size, void* d_ws, size_t ws_size, hipStream_t stream) {
    static int grid_blocks = 0;
    if (!grid_blocks) {
        int dev = 0, cus = 0, per_cu = 0;
        hipGetDevice(&dev);
        hipDeviceGetAttribute(&cus, hipDeviceAttributeMultiprocessorCount, dev);
        hipFuncSetAttribute((const void*)mega_kernel, hipFuncAttributeMaxDynamicSharedMemorySize, SMEM_BYTES);
        hipOccupancyMaxActiveBlocksPerMultiprocessor(&per_cu, mega_kernel, NTHR, SMEM_BYTES);
        if (per_cu > 2) per_cu = 2;
        if (per_cu < 1) per_cu = 1;
        grid_blocks = cus * per_cu;
    }
    Params p; memset(&p, 0, sizeof(p));
    const size_t need = fill_params(p, d_in, d_out, d_ws, grid_blocks);
    if (need > ws_size) { fprintf(stderr, "workspace too small: need %zu have %zu\n", need, ws_size); return; }
    void* args[] = {&p};
    hipError_t e = hipLaunchCooperativeKernel((void*)mega_kernel, dim3(grid_blocks), dim3(NTHR), args, SMEM_BYTES, stream);
    if (e != hipSuccess) fprintf(stderr, "cooperative launch failed: %s (grid %d)\n", hipGetErrorString(e), grid_blocks);
}
#endif
```

```cpp
#ifdef CPU_EMU
#include "emu.h"
#else
#include <hip/hip_runtime.h>
#include <hip/hip_cooperative_groups.h>
#include <cstdio>
namespace cg = cooperative_groups;
#endif
#include <stdint.h>
#include <string.h>
#include <math.h>

#ifndef CFG_BATCH
#define CFG_BATCH 8
#endif
#ifndef CFG_SEQ
#define CFG_SEQ 2048
#endif
#ifndef CFG_CTX
#define CFG_CTX 256
#endif

#ifdef CPU_EMU
#define OPAQUE(x)
#else
#define OPAQUE(x) asm volatile("" : "+v"(x))
#endif
#define DEV __device__ __forceinline__

typedef unsigned short bf16_t;
typedef short bf16x8 __attribute__((ext_vector_type(8)));
typedef float f32x4 __attribute__((ext_vector_type(4)));
typedef unsigned short us4 __attribute__((ext_vector_type(4)));

constexpr int NB = CFG_BATCH, L = CFG_SEQ, LC = CFG_CTX;
constexpr int D = 1024, T = NB * L, TC = NB * LC, TA = T + TC;
constexpr int HW = 512, NH = 4, DH = 128, CH = 128, PC = 3584, NMODC = 6 * D;
constexpr int NCH = L / CH, NCC = LC / CH, NCT = NCH + NCC;
constexpr int NEXP = 16, EH = 512;
constexpr int UP = L + 64;
constexpr int NTHR = 256;
constexpr int SMEM_BYTES = 77824;
constexpr int MAXTILES = T * 2 / 128 + NEXP;

struct Params {
    const float *x, *c, *ctx, *c_ctx, *ada_w, *ada_b, *norm1_w, *w_in, *hy_conv_w, *hy_conv_b, *f_w1, *f_b1, *f_w2, *f_b2, *f_w3, *f_b3,
        *f_wout, *f_freq, *hy_skip, *hy_out_norm, *ret_gn_w, *w_out, *norm2_w, *rg_w, *rg_b, *re_w, *re_b, *exp_w1, *exp_w3, *exp_w2, *final_w;
    float* out;
    float* mod;
    bf16_t* w_in_t;
    bf16_t* w_out_t;
    bf16_t* w13_t;
    bf16_t* w2_t;
    bf16_t* gtap;
    float* rope;
    bf16_t* hbuf;
    float* RP;
    float* cb;
    bf16_t* pT;
    bf16_t* qn;
    bf16_t* kn;
    bf16_t* kT;
    bf16_t* vT;
    bf16_t* ckT;
    bf16_t* cvT;
    bf16_t* gbuf;
    float* Kst;
    bf16_t* Sst;
    bf16_t* yhyT;
    bf16_t* ycat;
    bf16_t* Pscr;
    float* x1;
    bf16_t* h2;
    unsigned* bar;
    int* cnt;
    int* elist;
    float* ewt;
    int* tok_e;
    int* tok_pos;
    bf16_t* hid;
    bf16_t* ymoe;
};

DEV uint32_t f_as_u(float f) { return __builtin_bit_cast(uint32_t, f); }
DEV float u_as_f(uint32_t u) { return __builtin_bit_cast(float, u); }
DEV float bf2f(bf16_t v) { return u_as_f(((uint32_t)v) << 16); }
DEV bf16_t f2bf(float f) { uint32_t u = f_as_u(f); u += 0x7fffu + ((u >> 16) & 1u); return (bf16_t)(u >> 16); }
DEV us4 pack4(float a, float b, float c, float d) { us4 r; r[0] = f2bf(a); r[1] = f2bf(b); r[2] = f2bf(c); r[3] = f2bf(d); return r; }
DEV float silu_f(float v) { return v / (1.f + expf(-v)); }
DEV float wave_sum(float v) { v += __shfl_xor(v, 1); v += __shfl_xor(v, 2); v += __shfl_xor(v, 4); v += __shfl_xor(v, 8); v += __shfl_xor(v, 16); v += __shfl_xor(v, 32); return v; }
DEV float lg2_gamma(int h, bool bwd) { return log2f(1.f - exp2f(-((bwd ? 5.5f : 5.0f) + (float)h))); }

struct LdPlain {
    const bf16_t* rp[4];
    DEV LdPlain(const bf16_t* base, size_t row0, size_t ld) { const int lrow = threadIdx.x >> 3, lc = threadIdx.x & 7;
#pragma unroll
        for (int i = 0; i < 4; ++i) rp[i] = base + (row0 + lrow + 32 * i) * ld + lc * 8; }
    DEV bf16x8 ld(int i, int kt) const { return *(const bf16x8*)(rp[i] + kt * 64); }
};
struct LdGather {
    const bf16_t* rp[4];
    DEV bf16x8 ld(int i, int kt) const { return *(const bf16x8*)(rp[i] + kt * 64); }
};
struct LdKScale {
    const bf16_t* rp[4]; float a, b;
    DEV LdKScale(const bf16_t* base, size_t row0, size_t ld, float a_, float b_) : a(a_), b(b_) { const int lrow = threadIdx.x >> 3, lc = threadIdx.x & 7;
#pragma unroll
        for (int i = 0; i < 4; ++i) rp[i] = base + (row0 + lrow + 32 * i) * ld + lc * 8; }
    DEV bf16x8 ld(int i, int kt) const { bf16x8 v = *(const bf16x8*)(rp[i] + kt * 64); const int k0 = kt * 64 + (threadIdx.x & 7) * 8; bf16x8 o;
#pragma unroll
        for (int e = 0; e < 8; ++e) o[e] = (short)f2bf(bf2f((bf16_t)v[e]) * exp2f(a + b * (float)(k0 + e)));
        return o; }
};
struct LdRowScale {
    const bf16_t* rp[4]; float sc[4];
    DEV LdRowScale(const bf16_t* base, size_t row0, size_t ld, float a, float b) { const int lrow = threadIdx.x >> 3, lc = threadIdx.x & 7;
#pragma unroll
        for (int i = 0; i < 4; ++i) { rp[i] = base + (row0 + lrow + 32 * i) * ld + lc * 8; sc[i] = exp2f(a + b * (float)(lrow + 32 * i)); } }
    DEV bf16x8 ld(int i, int kt) const { bf16x8 v = *(const bf16x8*)(rp[i] + kt * 64); bf16x8 o;
#pragma unroll
        for (int e = 0; e < 8; ++e) o[e] = (short)f2bf(bf2f((bf16_t)v[e]) * sc[i]);
        return o; }
};

template <class LX, class LY>
DEV void gemm_tile(f32x4 (&acc)[4][4], const LX& lx, const LY& ly, int nk, char* smem) {
    int tid = threadIdx.x; OPAQUE(tid);
    const int lane = tid & 63, wid = tid >> 6, wr = wid >> 1, wc = wid & 1;
    const int lrow = tid >> 3, lc = tid & 7, fr = lane & 15, quad = lane >> 4;
    bf16x8 rx[4], ry[4];
    int soff[4];
#pragma unroll
    for (int i = 0; i < 4; ++i) { const int row = lrow + 32 * i; soff[i] = row * 128 + ((lc ^ ((row >> 1) & 7)) << 4); }
#pragma unroll
    for (int i = 0; i < 4; ++i) { rx[i] = lx.ld(i, 0); ry[i] = ly.ld(i, 0); }
#pragma unroll
    for (int i = 0; i < 4; ++i) { *(bf16x8*)(smem + soff[i]) = rx[i]; *(bf16x8*)(smem + 32768 + soff[i]) = ry[i]; }
    __syncthreads();
    const int sw = fr >> 1;
    for (int kt = 0; kt < nk; ++kt) {
        const char* bx = smem + (kt & 1) * 16384; const char* by = smem + 32768 + (kt & 1) * 16384;
        if (kt + 1 < nk) {
#pragma unroll
            for (int i = 0; i < 4; ++i) { rx[i] = lx.ld(i, kt + 1); ry[i] = ly.ld(i, kt + 1); }
        }
#pragma unroll
        for (int kk = 0; kk < 2; ++kk) {
            bf16x8 xf[4], yf[4];
            const int ch = ((kk * 4 + quad) ^ sw) << 4;
#pragma unroll
            for (int mi = 0; mi < 4; ++mi) xf[mi] = *(const bf16x8*)(bx + (wr * 64 + mi * 16 + fr) * 128 + ch);
#pragma unroll
            for (int ni = 0; ni < 4; ++ni) yf[ni] = *(const bf16x8*)(by + (wc * 64 + ni * 16 + fr) * 128 + ch);
#pragma unroll
            for (int mi = 0; mi < 4; ++mi)
#pragma unroll
                for (int ni = 0; ni < 4; ++ni) acc[mi][ni] = __builtin_amdgcn_mfma_f32_16x16x32_bf16(xf[mi], yf[ni], acc[mi][ni], 0, 0, 0);
        }
        if (kt + 1 < nk) {
            char* nx = smem + ((kt + 1) & 1) * 16384;
#pragma unroll
            for (int i = 0; i < 4; ++i) { *(bf16x8*)(nx + soff[i]) = rx[i]; *(bf16x8*)(nx + 32768 + soff[i]) = ry[i]; }
        }
        __syncthreads();
    }
}
DEV void zero_acc(f32x4 (&acc)[4][4]) {
#pragma unroll
    for (int i = 0; i < 4; ++i)
#pragma unroll
        for (int j = 0; j < 4; ++j) acc[i][j] = (f32x4){0.f, 0.f, 0.f, 0.f};
}

DEV void task_ada(const Params& p, char* smem, int task) {
    float* sl = (float*)smem;
    float* red = sl + (NB + 1) * D;
    const int tid = threadIdx.x;
    for (int i = tid; i < (NB + 1) * D; i += NTHR) { const int r = i / D, k = i % D; const float v = r < NB ? p.c[r * D + k] : p.c_ctx[k]; sl[i] = silu_f(v); }
    __syncthreads();
    const int col = tid & 31, kq = tid >> 5, j = task * 32 + col;
    float acc[NB + 1];
#pragma unroll
    for (int r = 0; r <= NB; ++r) acc[r] = 0.f;
    for (int k = kq; k < D; k += 8) { const float w = p.ada_w[(size_t)k * NMODC + j];
#pragma unroll
        for (int r = 0; r <= NB; ++r) acc[r] += sl[r * D + k] * w; }
#pragma unroll
    for (int r = 0; r <= NB; ++r) red[(kq * (NB + 1) + r) * 32 + col] = acc[r];
    __syncthreads();
    for (int i = tid; i < (NB + 1) * 32; i += NTHR) { const int r = i / 32, cc = i % 32; float s = p.ada_b[task * 32 + cc];
        for (int q = 0; q < 8; ++q) s += red[(q * (NB + 1) + r) * 32 + cc];
        p.mod[r * NMODC + task * 32 + cc] = s; }
    __syncthreads();
}

DEV void transpose_tile(const float* src, int ldn, int k0, int n0, bf16_t* dst, size_t ldk, int mapmode, int which, const float* sc, int scsplit, const float* sc2, char* smem) {
    float* t = (float*)smem;
    const int tid = threadIdx.x;
    { const int r = tid >> 4, c4 = tid & 15;
#pragma unroll
      for (int i = 0; i < 4; ++i) { const int k = r + 16 * i; const f32x4 v = *(const f32x4*)(src + (size_t)(k0 + k) * ldn + n0 + c4 * 4);
          float s = 1.f; if (sc) { const int kk = k0 + k; s = kk < scsplit ? sc[kk] : sc2[kk - scsplit]; }
          t[k * 65 + c4 * 4 + 0] = v[0] * s; t[k * 65 + c4 * 4 + 1] = v[1] * s; t[k * 65 + c4 * 4 + 2] = v[2] * s; t[k * 65 + c4 * 4 + 3] = v[3] * s; } }
    __syncthreads();
    { const int n = tid >> 2, kc = tid & 3; const int nn = n0 + n;
      const int drow = mapmode == 0 ? nn : ((nn >> 6) * 128 + ((nn >> 5) & 1) * 64 + which * 32 + (nn & 31));
#pragma unroll
      for (int h = 0; h < 2; ++h) { bf16x8 o;
#pragma unroll
          for (int e = 0; e < 8; ++e) o[e] = (short)f2bf(t[(kc * 16 + h * 8 + e) * 65 + n]);
          *(bf16x8*)(dst + (size_t)drow * ldk + k0 + kc * 16 + h * 8) = o; } }
    __syncthreads();
}

DEV void task_filt(const Params& p, char* smem, int task) {
    float* z = (float*)smem;
    float* ha = z + 16 * 36;
    float* hb = ha + 16 * 64;
    const int tid = threadIdx.x, i0 = task * 16;
    for (int i = tid; i < 16 * 33; i += NTHR) { const int pp = i / 33, f = i % 33, pos = i0 + pp; float v;
        if (f == 0) v = (float)pos / (float)(L - 1);
        else { const int bnd = (f - 1) & 15; const float band = 1e-4f + (float)bnd * ((15.f - 1e-4f) / 15.f);
               const float ang = (6.283185307179586f / (float)L) * (float)pos * band; v = f <= 16 ? cosf(ang) : -sinf(ang); }
        z[pp * 36 + f] = v; }
    __syncthreads();
    const int pp = tid >> 4, jq = tid & 15;
#pragma unroll 1
    for (int m = 0; m < 4; ++m) { const int j = jq + 16 * m; float s = p.f_b1[j];
#pragma unroll 3
        for (int k = 0; k < 33; ++k) s += z[pp * 36 + k] * p.f_w1[k * 64 + j];
        ha[pp * 64 + j] = sinf(p.f_freq[j] * s); }
    __syncthreads();
#pragma unroll 1
    for (int m = 0; m < 4; ++m) { const int j = jq + 16 * m; float s = p.f_b2[j];
#pragma unroll 4
        for (int k = 0; k < 64; ++k) s += ha[pp * 64 + k] * p.f_w2[k * 64 + j];
        hb[pp * 64 + j] = sinf(p.f_freq[j] * s); }
    __syncthreads();
#pragma unroll 1
    for (int m = 0; m < 4; ++m) { const int j = jq + 16 * m; float s = p.f_b3[j];
#pragma unroll 4
        for (int k = 0; k < 64; ++k) s += hb[pp * 64 + k] * p.f_w3[k * 64 + j];
        ha[pp * 64 + j] = sinf(p.f_freq[j] * s); }
    __syncthreads();
    const float max_decay = logf(1e-2f) / 0.3f, min_decay = logf(1e-2f) / 1.5f;
#pragma unroll 1
    for (int m = 0; m < 4; ++m) { const int cc = tid + 256 * m; float acc[16];
#pragma unroll
        for (int q = 0; q < 16; ++q) acc[q] = 0.f;
#pragma unroll 2
        for (int k = 0; k < 64; ++k) { const float w = p.f_wout[k * 1024 + cc];
#pragma unroll
            for (int q = 0; q < 16; ++q) acc[q] += ha[q * 64 + k] * w; }
        const int c = cc & 511; const bool isb = cc >= 512;
        const float delta = fabsf(min_decay + (float)c * ((max_decay - min_decay) / 511.f));
#pragma unroll
        for (int q = 0; q < 16; ++q) { const int pos = i0 + q; const float tt = (float)pos / (float)(L - 1); const float win = expf(-tt * delta) + 0.05f; float val = acc[q] * win;
            if (!isb) { if (pos == 0) val += p.hy_skip[c]; p.gtap[(size_t)c * (2 * L) + (L - pos)] = f2bf(val); }
            else { if (pos == 0) p.gtap[(size_t)c * (2 * L)] = 0; else p.gtap[(size_t)c * (2 * L) + (L + pos)] = f2bf(val); } } }
    __syncthreads();
}

constexpr int NT_ADA = NMODC / 32;
constexpr int NT_WIN = 16 * 56, NT_WOUT = 16 * 16, NT_W13 = 16 * 2 * 16 * 8, NT_W2 = 16 * 8 * 16;
constexpr int NT_FILT = L / 16;
constexpr int NT_P0 = NT_ADA + NT_FILT + 1 + NT_WIN + NT_WOUT;

DEV void ph_prep(const Params& p, char* smem) {
    for (int task = blockIdx.x; task < NT_P0; task += gridDim.x) {
        int t = task;
        if (t < NT_ADA) { task_ada(p, smem, t); continue; } t -= NT_ADA;
        if (t < NT_FILT) { task_filt(p, smem, t); continue; } t -= NT_FILT;
        if (t < 1) {
            for (int i = threadIdx.x; i < 64 * 16; i += NTHR) { const int pos = i >> 4, f = i & 15; const float fr = powf(10000.f, -(float)f / 16.f); const float a = (float)pos * fr;
                p.rope[i * 2] = cosf(a); p.rope[i * 2 + 1] = sinf(a); }
            if (threadIdx.x < 32) p.cnt[threadIdx.x] = 0;
            continue; } t -= 1;
        if (t < NT_WIN) { const int kt = t / 56, nt = t % 56; transpose_tile(p.w_in, PC, kt * 64, nt * 64, p.w_in_t, 1024, 0, 0, nullptr, 0, nullptr, smem); continue; } t -= NT_WIN;
        { const int kt = t / 16, nt = t % 16; transpose_tile(p.w_out, D, kt * 64, nt * 64, p.w_out_t, 1024, 0, 0, p.hy_out_norm, 512, p.ret_gn_w, smem); }
    }
}
DEV void expert_conv_task(const Params& p, char* smem, int t) {
    if (t < NT_W13) { const int e = t / 256, r = t % 256, which = r / 128, r2 = r % 128, kt = r2 / 8, nt = r2 % 8;
        transpose_tile((which ? p.exp_w3 : p.exp_w1) + (size_t)e * D * EH, EH, kt * 64, nt * 64, p.w13_t + (size_t)e * 1024 * 1024, 1024, 1, which, nullptr, 0, nullptr, smem); return; }
    t -= NT_W13;
    { const int e = t / 128, r = t % 128, kt = r / 16, nt = r % 16;
        transpose_tile(p.exp_w2 + (size_t)e * EH * D, D, kt * 64, nt * 64, p.w2_t + (size_t)e * 1024 * EH, EH, 0, 0, nullptr, 0, nullptr, smem); }
}

DEV void ph_norm1(const Params& p, char* smem) {
    const int tid = threadIdx.x, lane = tid & 63, wid = tid >> 6;
    for (int row = blockIdx.x * 4 + wid; row < TA; row += gridDim.x * 4) {
        const float* src = row < T ? p.x + (size_t)row * D : p.ctx + (size_t)(row - T) * D;
        const int mb = row < T ? row / L : NB;
        const float* sh = p.mod + (size_t)mb * NMODC; const float* sc = sh + D;
        f32x4 v[4]; float ss = 0.f;
#pragma unroll
        for (int i = 0; i < 4; ++i) { v[i] = *(const f32x4*)(src + i * 256 + lane * 4); ss += v[i][0] * v[i][0] + v[i][1] * v[i][1] + v[i][2] * v[i][2] + v[i][3] * v[i][3]; }
        ss = wave_sum(ss);
        const float rstd = rsqrtf(ss * (1.f / D) + 1e-6f);
#pragma unroll
        for (int i = 0; i < 4; ++i) { const int k = i * 256 + lane * 4; const f32x4 w = *(const f32x4*)(p.norm1_w + k), s1 = *(const f32x4*)(sc + k), s0 = *(const f32x4*)(sh + k);
            *(us4*)(p.hbuf + (size_t)row * D + k) = pack4(v[i][0] * rstd * w[0] * (1.f + s1[0]) + s0[0], v[i][1] * rstd * w[1] * (1.f + s1[1]) + s0[1],
                                                          v[i][2] * rstd * w[2] * (1.f + s1[2]) + s0[2], v[i][3] * rstd * w[3] * (1.f + s1[3]) + s0[3]); }
    }
    const int gtid = blockIdx.x * NTHR + tid, gn = gridDim.x * NTHR;
    for (int i = gtid; i < NB * D * 32; i += gn) { const int ii = i & 3, j = (i >> 2) & 31, k4 = (i >> 7) & 255, b = i >> 15; const int k = k4 * 4 + ii;
        const float r = j < 4 ? p.rg_w[k * 4 + j] : (j < 20 ? p.re_w[k * 16 + (j - 4)] : 0.f);
        p.RP[i] = p.norm2_w[k] * (1.f + p.mod[(size_t)b * NMODC + 4 * D + k]) * r; }
    for (int wt = blockIdx.x * 4 + wid; wt < NB * 32; wt += gridDim.x * 4) { const int b = wt >> 5, j = wt & 31; float s = 0.f;
        if (j < 20) for (int k = lane; k < D; k += 64) { const float r = j < 4 ? p.rg_w[k * 4 + j] : p.re_w[k * 16 + (j - 4)]; s += p.mod[(size_t)b * NMODC + 3 * D + k] * r; }
        s = wave_sum(s);
        if (lane == 0) p.cb[wt] = j < 4 ? s + p.rg_b[j] : (j < 20 ? s + p.re_b[j - 4] : 0.f); }
}

constexpr int NT_INP = (T / 128) * 28 + (TC / 128) * 8;
DEV void inproj_tile(const Params& p, char* smem, int mt, int nt) {
    int tid = threadIdx.x; OPAQUE(tid);
    const int lane = tid & 63, wid = tid >> 6, wr = wid >> 1, wc = wid & 1, fr = lane & 15, quad = lane >> 4;
    const size_t row0 = (size_t)mt * 128;
    const bool is_ctx = mt >= T / 128;
    const bool actX = (nt < 12) || (nt >= 16 && nt < 24);
    f32x4 acc[4][4]; zero_acc(acc);
    LdPlain la(p.hbuf, row0, D), lw(p.w_in_t, (size_t)nt * 128, D);
    if (actX) gemm_tile(acc, la, lw, D / 64, smem); else gemm_tile(acc, lw, la, D / 64, smem);
    if (nt < 12) {
#pragma unroll
        for (int mi = 0; mi < 4; ++mi)
#pragma unroll
            for (int ni = 0; ni < 4; ++ni) { const size_t tok = row0 + wr * 64 + mi * 16 + quad * 4; const int c = nt * 128 + wc * 64 + ni * 16 + fr;
                *(us4*)(p.pT + (size_t)c * T + tok) = pack4(acc[mi][ni][0], acc[mi][ni][1], acc[mi][ni][2], acc[mi][ni][3]); }
    } else if (nt >= 16 && nt < 24) {
        const bool isk = nt < 20; const int h = (nt - 16) & 3;
        if (!is_ctx) {
            const int b = (int)(row0 / L), tl0 = (int)(row0 % L);
            if (isk) {
                if (wc == 0) {
#pragma unroll
                    for (int mi = 0; mi < 4; ++mi)
#pragma unroll
                        for (int r = 0; r < 4; ++r) { const int tl = tl0 + wr * 64 + mi * 16 + quad * 4 + r;
                            { const float* cs = p.rope + ((tl >> 6) * 16 + fr) * 2; const float a = acc[mi][0][r], bq = acc[mi][1][r]; acc[mi][0][r] = a * cs[0] - bq * cs[1]; acc[mi][1][r] = a * cs[1] + bq * cs[0]; }
                            { const float* cs = p.rope + ((tl & 63) * 16 + fr) * 2; const float a = acc[mi][2][r], bq = acc[mi][3][r]; acc[mi][2][r] = a * cs[0] - bq * cs[1]; acc[mi][3][r] = a * cs[1] + bq * cs[0]; } }
                }
                const float scl = 0.08838834764831845f;
#pragma unroll
                for (int mi = 0; mi < 4; ++mi)
#pragma unroll
                    for (int ni = 0; ni < 4; ++ni) { const int tl = tl0 + wr * 64 + mi * 16 + quad * 4, d = wc * 64 + ni * 16 + fr; const size_t bh = (size_t)b * NH + h;
                        const us4 o = pack4(acc[mi][ni][0] * scl, acc[mi][ni][1] * scl, acc[mi][ni][2] * scl, acc[mi][ni][3] * scl);
                        *(us4*)(p.kT + (bh * 128 + d) * L + tl) = o;
#pragma unroll
                        for (int r = 0; r < 4; ++r) p.kn[(bh * L + tl + r) * 128 + d] = o[r]; }
            } else {
#pragma unroll
                for (int mi = 0; mi < 4; ++mi)
#pragma unroll
                    for (int ni = 0; ni < 4; ++ni) { const int tl = tl0 + wr * 64 + mi * 16 + quad * 4, d = wc * 64 + ni * 16 + fr; const size_t bh = (size_t)b * NH + h;
                        *(us4*)(p.vT + (bh * 128 + d) * L + tl) = pack4(acc[mi][ni][0], acc[mi][ni][1], acc[mi][ni][2], acc[mi][ni][3]); }
            }
        } else {
            const size_t cr0 = row0 - T; const int b = (int)(cr0 / LC), tl0 = (int)(cr0 % LC); const float scl = isk ? 0.08838834764831845f : 1.f;
            bf16_t* dst = isk ? p.ckT : p.cvT;
#pragma unroll
            for (int mi = 0; mi < 4; ++mi)
#pragma unroll
                for (int ni = 0; ni < 4; ++ni) { const int tl = tl0 + wr * 64 + mi * 16 + quad * 4, d = wc * 64 + ni * 16 + fr; const size_t bh = (size_t)b * NH + h;
                    *(us4*)(dst + (bh * 128 + d) * LC + tl) = pack4(acc[mi][ni][0] * scl, acc[mi][ni][1] * scl, acc[mi][ni][2] * scl, acc[mi][ni][3] * scl); }
        }
    } else if (nt < 16) {
        const int h = nt - 12; const int b = (int)(row0 / L), tl0 = (int)(row0 % L);
        if (wr == 0) {
#pragma unroll
            for (int ni = 0; ni < 4; ++ni) { const int tl = tl0 + wc * 64 + ni * 16 + fr;
#pragma unroll
                for (int r = 0; r < 4; ++r) { const int j = quad * 4 + r;
                    { const float* cs = p.rope + ((tl >> 6) * 16 + j) * 2; const float a = acc[0][ni][r], bq = acc[1][ni][r]; acc[0][ni][r] = a * cs[0] - bq * cs[1]; acc[1][ni][r] = a * cs[1] + bq * cs[0]; }
                    { const float* cs = p.rope + ((tl & 63) * 16 + j) * 2; const float a = acc[2][ni][r], bq = acc[3][ni][r]; acc[2][ni][r] = a * cs[0] - bq * cs[1]; acc[3][ni][r] = a * cs[1] + bq * cs[0]; } } }
        }
#pragma unroll
        for (int mi = 0; mi < 4; ++mi)
#pragma unroll
            for (int ni = 0; ni < 4; ++ni) { const int tl = tl0 + wc * 64 + ni * 16 + fr, d = wr * 64 + mi * 16 + quad * 4; const size_t bh = (size_t)b * NH + h;
                *(us4*)(p.qn + (bh * L + tl) * 128 + d) = pack4(acc[mi][ni][0], acc[mi][ni][1], acc[mi][ni][2], acc[mi][ni][3]); }
    } else {
#pragma unroll
        for (int mi = 0; mi < 4; ++mi)
#pragma unroll
            for (int ni = 0; ni < 4; ++ni) { const size_t tok = row0 + wc * 64 + ni * 16 + fr; const int d = (nt - 24) * 128 + wr * 64 + mi * 16 + quad * 4;
                *(us4*)(p.gbuf + tok * 512 + d) = pack4(acc[mi][ni][0], acc[mi][ni][1], acc[mi][ni][2], acc[mi][ni][3]); }
    }
}
DEV void ph_inproj(const Params& p, char* smem) {
    for (int task = blockIdx.x; task < NT_INP; task += gridDim.x) {
        if (task < (T / 128) * 28) inproj_tile(p, smem, task / 28, task % 28);
        else { const int t = task - (T / 128) * 28; inproj_tile(p, smem, T / 128 + t / 8, 16 + t % 8); }
    }
}

constexpr int NU = L / 64, UPW = NU / 4;
DEV bf16x8 conv_afrag(const bf16_t* taps, int m0) { bf16x8 a;
#pragma unroll
    for (int e = 0; e < 8; ++e) a[e] = (short)taps[m0 + e];
    return a; }
DEV void conv3_w(const Params& p, int ch, float& w0, float& w1, float& w2, float& bs) { w0 = p.hy_conv_w[ch]; w1 = p.hy_conv_w[1536 + ch]; w2 = p.hy_conv_w[3072 + ch]; bs = p.hy_conv_b[ch]; }

DEV void conv_task(const Params& p, char* smem, int c) {
    bf16_t* taps = (bf16_t*)smem;
    bf16_t* U = taps + 2 * L + 8;
    const int tid = threadIdx.x, lane = tid & 63, w = tid >> 6, fr = lane & 15, quad = lane >> 4;
    for (int i = tid; i < 2 * L / 8; i += NTHR) *(bf16x8*)(taps + i * 8) = *(const bf16x8*)(p.gtap + (size_t)c * 2 * L + i * 8);
    for (int i = tid; i < 8 * UP / 8; i += NTHR) *(bf16x8*)(U + i * 8) = (bf16x8){0, 0, 0, 0, 0, 0, 0, 0};
    __syncthreads();
    { float a0, a1, a2, ab, v0, v1, v2, vb; conv3_w(p, 512 + c, a0, a1, a2, ab); conv3_w(p, 1024 + c, v0, v1, v2, vb);
      for (int g = tid; g < NB * (L / 8); g += NTHR) { const int b = g / (L / 8), t8 = (g % (L / 8)) * 8;
          const bf16_t* r1 = p.pT + (size_t)(512 + c) * T + (size_t)b * L + t8; const bf16_t* rv = p.pT + (size_t)(1024 + c) * T + (size_t)b * L + t8;
          const bf16x8 x1v = *(const bf16x8*)r1, vv = *(const bf16x8*)rv;
          float px[10], pv[10];
          px[0] = t8 > 0 ? bf2f(r1[-1]) : 0.f; pv[0] = t8 > 0 ? bf2f(rv[-1]) : 0.f;
          px[9] = t8 + 8 < L ? bf2f(r1[8]) : 0.f; pv[9] = t8 + 8 < L ? bf2f(rv[8]) : 0.f;
#pragma unroll
          for (int e = 0; e < 8; ++e) { px[e + 1] = bf2f((bf16_t)x1v[e]); pv[e + 1] = bf2f((bf16_t)vv[e]); }
          bf16x8 o;
#pragma unroll
          for (int e = 0; e < 8; ++e) { const float x1 = a0 * px[e] + a1 * px[e + 1] + a2 * px[e + 2] + ab; const float vq = v0 * pv[e] + v1 * pv[e + 1] + v2 * pv[e + 2] + vb; o[e] = (short)f2bf(x1 * vq); }
          *(bf16x8*)(U + b * UP + 32 + t8) = o; } }
    __syncthreads();
    f32x4 acc[2][UPW];
#pragma unroll
    for (int tp = 0; tp < 2; ++tp)
#pragma unroll
        for (int ui = 0; ui < UPW; ++ui) acc[tp][ui] = (f32x4){0.f, 0.f, 0.f, 0.f};
    const int bcol = fr & 7, i2 = fr >> 3;
    const bf16_t* Ub = U + bcol * UP + 32 + 32 * i2 + 8 * quad;
    const int mbase = L - fr + 8 * quad - 64 * (UPW * w);
#pragma unroll 1
    for (int jp = 1; jp >= 0; --jp) {
        bf16x8 af[2][UPW];
        int J0 = jp ? -1 : 0;
        if (jp) {
            const bf16x8 bfr = *(const bf16x8*)(Ub + 32 * J0);
#pragma unroll
            for (int tp = 0; tp < 2; ++tp)
#pragma unroll
                for (int ui = 0; ui < UPW; ++ui) { const bf16x8 a = conv_afrag(taps, mbase - 64 * ui - 16 * tp + 32 * J0); acc[tp][ui] = __builtin_amdgcn_mfma_f32_16x16x32_bf16(a, bfr, acc[tp][ui], 0, 0, 0); }
            J0 = 1;
        }
#pragma unroll
        for (int tp = 0; tp < 2; ++tp)
#pragma unroll
            for (int ui = 0; ui < UPW; ++ui) af[tp][ui] = conv_afrag(taps, mbase - 64 * ui - 16 * tp + 32 * J0);
#pragma unroll 1
        for (int grp = 0; grp < 4; ++grp) {
#pragma unroll
            for (int s = 0; s < UPW; ++s) {
                const bf16x8 bfr = *(const bf16x8*)(Ub + 32 * J0);
#pragma unroll
                for (int tp = 0; tp < 2; ++tp)
#pragma unroll
                    for (int ui = 0; ui < UPW; ++ui) acc[tp][ui] = __builtin_amdgcn_mfma_f32_16x16x32_bf16(af[tp][(ui - s + UPW) % UPW], bfr, acc[tp][ui], 0, 0, 0);
                J0 += 2;
                if (grp < 3 || s < UPW - 1) {
#pragma unroll
                    for (int tp = 0; tp < 2; ++tp) af[tp][(UPW - 1 - s) % UPW] = conv_afrag(taps, mbase - 16 * tp + 32 * J0);
                }
            }
        }
    }
    float w0, w1, w2, wb; conv3_w(p, c, w0, w1, w2, wb);
    if (bcol < NB) {
#pragma unroll
        for (int tp = 0; tp < 2; ++tp)
#pragma unroll
            for (int ui = 0; ui < UPW; ++ui) { const int I0 = 4 * (UPW * w + ui) + tp; const int t = 16 * (I0 + 2 * i2) + 4 * quad;
                const bf16_t* r0 = p.pT + (size_t)c * T + (size_t)bcol * L + t; const us4 cv = *(const us4*)r0;
                float pq[6]; pq[0] = t > 0 ? bf2f(r0[-1]) : 0.f; pq[5] = t + 4 < L ? bf2f(r0[4]) : 0.f;
#pragma unroll
                for (int e = 0; e < 4; ++e) pq[e + 1] = bf2f(cv[e]);
                float y[4];
#pragma unroll
                for (int e = 0; e < 4; ++e) y[e] = (w0 * pq[e] + w1 * pq[e + 1] + w2 * pq[e + 2] + wb) * acc[tp][ui][e];
                *(us4*)(p.yhyT + (size_t)c * T + (size_t)bcol * L + t) = pack4(y[0], y[1], y[2], y[3]); }
    }
    __syncthreads();
}

DEV void rstate_task(const Params& p, char* smem, int task) {
    const int bh = task / NCT, J = task % NCT, h = bh % NH;
    const int lane = threadIdx.x & 63, wid = threadIdx.x >> 6, wr = wid >> 1, wc = wid & 1, fr = lane & 15, quad = lane >> 4;
    const bf16_t *kb, *vb; size_t ld; int col0;
    if (J < NCC) { kb = p.ckT + (size_t)bh * 128 * LC; vb = p.cvT + (size_t)bh * 128 * LC; ld = LC; col0 = J * 128; }
    else { kb = p.kT + (size_t)bh * 128 * L; vb = p.vT + (size_t)bh * 128 * L; ld = L; col0 = (J - NCC) * 128; }
#pragma unroll 1
    for (int dir = 0; dir < 2; ++dir) {
        const float lg = lg2_gamma(h, dir == 1);
        f32x4 acc[4][4]; zero_acc(acc);
        LdKScale lk(kb + col0, 0, ld, dir == 0 ? 127.f * lg : 0.f, dir == 0 ? -lg : lg);
        LdPlain lv(vb + col0, 0, ld);
        gemm_tile(acc, lk, lv, 2, smem);
        float* dst = p.Kst + (((size_t)dir * NB * NH + bh) * NCT + J) * 16384;
#pragma unroll
        for (int mi = 0; mi < 4; ++mi)
#pragma unroll
            for (int ni = 0; ni < 4; ++ni) { const int d = wr * 64 + mi * 16 + quad * 4, e = wc * 64 + ni * 16 + fr; *(f32x4*)(dst + e * 128 + d) = acc[mi][ni]; }
    }
}
constexpr int NT_RST = NB * NH * NCT;
DEV void ph_conv_rstate(const Params& p, char* smem) {
    for (int task = blockIdx.x; task < HW + NT_RST; task += gridDim.x) {
        if (task < HW) conv_task(p, smem, task); else rstate_task(p, smem, task - HW);
    }
}

DEV void hynorm_task(const Params& p, char* smem, int task) {
    bf16_t* tl = (bf16_t*)smem;
    const int tid = threadIdx.x; const size_t pos0 = (size_t)task * 64;
    for (int half = 0; half < 2; ++half) { const int c = tid + 256 * half; const bf16_t* src = p.yhyT + (size_t)c * T + pos0;
#pragma unroll
        for (int q = 0; q < 8; ++q) { const bf16x8 v = *(const bf16x8*)(src + q * 8);
#pragma unroll
            for (int e = 0; e < 8; ++e) tl[(q * 8 + e) * 520 + c] = (bf16_t)v[e]; } }
    __syncthreads();
    const int pos = tid >> 2, part = tid & 3;
    float ss = 0.f;
    for (int q = 0; q < 16; ++q) { const bf16x8 v = *(const bf16x8*)(tl + pos * 520 + part * 128 + q * 8);
#pragma unroll
        for (int e = 0; e < 8; ++e) { const float f = bf2f((bf16_t)v[e]); ss += f * f; } }
    ss += __shfl_xor(ss, 1); ss += __shfl_xor(ss, 2);
    const float rstd = rsqrtf(ss * (1.f / 512.f) + 1e-6f);
    for (int q = 0; q < 16; ++q) { const bf16x8 v = *(const bf16x8*)(tl + pos * 520 + part * 128 + q * 8); bf16x8 o;
#pragma unroll
        for (int e = 0; e < 8; ++e) o[e] = (short)f2bf(bf2f((bf16_t)v[e]) * rstd);
        *(bf16x8*)(p.ycat + (pos0 + pos) * 1024 + part * 128 + q * 8) = o; }
    __syncthreads();
}
DEV void ph_scan_hynorm(const Params& p, char* smem) {
    const size_t gtid = (size_t)blockIdx.x * NTHR + threadIdx.x, gn = (size_t)gridDim.x * NTHR;
    for (size_t i = gtid; i < (size_t)2 * NB * NH * 16384; i += gn) {
        const int ed = (int)(i & 16383); const int bh = (int)((i >> 14) % (NB * NH)); const int dir = (int)(i / ((size_t)NB * NH * 16384));
        const float gch = exp2f(128.f * lg2_gamma(bh % NH, dir == 1));
        const float* ks = p.Kst + (((size_t)dir * NB * NH + bh) * NCT) * 16384 + ed;
        bf16_t* so = p.Sst + (((size_t)dir * NB * NH + bh) * NCH) * 16384 + ed;
        float s = 0.f;
        if (dir == 0) { for (int J = 0; J < NCC; ++J) s = s * gch + ks[(size_t)J * 16384];
            for (int I = 0; I < NCH; ++I) { so[(size_t)I * 16384] = f2bf(s); s = s * gch + ks[(size_t)(NCC + I) * 16384]; } }
        else { for (int J = NCC - 1; J >= 0; --J) s = s * gch + ks[(size_t)J * 16384];
            for (int I = NCH - 1; I >= 0; --I) { so[(size_t)I * 16384] = f2bf(s); s = s * gch + ks[(size_t)(NCC + I) * 16384]; } }
    }
    for (int task = blockIdx.x; task < T / 64; task += gridDim.x) hynorm_task(p, smem, task);
}

DEV void rout_task(const Params& p, char* smem, int task) {
    const int bh = task / NCH, I = task % NCH, h = bh % NH, b = bh / NH;
    int tid = threadIdx.x; OPAQUE(tid);
    const int lane = tid & 63, wid = tid >> 6, wr = wid >> 1, wc = wid & 1, fr = lane & 15, quad = lane >> 4;
    const float lgf = lg2_gamma(h, false), lgb = lg2_gamma(h, true);
    bf16_t* P = p.Pscr + (size_t)blockIdx.x * 16384;
    const bf16_t* qb = p.qn + ((size_t)bh * L + I * 128) * 128; const bf16_t* kb = p.kn + ((size_t)bh * L + I * 128) * 128;
    {
        f32x4 acc[4][4]; zero_acc(acc);
        LdPlain lk(kb, 0, 128), lq(qb, 0, 128);
        gemm_tile(acc, lk, lq, 2, smem);
#pragma unroll
        for (int mi = 0; mi < 4; ++mi)
#pragma unroll
            for (int ni = 0; ni < 4; ++ni) { const int i = wc * 64 + ni * 16 + fr, j0 = wr * 64 + mi * 16 + quad * 4; float v[4];
#pragma unroll
                for (int r = 0; r < 4; ++r) { const int j = j0 + r; const float dcy = i > j ? exp2f(lgf * (float)(i - j)) : (i == j ? 2.f : exp2f(lgb * (float)(j - i))); v[r] = acc[mi][ni][r] * dcy; }
                *(us4*)(P + i * 128 + j0) = pack4(v[0], v[1], v[2], v[3]); }
    }
    __syncthreads();
    f32x4 acc[4][4]; zero_acc(acc);
    {
        LdPlain lv(p.vT + (size_t)bh * 128 * L + I * 128, 0, L), lp(P, 0, 128);
        gemm_tile(acc, lv, lp, 2, smem);
    }
    {
        LdPlain ls(p.Sst + (((size_t)0 * NB * NH + bh) * NCH + I) * 16384, 0, 128); LdRowScale lq(qb, 0, 128, lgf, lgf);
        gemm_tile(acc, ls, lq, 2, smem);
    }
    {
        LdPlain ls(p.Sst + (((size_t)1 * NB * NH + bh) * NCH + I) * 16384, 0, 128); LdRowScale lq(qb, 0, 128, 128.f * lgb, -lgb);
        gemm_tile(acc, ls, lq, 2, smem);
    }
    float* red = (float*)smem;
    float mean[4], rstd[4];
#pragma unroll
    for (int ni = 0; ni < 4; ++ni) { float s = 0.f, ss = 0.f;
#pragma unroll
        for (int mi = 0; mi < 4; ++mi)
#pragma unroll
            for (int r = 0; r < 4; ++r) { const float v = acc[mi][ni][r]; s += v; ss += v * v; }
        s += __shfl_xor(s, 16); s += __shfl_xor(s, 32); ss += __shfl_xor(ss, 16); ss += __shfl_xor(ss, 32);
        if (quad == 0) { const int i = wc * 64 + ni * 16 + fr; red[(wr * 128 + i) * 2] = s; red[(wr * 128 + i) * 2 + 1] = ss; } }
    __syncthreads();
#pragma unroll
    for (int ni = 0; ni < 4; ++ni) { const int i = wc * 64 + ni * 16 + fr; const float s = red[i * 2] + red[(128 + i) * 2], ss = red[i * 2 + 1] + red[(128 + i) * 2 + 1];
        mean[ni] = s * (1.f / 128.f); const float var = ss * (1.f / 128.f) - mean[ni] * mean[ni]; rstd[ni] = rsqrtf(fmaxf(var, 0.f) + 1e-6f); }
#pragma unroll
    for (int mi = 0; mi < 4; ++mi)
#pragma unroll
        for (int ni = 0; ni < 4; ++ni) { const int i = wc * 64 + ni * 16 + fr, e = wr * 64 + mi * 16 + quad * 4; const size_t tok = (size_t)b * L + I * 128 + i;
            const us4 gv = *(const us4*)(p.gbuf + tok * 512 + h * 128 + e); float y[4];
#pragma unroll
            for (int r = 0; r < 4; ++r) y[r] = (acc[mi][ni][r] - mean[ni]) * rstd[ni] * silu_f(bf2f(gv[r]));
            *(us4*)(p.ycat + tok * 1024 + 512 + h * 128 + e) = pack4(y[0], y[1], y[2], y[3]); }
    __syncthreads();
}
DEV void ph_rout(const Params& p, char* smem) {
#pragma unroll 1
    for (int task = blockIdx.x; task < NB * NH * NCH; task += gridDim.x) rout_task(p, smem, task); }

DEV void ph_outproj(const Params& p, char* smem) {
    const int lane = threadIdx.x & 63, wid = threadIdx.x >> 6, wr = wid >> 1, wc = wid & 1, fr = lane & 15, quad = lane >> 4;
    for (int task = blockIdx.x; task < (T / 128) * 8 + NT_W13 + NT_W2; task += gridDim.x) {
        if (task >= (T / 128) * 8) { expert_conv_task(p, smem, task - (T / 128) * 8); continue; }
        const int mt = task / 8, nt = task % 8;
        f32x4 acc[4][4]; zero_acc(acc);
        LdPlain lw(p.w_out_t, (size_t)nt * 128, D), la(p.ycat, (size_t)mt * 128, D);
        gemm_tile(acc, lw, la, D / 64, smem);
        const int b = (mt * 128) / L; const float* g1 = p.mod + (size_t)b * NMODC + 2 * D;
#pragma unroll
        for (int mi = 0; mi < 4; ++mi)
#pragma unroll
            for (int ni = 0; ni < 4; ++ni) { const size_t tok = (size_t)mt * 128 + wc * 64 + ni * 16 + fr; const int col = nt * 128 + wr * 64 + mi * 16 + quad * 4;
                const f32x4 xv = *(const f32x4*)(p.x + tok * D + col), gv = *(const f32x4*)(g1 + col);
                *(f32x4*)(p.x1 + tok * D + col) = xv + gv * acc[mi][ni]; }
    }
}

DEV void ph_norm2_router(const Params& p, char* smem) {
    const int tid = threadIdx.x, lane = tid & 63, wid = tid >> 6, fr = lane & 15, quad = lane >> 4;
    float* lgs = (float*)smem + wid * (16 * 33);
    float* rs = (float*)smem + 4 * 16 * 33 + wid * 16;
    for (int wt = blockIdx.x * 4 + wid; wt < T / 16; wt += gridDim.x * 4) {
        const size_t row0 = (size_t)wt * 16; const int b = (int)(row0 / L);
        const float* xr = p.x1 + (row0 + fr) * D + quad * 4;
        const float* rp = p.RP + (size_t)b * D * 32;
        f32x4 a0 = {0.f, 0.f, 0.f, 0.f}, a1 = a0; float ss = 0.f;
        for (int k0 = 0; k0 < D; k0 += 16) {
            const f32x4 xv = *(const f32x4*)(xr + k0);
            const f32x4 b0 = *(const f32x4*)(rp + ((size_t)(k0 / 4 + quad) * 32 + fr) * 4), b1 = *(const f32x4*)(rp + ((size_t)(k0 / 4 + quad) * 32 + 16 + fr) * 4);
            ss += xv[0] * xv[0] + xv[1] * xv[1] + xv[2] * xv[2] + xv[3] * xv[3];
#pragma unroll
            for (int i = 0; i < 4; ++i) { a0 = __builtin_amdgcn_mfma_f32_16x16x4f32(xv[i], b0[i], a0, 0, 0, 0); a1 = __builtin_amdgcn_mfma_f32_16x16x4f32(xv[i], b1[i], a1, 0, 0, 0); }
        }
        ss += __shfl_xor(ss, 16); ss += __shfl_xor(ss, 32);
        const float rstd = rsqrtf(ss * (1.f / D) + 1e-6f);
        if (quad == 0) rs[fr] = rstd;
#pragma unroll
        for (int r = 0; r < 4; ++r) { lgs[(quad * 4 + r) * 33 + fr] = a0[r]; lgs[(quad * 4 + r) * 33 + 16 + fr] = a1[r]; }
        __syncthreads();
        if (lane < 16) {
            const size_t tok = row0 + lane; const float rsd = rs[lane]; float lg[20];
#pragma unroll
            for (int j = 0; j < 20; ++j) lg[j] = lgs[lane * 33 + j] * rsd + p.cb[b * 32 + j];
            int g = 0; float gm = lg[0];
#pragma unroll
            for (int j = 1; j < 4; ++j) if (lg[j] > gm) { gm = lg[j]; g = j; }
            float den = 0.f;
#pragma unroll
            for (int j = 0; j < 4; ++j) den += expf(lg[j] - gm);
            const float psel = 1.f / den;
            float le[4];
#pragma unroll
            for (int j = 0; j < 4; ++j) le[j] = g == 0 ? lg[4 + j] : (g == 1 ? lg[8 + j] : (g == 2 ? lg[12 + j] : lg[16 + j]));
            int i0 = 0; float m0 = le[0];
#pragma unroll
            for (int j = 1; j < 4; ++j) if (le[j] > m0) { m0 = le[j]; i0 = j; }
            int i1 = -1; float m1 = -3.0e38f;
#pragma unroll
            for (int j = 0; j < 4; ++j) if (j != i0 && le[j] > m1) { m1 = le[j]; i1 = j; }
            const float ex = expf(m1 - m0); const float w0 = psel / (1.f + ex), w1 = psel * ex / (1.f + ex);
            const int e0 = g * 4 + i0, e1 = g * 4 + i1;
            const int p0 = atomicAdd(p.cnt + e0, 1), p1 = atomicAdd(p.cnt + e1, 1);
            p.elist[(size_t)e0 * T + p0] = (int)tok * 2; p.ewt[(size_t)e0 * T + p0] = w0;
            p.elist[(size_t)e1 * T + p1] = (int)tok * 2 + 1; p.ewt[(size_t)e1 * T + p1] = w1;
            p.tok_e[tok * 2] = e0; p.tok_e[tok * 2 + 1] = e1; p.tok_pos[tok * 2] = p0; p.tok_pos[tok * 2 + 1] = p1;
        }
        const float* sh = p.mod + (size_t)b * NMODC + 3 * D; const float* sc = sh + D;
        for (int r = 0; r < 16; ++r) { const float rsd = rs[r]; const float* src = p.x1 + (row0 + r) * D;
#pragma unroll
            for (int i = 0; i < 4; ++i) { const int k = i * 256 + lane * 4; const f32x4 v = *(const f32x4*)(src + k), w = *(const f32x4*)(p.norm2_w + k), s1 = *(const f32x4*)(sc + k), s0 = *(const f32x4*)(sh + k);
                *(us4*)(p.h2 + (row0 + r) * D + k) = pack4(v[0] * rsd * w[0] * (1.f + s1[0]) + s0[0], v[1] * rsd * w[1] * (1.f + s1[1]) + s0[1],
                                                           v[2] * rsd * w[2] * (1.f + s1[2]) + s0[2], v[3] * rsd * w[3] * (1.f + s1[3]) + s0[3]); } }
        __syncthreads();
    }
}

DEV bool moe_find_tile(const Params& p, int mtile, int& e, int& lt, int& rowoff, int& cnt) {
    int acc = 0;
    for (int q = 0; q < NEXP; ++q) { const int c = p.cnt[q]; const int nt = (c + 127) >> 7; if (mtile < acc + nt) { e = q; lt = mtile - acc; rowoff = acc * 128; cnt = c; return true; } acc += nt; }
    return false;
}
DEV void ph_moe_up(const Params& p, char* smem) {
    const int tid = threadIdx.x, lane = tid & 63, wid = tid >> 6, wr = wid >> 1, wc = wid & 1, fr = lane & 15, quad = lane >> 4;
    for (int task = blockIdx.x; task < MAXTILES * 8; task += gridDim.x) { const int mtile = task >> 3, nt = task & 7;
        int e, lt, rowoff, cnt; if (!moe_find_tile(p, mtile, e, lt, rowoff, cnt)) break;
        LdGather la; const int lrow = tid >> 3, lc = tid & 7;
#pragma unroll
        for (int i = 0; i < 4; ++i) { int li = lt * 128 + lrow + 32 * i; if (li >= cnt) li = cnt - 1; const int tok = p.elist[(size_t)e * T + li] >> 1; la.rp[i] = p.h2 + (size_t)tok * D + lc * 8; }
        LdPlain lw(p.w13_t + (size_t)e * 1024 * 1024, (size_t)nt * 128, D);
        f32x4 acc[4][4]; zero_acc(acc);
        gemm_tile(acc, lw, la, D / 64, smem);
#pragma unroll
        for (int ni = 0; ni < 4; ++ni) { int li = lt * 128 + wc * 64 + ni * 16 + fr; const bool valid = li < cnt; if (!valid) li = cnt - 1; const float cw = p.ewt[(size_t)e * T + li];
#pragma unroll
            for (int mi = 0; mi < 2; ++mi) { float hv[4];
#pragma unroll
                for (int r = 0; r < 4; ++r) hv[r] = silu_f(acc[mi][ni][r]) * acc[mi + 2][ni][r] * cw;
                const int hidx = nt * 64 + wr * 32 + mi * 16 + quad * 4;
                if (valid) *(us4*)(p.hid + (size_t)(rowoff + lt * 128 + wc * 64 + ni * 16 + fr) * EH + hidx) = pack4(hv[0], hv[1], hv[2], hv[3]); } }
    }
}
DEV void ph_moe_down(const Params& p, char* smem) {
    const int tid = threadIdx.x, lane = tid & 63, wid = tid >> 6, wr = wid >> 1, wc = wid & 1, fr = lane & 15, quad = lane >> 4;
    for (int task = blockIdx.x; task < MAXTILES * 8; task += gridDim.x) { const int mtile = task >> 3, nt = task & 7;
        int e, lt, rowoff, cnt; if (!moe_find_tile(p, mtile, e, lt, rowoff, cnt)) break;
        LdGather la; const int lrow = tid >> 3, lc = tid & 7;
#pragma unroll
        for (int i = 0; i < 4; ++i) { int li = lt * 128 + lrow + 32 * i; if (li >= cnt) li = cnt - 1; la.rp[i] = p.hid + (size_t)(rowoff + li) * EH + lc * 8; }
        LdPlain lw(p.w2_t + (size_t)e * 1024 * EH, (size_t)nt * 128, EH);
        f32x4 acc[4][4]; zero_acc(acc);
        gemm_tile(acc, lw, la, EH / 64, smem);
#pragma unroll
        for (int ni = 0; ni < 4; ++ni) { const int li = lt * 128 + wc * 64 + ni * 16 + fr; if (li < cnt) { const int ts = p.elist[(size_t)e * T + li];
#pragma unroll
            for (int mi = 0; mi < 4; ++mi) *(us4*)(p.ymoe + (size_t)ts * D + nt * 128 + wr * 64 + mi * 16 + quad * 4) = pack4(acc[mi][ni][0], acc[mi][ni][1], acc[mi][ni][2], acc[mi][ni][3]); } }
    }
}
DEV void ph_final(const Params& p, char* smem) {
    const int lane = threadIdx.x & 63, wid = threadIdx.x >> 6;
    for (int row = blockIdx.x * 4 + wid; row < T; row += gridDim.x * 4) { const int b = row / L; const float* g2 = p.mod + (size_t)b * NMODC + 5 * D;
        f32x4 v[4]; float ss = 0.f;
#pragma unroll
        for (int i = 0; i < 4; ++i) { const int k = i * 256 + lane * 4; const f32x4 xv = *(const f32x4*)(p.x1 + (size_t)row * D + k), gv = *(const f32x4*)(g2 + k);
            const us4 y0 = *(const us4*)(p.ymoe + ((size_t)row * 2) * D + k), y1 = *(const us4*)(p.ymoe + ((size_t)row * 2 + 1) * D + k);
#pragma unroll
            for (int e = 0; e < 4; ++e) { v[i][e] = xv[e] + gv[e] * (bf2f(y0[e]) + bf2f(y1[e])); ss += v[i][e] * v[i][e]; } }
        ss = wave_sum(ss); const float rstd = rsqrtf(ss * (1.f / D) + 1e-6f);
#pragma unroll
        for (int i = 0; i < 4; ++i) { const int k = i * 256 + lane * 4; const f32x4 w = *(const f32x4*)(p.final_w + k); *(f32x4*)(p.out + (size_t)row * D + k) = v[i] * rstd * w; }
    }
}


#define XB_TMO      128
#define XB_XCNT(j)  (256  + 64 * (j))
#define XB_XSUB(j)  (1280 + 64 * (j))
#define XB_XGEN(j)  (2304 + 64 * (j))
#define XB_TOP      3328
#define XB_TOPGEN   3392
#define XCD_BAR_WORDS 3456
#ifndef CPU_EMU
#define XB_SPIN_CAP (1u << 22)
#define LAS __attribute__((address_space(3)))
__device__ __forceinline__ unsigned xb_ld(unsigned* p)              { return __hip_atomic_load(p, __ATOMIC_RELAXED, __HIP_MEMORY_SCOPE_AGENT); }
__device__ __forceinline__ unsigned xb_add(unsigned* p, unsigned v) { return __hip_atomic_fetch_add(p, v, __ATOMIC_RELAXED, __HIP_MEMORY_SCOPE_AGENT); }
__device__ __forceinline__ unsigned xb_xcc_id() { return (unsigned)__builtin_amdgcn_s_getreg((3 << 11) | 20) & 0xFu; }
#define XB_SPIN(cond, bar) do { unsigned _sp = 0; while (cond) { __builtin_amdgcn_s_sleep(1); \
    if ((++_sp & 255u) == 0u) { if (xb_ld(&(bar)[XB_TMO])) break; if (_sp > XB_SPIN_CAP) { atomicAdd(&(bar)[XB_TMO], 1u); break; } } } } while (0)
struct XcdBarrier { unsigned* bar; unsigned x; volatile LAS unsigned* st; };
__device__ __forceinline__ XcdBarrier xcd_barrier_post(unsigned* bar, volatile LAS unsigned* st) {
    XcdBarrier b; b.bar = bar; b.x = xb_xcc_id(); b.st = st;
    if (threadIdx.x == 0) (void)xb_add(&bar[XB_XCNT(b.x)], 1u);
    return b;
}
__device__ __forceinline__ void xcd_barrier_complete(unsigned* bar, unsigned x, unsigned& nloc, unsigned& nx) {
    const unsigned G = gridDim.x * gridDim.y * gridDim.z;
    unsigned sum, cnt, mine, sp = 0u;
    for (;;) {
        sum = 0u; cnt = 0u; mine = 0u;
#pragma unroll
        for (unsigned j = 0; j < 16; ++j) { const unsigned c = xb_ld(&bar[XB_XCNT(j)]); sum += c; cnt += (c > 0u) ? 1u : 0u; mine = (j == x) ? c : mine; }
        if (sum == G) break;
        __builtin_amdgcn_s_sleep(1);
        if ((++sp & 255u) == 0u) { if (xb_ld(&bar[XB_TMO])) break; if (sp > XB_SPIN_CAP) { atomicAdd(&bar[XB_TMO], 1u); break; } }
    }
    nloc = mine > 0u ? mine : 1u; nx = cnt > 0u ? cnt : 1u;
}
__device__ __forceinline__ void xcd_barrier(const XcdBarrier& b) {
    asm volatile("s_waitcnt vmcnt(0)" ::: "memory");
    __syncthreads();
    if (threadIdx.x == 0) {
        unsigned* bar = b.bar;
        __builtin_amdgcn_s_waitcnt(0);
        unsigned nloc = b.st[0], nx = b.st[1];
        if (nloc == 0u) { xcd_barrier_complete(bar, b.x, nloc, nx); b.st[0] = nloc; b.st[1] = nx; }
        const unsigned old = xb_add(&bar[XB_XSUB(b.x)], 1u);
        const unsigned gen = old / nloc;
        if (old + 1u == (gen + 1u) * nloc) {
            __builtin_amdgcn_fence(__ATOMIC_RELEASE, "agent");
            asm volatile("s_waitcnt vmcnt(0)" ::: "memory");
            const unsigned og = xb_add(&bar[XB_TOP], 1u);
            const unsigned tg = og / nx;
            if (og + 1u == (tg + 1u) * nx) xb_add(&bar[XB_TOPGEN], 1u);
            else XB_SPIN(xb_ld(&bar[XB_TOPGEN]) == tg, bar);
            __builtin_amdgcn_fence(__ATOMIC_ACQUIRE, "agent");
            xb_add(&bar[XB_XGEN(b.x)], 1u);
            asm volatile("s_waitcnt vmcnt(0)" ::: "memory");
        } else {
            XB_SPIN(xb_ld(&bar[XB_XGEN(b.x)]) == gen, bar);
            __builtin_amdgcn_fence(__ATOMIC_ACQUIRE, "agent");
            asm volatile("s_waitcnt vmcnt(0)" ::: "memory");
        }
    }
    __syncthreads();
}
#endif

#define PHASE_LIST(X) X(ph_prep) X(ph_norm1) X(ph_inproj) X(ph_conv_rstate) X(ph_scan_hynorm) X(ph_rout) X(ph_outproj) X(ph_norm2_router) X(ph_moe_up) X(ph_moe_down)

struct WsBuf { size_t size, off; int p0, p1; };
static size_t fill_params(Params& p, void* const* d_in, void* d_out, void* d_ws, int grid) {
    const float** in = (const float**)d_in;
    p.x = in[0]; p.c = in[1]; p.ctx = in[2]; p.c_ctx = in[3]; p.ada_w = in[4]; p.ada_b = in[5]; p.norm1_w = in[6]; p.w_in = in[7]; p.hy_conv_w = in[8]; p.hy_conv_b = in[9];
    p.f_w1 = in[10]; p.f_b1 = in[11]; p.f_w2 = in[12]; p.f_b2 = in[13]; p.f_w3 = in[14]; p.f_b3 = in[15]; p.f_wout = in[16]; p.f_freq = in[17]; p.hy_skip = in[18]; p.hy_out_norm = in[19];
    p.ret_gn_w = in[20]; p.w_out = in[21]; p.norm2_w = in[22]; p.rg_w = in[23]; p.rg_b = in[24]; p.re_w = in[25]; p.re_b = in[26]; p.exp_w1 = in[27]; p.exp_w3 = in[28]; p.exp_w2 = in[29]; p.final_w = in[30];
    p.out = (float*)d_out;
    char* ws = (char*)d_ws; WsBuf bufs[48]; void** slots[48]; int nb = 0; size_t total = 0;
#define WS(field, type, count, p0, p1) { slots[nb] = (void**)&p.field; bufs[nb] = WsBuf{((sizeof(type) * (size_t)(count)) + 255) & ~(size_t)255, 0, p0, p1}; ++nb; }
    WS(mod, float, (NB + 1) * NMODC, 0, 10); WS(cnt, int, 64, 0, 10); WS(bar, unsigned, XCD_BAR_WORDS, 0, 10); WS(rope, float, 64 * 16 * 2, 0, 2); WS(w_in_t, bf16_t, PC * D, 0, 2); WS(w_out_t, bf16_t, D * D, 0, 6);
    WS(gtap, bf16_t, (size_t)HW * 2 * L, 0, 3);
    WS(hbuf, bf16_t, (size_t)TA * D, 1, 2); WS(RP, float, (size_t)NB * D * 32, 1, 7); WS(cb, float, NB * 32, 1, 7);
    WS(pT, bf16_t, (size_t)1536 * T, 2, 3); WS(qn, bf16_t, (size_t)T * 512, 2, 5); WS(kn, bf16_t, (size_t)T * 512, 2, 5); WS(kT, bf16_t, (size_t)T * 512, 2, 3); WS(vT, bf16_t, (size_t)T * 512, 2, 5);
    WS(ckT, bf16_t, (size_t)TC * 512, 2, 3); WS(cvT, bf16_t, (size_t)TC * 512, 2, 3); WS(gbuf, bf16_t, (size_t)T * 512, 2, 5);
    WS(Kst, float, (size_t)2 * NB * NH * NCT * 16384, 3, 4); WS(yhyT, bf16_t, (size_t)HW * T, 3, 4);
    WS(Sst, bf16_t, (size_t)2 * NB * NH * NCH * 16384, 4, 5); WS(ycat, bf16_t, (size_t)T * D, 4, 6);
    WS(Pscr, bf16_t, (size_t)grid * 16384, 5, 5);
    WS(x1, float, (size_t)T * D, 6, 10); WS(w13_t, bf16_t, (size_t)NEXP * 1024 * 1024, 6, 8); WS(w2_t, bf16_t, (size_t)NEXP * 1024 * EH, 6, 9);
    WS(h2, bf16_t, (size_t)T * D, 7, 8); WS(elist, int, (size_t)NEXP * T, 7, 10); WS(ewt, float, (size_t)NEXP * T, 7, 10); WS(tok_e, int, (size_t)T * 2, 7, 10); WS(tok_pos, int, (size_t)T * 2, 7, 10);
    WS(hid, bf16_t, (size_t)(2 * T + NEXP * 128) * EH, 8, 9); WS(ymoe, bf16_t, (size_t)2 * T * D, 9, 10);
#undef WS
    int order[48]; for (int i = 0; i < nb; ++i) order[i] = i;
    for (int i = 1; i < nb; ++i) { const int v = order[i]; int j = i - 1; while (j >= 0 && bufs[order[j]].size < bufs[v].size) { order[j + 1] = order[j]; --j; } order[j + 1] = v; }
    bool placed[48]; for (int i = 0; i < nb; ++i) placed[i] = false;
    for (int oi = 0; oi < nb; ++oi) { WsBuf& nbuf = bufs[order[oi]]; size_t off = 0;
        for (bool moved = true; moved;) { moved = false;
            for (int i = 0; i < nb; ++i) { if (!placed[i]) continue; const WsBuf& b = bufs[i];
                if (b.p1 < nbuf.p0 || b.p0 > nbuf.p1) continue;
                if (off < b.off + b.size && b.off < off + nbuf.size) { off = b.off + b.size; moved = true; } } }
        nbuf.off = off; placed[order[oi]] = true; *slots[order[oi]] = (void*)(ws + off); if (off + nbuf.size > total) total = off + nbuf.size; }
    return total;
}

#ifndef CPU_EMU
__global__ void __launch_bounds__(NTHR, 2) mega_kernel(Params p) {
    extern __shared__ __attribute__((aligned(16))) char smem[];
    volatile LAS unsigned* st = (volatile LAS unsigned*)(smem + SMEM_BYTES - 16);
    if (threadIdx.x == 0) { st[0] = 0u; st[1] = 0u; }
    __syncthreads();
    const XcdBarrier xb = xcd_barrier_post(p.bar, st);
    if (p.out == nullptr) cg::this_grid().sync();
#define X(f) f(p, smem); xcd_barrier(xb);
    PHASE_LIST(X)
#undef X
    ph_final(p, smem);
}

extern "C" void kernel_launch(void* const* d_in, const int* in_sizes, int n_in, void* d_out, int out_size, void* d_ws, size_t ws_size, hipStream_t stream) {
    static int grid_blocks = 0;
    if (!grid_blocks) {
        int dev = 0, cus = 0, per_cu = 0;
        (void)hipGetDevice(&dev);
        (void)hipDeviceGetAttribute(&cus, hipDeviceAttributeMultiprocessorCount, dev);
        (void)hipFuncSetAttribute((const void*)mega_kernel, hipFuncAttributeMaxDynamicSharedMemorySize, SMEM_BYTES);
        (void)hipOccupancyMaxActiveBlocksPerMultiprocessor(&per_cu, mega_kernel, NTHR, SMEM_BYTES);
        if (per_cu > 2) per_cu = 2;
        if (per_cu < 1) per_cu = 1;
        grid_blocks = cus * per_cu;
    }
    Params p; memset(&p, 0, sizeof(p));
    const size_t need = fill_params(p, d_in, d_out, d_ws, grid_blocks);
    if (need > ws_size) { fprintf(stderr, "workspace too small: need %zu have %zu\n", need, ws_size); return; }
    (void)hipMemsetAsync(p.bar, 0, XCD_BAR_WORDS * sizeof(unsigned), stream);
    void* args[] = {&p};
    hipError_t e = hipLaunchCooperativeKernel((void*)mega_kernel, dim3(grid_blocks), dim3(NTHR), args, SMEM_BYTES, stream);
    if (e != hipSuccess) fprintf(stderr, "cooperative launch failed: %s (grid %d)\n", hipGetErrorString(e), grid_blocks);
}
#endif
```

```cpp
#ifdef CPU_EMU
#include "emu.h"
#else
#include <hip/hip_runtime.h>
#include <hip/hip_cooperative_groups.h>
#include <cstdio>
namespace cg = cooperative_groups;
#endif
#include <stdint.h>
#include <string.h>
#include <math.h>

#ifndef CFG_BATCH
#define CFG_BATCH 8
#endif
#ifndef CFG_SEQ
#define CFG_SEQ 2048
#endif
#ifndef CFG_CTX
#define CFG_CTX 256
#endif

#ifdef CPU_EMU
#define OPAQUE(x)
#else
#define OPAQUE(x) asm volatile("" : "+v"(x))
#endif
#define DEV __device__ __forceinline__

typedef unsigned short bf16_t;
typedef short bf16x8 __attribute__((ext_vector_type(8)));
typedef float f32x4 __attribute__((ext_vector_type(4)));
typedef unsigned short us4 __attribute__((ext_vector_type(4)));

constexpr int NB = CFG_BATCH, L = CFG_SEQ, LC = CFG_CTX;
constexpr int D = 1024, T = NB * L, TC = NB * LC, TA = T + TC;
constexpr int HW = 512, NH = 4, DH = 128, CH = 128, PC = 3584, NMODC = 6 * D;
constexpr int NCH = L / CH, NCC = LC / CH, NCT = NCH + NCC;
constexpr int NEXP = 16, EH = 512;
constexpr int UP = L + 64;
constexpr int NTHR = 256;
constexpr int SMEM_BYTES = 77824;
constexpr int MAXTILES = T * 2 / 128 + NEXP;

struct Params {
    const float *x, *c, *ctx, *c_ctx, *ada_w, *ada_b, *norm1_w, *w_in, *hy_conv_w, *hy_conv_b, *f_w1, *f_b1, *f_w2, *f_b2, *f_w3, *f_b3,
        *f_wout, *f_freq, *hy_skip, *hy_out_norm, *ret_gn_w, *w_out, *norm2_w, *rg_w, *rg_b, *re_w, *re_b, *exp_w1, *exp_w3, *exp_w2, *final_w;
    float* out;
    float* mod;
    bf16_t* w_in_t;
    bf16_t* w_out_t;
    bf16_t* w13_t;
    bf16_t* w2_t;
    bf16_t* gtap;
    float* rope;
    bf16_t* hbuf;
    float* RP;
    float* cb;
    bf16_t* pT;
    bf16_t* qn;
    bf16_t* kn;
    bf16_t* kT;
    bf16_t* vT;
    bf16_t* ckT;
    bf16_t* cvT;
    bf16_t* gbuf;
    float* Kst;
    bf16_t* Sst;
    bf16_t* yhyT;
    bf16_t* ycat;
    bf16_t* Pscr;
    float* x1;
    bf16_t* h2;
    unsigned* bar;
    int* cnt;
    int* elist;
    float* ewt;
    int* tok_e;
    int* tok_pos;
    bf16_t* hid;
    bf16_t* ymoe;
};

DEV uint32_t f_as_u(float f) { return __builtin_bit_cast(uint32_t, f); }
DEV float u_as_f(uint32_t u) { return __builtin_bit_cast(float, u); }
DEV float bf2f(bf16_t v) { return u_as_f(((uint32_t)v) << 16); }
DEV bf16_t f2bf(float f) { uint32_t u = f_as_u(f); u += 0x7fffu + ((u >> 16) & 1u); return (bf16_t)(u >> 16); }
DEV us4 pack4(float a, float b, float c, float d) { us4 r; r[0] = f2bf(a); r[1] = f2bf(b); r[2] = f2bf(c); r[3] = f2bf(d); return r; }
DEV float silu_f(float v) { return v / (1.f + expf(-v)); }
DEV float wave_sum(float v) { v += __shfl_xor(v, 1); v += __shfl_xor(v, 2); v += __shfl_xor(v, 4); v += __shfl_xor(v, 8); v += __shfl_xor(v, 16); v += __shfl_xor(v, 32); return v; }
DEV float lg2_gamma(int h, bool bwd) { return log2f(1.f - exp2f(-((bwd ? 5.5f : 5.0f) + (float)h))); }

struct LdPlain {
    const bf16_t* rp[4];
    DEV LdPlain(const bf16_t* base, size_t row0, size_t ld) { const int lrow = threadIdx.x >> 3, lc = threadIdx.x & 7;
#pragma unroll
        for (int i = 0; i < 4; ++i) rp[i] = base + (row0 + lrow + 32 * i) * ld + lc * 8; }
    DEV bf16x8 ld(int i, int kt) const { return *(const bf16x8*)(rp[i] + kt * 64); }
};
struct LdGather {
    const bf16_t* rp[4];
    DEV bf16x8 ld(int i, int kt) const { return *(const bf16x8*)(rp[i] + kt * 64); }
};
struct LdKScale {
    const bf16_t* rp[4]; float a, b;
    DEV LdKScale(const bf16_t* base, size_t row0, size_t ld, float a_, float b_) : a(a_), b(b_) { const int lrow = threadIdx.x >> 3, lc = threadIdx.x & 7;
#pragma unroll
        for (int i = 0; i < 4; ++i) rp[i] = base + (row0 + lrow + 32 * i) * ld + lc * 8; }
    DEV bf16x8 ld(int i, int kt) const { bf16x8 v = *(const bf16x8*)(rp[i] + kt * 64); const int k0 = kt * 64 + (threadIdx.x & 7) * 8; bf16x8 o;
#pragma unroll
        for (int e = 0; e < 8; ++e) o[e] = (short)f2bf(bf2f((bf16_t)v[e]) * exp2f(a + b * (float)(k0 + e)));
        return o; }
};
struct LdRowScale {
    const bf16_t* rp[4]; float sc[4];
    DEV LdRowScale(const bf16_t* base, size_t row0, size_t ld, float a, float b) { const int lrow = threadIdx.x >> 3, lc = threadIdx.x & 7;
#pragma unroll
        for (int i = 0; i < 4; ++i) { rp[i] = base + (row0 + lrow + 32 * i) * ld + lc * 8; sc[i] = exp2f(a + b * (float)(lrow + 32 * i)); } }
    DEV bf16x8 ld(int i, int kt) const { bf16x8 v = *(const bf16x8*)(rp[i] + kt * 64); bf16x8 o;
#pragma unroll
        for (int e = 0; e < 8; ++e) o[e] = (short)f2bf(bf2f((bf16_t)v[e]) * sc[i]);
        return o; }
};

template <class LX, class LY>
DEV void gemm_tile(f32x4 (&acc)[4][4], const LX& lx, const LY& ly, int nk, char* smem) {
    int tid = threadIdx.x; OPAQUE(tid);
    const int lane = tid & 63, wid = tid >> 6, wr = wid >> 1, wc = wid & 1;
    const int lrow = tid >> 3, lc = tid & 7, fr = lane & 15, quad = lane >> 4;
    bf16x8 rx[4], ry[4];
    int soff[4];
#pragma unroll
    for (int i = 0; i < 4; ++i) { const int row = lrow + 32 * i; soff[i] = row * 128 + ((lc ^ ((row >> 1) & 7)) << 4); }
#pragma unroll
    for (int i = 0; i < 4; ++i) { rx[i] = lx.ld(i, 0); ry[i] = ly.ld(i, 0); }
#pragma unroll
    for (int i = 0; i < 4; ++i) { *(bf16x8*)(smem + soff[i]) = rx[i]; *(bf16x8*)(smem + 32768 + soff[i]) = ry[i]; }
    __syncthreads();
    const int sw = fr >> 1;
    for (int kt = 0; kt < nk; ++kt) {
        const char* bx = smem + (kt & 1) * 16384; const char* by = smem + 32768 + (kt & 1) * 16384;
        if (kt + 1 < nk) {
#pragma unroll
            for (int i = 0; i < 4; ++i) { rx[i] = lx.ld(i, kt + 1); ry[i] = ly.ld(i, kt + 1); }
        }
#pragma unroll
        for (int kk = 0; kk < 2; ++kk) {
            bf16x8 xf[4], yf[4];
            const int ch = ((kk * 4 + quad) ^ sw) << 4;
#pragma unroll
            for (int mi = 0; mi < 4; ++mi) xf[mi] = *(const bf16x8*)(bx + (wr * 64 + mi * 16 + fr) * 128 + ch);
#pragma unroll
            for (int ni = 0; ni < 4; ++ni) yf[ni] = *(const bf16x8*)(by + (wc * 64 + ni * 16 + fr) * 128 + ch);
#pragma unroll
            for (int mi = 0; mi < 4; ++mi)
#pragma unroll
                for (int ni = 0; ni < 4; ++ni) acc[mi][ni] = __builtin_amdgcn_mfma_f32_16x16x32_bf16(xf[mi], yf[ni], acc[mi][ni], 0, 0, 0);
        }
        if (kt + 1 < nk) {
            char* nx = smem + ((kt + 1) & 1) * 16384;
#pragma unroll
            for (int i = 0; i < 4; ++i) { *(bf16x8*)(nx + soff[i]) = rx[i]; *(bf16x8*)(nx + 32768 + soff[i]) = ry[i]; }
        }
        __syncthreads();
    }
}
DEV void zero_acc(f32x4 (&acc)[4][4]) {
#pragma unroll
    for (int i = 0; i < 4; ++i)
#pragma unroll
        for (int j = 0; j < 4; ++j) acc[i][j] = (f32x4){0.f, 0.f, 0.f, 0.f};
}

DEV void task_ada(const Params& p, char* smem, int task) {
    float* sl = (float*)smem;
    float* red = sl + (NB + 1) * D;
    const int tid = threadIdx.x;
    for (int i = tid; i < (NB + 1) * D; i += NTHR) { const int r = i / D, k = i % D; const float v = r < NB ? p.c[r * D + k] : p.c_ctx[k]; sl[i] = silu_f(v); }
    __syncthreads();
    const int col = tid & 31, kq = tid >> 5, j = task * 32 + col;
    float acc[NB + 1];
#pragma unroll
    for (int r = 0; r <= NB; ++r) acc[r] = 0.f;
#pragma unroll 1
    for (int k = kq; k < D; k += 64) { float wv[8];
#pragma unroll
        for (int u = 0; u < 8; ++u) wv[u] = p.ada_w[(size_t)(k + 8 * u) * NMODC + j];
#pragma unroll
        for (int u = 0; u < 8; ++u)
#pragma unroll
            for (int r = 0; r <= NB; ++r) acc[r] += sl[r * D + k + 8 * u] * wv[u]; }
#pragma unroll
    for (int r = 0; r <= NB; ++r) red[(kq * (NB + 1) + r) * 32 + col] = acc[r];
    __syncthreads();
    for (int i = tid; i < (NB + 1) * 32; i += NTHR) { const int r = i / 32, cc = i % 32; float s = p.ada_b[task * 32 + cc];
        for (int q = 0; q < 8; ++q) s += red[(q * (NB + 1) + r) * 32 + cc];
        p.mod[r * NMODC + task * 32 + cc] = s; }
    __syncthreads();
}

DEV void transpose_tile(const float* src, int ldn, int k0, int n0, bf16_t* dst, size_t ldk, int mapmode, int which, const float* sc, int scsplit, const float* sc2, char* smem) {
    float* t = (float*)smem;
    const int tid = threadIdx.x;
    { const int r = tid >> 4, c4 = tid & 15;
#pragma unroll
      for (int i = 0; i < 4; ++i) { const int k = r + 16 * i; const f32x4 v = *(const f32x4*)(src + (size_t)(k0 + k) * ldn + n0 + c4 * 4);
          float s = 1.f; if (sc) { const int kk = k0 + k; s = kk < scsplit ? sc[kk] : sc2[kk - scsplit]; }
          t[k * 65 + c4 * 4 + 0] = v[0] * s; t[k * 65 + c4 * 4 + 1] = v[1] * s; t[k * 65 + c4 * 4 + 2] = v[2] * s; t[k * 65 + c4 * 4 + 3] = v[3] * s; } }
    __syncthreads();
    { const int n = tid >> 2, kc = tid & 3; const int nn = n0 + n;
      const int drow = mapmode == 0 ? nn : ((nn >> 6) * 128 + ((nn >> 5) & 1) * 64 + which * 32 + (nn & 31));
#pragma unroll
      for (int h = 0; h < 2; ++h) { bf16x8 o;
#pragma unroll
          for (int e = 0; e < 8; ++e) o[e] = (short)f2bf(t[(kc * 16 + h * 8 + e) * 65 + n]);
          *(bf16x8*)(dst + (size_t)drow * ldk + k0 + kc * 16 + h * 8) = o; } }
    __syncthreads();
}

DEV void task_filt(const Params& p, char* smem, int task) {
    float* z = (float*)smem;
    float* ha = z + 16 * 36;
    float* hb = ha + 16 * 64;
    float* w1 = hb + 16 * 64;
    float* w2 = w1 + 33 * 64;
    float* w3 = w2 + 64 * 64;
    const int tid = threadIdx.x, i0 = task * 16;
    for (int i = tid; i < 33 * 64; i += NTHR) w1[i] = p.f_w1[i];
    for (int i = tid; i < 64 * 64; i += NTHR) { w2[i] = p.f_w2[i]; w3[i] = p.f_w3[i]; }
    for (int i = tid; i < 16 * 33; i += NTHR) { const int pp = i / 33, f = i % 33, pos = i0 + pp; float v;
        if (f == 0) v = (float)pos / (float)(L - 1);
        else { const int bnd = (f - 1) & 15; const float band = 1e-4f + (float)bnd * ((15.f - 1e-4f) / 15.f);
               const float ang = (6.283185307179586f / (float)L) * (float)pos * band; v = f <= 16 ? cosf(ang) : -sinf(ang); }
        z[pp * 36 + f] = v; }
    __syncthreads();
    const int pp = tid >> 4, jq = tid & 15;
#pragma unroll 1
    for (int m = 0; m < 4; ++m) { const int j = jq + 16 * m; float s = p.f_b1[j];
#pragma unroll 3
        for (int k = 0; k < 33; ++k) s += z[pp * 36 + k] * w1[k * 64 + j];
        ha[pp * 64 + j] = sinf(p.f_freq[j] * s); }
    __syncthreads();
#pragma unroll 1
    for (int m = 0; m < 4; ++m) { const int j = jq + 16 * m; float s = p.f_b2[j];
#pragma unroll 4
        for (int k = 0; k < 64; ++k) s += ha[pp * 64 + k] * w2[k * 64 + j];
        hb[pp * 64 + j] = sinf(p.f_freq[j] * s); }
    __syncthreads();
#pragma unroll 1
    for (int m = 0; m < 4; ++m) { const int j = jq + 16 * m; float s = p.f_b3[j];
#pragma unroll 4
        for (int k = 0; k < 64; ++k) s += hb[pp * 64 + k] * w3[k * 64 + j];
        ha[pp * 64 + j] = sinf(p.f_freq[j] * s); }
    __syncthreads();
    const float max_decay = logf(1e-2f) / 0.3f, min_decay = logf(1e-2f) / 1.5f;
#pragma unroll 1
    for (int m = 0; m < 4; ++m) { const int cc = tid + 256 * m; float acc[16];
#pragma unroll
        for (int q = 0; q < 16; ++q) acc[q] = 0.f;
#pragma unroll 1
        for (int k0 = 0; k0 < 64; k0 += 16) { float wv[16];
#pragma unroll
            for (int kk = 0; kk < 16; ++kk) wv[kk] = p.f_wout[(k0 + kk) * 1024 + cc];
#pragma unroll
            for (int kk = 0; kk < 16; ++kk)
#pragma unroll
                for (int q = 0; q < 16; ++q) acc[q] += ha[q * 64 + k0 + kk] * wv[kk]; }
        const int c = cc & 511; const bool isb = cc >= 512;
        const float delta = fabsf(min_decay + (float)c * ((max_decay - min_decay) / 511.f));
#pragma unroll
        for (int q = 0; q < 16; ++q) { const int pos = i0 + q; const float tt = (float)pos / (float)(L - 1); const float win = expf(-tt * delta) + 0.05f; float val = acc[q] * win;
            if (!isb) { if (pos == 0) val += p.hy_skip[c]; p.gtap[(size_t)c * (2 * L) + (L - pos)] = f2bf(val); }
            else { if (pos == 0) p.gtap[(size_t)c * (2 * L)] = 0; else p.gtap[(size_t)c * (2 * L) + (L + pos)] = f2bf(val); } } }
    __syncthreads();
}

constexpr int NT_ADA = NMODC / 32;
constexpr int NT_WIN = 16 * 56, NT_WOUT = 16 * 16, NT_W13 = 16 * 2 * 16 * 8, NT_W2 = 16 * 8 * 16;
constexpr int NT_FILT = L / 16;
constexpr int NT_P0 = NT_ADA + NT_FILT + 1 + NT_WIN + NT_WOUT;

DEV void ph_prep(const Params& p, char* smem) {
    for (int task = blockIdx.x; task < NT_P0; task += gridDim.x) {
        int t = task;
        if (t < NT_ADA) { task_ada(p, smem, t); continue; } t -= NT_ADA;
        if (t < NT_FILT) { task_filt(p, smem, t); continue; } t -= NT_FILT;
        if (t < 1) {
            for (int i = threadIdx.x; i < 64 * 16; i += NTHR) { const int pos = i >> 4, f = i & 15; const float fr = powf(10000.f, -(float)f / 16.f); const float a = (float)pos * fr;
                p.rope[i * 2] = cosf(a); p.rope[i * 2 + 1] = sinf(a); }
            if (threadIdx.x < 32) p.cnt[threadIdx.x] = 0;
            continue; } t -= 1;
        if (t < NT_WIN) { const int kt = t / 56, nt = t % 56; transpose_tile(p.w_in, PC, kt * 64, nt * 64, p.w_in_t, 1024, 0, 0, nullptr, 0, nullptr, smem); continue; } t -= NT_WIN;
        { const int kt = t / 16, nt = t % 16; transpose_tile(p.w_out, D, kt * 64, nt * 64, p.w_out_t, 1024, 0, 0, p.hy_out_norm, 512, p.ret_gn_w, smem); }
    }
}
DEV void expert_conv_task(const Params& p, char* smem, int t) {
    if (t < NT_W13) { const int e = t / 256, r = t % 256, which = r / 128, r2 = r % 128, kt = r2 / 8, nt = r2 % 8;
        transpose_tile((which ? p.exp_w3 : p.exp_w1) + (size_t)e * D * EH, EH, kt * 64, nt * 64, p.w13_t + (size_t)e * 1024 * 1024, 1024, 1, which, nullptr, 0, nullptr, smem); return; }
    t -= NT_W13;
    { const int e = t / 128, r = t % 128, kt = r / 16, nt = r % 16;
        transpose_tile(p.exp_w2 + (size_t)e * EH * D, D, kt * 64, nt * 64, p.w2_t + (size_t)e * 1024 * EH, EH, 0, 0, nullptr, 0, nullptr, smem); }
}

DEV void ph_norm1(const Params& p, char* smem) {
    const int tid = threadIdx.x, lane = tid & 63, wid = tid >> 6;
    for (int row = blockIdx.x * 4 + wid; row < TA; row += gridDim.x * 4) {
        const float* src = row < T ? p.x + (size_t)row * D : p.ctx + (size_t)(row - T) * D;
        const int mb = row < T ? row / L : NB;
        const float* sh = p.mod + (size_t)mb * NMODC; const float* sc = sh + D;
        f32x4 v[4]; float ss = 0.f;
#pragma unroll
        for (int i = 0; i < 4; ++i) { v[i] = *(const f32x4*)(src + i * 256 + lane * 4); ss += v[i][0] * v[i][0] + v[i][1] * v[i][1] + v[i][2] * v[i][2] + v[i][3] * v[i][3]; }
        ss = wave_sum(ss);
        const float rstd = rsqrtf(ss * (1.f / D) + 1e-6f);
#pragma unroll
        for (int i = 0; i < 4; ++i) { const int k = i * 256 + lane * 4; const f32x4 w = *(const f32x4*)(p.norm1_w + k), s1 = *(const f32x4*)(sc + k), s0 = *(const f32x4*)(sh + k);
            *(us4*)(p.hbuf + (size_t)row * D + k) = pack4(v[i][0] * rstd * w[0] * (1.f + s1[0]) + s0[0], v[i][1] * rstd * w[1] * (1.f + s1[1]) + s0[1],
                                                          v[i][2] * rstd * w[2] * (1.f + s1[2]) + s0[2], v[i][3] * rstd * w[3] * (1.f + s1[3]) + s0[3]); }
    }
    const int gtid = blockIdx.x * NTHR + tid, gn = gridDim.x * NTHR;
    for (int i = gtid; i < NB * D * 32; i += gn) { const int ii = i & 3, j = (i >> 2) & 31, k4 = (i >> 7) & 255, b = i >> 15; const int k = k4 * 4 + ii;
        const float r = j < 4 ? p.rg_w[k * 4 + j] : (j < 20 ? p.re_w[k * 16 + (j - 4)] : 0.f);
        p.RP[i] = p.norm2_w[k] * (1.f + p.mod[(size_t)b * NMODC + 4 * D + k]) * r; }
    for (int wt = blockIdx.x * 4 + wid; wt < NB * 32; wt += gridDim.x * 4) { const int b = wt >> 5, j = wt & 31; float s = 0.f;
        if (j < 20) for (int k = lane; k < D; k += 64) { const float r = j < 4 ? p.rg_w[k * 4 + j] : p.re_w[k * 16 + (j - 4)]; s += p.mod[(size_t)b * NMODC + 3 * D + k] * r; }
        s = wave_sum(s);
        if (lane == 0) p.cb[wt] = j < 4 ? s + p.rg_b[j] : (j < 20 ? s + p.re_b[j - 4] : 0.f); }
}

constexpr int NT_INP = (T / 128) * 28 + (TC / 128) * 8;
DEV void inproj_tile(const Params& p, char* smem, int mt, int nt) {
    int tid = threadIdx.x; OPAQUE(tid);
    const int lane = tid & 63, wid = tid >> 6, wr = wid >> 1, wc = wid & 1, fr = lane & 15, quad = lane >> 4;
    const size_t row0 = (size_t)mt * 128;
    const bool is_ctx = mt >= T / 128;
    const bool actX = (nt < 12) || (nt >= 16 && nt < 24);
    f32x4 acc[4][4]; zero_acc(acc);
    LdPlain la(p.hbuf, row0, D), lw(p.w_in_t, (size_t)nt * 128, D);
    if (actX) gemm_tile(acc, la, lw, D / 64, smem); else gemm_tile(acc, lw, la, D / 64, smem);
    if (nt < 12) {
#pragma unroll
        for (int mi = 0; mi < 4; ++mi)
#pragma unroll
            for (int ni = 0; ni < 4; ++ni) { const size_t tok = row0 + wr * 64 + mi * 16 + quad * 4; const int c = nt * 128 + wc * 64 + ni * 16 + fr;
                *(us4*)(p.pT + (size_t)c * T + tok) = pack4(acc[mi][ni][0], acc[mi][ni][1], acc[mi][ni][2], acc[mi][ni][3]); }
    } else if (nt >= 16 && nt < 24) {
        const bool isk = nt < 20; const int h = (nt - 16) & 3;
        if (!is_ctx) {
            const int b = (int)(row0 / L), tl0 = (int)(row0 % L);
            if (isk) {
                if (wc == 0) {
#pragma unroll
                    for (int mi = 0; mi < 4; ++mi)
#pragma unroll
                        for (int r = 0; r < 4; ++r) { const int tl = tl0 + wr * 64 + mi * 16 + quad * 4 + r;
                            { const float* cs = p.rope + ((tl >> 6) * 16 + fr) * 2; const float a = acc[mi][0][r], bq = acc[mi][1][r]; acc[mi][0][r] = a * cs[0] - bq * cs[1]; acc[mi][1][r] = a * cs[1] + bq * cs[0]; }
                            { const float* cs = p.rope + ((tl & 63) * 16 + fr) * 2; const float a = acc[mi][2][r], bq = acc[mi][3][r]; acc[mi][2][r] = a * cs[0] - bq * cs[1]; acc[mi][3][r] = a * cs[1] + bq * cs[0]; } }
                }
                const float scl = 0.08838834764831845f;
#pragma unroll
                for (int mi = 0; mi < 4; ++mi)
#pragma unroll
                    for (int ni = 0; ni < 4; ++ni) { const int tl = tl0 + wr * 64 + mi * 16 + quad * 4, d = wc * 64 + ni * 16 + fr; const size_t bh = (size_t)b * NH + h;
                        const us4 o = pack4(acc[mi][ni][0] * scl, acc[mi][ni][1] * scl, acc[mi][ni][2] * scl, acc[mi][ni][3] * scl);
                        *(us4*)(p.kT + (bh * 128 + d) * L + tl) = o;
#pragma unroll
                        for (int r = 0; r < 4; ++r) p.kn[(bh * L + tl + r) * 128 + d] = o[r]; }
            } else {
#pragma unroll
                for (int mi = 0; mi < 4; ++mi)
#pragma unroll
                    for (int ni = 0; ni < 4; ++ni) { const int tl = tl0 + wr * 64 + mi * 16 + quad * 4, d = wc * 64 + ni * 16 + fr; const size_t bh = (size_t)b * NH + h;
                        *(us4*)(p.vT + (bh * 128 + d) * L + tl) = pack4(acc[mi][ni][0], acc[mi][ni][1], acc[mi][ni][2], acc[mi][ni][3]); }
            }
        } else {
            const size_t cr0 = row0 - T; const int b = (int)(cr0 / LC), tl0 = (int)(cr0 % LC); const float scl = isk ? 0.08838834764831845f : 1.f;
            bf16_t* dst = isk ? p.ckT : p.cvT;
#pragma unroll
            for (int mi = 0; mi < 4; ++mi)
#pragma unroll
                for (int ni = 0; ni < 4; ++ni) { const int tl = tl0 + wr * 64 + mi * 16 + quad * 4, d = wc * 64 + ni * 16 + fr; const size_t bh = (size_t)b * NH + h;
                    *(us4*)(dst + (bh * 128 + d) * LC + tl) = pack4(acc[mi][ni][0] * scl, acc[mi][ni][1] * scl, acc[mi][ni][2] * scl, acc[mi][ni][3] * scl); }
        }
    } else if (nt < 16) {
        const int h = nt - 12; const int b = (int)(row0 / L), tl0 = (int)(row0 % L);
        if (wr == 0) {
#pragma unroll
            for (int ni = 0; ni < 4; ++ni) { const int tl = tl0 + wc * 64 + ni * 16 + fr;
#pragma unroll
                for (int r = 0; r < 4; ++r) { const int j = quad * 4 + r;
                    { const float* cs = p.rope + ((tl >> 6) * 16 + j) * 2; const float a = acc[0][ni][r], bq = acc[1][ni][r]; acc[0][ni][r] = a * cs[0] - bq * cs[1]; acc[1][ni][r] = a * cs[1] + bq * cs[0]; }
                    { const float* cs = p.rope + ((tl & 63) * 16 + j) * 2; const float a = acc[2][ni][r], bq = acc[3][ni][r]; acc[2][ni][r] = a * cs[0] - bq * cs[1]; acc[3][ni][r] = a * cs[1] + bq * cs[0]; } } }
        }
#pragma unroll
        for (int mi = 0; mi < 4; ++mi)
#pragma unroll
            for (int ni = 0; ni < 4; ++ni) { const int tl = tl0 + wc * 64 + ni * 16 + fr, d = wr * 64 + mi * 16 + quad * 4; const size_t bh = (size_t)b * NH + h;
                *(us4*)(p.qn + (bh * L + tl) * 128 + d) = pack4(acc[mi][ni][0], acc[mi][ni][1], acc[mi][ni][2], acc[mi][ni][3]); }
    } else {
#pragma unroll
        for (int mi = 0; mi < 4; ++mi)
#pragma unroll
            for (int ni = 0; ni < 4; ++ni) { const size_t tok = row0 + wc * 64 + ni * 16 + fr; const int d = (nt - 24) * 128 + wr * 64 + mi * 16 + quad * 4;
                *(us4*)(p.gbuf + tok * 512 + d) = pack4(acc[mi][ni][0], acc[mi][ni][1], acc[mi][ni][2], acc[mi][ni][3]); }
    }
}
DEV void ph_inproj(const Params& p, char* smem) {
    for (int task = blockIdx.x; task < NT_INP; task += gridDim.x) {
        if (task < (T / 128) * 28) inproj_tile(p, smem, task / 28, task % 28);
        else { const int t = task - (T / 128) * 28; inproj_tile(p, smem, T / 128 + t / 8, 16 + t % 8); }
    }
}

constexpr int NU = L / 64, UPW = NU / 4;
DEV bf16x8 conv_afrag(const bf16_t* taps, int m0) { bf16x8 a;
#pragma unroll
    for (int e = 0; e < 8; ++e) a[e] = (short)taps[m0 + e];
    return a; }
DEV void conv3_w(const Params& p, int ch, float& w0, float& w1, float& w2, float& bs) { w0 = p.hy_conv_w[ch]; w1 = p.hy_conv_w[1536 + ch]; w2 = p.hy_conv_w[3072 + ch]; bs = p.hy_conv_b[ch]; }

DEV void conv_task(const Params& p, char* smem, int c) {
    bf16_t* taps = (bf16_t*)smem;
    bf16_t* U = taps + 2 * L + 8;
    const int tid = threadIdx.x, lane = tid & 63, w = tid >> 6, fr = lane & 15, quad = lane >> 4;
    for (int i = tid; i < 2 * L / 8; i += NTHR) *(bf16x8*)(taps + i * 8) = *(const bf16x8*)(p.gtap + (size_t)c * 2 * L + i * 8);
    for (int i = tid; i < 8 * UP / 8; i += NTHR) *(bf16x8*)(U + i * 8) = (bf16x8){0, 0, 0, 0, 0, 0, 0, 0};
    __syncthreads();
    { float a0, a1, a2, ab, v0, v1, v2, vb; conv3_w(p, 512 + c, a0, a1, a2, ab); conv3_w(p, 1024 + c, v0, v1, v2, vb);
      for (int g = tid; g < NB * (L / 8); g += NTHR) { const int b = g / (L / 8), t8 = (g % (L / 8)) * 8;
          const bf16_t* r1 = p.pT + (size_t)(512 + c) * T + (size_t)b * L + t8; const bf16_t* rv = p.pT + (size_t)(1024 + c) * T + (size_t)b * L + t8;
          const bf16x8 x1v = *(const bf16x8*)r1, vv = *(const bf16x8*)rv;
          float px[10], pv[10];
          px[0] = t8 > 0 ? bf2f(r1[-1]) : 0.f; pv[0] = t8 > 0 ? bf2f(rv[-1]) : 0.f;
          px[9] = t8 + 8 < L ? bf2f(r1[8]) : 0.f; pv[9] = t8 + 8 < L ? bf2f(rv[8]) : 0.f;
#pragma unroll
          for (int e = 0; e < 8; ++e) { px[e + 1] = bf2f((bf16_t)x1v[e]); pv[e + 1] = bf2f((bf16_t)vv[e]); }
          bf16x8 o;
#pragma unroll
          for (int e = 0; e < 8; ++e) { const float x1 = a0 * px[e] + a1 * px[e + 1] + a2 * px[e + 2] + ab; const float vq = v0 * pv[e] + v1 * pv[e + 1] + v2 * pv[e + 2] + vb; o[e] = (short)f2bf(x1 * vq); }
          *(bf16x8*)(U + b * UP + 32 + t8) = o; } }
    __syncthreads();
    f32x4 acc[2][UPW];
#pragma unroll
    for (int tp = 0; tp < 2; ++tp)
#pragma unroll
        for (int ui = 0; ui < UPW; ++ui) acc[tp][ui] = (f32x4){0.f, 0.f, 0.f, 0.f};
    const int bcol = fr & 7, i2 = fr >> 3;
    const bf16_t* Ub = U + bcol * UP + 32 + 32 * i2 + 8 * quad;
    const int mbase = L - fr + 8 * quad - 64 * (UPW * w);
#pragma unroll 1
    for (int jp = 1; jp >= 0; --jp) {
        bf16x8 af[2][UPW];
        int J0 = jp ? -1 : 0;
        if (jp) {
            const bf16x8 bfr = *(const bf16x8*)(Ub + 32 * J0);
#pragma unroll
            for (int tp = 0; tp < 2; ++tp)
#pragma unroll
                for (int ui = 0; ui < UPW; ++ui) { const bf16x8 a = conv_afrag(taps, mbase - 64 * ui - 16 * tp + 32 * J0); acc[tp][ui] = __builtin_amdgcn_mfma_f32_16x16x32_bf16(a, bfr, acc[tp][ui], 0, 0, 0); }
            J0 = 1;
        }
#pragma unroll
        for (int tp = 0; tp < 2; ++tp)
#pragma unroll
            for (int ui = 0; ui < UPW; ++ui) af[tp][ui] = conv_afrag(taps, mbase - 64 * ui - 16 * tp + 32 * J0);
#pragma unroll 1
        for (int grp = 0; grp < 4; ++grp) {
#pragma unroll
            for (int s = 0; s < UPW; ++s) {
                const bf16x8 bfr = *(const bf16x8*)(Ub + 32 * J0);
#pragma unroll
                for (int tp = 0; tp < 2; ++tp)
#pragma unroll
                    for (int ui = 0; ui < UPW; ++ui) acc[tp][ui] = __builtin_amdgcn_mfma_f32_16x16x32_bf16(af[tp][(ui - s + UPW) % UPW], bfr, acc[tp][ui], 0, 0, 0);
                J0 += 2;
                if (grp < 3 || s < UPW - 1) {
#pragma unroll
                    for (int tp = 0; tp < 2; ++tp) af[tp][(UPW - 1 - s) % UPW] = conv_afrag(taps, mbase - 16 * tp + 32 * J0);
                }
            }
        }
    }
    float w0, w1, w2, wb; conv3_w(p, c, w0, w1, w2, wb);
    if (bcol < NB) {
#pragma unroll
        for (int tp = 0; tp < 2; ++tp)
#pragma unroll
            for (int ui = 0; ui < UPW; ++ui) { const int I0 = 4 * (UPW * w + ui) + tp; const int t = 16 * (I0 + 2 * i2) + 4 * quad;
                const bf16_t* r0 = p.pT + (size_t)c * T + (size_t)bcol * L + t; const us4 cv = *(const us4*)r0;
                float pq[6]; pq[0] = t > 0 ? bf2f(r0[-1]) : 0.f; pq[5] = t + 4 < L ? bf2f(r0[4]) : 0.f;
#pragma unroll
                for (int e = 0; e < 4; ++e) pq[e + 1] = bf2f(cv[e]);
                float y[4];
#pragma unroll
                for (int e = 0; e < 4; ++e) y[e] = (w0 * pq[e] + w1 * pq[e + 1] + w2 * pq[e + 2] + wb) * acc[tp][ui][e];
                *(us4*)(p.yhyT + (size_t)c * T + (size_t)bcol * L + t) = pack4(y[0], y[1], y[2], y[3]); }
    }
    __syncthreads();
}

DEV void rstate_task(const Params& p, char* smem, int task) {
    const int bh = task / NCT, J = task % NCT, h = bh % NH;
    const int lane = threadIdx.x & 63, wid = threadIdx.x >> 6, wr = wid >> 1, wc = wid & 1, fr = lane & 15, quad = lane >> 4;
    const bf16_t *kb, *vb; size_t ld; int col0;
    if (J < NCC) { kb = p.ckT + (size_t)bh * 128 * LC; vb = p.cvT + (size_t)bh * 128 * LC; ld = LC; col0 = J * 128; }
    else { kb = p.kT + (size_t)bh * 128 * L; vb = p.vT + (size_t)bh * 128 * L; ld = L; col0 = (J - NCC) * 128; }
#pragma unroll 1
    for (int dir = 0; dir < 2; ++dir) {
        const float lg = lg2_gamma(h, dir == 1);
        f32x4 acc[4][4]; zero_acc(acc);
        LdKScale lk(kb + col0, 0, ld, dir == 0 ? 127.f * lg : 0.f, dir == 0 ? -lg : lg);
        LdPlain lv(vb + col0, 0, ld);
        gemm_tile(acc, lk, lv, 2, smem);
        float* dst = p.Kst + (((size_t)dir * NB * NH + bh) * NCT + J) * 16384;
#pragma unroll
        for (int mi = 0; mi < 4; ++mi)
#pragma unroll
            for (int ni = 0; ni < 4; ++ni) { const int d = wr * 64 + mi * 16 + quad * 4, e = wc * 64 + ni * 16 + fr; *(f32x4*)(dst + e * 128 + d) = acc[mi][ni]; }
    }
}
constexpr int NT_RST = NB * NH * NCT;
DEV void ph_conv_rstate(const Params& p, char* smem) {
    for (int task = blockIdx.x; task < HW + NT_RST; task += gridDim.x) {
        if (task < HW) conv_task(p, smem, task); else rstate_task(p, smem, task - HW);
    }
}

DEV void hynorm_task(const Params& p, char* smem, int task) {
    bf16_t* tl = (bf16_t*)smem;
    const int tid = threadIdx.x; const size_t pos0 = (size_t)task * 64;
    for (int half = 0; half < 2; ++half) { const int c = tid + 256 * half; const bf16_t* src = p.yhyT + (size_t)c * T + pos0;
#pragma unroll
        for (int q = 0; q < 8; ++q) { const bf16x8 v = *(const bf16x8*)(src + q * 8);
#pragma unroll
            for (int e = 0; e < 8; ++e) tl[(q * 8 + e) * 520 + c] = (bf16_t)v[e]; } }
    __syncthreads();
    const int pos = tid >> 2, part = tid & 3;
    float ss = 0.f;
    for (int q = 0; q < 16; ++q) { const bf16x8 v = *(const bf16x8*)(tl + pos * 520 + part * 128 + q * 8);
#pragma unroll
        for (int e = 0; e < 8; ++e) { const float f = bf2f((bf16_t)v[e]); ss += f * f; } }
    ss += __shfl_xor(ss, 1); ss += __shfl_xor(ss, 2);
    const float rstd = rsqrtf(ss * (1.f / 512.f) + 1e-6f);
    for (int q = 0; q < 16; ++q) { const bf16x8 v = *(const bf16x8*)(tl + pos * 520 + part * 128 + q * 8); bf16x8 o;
#pragma unroll
        for (int e = 0; e < 8; ++e) o[e] = (short)f2bf(bf2f((bf16_t)v[e]) * rstd);
        *(bf16x8*)(p.ycat + (pos0 + pos) * 1024 + part * 128 + q * 8) = o; }
    __syncthreads();
}
DEV void ph_scan_hynorm(const Params& p, char* smem) {
    const size_t gtid = (size_t)blockIdx.x * NTHR + threadIdx.x, gn = (size_t)gridDim.x * NTHR;
    for (size_t i = gtid; i < (size_t)2 * NB * NH * 16384; i += gn) {
        const int ed = (int)(i & 16383); const int bh = (int)((i >> 14) % (NB * NH)); const int dir = (int)(i / ((size_t)NB * NH * 16384));
        const float gch = exp2f(128.f * lg2_gamma(bh % NH, dir == 1));
        const float* ks = p.Kst + (((size_t)dir * NB * NH + bh) * NCT) * 16384 + ed;
        bf16_t* so = p.Sst + (((size_t)dir * NB * NH + bh) * NCH) * 16384 + ed;
        float s = 0.f;
        if (dir == 0) { for (int J = 0; J < NCC; ++J) s = s * gch + ks[(size_t)J * 16384];
            for (int I = 0; I < NCH; ++I) { so[(size_t)I * 16384] = f2bf(s); s = s * gch + ks[(size_t)(NCC + I) * 16384]; } }
        else { for (int J = NCC - 1; J >= 0; --J) s = s * gch + ks[(size_t)J * 16384];
            for (int I = NCH - 1; I >= 0; --I) { so[(size_t)I * 16384] = f2bf(s); s = s * gch + ks[(size_t)(NCC + I) * 16384]; } }
    }
    for (int task = blockIdx.x; task < T / 64; task += gridDim.x) hynorm_task(p, smem, task);
}

DEV void rout_task(const Params& p, char* smem, int task) {
    const int bh = task / NCH, I = task % NCH, h = bh % NH, b = bh / NH;
    int tid = threadIdx.x; OPAQUE(tid);
    const int lane = tid & 63, wid = tid >> 6, wr = wid >> 1, wc = wid & 1, fr = lane & 15, quad = lane >> 4;
    const float lgf = lg2_gamma(h, false), lgb = lg2_gamma(h, true);
    bf16_t* P = p.Pscr + (size_t)blockIdx.x * 16384;
    const bf16_t* qb = p.qn + ((size_t)bh * L + I * 128) * 128; const bf16_t* kb = p.kn + ((size_t)bh * L + I * 128) * 128;
    {
        f32x4 acc[4][4]; zero_acc(acc);
        LdPlain lk(kb, 0, 128), lq(qb, 0, 128);
        gemm_tile(acc, lk, lq, 2, smem);
#pragma unroll
        for (int mi = 0; mi < 4; ++mi)
#pragma unroll
            for (int ni = 0; ni < 4; ++ni) { const int i = wc * 64 + ni * 16 + fr, j0 = wr * 64 + mi * 16 + quad * 4; float v[4];
#pragma unroll
                for (int r = 0; r < 4; ++r) { const int j = j0 + r; const float dcy = i > j ? exp2f(lgf * (float)(i - j)) : (i == j ? 2.f : exp2f(lgb * (float)(j - i))); v[r] = acc[mi][ni][r] * dcy; }
                *(us4*)(P + i * 128 + j0) = pack4(v[0], v[1], v[2], v[3]); }
    }
    __syncthreads();
    f32x4 acc[4][4]; zero_acc(acc);
    {
        LdPlain lv(p.vT + (size_t)bh * 128 * L + I * 128, 0, L), lp(P, 0, 128);
        gemm_tile(acc, lv, lp, 2, smem);
    }
    {
        LdPlain ls(p.Sst + (((size_t)0 * NB * NH + bh) * NCH + I) * 16384, 0, 128); LdRowScale lq(qb, 0, 128, lgf, lgf);
        gemm_tile(acc, ls, lq, 2, smem);
    }
    {
        LdPlain ls(p.Sst + (((size_t)1 * NB * NH + bh) * NCH + I) * 16384, 0, 128); LdRowScale lq(qb, 0, 128, 128.f * lgb, -lgb);
        gemm_tile(acc, ls, lq, 2, smem);
    }
    float* red = (float*)smem;
    float mean[4], rstd[4];
#pragma unroll
    for (int ni = 0; ni < 4; ++ni) { float s = 0.f, ss = 0.f;
#pragma unroll
        for (int mi = 0; mi < 4; ++mi)
#pragma unroll
            for (int r = 0; r < 4; ++r) { const float v = acc[mi][ni][r]; s += v; ss += v * v; }
        s += __shfl_xor(s, 16); s += __shfl_xor(s, 32); ss += __shfl_xor(ss, 16); ss += __shfl_xor(ss, 32);
        if (quad == 0) { const int i = wc * 64 + ni * 16 + fr; red[(wr * 128 + i) * 2] = s; red[(wr * 128 + i) * 2 + 1] = ss; } }
    __syncthreads();
#pragma unroll
    for (int ni = 0; ni < 4; ++ni) { const int i = wc * 64 + ni * 16 + fr; const float s = red[i * 2] + red[(128 + i) * 2], ss = red[i * 2 + 1] + red[(128 + i) * 2 + 1];
        mean[ni] = s * (1.f / 128.f); const float var = ss * (1.f / 128.f) - mean[ni] * mean[ni]; rstd[ni] = rsqrtf(fmaxf(var, 0.f) + 1e-6f); }
#pragma unroll
    for (int mi = 0; mi < 4; ++mi)
#pragma unroll
        for (int ni = 0; ni < 4; ++ni) { const int i = wc * 64 + ni * 16 + fr, e = wr * 64 + mi * 16 + quad * 4; const size_t tok = (size_t)b * L + I * 128 + i;
            const us4 gv = *(const us4*)(p.gbuf + tok * 512 + h * 128 + e); float y[4];
#pragma unroll
            for (int r = 0; r < 4; ++r) y[r] = (acc[mi][ni][r] - mean[ni]) * rstd[ni] * silu_f(bf2f(gv[r]));
            *(us4*)(p.ycat + tok * 1024 + 512 + h * 128 + e) = pack4(y[0], y[1], y[2], y[3]); }
    __syncthreads();
}
DEV void ph_rout(const Params& p, char* smem) {
#pragma unroll 1
    for (int task = blockIdx.x; task < NB * NH * NCH; task += gridDim.x) rout_task(p, smem, task); }

DEV void ph_outproj(const Params& p, char* smem) {
    const int lane = threadIdx.x & 63, wid = threadIdx.x >> 6, wr = wid >> 1, wc = wid & 1, fr = lane & 15, quad = lane >> 4;
    for (int task = blockIdx.x; task < (T / 128) * 8 + NT_W13 + NT_W2; task += gridDim.x) {
        if (task >= (T / 128) * 8) { expert_conv_task(p, smem, task - (T / 128) * 8); continue; }
        const int mt = task / 8, nt = task % 8;
        f32x4 acc[4][4]; zero_acc(acc);
        LdPlain lw(p.w_out_t, (size_t)nt * 128, D), la(p.ycat, (size_t)mt * 128, D);
        gemm_tile(acc, lw, la, D / 64, smem);
        const int b = (mt * 128) / L; const float* g1 = p.mod + (size_t)b * NMODC + 2 * D;
#pragma unroll
        for (int mi = 0; mi < 4; ++mi)
#pragma unroll
            for (int ni = 0; ni < 4; ++ni) { const size_t tok = (size_t)mt * 128 + wc * 64 + ni * 16 + fr; const int col = nt * 128 + wr * 64 + mi * 16 + quad * 4;
                const f32x4 xv = *(const f32x4*)(p.x + tok * D + col), gv = *(const f32x4*)(g1 + col);
                *(f32x4*)(p.x1 + tok * D + col) = xv + gv * acc[mi][ni]; }
    }
}

DEV void ph_norm2_router(const Params& p, char* smem) {
    const int tid = threadIdx.x, lane = tid & 63, wid = tid >> 6, fr = lane & 15, quad = lane >> 4;
    float* lgs = (float*)smem + wid * (16 * 33);
    float* rs = (float*)smem + 4 * 16 * 33 + wid * 16;
    for (int wt = blockIdx.x * 4 + wid; wt < T / 16; wt += gridDim.x * 4) {
        const size_t row0 = (size_t)wt * 16; const int b = (int)(row0 / L);
        const float* xr = p.x1 + (row0 + fr) * D + quad * 4;
        const float* rp = p.RP + (size_t)b * D * 32;
        f32x4 a0 = {0.f, 0.f, 0.f, 0.f}, a1 = a0; float ss = 0.f;
        const float* rpl = rp + ((size_t)quad * 32 + fr) * 4;
        f32x4 xv[4], b0[4], b1[4];
#pragma unroll
        for (int u = 0; u < 4; ++u) { xv[u] = *(const f32x4*)(xr + u * 16); b0[u] = *(const f32x4*)(rpl + (size_t)u * 512); b1[u] = *(const f32x4*)(rpl + (size_t)u * 512 + 64); }
#pragma unroll 1
        for (int k0 = 0; k0 < D; k0 += 64) {
            f32x4 xn[4], c0[4], c1[4];
            const int kn = k0 + 64 < D ? k0 + 64 : k0;
#pragma unroll
            for (int u = 0; u < 4; ++u) { xn[u] = *(const f32x4*)(xr + kn + u * 16); c0[u] = *(const f32x4*)(rpl + (size_t)(kn / 4 + u * 4) * 128); c1[u] = *(const f32x4*)(rpl + (size_t)(kn / 4 + u * 4) * 128 + 64); }
#pragma unroll
            for (int u = 0; u < 4; ++u) {
                ss += xv[u][0] * xv[u][0] + xv[u][1] * xv[u][1] + xv[u][2] * xv[u][2] + xv[u][3] * xv[u][3];
#pragma unroll
                for (int i = 0; i < 4; ++i) { a0 = __builtin_amdgcn_mfma_f32_16x16x4f32(xv[u][i], b0[u][i], a0, 0, 0, 0); a1 = __builtin_amdgcn_mfma_f32_16x16x4f32(xv[u][i], b1[u][i], a1, 0, 0, 0); }
            }
#pragma unroll
            for (int u = 0; u < 4; ++u) { xv[u] = xn[u]; b0[u] = c0[u]; b1[u] = c1[u]; }
        }
        ss += __shfl_xor(ss, 16); ss += __shfl_xor(ss, 32);
        const float rstd = rsqrtf(ss * (1.f / D) + 1e-6f);
        if (quad == 0) rs[fr] = rstd;
#pragma unroll
        for (int r = 0; r < 4; ++r) { lgs[(quad * 4 + r) * 33 + fr] = a0[r]; lgs[(quad * 4 + r) * 33 + 16 + fr] = a1[r]; }
        __syncthreads();
        if (lane < 16) {
            const size_t tok = row0 + lane; const float rsd = rs[lane]; float lg[20];
#pragma unroll
            for (int j = 0; j < 20; ++j) lg[j] = lgs[lane * 33 + j] * rsd + p.cb[b * 32 + j];
            int g = 0; float gm = lg[0];
#pragma unroll
            for (int j = 1; j < 4; ++j) if (lg[j] > gm) { gm = lg[j]; g = j; }
            float den = 0.f;
#pragma unroll
            for (int j = 0; j < 4; ++j) den += expf(lg[j] - gm);
            const float psel = 1.f / den;
            float le[4];
#pragma unroll
            for (int j = 0; j < 4; ++j) le[j] = g == 0 ? lg[4 + j] : (g == 1 ? lg[8 + j] : (g == 2 ? lg[12 + j] : lg[16 + j]));
            int i0 = 0; float m0 = le[0];
#pragma unroll
            for (int j = 1; j < 4; ++j) if (le[j] > m0) { m0 = le[j]; i0 = j; }
            int i1 = -1; float m1 = -3.0e38f;
#pragma unroll
            for (int j = 0; j < 4; ++j) if (j != i0 && le[j] > m1) { m1 = le[j]; i1 = j; }
            const float ex = expf(m1 - m0); const float w0 = psel / (1.f + ex), w1 = psel * ex / (1.f + ex);
            const int e0 = g * 4 + i0, e1 = g * 4 + i1;
            const int p0 = atomicAdd(p.cnt + e0, 1), p1 = atomicAdd(p.cnt + e1, 1);
            p.elist[(size_t)e0 * T + p0] = (int)tok * 2; p.ewt[(size_t)e0 * T + p0] = w0;
            p.elist[(size_t)e1 * T + p1] = (int)tok * 2 + 1; p.ewt[(size_t)e1 * T + p1] = w1;
            p.tok_e[tok * 2] = e0; p.tok_e[tok * 2 + 1] = e1; p.tok_pos[tok * 2] = p0; p.tok_pos[tok * 2 + 1] = p1;
        }
        const float* sh = p.mod + (size_t)b * NMODC + 3 * D; const float* sc = sh + D;
        f32x4 wm[4], sa[4];
#pragma unroll
        for (int i = 0; i < 4; ++i) { const int k = i * 256 + lane * 4; const f32x4 w = *(const f32x4*)(p.norm2_w + k), s1 = *(const f32x4*)(sc + k); sa[i] = *(const f32x4*)(sh + k); wm[i] = w * (1.f + s1); }
        f32x4 cur[4];
#pragma unroll
        for (int i = 0; i < 4; ++i) cur[i] = *(const f32x4*)(p.x1 + row0 * D + i * 256 + lane * 4);
#pragma unroll 1
        for (int r = 0; r < 16; ++r) { const float rsd = rs[r]; f32x4 nxt[4]; const int rn = r < 15 ? r + 1 : r;
#pragma unroll
            for (int i = 0; i < 4; ++i) nxt[i] = *(const f32x4*)(p.x1 + (row0 + rn) * D + i * 256 + lane * 4);
#pragma unroll
            for (int i = 0; i < 4; ++i) { const int k = i * 256 + lane * 4; const f32x4 v = cur[i] * rsd * wm[i] + sa[i];
                *(us4*)(p.h2 + (row0 + r) * D + k) = pack4(v[0], v[1], v[2], v[3]); }
#pragma unroll
            for (int i = 0; i < 4; ++i) cur[i] = nxt[i];
        }
        __syncthreads();
    }
}

DEV bool moe_find_tile(const Params& p, int mtile, int& e, int& lt, int& rowoff, int& cnt) {
    int acc = 0;
    for (int q = 0; q < NEXP; ++q) { const int c = p.cnt[q]; const int nt = (c + 127) >> 7; if (mtile < acc + nt) { e = q; lt = mtile - acc; rowoff = acc * 128; cnt = c; return true; } acc += nt; }
    return false;
}
DEV void ph_moe_up(const Params& p, char* smem) {
    const int tid = threadIdx.x, lane = tid & 63, wid = tid >> 6, wr = wid >> 1, wc = wid & 1, fr = lane & 15, quad = lane >> 4;
    for (int task = blockIdx.x; task < MAXTILES * 8; task += gridDim.x) { const int mtile = task >> 3, nt = task & 7;
        int e, lt, rowoff, cnt; if (!moe_find_tile(p, mtile, e, lt, rowoff, cnt)) break;
        LdGather la; const int lrow = tid >> 3, lc = tid & 7;
#pragma unroll
        for (int i = 0; i < 4; ++i) { int li = lt * 128 + lrow + 32 * i; if (li >= cnt) li = cnt - 1; const int tok = p.elist[(size_t)e * T + li] >> 1; la.rp[i] = p.h2 + (size_t)tok * D + lc * 8; }
        LdPlain lw(p.w13_t + (size_t)e * 1024 * 1024, (size_t)nt * 128, D);
        f32x4 acc[4][4]; zero_acc(acc);
        gemm_tile(acc, lw, la, D / 64, smem);
#pragma unroll
        for (int ni = 0; ni < 4; ++ni) { int li = lt * 128 + wc * 64 + ni * 16 + fr; const bool valid = li < cnt; if (!valid) li = cnt - 1; const float cw = p.ewt[(size_t)e * T + li];
#pragma unroll
            for (int mi = 0; mi < 2; ++mi) { float hv[4];
#pragma unroll
                for (int r = 0; r < 4; ++r) hv[r] = silu_f(acc[mi][ni][r]) * acc[mi + 2][ni][r] * cw;
                const int hidx = nt * 64 + wr * 32 + mi * 16 + quad * 4;
                if (valid) *(us4*)(p.hid + (size_t)(rowoff + lt * 128 + wc * 64 + ni * 16 + fr) * EH + hidx) = pack4(hv[0], hv[1], hv[2], hv[3]); } }
    }
}
DEV void ph_moe_down(const Params& p, char* smem) {
    const int tid = threadIdx.x, lane = tid & 63, wid = tid >> 6, wr = wid >> 1, wc = wid & 1, fr = lane & 15, quad = lane >> 4;
    for (int task = blockIdx.x; task < MAXTILES * 8; task += gridDim.x) { const int mtile = task >> 3, nt = task & 7;
        int e, lt, rowoff, cnt; if (!moe_find_tile(p, mtile, e, lt, rowoff, cnt)) break;
        LdGather la; const int lrow = tid >> 3, lc = tid & 7;
#pragma unroll
        for (int i = 0; i < 4; ++i) { int li = lt * 128 + lrow + 32 * i; if (li >= cnt) li = cnt - 1; la.rp[i] = p.hid + (size_t)(rowoff + li) * EH + lc * 8; }
        LdPlain lw(p.w2_t + (size_t)e * 1024 * EH, (size_t)nt * 128, EH);
        f32x4 acc[4][4]; zero_acc(acc);
        gemm_tile(acc, lw, la, EH / 64, smem);
#pragma unroll
        for (int ni = 0; ni < 4; ++ni) { const int li = lt * 128 + wc * 64 + ni * 16 + fr; if (li < cnt) { const int ts = p.elist[(size_t)e * T + li];
#pragma unroll
            for (int mi = 0; mi < 4; ++mi) *(us4*)(p.ymoe + (size_t)ts * D + nt * 128 + wr * 64 + mi * 16 + quad * 4) = pack4(acc[mi][ni][0], acc[mi][ni][1], acc[mi][ni][2], acc[mi][ni][3]); } }
    }
}
DEV void ph_final(const Params& p, char* smem) {
    const int lane = threadIdx.x & 63, wid = threadIdx.x >> 6;
    for (int row = blockIdx.x * 4 + wid; row < T; row += gridDim.x * 4) { const int b = row / L; const float* g2 = p.mod + (size_t)b * NMODC + 5 * D;
        f32x4 v[4]; float ss = 0.f;
#pragma unroll
        for (int i = 0; i < 4; ++i) { const int k = i * 256 + lane * 4; const f32x4 xv = *(const f32x4*)(p.x1 + (size_t)row * D + k), gv = *(const f32x4*)(g2 + k);
            const us4 y0 = *(const us4*)(p.ymoe + ((size_t)row * 2) * D + k), y1 = *(const us4*)(p.ymoe + ((size_t)row * 2 + 1) * D + k);
#pragma unroll
            for (int e = 0; e < 4; ++e) { v[i][e] = xv[e] + gv[e] * (bf2f(y0[e]) + bf2f(y1[e])); ss += v[i][e] * v[i][e]; } }
        ss = wave_sum(ss); const float rstd = rsqrtf(ss * (1.f / D) + 1e-6f);
#pragma unroll
        for (int i = 0; i < 4; ++i) { const int k = i * 256 + lane * 4; const f32x4 w = *(const f32x4*)(p.final_w + k); *(f32x4*)(p.out + (size_t)row * D + k) = v[i] * rstd * w; }
    }
}


#define XB_TMO      128
#define XB_XCNT(j)  (256  + 64 * (j))
#define XB_XSUB(j)  (1280 + 64 * (j))
#define XB_XGEN(j)  (2304 + 64 * (j))
#define XB_TOP      3328
#define XB_TOPGEN   3392
#define XCD_BAR_WORDS 3456
#ifndef CPU_EMU
#define XB_SPIN_CAP (1u << 22)
#define LAS __attribute__((address_space(3)))
__device__ __forceinline__ unsigned xb_ld(unsigned* p)              { return __hip_atomic_load(p, __ATOMIC_RELAXED, __HIP_MEMORY_SCOPE_AGENT); }
__device__ __forceinline__ unsigned xb_add(unsigned* p, unsigned v) { return __hip_atomic_fetch_add(p, v, __ATOMIC_RELAXED, __HIP_MEMORY_SCOPE_AGENT); }
__device__ __forceinline__ unsigned xb_xcc_id() { return (unsigned)__builtin_amdgcn_s_getreg((3 << 11) | 20) & 0xFu; }
#define XB_SPIN(cond, bar) do { unsigned _sp = 0; while (cond) { __builtin_amdgcn_s_sleep(1); \
    if ((++_sp & 255u) == 0u) { if (xb_ld(&(bar)[XB_TMO])) break; if (_sp > XB_SPIN_CAP) { atomicAdd(&(bar)[XB_TMO], 1u); break; } } } } while (0)
struct XcdBarrier { unsigned* bar; unsigned x; volatile LAS unsigned* st; };
__device__ __forceinline__ XcdBarrier xcd_barrier_post(unsigned* bar, volatile LAS unsigned* st) {
    XcdBarrier b; b.bar = bar; b.x = xb_xcc_id(); b.st = st;
    if (threadIdx.x == 0) (void)xb_add(&bar[XB_XCNT(b.x)], 1u);
    return b;
}
__device__ __forceinline__ void xcd_barrier_complete(unsigned* bar, unsigned x, unsigned& nloc, unsigned& nx) {
    const unsigned G = gridDim.x * gridDim.y * gridDim.z;
    unsigned sum, cnt, mine, sp = 0u;
    for (;;) {
        sum = 0u; cnt = 0u; mine = 0u;
#pragma unroll
        for (unsigned j = 0; j < 16; ++j) { const unsigned c = xb_ld(&bar[XB_XCNT(j)]); sum += c; cnt += (c > 0u) ? 1u : 0u; mine = (j == x) ? c : mine; }
        if (sum == G) break;
        __builtin_amdgcn_s_sleep(1);
        if ((++sp & 255u) == 0u) { if (xb_ld(&bar[XB_TMO])) break; if (sp > XB_SPIN_CAP) { atomicAdd(&bar[XB_TMO], 1u); break; } }
    }
    nloc = mine > 0u ? mine : 1u; nx = cnt > 0u ? cnt : 1u;
}
__device__ __forceinline__ void xcd_barrier(const XcdBarrier& b) {
    asm volatile("s_waitcnt vmcnt(0)" ::: "memory");
    __syncthreads();
    if (threadIdx.x == 0) {
        unsigned* bar = b.bar;
        __builtin_amdgcn_s_waitcnt(0);
        unsigned nloc = b.st[0], nx = b.st[1];
        if (nloc == 0u) { xcd_barrier_complete(bar, b.x, nloc, nx); b.st[0] = nloc; b.st[1] = nx; }
        const unsigned old = xb_add(&bar[XB_XSUB(b.x)], 1u);
        const unsigned gen = old / nloc;
        if (old + 1u == (gen + 1u) * nloc) {
            __builtin_amdgcn_fence(__ATOMIC_RELEASE, "agent");
            asm volatile("s_waitcnt vmcnt(0)" ::: "memory");
            const unsigned og = xb_add(&bar[XB_TOP], 1u);
            const unsigned tg = og / nx;
            if (og + 1u == (tg + 1u) * nx) xb_add(&bar[XB_TOPGEN], 1u);
            else XB_SPIN(xb_ld(&bar[XB_TOPGEN]) == tg, bar);
            __builtin_amdgcn_fence(__ATOMIC_ACQUIRE, "agent");
            xb_add(&bar[XB_XGEN(b.x)], 1u);
            asm volatile("s_waitcnt vmcnt(0)" ::: "memory");
        } else {
            XB_SPIN(xb_ld(&bar[XB_XGEN(b.x)]) == gen, bar);
            __builtin_amdgcn_fence(__ATOMIC_ACQUIRE, "agent");
            asm volatile("s_waitcnt vmcnt(0)" ::: "memory");
        }
    }
    __syncthreads();
}
#endif

#define PHASE_LIST(X) X(ph_prep) X(ph_norm1) X(ph_inproj) X(ph_conv_rstate) X(ph_scan_hynorm) X(ph_rout) X(ph_outproj) X(ph_norm2_router) X(ph_moe_up) X(ph_moe_down)

struct WsBuf { size_t size, off; int p0, p1; };
static size_t fill_params(Params& p, void* const* d_in, void* d_out, void* d_ws, int grid) {
    const float** in = (const float**)d_in;
    p.x = in[0]; p.c = in[1]; p.ctx = in[2]; p.c_ctx = in[3]; p.ada_w = in[4]; p.ada_b = in[5]; p.norm1_w = in[6]; p.w_in = in[7]; p.hy_conv_w = in[8]; p.hy_conv_b = in[9];
    p.f_w1 = in[10]; p.f_b1 = in[11]; p.f_w2 = in[12]; p.f_b2 = in[13]; p.f_w3 = in[14]; p.f_b3 = in[15]; p.f_wout = in[16]; p.f_freq = in[17]; p.hy_skip = in[18]; p.hy_out_norm = in[19];
    p.ret_gn_w = in[20]; p.w_out = in[21]; p.norm2_w = in[22]; p.rg_w = in[23]; p.rg_b = in[24]; p.re_w = in[25]; p.re_b = in[26]; p.exp_w1 = in[27]; p.exp_w3 = in[28]; p.exp_w2 = in[29]; p.final_w = in[30];
    p.out = (float*)d_out;
    char* ws = (char*)d_ws; WsBuf bufs[48]; void** slots[48]; int nb = 0; size_t total = 0;
#define WS(field, type, count, p0, p1) { slots[nb] = (void**)&p.field; bufs[nb] = WsBuf{((sizeof(type) * (size_t)(count)) + 255) & ~(size_t)255, 0, p0, p1}; ++nb; }
    WS(mod, float, (NB + 1) * NMODC, 0, 10); WS(cnt, int, 64, 0, 10); WS(bar, unsigned, XCD_BAR_WORDS, 0, 10); WS(rope, float, 64 * 16 * 2, 0, 2); WS(w_in_t, bf16_t, PC * D, 0, 2); WS(w_out_t, bf16_t, D * D, 0, 6);
    WS(gtap, bf16_t, (size_t)HW * 2 * L, 0, 3);
    WS(hbuf, bf16_t, (size_t)TA * D, 1, 2); WS(RP, float, (size_t)NB * D * 32, 1, 7); WS(cb, float, NB * 32, 1, 7);
    WS(pT, bf16_t, (size_t)1536 * T, 2, 3); WS(qn, bf16_t, (size_t)T * 512, 2, 5); WS(kn, bf16_t, (size_t)T * 512, 2, 5); WS(kT, bf16_t, (size_t)T * 512, 2, 3); WS(vT, bf16_t, (size_t)T * 512, 2, 5);
    WS(ckT, bf16_t, (size_t)TC * 512, 2, 3); WS(cvT, bf16_t, (size_t)TC * 512, 2, 3); WS(gbuf, bf16_t, (size_t)T * 512, 2, 5);
    WS(Kst, float, (size_t)2 * NB * NH * NCT * 16384, 3, 4); WS(yhyT, bf16_t, (size_t)HW * T, 3, 4);
    WS(Sst, bf16_t, (size_t)2 * NB * NH * NCH * 16384, 4, 5); WS(ycat, bf16_t, (size_t)T * D, 4, 6);
    WS(Pscr, bf16_t, (size_t)grid * 16384, 5, 5);
    WS(x1, float, (size_t)T * D, 6, 10); WS(w13_t, bf16_t, (size_t)NEXP * 1024 * 1024, 6, 8); WS(w2_t, bf16_t, (size_t)NEXP * 1024 * EH, 6, 9);
    WS(h2, bf16_t, (size_t)T * D, 7, 8); WS(elist, int, (size_t)NEXP * T, 7, 10); WS(ewt, float, (size_t)NEXP * T, 7, 10); WS(tok_e, int, (size_t)T * 2, 7, 10); WS(tok_pos, int, (size_t)T * 2, 7, 10);
    WS(hid, bf16_t, (size_t)(2 * T + NEXP * 128) * EH, 8, 9); WS(ymoe, bf16_t, (size_t)2 * T * D, 9, 10);
#undef WS
    int order[48]; for (int i = 0; i < nb; ++i) order[i] = i;
    for (int i = 1; i < nb; ++i) { const int v = order[i]; int j = i - 1; while (j >= 0 && bufs[order[j]].size < bufs[v].size) { order[j + 1] = order[j]; --j; } order[j + 1] = v; }
    bool placed[48]; for (int i = 0; i < nb; ++i) placed[i] = false;
    for (int oi = 0; oi < nb; ++oi) { WsBuf& nbuf = bufs[order[oi]]; size_t off = 0;
        for (bool moved = true; moved;) { moved = false;
            for (int i = 0; i < nb; ++i) { if (!placed[i]) continue; const WsBuf& b = bufs[i];
                if (b.p1 < nbuf.p0 || b.p0 > nbuf.p1) continue;
                if (off < b.off + b.size && b.off < off + nbuf.size) { off = b.off + b.size; moved = true; } } }
        nbuf.off = off; placed[order[oi]] = true; *slots[order[oi]] = (void*)(ws + off); if (off + nbuf.size > total) total = off + nbuf.size; }
    return total;
}

#ifndef CPU_EMU
__global__ void __launch_bounds__(NTHR, 2) mega_kernel(Params p) {
    extern __shared__ __attribute__((aligned(16))) char smem[];
    volatile LAS unsigned* st = (volatile LAS unsigned*)(smem + SMEM_BYTES - 16);
    if (threadIdx.x == 0) { st[0] = 0u; st[1] = 0u; }
    __syncthreads();
    const XcdBarrier xb = xcd_barrier_post(p.bar, st);
    if (p.out == nullptr) cg::this_grid().sync();
#define X(f) f(p, smem); xcd_barrier(xb);
    PHASE_LIST(X)
#undef X
    ph_final(p, smem);
}

extern "C" void kernel_launch(void* const* d_in, const int* in_sizes, int n_in, void* d_out, int out_size, void* d_ws, size_t ws_size, hipStream_t stream) {
    static int grid_blocks = 0;
    if (!grid_blocks) {
        int dev = 0, cus = 0, per_cu = 0;
        (void)hipGetDevice(&dev);
        (void)hipDeviceGetAttribute(&cus, hipDeviceAttributeMultiprocessorCount, dev);
        (void)hipFuncSetAttribute((const void*)mega_kernel, hipFuncAttributeMaxDynamicSharedMemorySize, SMEM_BYTES);
        (void)hipOccupancyMaxActiveBlocksPerMultiprocessor(&per_cu, mega_kernel, NTHR, SMEM_BYTES);
        if (per_cu > 2) per_cu = 2;
        if (per_cu < 1) per_cu = 1;
        grid_blocks = cus * per_cu;
    }
    Params p; memset(&p, 0, sizeof(p));
    const size_t need = fill_params(p, d_in, d_out, d_ws, grid_blocks);
    if (need > ws_size) { fprintf(stderr, "workspace too small: need %zu have %zu\n", need, ws_size); return; }
    (void)hipMemsetAsync(p.bar, 0, XCD_BAR_WORDS * sizeof(unsigned), stream);
    void* args[] = {&p};
    hipError_t e = hipLaunchCooperativeKernel((void*)mega_kernel, dim3(grid_blocks), dim3(NTHR), args, SMEM_BYTES, stream);
    if (e != hipSuccess) fprintf(stderr, "cooperative launch failed: %s (grid %d)\n", hipGetErrorString(e), grid_blocks);
}
#endif
```

```cpp
#ifdef CPU_EMU
#include "emu.h"
#else
#include <hip/hip_runtime.h>
#include <hip/hip_cooperative_groups.h>
#include <cstdio>
namespace cg = cooperative_groups;
#endif
#include <stdint.h>
#include <string.h>
#include <math.h>

#ifndef CFG_BATCH
#define CFG_BATCH 8
#endif
#ifndef CFG_SEQ
#define CFG_SEQ 2048
#endif
#ifndef CFG_CTX
#define CFG_CTX 256
#endif

#ifdef CPU_EMU
#define OPAQUE(x)
#define SCHED_FENCE()
#define LDS_AS
#else
#define LDS_AS __attribute__((address_space(3)))
#define OPAQUE(x) asm volatile("" : "+v"(x))
#define SCHED_FENCE() __builtin_amdgcn_sched_barrier(0)
#endif
#define DEV __device__ __forceinline__

typedef unsigned short bf16_t;
typedef short bf16x8 __attribute__((ext_vector_type(8)));
typedef float f32x4 __attribute__((ext_vector_type(4)));
typedef unsigned short us4 __attribute__((ext_vector_type(4)));

constexpr int NB = CFG_BATCH, L = CFG_SEQ, LC = CFG_CTX;
constexpr int D = 1024, T = NB * L, TC = NB * LC, TA = T + TC;
constexpr int HW = 512, NH = 4, DH = 128, CH = 128, PC = 3584, NMODC = 6 * D;
constexpr int NCH = L / CH, NCC = LC / CH, NCT = NCH + NCC;
constexpr int NEXP = 16, EH = 512;
constexpr int UP = L + 64;
constexpr int NTHR = 256;
constexpr int SMEM_BYTES = 77824;
constexpr int MAXTILES = T * 2 / 128 + NEXP;

struct Params {
    const float *x, *c, *ctx, *c_ctx, *ada_w, *ada_b, *norm1_w, *w_in, *hy_conv_w, *hy_conv_b, *f_w1, *f_b1, *f_w2, *f_b2, *f_w3, *f_b3,
        *f_wout, *f_freq, *hy_skip, *hy_out_norm, *ret_gn_w, *w_out, *norm2_w, *rg_w, *rg_b, *re_w, *re_b, *exp_w1, *exp_w3, *exp_w2, *final_w;
    float* out;
    float* mod;
    bf16_t* w_in_t;
    bf16_t* w_out_t;
    bf16_t* w13_t;
    bf16_t* w2_t;
    bf16_t* gtap;
    float* rope;
    bf16_t* hbuf;
    float* RP;
    float* cb;
    bf16_t* pT;
    bf16_t* qn;
    bf16_t* kn;
    bf16_t* kT;
    bf16_t* vT;
    bf16_t* ckT;
    bf16_t* cvT;
    bf16_t* gbuf;
    float* Kst;
    bf16_t* Sst;
    bf16_t* yhyT;
    bf16_t* ycat;
    bf16_t* Pscr;
    float* x1;
    bf16_t* h2;
    unsigned* bar;
    int* cnt;
    int* elist;
    float* ewt;
    int* tok_e;
    int* tok_pos;
    bf16_t* hid;
    bf16_t* ymoe;
};

DEV uint32_t f_as_u(float f) { return __builtin_bit_cast(uint32_t, f); }
DEV float u_as_f(uint32_t u) { return __builtin_bit_cast(float, u); }
DEV float bf2f(bf16_t v) { return u_as_f(((uint32_t)v) << 16); }
DEV bf16_t f2bf(float f) { uint32_t u = f_as_u(f); u += 0x7fffu + ((u >> 16) & 1u); return (bf16_t)(u >> 16); }
DEV us4 pack4(float a, float b, float c, float d) { us4 r; r[0] = f2bf(a); r[1] = f2bf(b); r[2] = f2bf(c); r[3] = f2bf(d); return r; }
DEV float silu_f(float v) { return v / (1.f + expf(-v)); }
DEV float wave_sum(float v) { v += __shfl_xor(v, 1); v += __shfl_xor(v, 2); v += __shfl_xor(v, 4); v += __shfl_xor(v, 8); v += __shfl_xor(v, 16); v += __shfl_xor(v, 32); return v; }
DEV float lg2_gamma(int h, bool bwd) { return log2f(1.f - exp2f(-((bwd ? 5.5f : 5.0f) + (float)h))); }

DEV int stage_chunk() { return ((threadIdx.x & 7) ^ ((threadIdx.x >> 4) & 7)) * 8; }
struct LdPlain {
    static constexpr bool kDirect = true;
    const bf16_t* rp[4];
    DEV LdPlain(const bf16_t* base, size_t row0, size_t ld) { const int lrow = threadIdx.x >> 3, lc = stage_chunk();
#pragma unroll
        for (int i = 0; i < 4; ++i) rp[i] = base + (row0 + lrow + 32 * i) * ld + lc; }
    DEV const bf16_t* src(int i, int kt) const { return rp[i] + kt * 64; }
    DEV bf16x8 ld(int i, int kt) const { return *(const bf16x8*)(rp[i] + kt * 64); }
};
struct LdGather {
    static constexpr bool kDirect = true;
    const bf16_t* rp[4];
    DEV const bf16_t* src(int i, int kt) const { return rp[i] + kt * 64; }
    DEV bf16x8 ld(int i, int kt) const { return *(const bf16x8*)(rp[i] + kt * 64); }
};
struct LdKScale {
    static constexpr bool kDirect = false;
    const bf16_t* rp[4]; float a, b; int lc;
    DEV LdKScale(const bf16_t* base, size_t row0, size_t ld, float a_, float b_) : a(a_), b(b_) { const int lrow = threadIdx.x >> 3; lc = stage_chunk();
#pragma unroll
        for (int i = 0; i < 4; ++i) rp[i] = base + (row0 + lrow + 32 * i) * ld + lc; }
    DEV const bf16_t* src(int i, int kt) const { return rp[i] + kt * 64; }
    DEV bf16x8 ld(int i, int kt) const { bf16x8 v = *(const bf16x8*)(rp[i] + kt * 64); const int k0 = kt * 64 + lc; bf16x8 o;
#pragma unroll
        for (int e = 0; e < 8; ++e) o[e] = (short)f2bf(bf2f((bf16_t)v[e]) * exp2f(a + b * (float)(k0 + e)));
        return o; }
};
struct LdRowScale {
    static constexpr bool kDirect = false;
    const bf16_t* rp[4]; float sc[4];
    DEV LdRowScale(const bf16_t* base, size_t row0, size_t ld, float a, float b) { const int lrow = threadIdx.x >> 3, lc = stage_chunk();
#pragma unroll
        for (int i = 0; i < 4; ++i) { rp[i] = base + (row0 + lrow + 32 * i) * ld + lc; sc[i] = exp2f(a + b * (float)(lrow + 32 * i)); } }
    DEV const bf16_t* src(int i, int kt) const { return rp[i] + kt * 64; }
    DEV bf16x8 ld(int i, int kt) const { bf16x8 v = *(const bf16x8*)(rp[i] + kt * 64); bf16x8 o;
#pragma unroll
        for (int e = 0; e < 8; ++e) o[e] = (short)f2bf(bf2f((bf16_t)v[e]) * sc[i]);
        return o; }
};
#ifdef CPU_EMU
DEV void glds16(const bf16_t* g, char* l) { memcpy(l, g, 16); }
DEV void wait_vm0() {}
#else
DEV void glds16(const bf16_t* g, char* l) { __builtin_amdgcn_global_load_lds((const __attribute__((address_space(1))) void*)g, (__attribute__((address_space(3))) void*)l, 16, 0, 0); }
DEV void wait_vm0() { asm volatile("s_waitcnt vmcnt(0)" ::: "memory"); }
#endif

template <class LX, class LY>
DEV void gemm_tile(f32x4 (&acc)[4][4], const LX& lx, const LY& ly, int nk, char* smem) {
    int tid = threadIdx.x; OPAQUE(tid);
    const int lane = tid & 63, wid = tid >> 6, wr = wid >> 1, wc = wid & 1;
    const int fr = lane & 15, quad = lane >> 4;
    bf16x8 rx[4], ry[4];
    char* const sx = smem + tid * 16; char* const sy = smem + 32768 + tid * 16;
#pragma unroll
    for (int i = 0; i < 4; ++i) {
        if (LX::kDirect) glds16(lx.src(i, 0), sx + i * 4096); else rx[i] = lx.ld(i, 0);
        if (LY::kDirect) glds16(ly.src(i, 0), sy + i * 4096); else ry[i] = ly.ld(i, 0); }
#pragma unroll
    for (int i = 0; i < 4; ++i) { if (!LX::kDirect) *(bf16x8*)(sx + i * 4096) = rx[i]; if (!LY::kDirect) *(bf16x8*)(sy + i * 4096) = ry[i]; }
    wait_vm0();
    __syncthreads();
    const int sw = fr >> 1;
    for (int kt = 0; kt < nk; ++kt) {
        const char* bx = smem + (kt & 1) * 16384; const char* by = smem + 32768 + (kt & 1) * 16384;
        const int nb = ((kt + 1) & 1) * 16384;
        if (kt + 1 < nk) {
#pragma unroll
            for (int i = 0; i < 4; ++i) {
                if (LX::kDirect) glds16(lx.src(i, kt + 1), sx + nb + i * 4096); else rx[i] = lx.ld(i, kt + 1);
                if (LY::kDirect) glds16(ly.src(i, kt + 1), sy + nb + i * 4096); else ry[i] = ly.ld(i, kt + 1); }
        }
        SCHED_FENCE();
#pragma unroll
        for (int kk = 0; kk < 2; ++kk) {
            bf16x8 xf[4], yf[4];
            const int ch = ((kk * 4 + quad) ^ sw) << 4;
#pragma unroll
            for (int mi = 0; mi < 4; ++mi) xf[mi] = *(const bf16x8*)(bx + (wr * 64 + mi * 16 + fr) * 128 + ch);
#pragma unroll
            for (int ni = 0; ni < 4; ++ni) yf[ni] = *(const bf16x8*)(by + (wc * 64 + ni * 16 + fr) * 128 + ch);
#pragma unroll
            for (int mi = 0; mi < 4; ++mi)
#pragma unroll
                for (int ni = 0; ni < 4; ++ni) acc[mi][ni] = __builtin_amdgcn_mfma_f32_16x16x32_bf16(xf[mi], yf[ni], acc[mi][ni], 0, 0, 0);
        }
        SCHED_FENCE();
        if (kt + 1 < nk) {
#pragma unroll
            for (int i = 0; i < 4; ++i) { if (!LX::kDirect) *(bf16x8*)(sx + nb + i * 4096) = rx[i]; if (!LY::kDirect) *(bf16x8*)(sy + nb + i * 4096) = ry[i]; }
        }
        wait_vm0();
        __syncthreads();
    }
}
DEV void zero_acc(f32x4 (&acc)[4][4]) {
#pragma unroll
    for (int i = 0; i < 4; ++i)
#pragma unroll
        for (int j = 0; j < 4; ++j) acc[i][j] = (f32x4){0.f, 0.f, 0.f, 0.f};
}

DEV void task_ada(const Params& p, char* smem, int task) {
    float* sl = (float*)smem;
    float* red = sl + (NB + 1) * D;
    const int tid = threadIdx.x;
    for (int i = tid; i < (NB + 1) * D; i += NTHR) { const int r = i / D, k = i % D; const float v = r < NB ? p.c[r * D + k] : p.c_ctx[k]; sl[i] = silu_f(v); }
    __syncthreads();
    const int col = tid & 31, kq = tid >> 5, j = task * 32 + col;
    float acc[NB + 1];
#pragma unroll
    for (int r = 0; r <= NB; ++r) acc[r] = 0.f;
#pragma unroll 1
    for (int k = kq; k < D; k += 256) { float wv[32];
#pragma unroll
        for (int u = 0; u < 32; ++u) wv[u] = p.ada_w[(size_t)(k + 8 * u) * NMODC + j];
        SCHED_FENCE();
#pragma unroll
        for (int u = 0; u < 32; ++u) {
#pragma unroll
            for (int r = 0; r <= NB; ++r) acc[r] += sl[r * D + k + 8 * u] * wv[u];
            if ((u & 3) == 3) SCHED_FENCE(); } }
#pragma unroll
    for (int r = 0; r <= NB; ++r) red[(kq * (NB + 1) + r) * 32 + col] = acc[r];
    __syncthreads();
    for (int i = tid; i < (NB + 1) * 32; i += NTHR) { const int r = i / 32, cc = i % 32; float s = p.ada_b[task * 32 + cc];
        for (int q = 0; q < 8; ++q) s += red[(q * (NB + 1) + r) * 32 + cc];
        p.mod[r * NMODC + task * 32 + cc] = s; }
    __syncthreads();
}

DEV void transpose_tile(const float* src, int ldn, int k0, int n0, bf16_t* dst, size_t ldk, int mapmode, int which, const float* sc, int scsplit, const float* sc2, char* smem) {
    float* t = (float*)smem;
    const int tid = threadIdx.x;
    { const int r = tid >> 4, c4 = tid & 15;
#pragma unroll
      for (int i = 0; i < 4; ++i) { const int k = r + 16 * i; const f32x4 v = *(const f32x4*)(src + (size_t)(k0 + k) * ldn + n0 + c4 * 4);
          float s = 1.f; if (sc) { const int kk = k0 + k; s = kk < scsplit ? sc[kk] : sc2[kk - scsplit]; }
          t[k * 65 + c4 * 4 + 0] = v[0] * s; t[k * 65 + c4 * 4 + 1] = v[1] * s; t[k * 65 + c4 * 4 + 2] = v[2] * s; t[k * 65 + c4 * 4 + 3] = v[3] * s; } }
    __syncthreads();
    { const int n = tid >> 2, kc = tid & 3; const int nn = n0 + n;
      const int drow = mapmode == 0 ? nn : ((nn >> 6) * 128 + ((nn >> 5) & 1) * 64 + which * 32 + (nn & 31));
#pragma unroll
      for (int h = 0; h < 2; ++h) { bf16x8 o;
#pragma unroll
          for (int e = 0; e < 8; ++e) o[e] = (short)f2bf(t[(kc * 16 + h * 8 + e) * 65 + n]);
          *(bf16x8*)(dst + (size_t)drow * ldk + k0 + kc * 16 + h * 8) = o; } }
    __syncthreads();
}

DEV void task_filt(const Params& p, char* smem, int task) {
    float* z = (float*)smem;
    float* ha = z + 16 * 36;
    float* hb = ha + 16 * 64;
    float* w1 = hb + 16 * 64;
    float* w2 = w1 + 33 * 64;
    float* w3 = w2 + 64 * 64;
    const int tid = threadIdx.x, i0 = task * 16;
    for (int i = tid; i < 33 * 64; i += NTHR) w1[i] = p.f_w1[i];
    for (int i = tid; i < 64 * 64; i += NTHR) { w2[i] = p.f_w2[i]; w3[i] = p.f_w3[i]; }
    for (int i = tid; i < 16 * 33; i += NTHR) { const int pp = i / 33, f = i % 33, pos = i0 + pp; float v;
        if (f == 0) v = (float)pos / (float)(L - 1);
        else { const int bnd = (f - 1) & 15; const float band = 1e-4f + (float)bnd * ((15.f - 1e-4f) / 15.f);
               const float ang = (6.283185307179586f / (float)L) * (float)pos * band; v = f <= 16 ? cosf(ang) : -sinf(ang); }
        z[pp * 36 + f] = v; }
    __syncthreads();
    const int pp = tid >> 4, jq = tid & 15;
#pragma unroll 1
    for (int m = 0; m < 4; ++m) { const int j = jq + 16 * m; float s = p.f_b1[j];
#pragma unroll 3
        for (int k = 0; k < 33; ++k) s += z[pp * 36 + k] * w1[k * 64 + j];
        ha[pp * 64 + j] = sinf(p.f_freq[j] * s); }
    __syncthreads();
#pragma unroll 1
    for (int m = 0; m < 4; ++m) { const int j = jq + 16 * m; float s = p.f_b2[j];
#pragma unroll 4
        for (int k = 0; k < 64; ++k) s += ha[pp * 64 + k] * w2[k * 64 + j];
        hb[pp * 64 + j] = sinf(p.f_freq[j] * s); }
    __syncthreads();
#pragma unroll 1
    for (int m = 0; m < 4; ++m) { const int j = jq + 16 * m; float s = p.f_b3[j];
#pragma unroll 4
        for (int k = 0; k < 64; ++k) s += hb[pp * 64 + k] * w3[k * 64 + j];
        ha[pp * 64 + j] = sinf(p.f_freq[j] * s); }
    __syncthreads();
    const float max_decay = logf(1e-2f) / 0.3f, min_decay = logf(1e-2f) / 1.5f;
#pragma unroll 1
    for (int m = 0; m < 4; ++m) { const int cc = tid + 256 * m; float acc[16];
#pragma unroll
        for (int q = 0; q < 16; ++q) acc[q] = 0.f;
        float wa[16];
#pragma unroll
        for (int kk = 0; kk < 16; ++kk) wa[kk] = p.f_wout[kk * 1024 + cc];
#pragma unroll 1
        for (int k0 = 0; k0 < 64; k0 += 16) {
            float wb[16]; const int kn = k0 + 16 < 64 ? k0 + 16 : k0;
#pragma unroll
            for (int kk = 0; kk < 16; ++kk) wb[kk] = p.f_wout[(kn + kk) * 1024 + cc];
#pragma unroll
            for (int kk = 0; kk < 16; ++kk)
#pragma unroll
                for (int q = 0; q < 16; ++q) acc[q] += ha[q * 64 + k0 + kk] * wa[kk];
#pragma unroll
            for (int kk = 0; kk < 16; ++kk) wa[kk] = wb[kk];
        }
        const int c = cc & 511; const bool isb = cc >= 512;
        const float delta = fabsf(min_decay + (float)c * ((max_decay - min_decay) / 511.f));
#pragma unroll
        for (int q = 0; q < 16; ++q) { const int pos = i0 + q; const float tt = (float)pos / (float)(L - 1); const float win = expf(-tt * delta) + 0.05f; float val = acc[q] * win;
            if (!isb) { if (pos == 0) val += p.hy_skip[c]; p.gtap[(size_t)c * (2 * L) + (L - pos)] = f2bf(val); }
            else { if (pos == 0) p.gtap[(size_t)c * (2 * L)] = 0; else p.gtap[(size_t)c * (2 * L) + (L + pos)] = f2bf(val); } } }
    __syncthreads();
}

constexpr int NT_ADA = NMODC / 32;
constexpr int NT_WIN = 16 * 56, NT_WOUT = 16 * 16, NT_W13 = 16 * 2 * 16 * 8, NT_W2 = 16 * 8 * 16;
constexpr int NT_FILT = L / 16;
constexpr int NT_P0 = NT_ADA + NT_FILT + 1 + NT_WIN + NT_WOUT;

DEV void ph_prep(const Params& p, char* smem) {
    for (int task = blockIdx.x; task < NT_P0; task += gridDim.x) {
        int t = task;
        if (t < NT_ADA) { task_ada(p, smem, t); continue; } t -= NT_ADA;
        if (t < NT_FILT) { task_filt(p, smem, t); continue; } t -= NT_FILT;
        if (t < 1) {
            for (int i = threadIdx.x; i < 64 * 16; i += NTHR) { const int pos = i >> 4, f = i & 15; const float fr = powf(10000.f, -(float)f / 16.f); const float a = (float)pos * fr;
                p.rope[i * 2] = cosf(a); p.rope[i * 2 + 1] = sinf(a); }
            if (threadIdx.x < 32) p.cnt[threadIdx.x] = 0;
            continue; } t -= 1;
        if (t < NT_WIN) { const int kt = t / 56, nt = t % 56; transpose_tile(p.w_in, PC, kt * 64, nt * 64, p.w_in_t, 1024, 0, 0, nullptr, 0, nullptr, smem); continue; } t -= NT_WIN;
        { const int kt = t / 16, nt = t % 16; transpose_tile(p.w_out, D, kt * 64, nt * 64, p.w_out_t, 1024, 0, 0, p.hy_out_norm, 512, p.ret_gn_w, smem); }
    }
}
DEV void expert_conv_task(const Params& p, char* smem, int t) {
    if (t < NT_W13) { const int e = t / 256, r = t % 256, which = r / 128, r2 = r % 128, kt = r2 / 8, nt = r2 % 8;
        transpose_tile((which ? p.exp_w3 : p.exp_w1) + (size_t)e * D * EH, EH, kt * 64, nt * 64, p.w13_t + (size_t)e * 1024 * 1024, 1024, 1, which, nullptr, 0, nullptr, smem); return; }
    t -= NT_W13;
    { const int e = t / 128, r = t % 128, kt = r / 16, nt = r % 16;
        transpose_tile(p.exp_w2 + (size_t)e * EH * D, D, kt * 64, nt * 64, p.w2_t + (size_t)e * 1024 * EH, EH, 0, 0, nullptr, 0, nullptr, smem); }
}

DEV void ph_norm1(const Params& p, char* smem) {
    const int tid = threadIdx.x, lane = tid & 63, wid = tid >> 6;
    {
        const int rstep = gridDim.x * 4; int row = blockIdx.x * 4 + wid;
        f32x4 w4[4];
#pragma unroll
        for (int i = 0; i < 4; ++i) w4[i] = *(const f32x4*)(p.norm1_w + i * 256 + lane * 4);
        f32x4 cur[4];
        if (row < TA) { const float* src = row < T ? p.x + (size_t)row * D : p.ctx + (size_t)(row - T) * D;
#pragma unroll
            for (int i = 0; i < 4; ++i) cur[i] = *(const f32x4*)(src + i * 256 + lane * 4); }
#pragma unroll 1
        for (; row < TA; row += rstep) {
            const int nrow = row + rstep < TA ? row + rstep : row;
            const float* nsrc = nrow < T ? p.x + (size_t)nrow * D : p.ctx + (size_t)(nrow - T) * D;
            f32x4 nxt[4];
#pragma unroll
            for (int i = 0; i < 4; ++i) nxt[i] = *(const f32x4*)(nsrc + i * 256 + lane * 4);
            const int mb = row < T ? row / L : NB;
            const float* sh = p.mod + (size_t)mb * NMODC; const float* sc = sh + D;
            f32x4 s1[4], s0[4];
#pragma unroll
            for (int i = 0; i < 4; ++i) { s1[i] = *(const f32x4*)(sc + i * 256 + lane * 4); s0[i] = *(const f32x4*)(sh + i * 256 + lane * 4); }
            float ss = 0.f;
#pragma unroll
            for (int i = 0; i < 4; ++i) ss += cur[i][0] * cur[i][0] + cur[i][1] * cur[i][1] + cur[i][2] * cur[i][2] + cur[i][3] * cur[i][3];
            ss = wave_sum(ss);
            const float rstd = rsqrtf(ss * (1.f / D) + 1e-6f);
#pragma unroll
            for (int i = 0; i < 4; ++i) { const int k = i * 256 + lane * 4; const f32x4 v = cur[i] * rstd * w4[i] * (1.f + s1[i]) + s0[i];
                *(us4*)(p.hbuf + (size_t)row * D + k) = pack4(v[0], v[1], v[2], v[3]); }
#pragma unroll
            for (int i = 0; i < 4; ++i) cur[i] = nxt[i];
        }
    }
    const int gtid = blockIdx.x * NTHR + tid, gn = gridDim.x * NTHR;
    for (int i = gtid; i < NB * D * 32; i += gn) { const int ii = i & 3, j = (i >> 2) & 31, k4 = (i >> 7) & 255, b = i >> 15; const int k = k4 * 4 + ii;
        const float r = j < 4 ? p.rg_w[k * 4 + j] : (j < 20 ? p.re_w[k * 16 + (j - 4)] : 0.f);
        p.RP[i] = p.norm2_w[k] * (1.f + p.mod[(size_t)b * NMODC + 4 * D + k]) * r; }
    for (int wt = blockIdx.x * 4 + wid; wt < NB * 32; wt += gridDim.x * 4) { const int b = wt >> 5, j = wt & 31; float s = 0.f;
        if (j < 20) for (int k = lane; k < D; k += 64) { const float r = j < 4 ? p.rg_w[k * 4 + j] : p.re_w[k * 16 + (j - 4)]; s += p.mod[(size_t)b * NMODC + 3 * D + k] * r; }
        s = wave_sum(s);
        if (lane == 0) p.cb[wt] = j < 4 ? s + p.rg_b[j] : (j < 20 ? s + p.re_b[j - 4] : 0.f); }
}

constexpr int NT_INP = (T / 128) * 28 + (TC / 128) * 8;
DEV void inproj_tile(const Params& p, char* smem, int mt, int nt) {
    int tid = threadIdx.x; OPAQUE(tid);
    const int lane = tid & 63, wid = tid >> 6, wr = wid >> 1, wc = wid & 1, fr = lane & 15, quad = lane >> 4;
    const size_t row0 = (size_t)mt * 128;
    const bool is_ctx = mt >= T / 128;
    const bool actX = (nt < 12) || (nt >= 16 && nt < 24);
    f32x4 acc[4][4]; zero_acc(acc);
    LdPlain la(p.hbuf, row0, D), lw(p.w_in_t, (size_t)nt * 128, D);
    if (actX) gemm_tile(acc, la, lw, D / 64, smem); else gemm_tile(acc, lw, la, D / 64, smem);
    if (nt < 12) {
#pragma unroll
        for (int mi = 0; mi < 4; ++mi)
#pragma unroll
            for (int ni = 0; ni < 4; ++ni) { const size_t tok = row0 + wr * 64 + mi * 16 + quad * 4; const int c = nt * 128 + wc * 64 + ni * 16 + fr;
                *(us4*)(p.pT + (size_t)c * T + tok) = pack4(acc[mi][ni][0], acc[mi][ni][1], acc[mi][ni][2], acc[mi][ni][3]); }
    } else if (nt >= 16 && nt < 24) {
        const bool isk = nt < 20; const int h = (nt - 16) & 3;
        if (!is_ctx) {
            const int b = (int)(row0 / L), tl0 = (int)(row0 % L);
            if (isk) {
                if (wc == 0) {
#pragma unroll
                    for (int mi = 0; mi < 4; ++mi)
#pragma unroll
                        for (int r = 0; r < 4; ++r) { const int tl = tl0 + wr * 64 + mi * 16 + quad * 4 + r;
                            { const float* cs = p.rope + ((tl >> 6) * 16 + fr) * 2; const float a = acc[mi][0][r], bq = acc[mi][1][r]; acc[mi][0][r] = a * cs[0] - bq * cs[1]; acc[mi][1][r] = a * cs[1] + bq * cs[0]; }
                            { const float* cs = p.rope + ((tl & 63) * 16 + fr) * 2; const float a = acc[mi][2][r], bq = acc[mi][3][r]; acc[mi][2][r] = a * cs[0] - bq * cs[1]; acc[mi][3][r] = a * cs[1] + bq * cs[0]; } }
                }
                const float scl = 0.08838834764831845f;
#pragma unroll
                for (int mi = 0; mi < 4; ++mi)
#pragma unroll
                    for (int ni = 0; ni < 4; ++ni) { const int tl = tl0 + wr * 64 + mi * 16 + quad * 4, d = wc * 64 + ni * 16 + fr; const size_t bh = (size_t)b * NH + h;
                        const us4 o = pack4(acc[mi][ni][0] * scl, acc[mi][ni][1] * scl, acc[mi][ni][2] * scl, acc[mi][ni][3] * scl);
                        *(us4*)(p.kT + (bh * 128 + d) * L + tl) = o;
#pragma unroll
                        for (int r = 0; r < 4; ++r) p.kn[(bh * L + tl + r) * 128 + d] = o[r]; }
            } else {
#pragma unroll
                for (int mi = 0; mi < 4; ++mi)
#pragma unroll
                    for (int ni = 0; ni < 4; ++ni) { const int tl = tl0 + wr * 64 + mi * 16 + quad * 4, d = wc * 64 + ni * 16 + fr; const size_t bh = (size_t)b * NH + h;
                        *(us4*)(p.vT + (bh * 128 + d) * L + tl) = pack4(acc[mi][ni][0], acc[mi][ni][1], acc[mi][ni][2], acc[mi][ni][3]); }
            }
        } else {
            const size_t cr0 = row0 - T; const int b = (int)(cr0 / LC), tl0 = (int)(cr0 % LC); const float scl = isk ? 0.08838834764831845f : 1.f;
            bf16_t* dst = isk ? p.ckT : p.cvT;
#pragma unroll
            for (int mi = 0; mi < 4; ++mi)
#pragma unroll
                for (int ni = 0; ni < 4; ++ni) { const int tl = tl0 + wr * 64 + mi * 16 + quad * 4, d = wc * 64 + ni * 16 + fr; const size_t bh = (size_t)b * NH + h;
                    *(us4*)(dst + (bh * 128 + d) * LC + tl) = pack4(acc[mi][ni][0] * scl, acc[mi][ni][1] * scl, acc[mi][ni][2] * scl, acc[mi][ni][3] * scl); }
        }
    } else if (nt < 16) {
        const int h = nt - 12; const int b = (int)(row0 / L), tl0 = (int)(row0 % L);
        if (wr == 0) {
#pragma unroll
            for (int ni = 0; ni < 4; ++ni) { const int tl = tl0 + wc * 64 + ni * 16 + fr;
#pragma unroll
                for (int r = 0; r < 4; ++r) { const int j = quad * 4 + r;
                    { const float* cs = p.rope + ((tl >> 6) * 16 + j) * 2; const float a = acc[0][ni][r], bq = acc[1][ni][r]; acc[0][ni][r] = a * cs[0] - bq * cs[1]; acc[1][ni][r] = a * cs[1] + bq * cs[0]; }
                    { const float* cs = p.rope + ((tl & 63) * 16 + j) * 2; const float a = acc[2][ni][r], bq = acc[3][ni][r]; acc[2][ni][r] = a * cs[0] - bq * cs[1]; acc[3][ni][r] = a * cs[1] + bq * cs[0]; } } }
        }
#pragma unroll
        for (int mi = 0; mi < 4; ++mi)
#pragma unroll
            for (int ni = 0; ni < 4; ++ni) { const int tl = tl0 + wc * 64 + ni * 16 + fr, d = wr * 64 + mi * 16 + quad * 4; const size_t bh = (size_t)b * NH + h;
                *(us4*)(p.qn + (bh * L + tl) * 128 + d) = pack4(acc[mi][ni][0], acc[mi][ni][1], acc[mi][ni][2], acc[mi][ni][3]); }
    } else {
#pragma unroll
        for (int mi = 0; mi < 4; ++mi)
#pragma unroll
            for (int ni = 0; ni < 4; ++ni) { const size_t tok = row0 + wc * 64 + ni * 16 + fr; const int d = (nt - 24) * 128 + wr * 64 + mi * 16 + quad * 4;
                *(us4*)(p.gbuf + tok * 512 + d) = pack4(acc[mi][ni][0], acc[mi][ni][1], acc[mi][ni][2], acc[mi][ni][3]); }
    }
}
DEV void ph_inproj(const Params& p, char* smem) {
    for (int task = blockIdx.x; task < NT_INP; task += gridDim.x) {
        if (task < (T / 128) * 28) inproj_tile(p, smem, task / 28, task % 28);
        else { const int t = task - (T / 128) * 28; inproj_tile(p, smem, T / 128 + t / 8, 16 + t % 8); }
    }
}

constexpr int NU = L / 64, UPW = NU / 4;
typedef unsigned u32x2 __attribute__((ext_vector_type(2)));
typedef unsigned u32x4 __attribute__((ext_vector_type(4)));
constexpr int TAPC = 2 * L + 16;
DEV bf16x8 conv_afrag(const bf16_t* tcp, int m0a) {
    const u32x2 lo = *(const volatile LDS_AS u32x2*)(tcp + m0a), hi = *(const volatile LDS_AS u32x2*)(tcp + m0a + 4);
    const u32x4 v = {lo[0], lo[1], hi[0], hi[1]};
    return __builtin_bit_cast(bf16x8, v); }
DEV void conv3_w(const Params& p, int ch, float& w0, float& w1, float& w2, float& bs) { w0 = p.hy_conv_w[ch]; w1 = p.hy_conv_w[1536 + ch]; w2 = p.hy_conv_w[3072 + ch]; bs = p.hy_conv_b[ch]; }

DEV void conv_task(const Params& p, char* smem, int c) {
    bf16_t* taps = (bf16_t*)smem;
    bf16_t* U = taps + 4 * TAPC;
    int tid = threadIdx.x; OPAQUE(tid);
    const int lane = tid & 63, w = tid >> 6, fr = lane & 15, quad = lane >> 4;
    for (int i = tid; i < 2 * L / 8; i += NTHR) { const bf16x8 v = *(const bf16x8*)(p.gtap + (size_t)c * 2 * L + i * 8);
        *(bf16x8*)(taps + i * 8) = v;
#pragma unroll
        for (int a = 1; a < 4; ++a)
#pragma unroll
            for (int e = 0; e < 8; ++e) { const int q = i * 8 + e - a; if (q >= 0) taps[a * TAPC + q] = (bf16_t)v[e]; } }
    for (int i = tid; i < 8 * UP / 8; i += NTHR) *(bf16x8*)(U + i * 8) = (bf16x8){0, 0, 0, 0, 0, 0, 0, 0};
    __syncthreads();
    { float a0, a1, a2, ab, v0, v1, v2, vb; conv3_w(p, 512 + c, a0, a1, a2, ab); conv3_w(p, 1024 + c, v0, v1, v2, vb);
      for (int g = tid; g < NB * (L / 8); g += NTHR) { const int b = g / (L / 8), t8 = (g % (L / 8)) * 8;
          const bf16_t* r1 = p.pT + (size_t)(512 + c) * T + (size_t)b * L + t8; const bf16_t* rv = p.pT + (size_t)(1024 + c) * T + (size_t)b * L + t8;
          const bf16x8 x1v = *(const bf16x8*)r1, vv = *(const bf16x8*)rv;
          float px[10], pv[10];
          px[0] = t8 > 0 ? bf2f(r1[-1]) : 0.f; pv[0] = t8 > 0 ? bf2f(rv[-1]) : 0.f;
          px[9] = t8 + 8 < L ? bf2f(r1[8]) : 0.f; pv[9] = t8 + 8 < L ? bf2f(rv[8]) : 0.f;
#pragma unroll
          for (int e = 0; e < 8; ++e) { px[e + 1] = bf2f((bf16_t)x1v[e]); pv[e + 1] = bf2f((bf16_t)vv[e]); }
          bf16x8 o;
#pragma unroll
          for (int e = 0; e < 8; ++e) { const float x1 = a0 * px[e] + a1 * px[e + 1] + a2 * px[e + 2] + ab; const float vq = v0 * pv[e] + v1 * pv[e + 1] + v2 * pv[e + 2] + vb; o[e] = (short)f2bf(x1 * vq); }
          *(bf16x8*)(U + b * UP + 32 + t8) = o; } }
    __syncthreads();
    f32x4 acc[2][UPW];
#pragma unroll
    for (int tp = 0; tp < 2; ++tp)
#pragma unroll
        for (int ui = 0; ui < UPW; ++ui) acc[tp][ui] = (f32x4){0.f, 0.f, 0.f, 0.f};
    const int bcol = fr & 7, i2 = fr >> 3;
    const bf16_t* Ub = U + bcol * UP + 32 + 32 * i2 + 8 * quad;
    const int al = (L - fr) & 3;
    const bf16_t* tcp = taps + al * TAPC;
    const int mbase = L - fr + 8 * quad - 64 * (UPW * w) - al;
#pragma unroll 1
    for (int jp = 1; jp >= 0; --jp) {
        bf16x8 af[2][UPW];
        int J0 = jp ? -1 : 0;
        if (jp) {
            const bf16x8 bfr = *(const bf16x8*)(Ub + 32 * J0);
#pragma unroll
            for (int tp = 0; tp < 2; ++tp)
#pragma unroll
                for (int ui = 0; ui < UPW; ++ui) { const bf16x8 a = conv_afrag(tcp, mbase - 64 * ui - 16 * tp + 32 * J0); acc[tp][ui] = __builtin_amdgcn_mfma_f32_16x16x32_bf16(a, bfr, acc[tp][ui], 0, 0, 0); }
            J0 = 1;
        }
#pragma unroll
        for (int tp = 0; tp < 2; ++tp)
#pragma unroll
            for (int ui = 0; ui < UPW; ++ui) af[tp][ui] = conv_afrag(tcp, mbase - 64 * ui - 16 * tp + 32 * J0);
#pragma unroll 1
        for (int grp = 0; grp < 4; ++grp) {
#pragma unroll
            for (int s = 0; s < UPW; ++s) {
                const bf16x8 bfr = *(const bf16x8*)(Ub + 32 * J0);
#pragma unroll
                for (int tp = 0; tp < 2; ++tp)
#pragma unroll
                    for (int ui = 0; ui < UPW; ++ui) acc[tp][ui] = __builtin_amdgcn_mfma_f32_16x16x32_bf16(af[tp][(ui - s + UPW) % UPW], bfr, acc[tp][ui], 0, 0, 0);
                J0 += 2;
                if (grp < 3 || s < UPW - 1) {
#pragma unroll
                    for (int tp = 0; tp < 2; ++tp) af[tp][(UPW - 1 - s) % UPW] = conv_afrag(tcp, mbase - 16 * tp + 32 * J0);
                }
            }
        }
    }
    float w0, w1, w2, wb; conv3_w(p, c, w0, w1, w2, wb);
    if (bcol < NB) {
#pragma unroll
        for (int tp = 0; tp < 2; ++tp)
#pragma unroll
            for (int ui = 0; ui < UPW; ++ui) { const int I0 = 4 * (UPW * w + ui) + tp; const int t = 16 * (I0 + 2 * i2) + 4 * quad;
                const bf16_t* r0 = p.pT + (size_t)c * T + (size_t)bcol * L + t; const us4 cv = *(const us4*)r0;
                float pq[6]; pq[0] = t > 0 ? bf2f(r0[-1]) : 0.f; pq[5] = t + 4 < L ? bf2f(r0[4]) : 0.f;
#pragma unroll
                for (int e = 0; e < 4; ++e) pq[e + 1] = bf2f(cv[e]);
                float y[4];
#pragma unroll
                for (int e = 0; e < 4; ++e) y[e] = (w0 * pq[e] + w1 * pq[e + 1] + w2 * pq[e + 2] + wb) * acc[tp][ui][e];
                *(us4*)(p.yhyT + (size_t)c * T + (size_t)bcol * L + t) = pack4(y[0], y[1], y[2], y[3]);
                if (ui & 1) SCHED_FENCE(); }
    }
    __syncthreads();
}

DEV void rstate_task(const Params& p, char* smem, int task) {
    const int bh = task / NCT, J = task % NCT, h = bh % NH;
    int tid = threadIdx.x; OPAQUE(tid);
    const int lane = tid & 63, wid = tid >> 6, wr = wid >> 1, wc = wid & 1, fr = lane & 15, quad = lane >> 4;
    const bf16_t *kb, *vb; size_t ld; int col0;
    if (J < NCC) { kb = p.ckT + (size_t)bh * 128 * LC; vb = p.cvT + (size_t)bh * 128 * LC; ld = LC; col0 = J * 128; }
    else { kb = p.kT + (size_t)bh * 128 * L; vb = p.vT + (size_t)bh * 128 * L; ld = L; col0 = (J - NCC) * 128; }
#pragma unroll 1
    for (int dir = 0; dir < 2; ++dir) {
        const float lg = lg2_gamma(h, dir == 1);
        f32x4 acc[4][4]; zero_acc(acc);
        LdKScale lk(kb + col0, 0, ld, dir == 0 ? 127.f * lg : 0.f, dir == 0 ? -lg : lg);
        LdPlain lv(vb + col0, 0, ld);
        gemm_tile(acc, lk, lv, 2, smem);
        float* dst = p.Kst + (((size_t)dir * NB * NH + bh) * NCT + J) * 16384;
#pragma unroll
        for (int mi = 0; mi < 4; ++mi)
#pragma unroll
            for (int ni = 0; ni < 4; ++ni) { const int d = wr * 64 + mi * 16 + quad * 4, e = wc * 64 + ni * 16 + fr; *(f32x4*)(dst + e * 128 + d) = acc[mi][ni]; }
    }
}
constexpr int NT_RST = NB * NH * NCT;
DEV void ph_conv_rstate(const Params& p, char* smem) {
    for (int task = blockIdx.x; task < HW + NT_RST; task += gridDim.x) {
        if (task < HW) conv_task(p, smem, task); else rstate_task(p, smem, task - HW);
    }
}

DEV void hynorm_task(const Params& p, char* smem, int task) {
    bf16_t* tl = (bf16_t*)smem;
    const int tid = threadIdx.x; const size_t pos0 = (size_t)task * 64;
    for (int half = 0; half < 2; ++half) { const int c = tid + 256 * half; const bf16_t* src = p.yhyT + (size_t)c * T + pos0;
#pragma unroll
        for (int q = 0; q < 8; ++q) { const bf16x8 v = *(const bf16x8*)(src + q * 8);
#pragma unroll
            for (int e = 0; e < 8; ++e) tl[(q * 8 + e) * 520 + c] = (bf16_t)v[e]; } }
    __syncthreads();
    const int pos = tid >> 2, part = tid & 3;
    float ss = 0.f;
    for (int q = 0; q < 16; ++q) { const bf16x8 v = *(const bf16x8*)(tl + pos * 520 + part * 128 + q * 8);
#pragma unroll
        for (int e = 0; e < 8; ++e) { const float f = bf2f((bf16_t)v[e]); ss += f * f; } }
    ss += __shfl_xor(ss, 1); ss += __shfl_xor(ss, 2);
    const float rstd = rsqrtf(ss * (1.f / 512.f) + 1e-6f);
    for (int q = 0; q < 16; ++q) { const bf16x8 v = *(const bf16x8*)(tl + pos * 520 + part * 128 + q * 8); bf16x8 o;
#pragma unroll
        for (int e = 0; e < 8; ++e) o[e] = (short)f2bf(bf2f((bf16_t)v[e]) * rstd);
        *(bf16x8*)(p.ycat + (pos0 + pos) * 1024 + part * 128 + q * 8) = o; }
    __syncthreads();
}
DEV void ph_scan_hynorm(const Params& p, char* smem) {
    const size_t gtid = (size_t)blockIdx.x * NTHR + threadIdx.x, gn = (size_t)gridDim.x * NTHR;
    for (size_t i = gtid; i < (size_t)2 * NB * NH * 16384; i += gn) {
        const int ed = (int)(i & 16383); const int bh = (int)((i >> 14) % (NB * NH)); const int dir = (int)(i / ((size_t)NB * NH * 16384));
        const float gch = exp2f(128.f * lg2_gamma(bh % NH, dir == 1));
        const float* ks = p.Kst + (((size_t)dir * NB * NH + bh) * NCT) * 16384 + ed;
        bf16_t* so = p.Sst + (((size_t)dir * NB * NH + bh) * NCH) * 16384 + ed;
        float kv[NCT];
#pragma unroll
        for (int J = 0; J < NCT; ++J) kv[J] = ks[(size_t)J * 16384];
        float s = 0.f;
        if (dir == 0) {
#pragma unroll
            for (int J = 0; J < NCC; ++J) s = s * gch + kv[J];
#pragma unroll
            for (int I = 0; I < NCH; ++I) { so[(size_t)I * 16384] = f2bf(s); s = s * gch + kv[NCC + I]; } }
        else {
#pragma unroll
            for (int J = NCC - 1; J >= 0; --J) s = s * gch + kv[J];
#pragma unroll
            for (int I = NCH - 1; I >= 0; --I) { so[(size_t)I * 16384] = f2bf(s); s = s * gch + kv[NCC + I]; } }
    }
    for (int task = blockIdx.x; task < T / 64; task += gridDim.x) hynorm_task(p, smem, task);
}

DEV void rout_task(const Params& p, char* smem, int task) {
    const int bh = task / NCH, I = task % NCH, h = bh % NH, b = bh / NH;
    int tid = threadIdx.x; OPAQUE(tid);
    const int lane = tid & 63, wid = tid >> 6, wr = wid >> 1, wc = wid & 1, fr = lane & 15, quad = lane >> 4;
    const float lgf = lg2_gamma(h, false), lgb = lg2_gamma(h, true);
    bf16_t* P = p.Pscr + (size_t)blockIdx.x * 16384;
    const bf16_t* qb = p.qn + ((size_t)bh * L + I * 128) * 128; const bf16_t* kb = p.kn + ((size_t)bh * L + I * 128) * 128;
    {
        f32x4 acc[4][4]; zero_acc(acc);
        LdPlain lk(kb, 0, 128), lq(qb, 0, 128);
        gemm_tile(acc, lk, lq, 2, smem);
#pragma unroll
        for (int mi = 0; mi < 4; ++mi)
#pragma unroll
            for (int ni = 0; ni < 4; ++ni) { const int i = wc * 64 + ni * 16 + fr, j0 = wr * 64 + mi * 16 + quad * 4; float v[4];
#pragma unroll
                for (int r = 0; r < 4; ++r) { const int j = j0 + r; const float dcy = i > j ? exp2f(lgf * (float)(i - j)) : (i == j ? 2.f : exp2f(lgb * (float)(j - i))); v[r] = acc[mi][ni][r] * dcy; }
                *(us4*)(P + i * 128 + j0) = pack4(v[0], v[1], v[2], v[3]); }
    }
    __syncthreads();
    f32x4 acc[4][4]; zero_acc(acc);
    {
        LdPlain lv(p.vT + (size_t)bh * 128 * L + I * 128, 0, L), lp(P, 0, 128);
        gemm_tile(acc, lv, lp, 2, smem);
    }
    {
        LdPlain ls(p.Sst + (((size_t)0 * NB * NH + bh) * NCH + I) * 16384, 0, 128); LdRowScale lq(qb, 0, 128, lgf, lgf);
        gemm_tile(acc, ls, lq, 2, smem);
    }
    {
        LdPlain ls(p.Sst + (((size_t)1 * NB * NH + bh) * NCH + I) * 16384, 0, 128); LdRowScale lq(qb, 0, 128, 128.f * lgb, -lgb);
        gemm_tile(acc, ls, lq, 2, smem);
    }
    float* red = (float*)smem;
    float mean[4], rstd[4];
#pragma unroll
    for (int ni = 0; ni < 4; ++ni) { float s = 0.f, ss = 0.f;
#pragma unroll
        for (int mi = 0; mi < 4; ++mi)
#pragma unroll
            for (int r = 0; r < 4; ++r) { const float v = acc[mi][ni][r]; s += v; ss += v * v; }
        s += __shfl_xor(s, 16); s += __shfl_xor(s, 32); ss += __shfl_xor(ss, 16); ss += __shfl_xor(ss, 32);
        if (quad == 0) { const int i = wc * 64 + ni * 16 + fr; red[(wr * 128 + i) * 2] = s; red[(wr * 128 + i) * 2 + 1] = ss; } }
    __syncthreads();
#pragma unroll
    for (int ni = 0; ni < 4; ++ni) { const int i = wc * 64 + ni * 16 + fr; const float s = red[i * 2] + red[(128 + i) * 2], ss = red[i * 2 + 1] + red[(128 + i) * 2 + 1];
        mean[ni] = s * (1.f / 128.f); const float var = ss * (1.f / 128.f) - mean[ni] * mean[ni]; rstd[ni] = rsqrtf(fmaxf(var, 0.f) + 1e-6f); }
#pragma unroll
    for (int mi = 0; mi < 4; ++mi)
#pragma unroll
        for (int ni = 0; ni < 4; ++ni) { const int i = wc * 64 + ni * 16 + fr, e = wr * 64 + mi * 16 + quad * 4; const size_t tok = (size_t)b * L + I * 128 + i;
            const us4 gv = *(const us4*)(p.gbuf + tok * 512 + h * 128 + e); float y[4];
#pragma unroll
            for (int r = 0; r < 4; ++r) y[r] = (acc[mi][ni][r] - mean[ni]) * rstd[ni] * silu_f(bf2f(gv[r]));
            *(us4*)(p.ycat + tok * 1024 + 512 + h * 128 + e) = pack4(y[0], y[1], y[2], y[3]); }
    __syncthreads();
}
DEV void ph_rout(const Params& p, char* smem) {
#pragma unroll 1
    for (int task = blockIdx.x; task < NB * NH * NCH; task += gridDim.x) rout_task(p, smem, task); }

DEV void ph_outproj(const Params& p, char* smem) {
    const int lane = threadIdx.x & 63, wid = threadIdx.x >> 6, wr = wid >> 1, wc = wid & 1, fr = lane & 15, quad = lane >> 4;
    for (int task = blockIdx.x; task < (T / 128) * 8 + NT_W13 + NT_W2; task += gridDim.x) {
        if (task >= (T / 128) * 8) { expert_conv_task(p, smem, task - (T / 128) * 8); continue; }
        const int mt = task / 8, nt = task % 8;
        f32x4 acc[4][4]; zero_acc(acc);
        LdPlain lw(p.w_out_t, (size_t)nt * 128, D), la(p.ycat, (size_t)mt * 128, D);
        gemm_tile(acc, lw, la, D / 64, smem);
        const int b = (mt * 128) / L; const float* g1 = p.mod + (size_t)b * NMODC + 2 * D;
#pragma unroll
        for (int mi = 0; mi < 4; ++mi)
#pragma unroll
            for (int ni = 0; ni < 4; ++ni) { const size_t tok = (size_t)mt * 128 + wc * 64 + ni * 16 + fr; const int col = nt * 128 + wr * 64 + mi * 16 + quad * 4;
                const f32x4 xv = *(const f32x4*)(p.x + tok * D + col), gv = *(const f32x4*)(g1 + col);
                *(f32x4*)(p.x1 + tok * D + col) = xv + gv * acc[mi][ni]; }
    }
}

DEV void ph_norm2_router(const Params& p, char* smem) {
    const int tid = threadIdx.x, lane = tid & 63, wid = tid >> 6, fr = lane & 15, quad = lane >> 4;
    float* lgs = (float*)smem + wid * (16 * 33);
    float* rs = (float*)smem + 4 * 16 * 33 + wid * 16;
    for (int wt = blockIdx.x * 4 + wid; wt < T / 16; wt += gridDim.x * 4) {
        const size_t row0 = (size_t)wt * 16; const int b = (int)(row0 / L);
        const float* xr = p.x1 + (row0 + fr) * D + quad * 4;
        const float* rp = p.RP + (size_t)b * D * 32;
        f32x4 a0 = {0.f, 0.f, 0.f, 0.f}, a1 = a0; float ss = 0.f;
        const float* rpl = rp + ((size_t)quad * 32 + fr) * 4;
        f32x4 xv[4], b0[4], b1[4];
#pragma unroll
        for (int u = 0; u < 4; ++u) { xv[u] = *(const f32x4*)(xr + u * 16); b0[u] = *(const f32x4*)(rpl + (size_t)u * 512); b1[u] = *(const f32x4*)(rpl + (size_t)u * 512 + 64); }
#pragma unroll 1
        for (int k0 = 0; k0 < D; k0 += 64) {
            f32x4 xn[4], c0[4], c1[4];
            const int kn = k0 + 64 < D ? k0 + 64 : k0;
#pragma unroll
            for (int u = 0; u < 4; ++u) { xn[u] = *(const f32x4*)(xr + kn + u * 16); c0[u] = *(const f32x4*)(rpl + (size_t)(kn / 4 + u * 4) * 128); c1[u] = *(const f32x4*)(rpl + (size_t)(kn / 4 + u * 4) * 128 + 64); }
#pragma unroll
            for (int u = 0; u < 4; ++u) {
                ss += xv[u][0] * xv[u][0] + xv[u][1] * xv[u][1] + xv[u][2] * xv[u][2] + xv[u][3] * xv[u][3];
#pragma unroll
                for (int i = 0; i < 4; ++i) { a0 = __builtin_amdgcn_mfma_f32_16x16x4f32(xv[u][i], b0[u][i], a0, 0, 0, 0); a1 = __builtin_amdgcn_mfma_f32_16x16x4f32(xv[u][i], b1[u][i], a1, 0, 0, 0); }
            }
#pragma unroll
            for (int u = 0; u < 4; ++u) { xv[u] = xn[u]; b0[u] = c0[u]; b1[u] = c1[u]; }
        }
        ss += __shfl_xor(ss, 16); ss += __shfl_xor(ss, 32);
        const float rstd = rsqrtf(ss * (1.f / D) + 1e-6f);
        if (quad == 0) rs[fr] = rstd;
#pragma unroll
        for (int r = 0; r < 4; ++r) { lgs[(quad * 4 + r) * 33 + fr] = a0[r]; lgs[(quad * 4 + r) * 33 + 16 + fr] = a1[r]; }
        __syncthreads();
        if (lane < 16) {
            const size_t tok = row0 + lane; const float rsd = rs[lane]; float lg[20];
#pragma unroll
            for (int j = 0; j < 20; ++j) lg[j] = lgs[lane * 33 + j] * rsd + p.cb[b * 32 + j];
            int g = 0; float gm = lg[0];
#pragma unroll
            for (int j = 1; j < 4; ++j) if (lg[j] > gm) { gm = lg[j]; g = j; }
            float den = 0.f;
#pragma unroll
            for (int j = 0; j < 4; ++j) den += expf(lg[j] - gm);
            const float psel = 1.f / den;
            float le[4];
#pragma unroll
            for (int j = 0; j < 4; ++j) le[j] = g == 0 ? lg[4 + j] : (g == 1 ? lg[8 + j] : (g == 2 ? lg[12 + j] : lg[16 + j]));
            int i0 = 0; float m0 = le[0];
#pragma unroll
            for (int j = 1; j < 4; ++j) if (le[j] > m0) { m0 = le[j]; i0 = j; }
            int i1 = -1; float m1 = -3.0e38f;
#pragma unroll
            for (int j = 0; j < 4; ++j) if (j != i0 && le[j] > m1) { m1 = le[j]; i1 = j; }
            const float ex = expf(m1 - m0); const float w0 = psel / (1.f + ex), w1 = psel * ex / (1.f + ex);
            const int e0 = g * 4 + i0, e1 = g * 4 + i1;
            const int p0 = atomicAdd(p.cnt + e0, 1), p1 = atomicAdd(p.cnt + e1, 1);
            p.elist[(size_t)e0 * T + p0] = (int)tok * 2; p.ewt[(size_t)e0 * T + p0] = w0;
            p.elist[(size_t)e1 * T + p1] = (int)tok * 2 + 1; p.ewt[(size_t)e1 * T + p1] = w1;
            p.tok_e[tok * 2] = e0; p.tok_e[tok * 2 + 1] = e1; p.tok_pos[tok * 2] = p0; p.tok_pos[tok * 2 + 1] = p1;
        }
        const float* sh = p.mod + (size_t)b * NMODC + 3 * D; const float* sc = sh + D;
        f32x4 wm[4], sa[4];
#pragma unroll
        for (int i = 0; i < 4; ++i) { const int k = i * 256 + lane * 4; const f32x4 w = *(const f32x4*)(p.norm2_w + k), s1 = *(const f32x4*)(sc + k); sa[i] = *(const f32x4*)(sh + k); wm[i] = w * (1.f + s1); }
        f32x4 cur[4];
#pragma unroll
        for (int i = 0; i < 4; ++i) cur[i] = *(const f32x4*)(p.x1 + row0 * D + i * 256 + lane * 4);
#pragma unroll 1
        for (int r = 0; r < 16; ++r) { const float rsd = rs[r]; f32x4 nxt[4]; const int rn = r < 15 ? r + 1 : r;
#pragma unroll
            for (int i = 0; i < 4; ++i) nxt[i] = *(const f32x4*)(p.x1 + (row0 + rn) * D + i * 256 + lane * 4);
#pragma unroll
            for (int i = 0; i < 4; ++i) { const int k = i * 256 + lane * 4; const f32x4 v = cur[i] * rsd * wm[i] + sa[i];
                *(us4*)(p.h2 + (row0 + r) * D + k) = pack4(v[0], v[1], v[2], v[3]); }
#pragma unroll
            for (int i = 0; i < 4; ++i) cur[i] = nxt[i];
        }
        __syncthreads();
    }
}

DEV bool moe_find_tile(const Params& p, int mtile, int& e, int& lt, int& rowoff, int& cnt) {
    int acc = 0;
    for (int q = 0; q < NEXP; ++q) { const int c = p.cnt[q]; const int nt = (c + 127) >> 7; if (mtile < acc + nt) { e = q; lt = mtile - acc; rowoff = acc * 128; cnt = c; return true; } acc += nt; }
    return false;
}
DEV void ph_moe_up(const Params& p, char* smem) {
    const int tid = threadIdx.x, lane = tid & 63, wid = tid >> 6, wr = wid >> 1, wc = wid & 1, fr = lane & 15, quad = lane >> 4;
    for (int task = blockIdx.x; task < MAXTILES * 8; task += gridDim.x) { const int mtile = task >> 3, nt = task & 7;
        int e, lt, rowoff, cnt; if (!moe_find_tile(p, mtile, e, lt, rowoff, cnt)) break;
        LdGather la; const int lrow = tid >> 3, lc = stage_chunk();
#pragma unroll
        for (int i = 0; i < 4; ++i) { int li = lt * 128 + lrow + 32 * i; if (li >= cnt) li = cnt - 1; const int tok = p.elist[(size_t)e * T + li] >> 1; la.rp[i] = p.h2 + (size_t)tok * D + lc; }
        LdPlain lw(p.w13_t + (size_t)e * 1024 * 1024, (size_t)nt * 128, D);
        f32x4 acc[4][4]; zero_acc(acc);
        gemm_tile(acc, lw, la, D / 64, smem);
#pragma unroll
        for (int ni = 0; ni < 4; ++ni) { int li = lt * 128 + wc * 64 + ni * 16 + fr; const bool valid = li < cnt; if (!valid) li = cnt - 1; const float cw = p.ewt[(size_t)e * T + li];
#pragma unroll
            for (int mi = 0; mi < 2; ++mi) { float hv[4];
#pragma unroll
                for (int r = 0; r < 4; ++r) hv[r] = silu_f(acc[mi][ni][r]) * acc[mi + 2][ni][r] * cw;
                const int hidx = nt * 64 + wr * 32 + mi * 16 + quad * 4;
                if (valid) *(us4*)(p.hid + (size_t)(rowoff + lt * 128 + wc * 64 + ni * 16 + fr) * EH + hidx) = pack4(hv[0], hv[1], hv[2], hv[3]); } }
    }
}
DEV void ph_moe_down(const Params& p, char* smem) {
    const int tid = threadIdx.x, lane = tid & 63, wid = tid >> 6, wr = wid >> 1, wc = wid & 1, fr = lane & 15, quad = lane >> 4;
    for (int task = blockIdx.x; task < MAXTILES * 8; task += gridDim.x) { const int mtile = task >> 3, nt = task & 7;
        int e, lt, rowoff, cnt; if (!moe_find_tile(p, mtile, e, lt, rowoff, cnt)) break;
        LdGather la; const int lrow = tid >> 3, lc = stage_chunk();
#pragma unroll
        for (int i = 0; i < 4; ++i) { int li = lt * 128 + lrow + 32 * i; if (li >= cnt) li = cnt - 1; la.rp[i] = p.hid + (size_t)(rowoff + li) * EH + lc; }
        LdPlain lw(p.w2_t + (size_t)e * 1024 * EH, (size_t)nt * 128, EH);
        f32x4 acc[4][4]; zero_acc(acc);
        gemm_tile(acc, lw, la, EH / 64, smem);
#pragma unroll
        for (int ni = 0; ni < 4; ++ni) { const int li = lt * 128 + wc * 64 + ni * 16 + fr; if (li < cnt) { const int ts = p.elist[(size_t)e * T + li];
#pragma unroll
            for (int mi = 0; mi < 4; ++mi) *(us4*)(p.ymoe + (size_t)ts * D + nt * 128 + wr * 64 + mi * 16 + quad * 4) = pack4(acc[mi][ni][0], acc[mi][ni][1], acc[mi][ni][2], acc[mi][ni][3]); } }
    }
}
DEV void ph_final(const Params& p, char* smem) {
    const int lane = threadIdx.x & 63, wid = threadIdx.x >> 6;
    for (int row = blockIdx.x * 4 + wid; row < T; row += gridDim.x * 4) { const int b = row / L; const float* g2 = p.mod + (size_t)b * NMODC + 5 * D;
        f32x4 v[4]; float ss = 0.f;
#pragma unroll
        for (int i = 0; i < 4; ++i) { const int k = i * 256 + lane * 4; const f32x4 xv = *(const f32x4*)(p.x1 + (size_t)row * D + k), gv = *(const f32x4*)(g2 + k);
            const us4 y0 = *(const us4*)(p.ymoe + ((size_t)row * 2) * D + k), y1 = *(const us4*)(p.ymoe + ((size_t)row * 2 + 1) * D + k);
#pragma unroll
            for (int e = 0; e < 4; ++e) { v[i][e] = xv[e] + gv[e] * (bf2f(y0[e]) + bf2f(y1[e])); ss += v[i][e] * v[i][e]; } }
        ss = wave_sum(ss); const float rstd = rsqrtf(ss * (1.f / D) + 1e-6f);
#pragma unroll
        for (int i = 0; i < 4; ++i) { const int k = i * 256 + lane * 4; const f32x4 w = *(const f32x4*)(p.final_w + k); *(f32x4*)(p.out + (size_t)row * D + k) = v[i] * rstd * w; }
    }
}


#define XB_TMO      128
#define XB_XCNT(j)  (256  + 64 * (j))
#define XB_XSUB(j)  (1280 + 64 * (j))
#define XB_XGEN(j)  (2304 + 64 * (j))
#define XB_TOP      3328
#define XB_TOPGEN   3392
#define XCD_BAR_WORDS 3456
#ifndef CPU_EMU
#define XB_SPIN_CAP (1u << 22)
#define LAS __attribute__((address_space(3)))
__device__ __forceinline__ unsigned xb_ld(unsigned* p)              { return __hip_atomic_load(p, __ATOMIC_RELAXED, __HIP_MEMORY_SCOPE_AGENT); }
__device__ __forceinline__ unsigned xb_add(unsigned* p, unsigned v) { return __hip_atomic_fetch_add(p, v, __ATOMIC_RELAXED, __HIP_MEMORY_SCOPE_AGENT); }
__device__ __forceinline__ unsigned xb_xcc_id() { return (unsigned)__builtin_amdgcn_s_getreg((3 << 11) | 20) & 0xFu; }
#define XB_SPIN(cond, bar) do { unsigned _sp = 0; while (cond) { __builtin_amdgcn_s_sleep(1); \
    if ((++_sp & 255u) == 0u) { if (xb_ld(&(bar)[XB_TMO])) break; if (_sp > XB_SPIN_CAP) { atomicAdd(&(bar)[XB_TMO], 1u); break; } } } } while (0)
struct XcdBarrier { unsigned* bar; unsigned x; volatile LAS unsigned* st; };
__device__ __forceinline__ XcdBarrier xcd_barrier_post(unsigned* bar, volatile LAS unsigned* st) {
    XcdBarrier b; b.bar = bar; b.x = xb_xcc_id(); b.st = st;
    if (threadIdx.x == 0) (void)xb_add(&bar[XB_XCNT(b.x)], 1u);
    return b;
}
__device__ __forceinline__ void xcd_barrier_complete(unsigned* bar, unsigned x, unsigned& nloc, unsigned& nx) {
    const unsigned G = gridDim.x * gridDim.y * gridDim.z;
    unsigned sum, cnt, mine, sp = 0u;
    for (;;) {
        sum = 0u; cnt = 0u; mine = 0u;
#pragma unroll
        for (unsigned j = 0; j < 16; ++j) { const unsigned c = xb_ld(&bar[XB_XCNT(j)]); sum += c; cnt += (c > 0u) ? 1u : 0u; mine = (j == x) ? c : mine; }
        if (sum == G) break;
        __builtin_amdgcn_s_sleep(1);
        if ((++sp & 255u) == 0u) { if (xb_ld(&bar[XB_TMO])) break; if (sp > XB_SPIN_CAP) { atomicAdd(&bar[XB_TMO], 1u); break; } }
    }
    nloc = mine > 0u ? mine : 1u; nx = cnt > 0u ? cnt : 1u;
}
__device__ __forceinline__ void xcd_barrier(const XcdBarrier& b) {
    asm volatile("s_waitcnt vmcnt(0)" ::: "memory");
    __syncthreads();
    if (threadIdx.x == 0) {
        unsigned* bar = b.bar;
        __builtin_amdgcn_s_waitcnt(0);
        unsigned nloc = b.st[0], nx = b.st[1];
        if (nloc == 0u) { xcd_barrier_complete(bar, b.x, nloc, nx); b.st[0] = nloc; b.st[1] = nx; }
        const unsigned old = xb_add(&bar[XB_XSUB(b.x)], 1u);
        const unsigned gen = old / nloc;
        if (old + 1u == (gen + 1u) * nloc) {
            __builtin_amdgcn_fence(__ATOMIC_RELEASE, "agent");
            asm volatile("s_waitcnt vmcnt(0)" ::: "memory");
            const unsigned og = xb_add(&bar[XB_TOP], 1u);
            const unsigned tg = og / nx;
            if (og + 1u == (tg + 1u) * nx) xb_add(&bar[XB_TOPGEN], 1u);
            else XB_SPIN(xb_ld(&bar[XB_TOPGEN]) == tg, bar);
            __builtin_amdgcn_fence(__ATOMIC_ACQUIRE, "agent");
            xb_add(&bar[XB_XGEN(b.x)], 1u);
            asm volatile("s_waitcnt vmcnt(0)" ::: "memory");
        } else {
            XB_SPIN(xb_ld(&bar[XB_XGEN(b.x)]) == gen, bar);
            __builtin_amdgcn_fence(__ATOMIC_ACQUIRE, "agent");
            asm volatile("s_waitcnt vmcnt(0)" ::: "memory");
        }
    }
    __syncthreads();
}
#endif

#define PHASE_LIST(X) X(ph_prep) X(ph_norm1) X(ph_inproj) X(ph_conv_rstate) X(ph_scan_hynorm) X(ph_rout) X(ph_outproj) X(ph_norm2_router) X(ph_moe_up) X(ph_moe_down)

struct WsBuf { size_t size, off; int p0, p1; };
static size_t fill_params(Params& p, void* const* d_in, void* d_out, void* d_ws, int grid) {
    const float** in = (const float**)d_in;
    p.x = in[0]; p.c = in[1]; p.ctx = in[2]; p.c_ctx = in[3]; p.ada_w = in[4]; p.ada_b = in[5]; p.norm1_w = in[6]; p.w_in = in[7]; p.hy_conv_w = in[8]; p.hy_conv_b = in[9];
    p.f_w1 = in[10]; p.f_b1 = in[11]; p.f_w2 = in[12]; p.f_b2 = in[13]; p.f_w3 = in[14]; p.f_b3 = in[15]; p.f_wout = in[16]; p.f_freq = in[17]; p.hy_skip = in[18]; p.hy_out_norm = in[19];
    p.ret_gn_w = in[20]; p.w_out = in[21]; p.norm2_w = in[22]; p.rg_w = in[23]; p.rg_b = in[24]; p.re_w = in[25]; p.re_b = in[26]; p.exp_w1 = in[27]; p.exp_w3 = in[28]; p.exp_w2 = in[29]; p.final_w = in[30];
    p.out = (float*)d_out;
    char* ws = (char*)d_ws; WsBuf bufs[48]; void** slots[48]; int nb = 0; size_t total = 0;
#define WS(field, type, count, p0, p1) { slots[nb] = (void**)&p.field; bufs[nb] = WsBuf{((sizeof(type) * (size_t)(count)) + 255) & ~(size_t)255, 0, p0, p1}; ++nb; }
    WS(mod, float, (NB + 1) * NMODC, 0, 10); WS(cnt, int, 64, 0, 10); WS(bar, unsigned, XCD_BAR_WORDS, 0, 10); WS(rope, float, 64 * 16 * 2, 0, 2); WS(w_in_t, bf16_t, PC * D, 0, 2); WS(w_out_t, bf16_t, D * D, 0, 6);
    WS(gtap, bf16_t, (size_t)HW * 2 * L, 0, 3);
    WS(hbuf, bf16_t, (size_t)TA * D, 1, 2); WS(RP, float, (size_t)NB * D * 32, 1, 7); WS(cb, float, NB * 32, 1, 7);
    WS(pT, bf16_t, (size_t)1536 * T, 2, 3); WS(qn, bf16_t, (size_t)T * 512, 2, 5); WS(kn, bf16_t, (size_t)T * 512, 2, 5); WS(kT, bf16_t, (size_t)T * 512, 2, 3); WS(vT, bf16_t, (size_t)T * 512, 2, 5);
    WS(ckT, bf16_t, (size_t)TC * 512, 2, 3); WS(cvT, bf16_t, (size_t)TC * 512, 2, 3); WS(gbuf, bf16_t, (size_t)T * 512, 2, 5);
    WS(Kst, float, (size_t)2 * NB * NH * NCT * 16384, 3, 4); WS(yhyT, bf16_t, (size_t)HW * T, 3, 4);
    WS(Sst, bf16_t, (size_t)2 * NB * NH * NCH * 16384, 4, 5); WS(ycat, bf16_t, (size_t)T * D, 4, 6);
    WS(Pscr, bf16_t, (size_t)grid * 16384, 5, 5);
    WS(x1, float, (size_t)T * D, 6, 10); WS(w13_t, bf16_t, (size_t)NEXP * 1024 * 1024, 6, 8); WS(w2_t, bf16_t, (size_t)NEXP * 1024 * EH, 6, 9);
    WS(h2, bf16_t, (size_t)T * D, 7, 8); WS(elist, int, (size_t)NEXP * T, 7, 10); WS(ewt, float, (size_t)NEXP * T, 7, 10); WS(tok_e, int, (size_t)T * 2, 7, 10); WS(tok_pos, int, (size_t)T * 2, 7, 10);
    WS(hid, bf16_t, (size_t)(2 * T + NEXP * 128) * EH, 8, 9); WS(ymoe, bf16_t, (size_t)2 * T * D, 9, 10);
#undef WS
    int order[48]; for (int i = 0; i < nb; ++i) order[i] = i;
    for (int i = 1; i < nb; ++i) { const int v = order[i]; int j = i - 1; while (j >= 0 && bufs[order[j]].size < bufs[v].size) { order[j + 1] = order[j]; --j; } order[j + 1] = v; }
    bool placed[48]; for (int i = 0; i < nb; ++i) placed[i] = false;
    for (int oi = 0; oi < nb; ++oi) { WsBuf& nbuf = bufs[order[oi]]; size_t off = 0;
        for (bool moved = true; moved;) { moved = false;
            for (int i = 0; i < nb; ++i) { if (!placed[i]) continue; const WsBuf& b = bufs[i];
                if (b.p1 < nbuf.p0 || b.p0 > nbuf.p1) continue;
                if (off < b.off + b.size && b.off < off + nbuf.size) { off = b.off + b.size; moved = true; } } }
        nbuf.off = off; placed[order[oi]] = true; *slots[order[oi]] = (void*)(ws + off); if (off + nbuf.size > total) total = off + nbuf.size; }
    return total;
}

#ifndef CPU_EMU
__global__ void __launch_bounds__(NTHR, 2) mega_kernel(Params p) {
    extern __shared__ __attribute__((aligned(16))) char smem[];
    volatile LAS unsigned* st = (volatile LAS unsigned*)(smem + SMEM_BYTES - 16);
    if (threadIdx.x == 0) { st[0] = 0u; st[1] = 0u; }
    __syncthreads();
    const XcdBarrier xb = xcd_barrier_post(p.bar, st);
    if (p.out == nullptr) cg::this_grid().sync();
#define X(f) f(p, smem); xcd_barrier(xb);
    PHASE_LIST(X)
#undef X
    ph_final(p, smem);
}

extern "C" void kernel_launch(void* const* d_in, const int* in_sizes, int n_in, void* d_out, int out_size, void* d_ws, size_t ws_size, hipStream_t stream) {
    static int grid_blocks = 0;
    if (!grid_blocks) {
        int dev = 0, cus = 0, per_cu = 0;
        (void)hipGetDevice(&dev);
        (void)hipDeviceGetAttribute(&cus, hipDeviceAttributeMultiprocessorCount, dev);
        (void)hipFuncSetAttribute((const void*)mega_kernel, hipFuncAttributeMaxDynamicSharedMemorySize, SMEM_BYTES);
        (void)hipOccupancyMaxActiveBlocksPerMultiprocessor(&per_cu, mega_kernel, NTHR, SMEM_BYTES);
        if (per_cu > 2) per_cu = 2;
        if (per_cu < 1) per_cu = 1;
        grid_blocks = cus * per_cu;
    }
    Params p; memset(&p, 0, sizeof(p));
    const size_t need = fill_params(p, d_in, d_out, d_ws, grid_blocks);
    if (need > ws_size) { fprintf(stderr, "workspace too small: need %zu have %zu\n", need, ws_size); return; }
    (void)hipMemsetAsync(p.bar, 0, XCD_BAR_WORDS * sizeof(unsigned), stream);
    void* args[] = {&p};
    hipError_t e = hipLaunchCooperativeKernel((void*)mega_kernel, dim3(grid_blocks), dim3(NTHR), args, SMEM_BYTES, stream);
    if (e != hipSuccess) fprintf(stderr, "cooperative launch failed: %s (grid %d)\n", hipGetErrorString(e), grid_blocks);
}
#endif
```

```cpp
#ifdef CPU_EMU
#include "emu.h"
#else
#include <hip/hip_runtime.h>
#include <hip/hip_cooperative_groups.h>
#include <cstdio>
namespace cg = cooperative_groups;
#endif
#include <stdint.h>
#include <string.h>
#include <math.h>

#ifndef CFG_BATCH
#define CFG_BATCH 8
#endif
#ifndef CFG_SEQ
#define CFG_SEQ 2048
#endif
#ifndef CFG_CTX
#define CFG_CTX 256
#endif

#ifdef CPU_EMU
#define OPAQUE(x)
#define SCHED_FENCE()
#define LDS_AS
#else
#define LDS_AS __attribute__((address_space(3)))
#define OPAQUE(x) asm volatile("" : "+v"(x))
#define SCHED_FENCE() __builtin_amdgcn_sched_barrier(0)
#endif
#define DEV __device__ __forceinline__

typedef unsigned short bf16_t;
typedef short bf16x8 __attribute__((ext_vector_type(8)));
typedef float f32x4 __attribute__((ext_vector_type(4)));
typedef unsigned short us4 __attribute__((ext_vector_type(4)));

constexpr int NB = CFG_BATCH, L = CFG_SEQ, LC = CFG_CTX;
constexpr int D = 1024, T = NB * L, TC = NB * LC, TA = T + TC;
constexpr int HW = 512, NH = 4, DH = 128, CH = 128, PC = 3584, NMODC = 6 * D;
constexpr int NCH = L / CH, NCC = LC / CH, NCT = NCH + NCC;
constexpr int NEXP = 16, EH = 512;
constexpr int UP = L + 64;
constexpr int NTHR = 256;
constexpr int SMEM_BYTES = 77824;
constexpr int MAXTILES = T * 2 / 128 + NEXP;

struct Params {
    const float *x, *c, *ctx, *c_ctx, *ada_w, *ada_b, *norm1_w, *w_in, *hy_conv_w, *hy_conv_b, *f_w1, *f_b1, *f_w2, *f_b2, *f_w3, *f_b3,
        *f_wout, *f_freq, *hy_skip, *hy_out_norm, *ret_gn_w, *w_out, *norm2_w, *rg_w, *rg_b, *re_w, *re_b, *exp_w1, *exp_w3, *exp_w2, *final_w;
    float* out;
    float* mod;
    bf16_t* w_in_t;
    bf16_t* w_out_t;
    bf16_t* w13_t;
    bf16_t* w2_t;
    bf16_t* gtap;
    float* rope;
    bf16_t* hbuf;
    float* RP;
    float* cb;
    bf16_t* pT;
    bf16_t* qn;
    bf16_t* kn;
    bf16_t* kTf;
    bf16_t* kTb;
    bf16_t* vT;
    bf16_t* ckTf;
    bf16_t* ckTb;
    bf16_t* cvT;
    bf16_t* gbuf;
    bf16_t* Sst;
    bf16_t* yhyT;
    bf16_t* ycat;
    bf16_t* Pscr;
    float* x1;
    bf16_t* h2;
    unsigned* bar;
    int* cnt;
    int* elist;
    float* ewt;
    int* tok_e;
    int* tok_pos;
    bf16_t* hid;
    bf16_t* ymoe;
};

DEV uint32_t f_as_u(float f) { return __builtin_bit_cast(uint32_t, f); }
DEV float u_as_f(uint32_t u) { return __builtin_bit_cast(float, u); }
DEV float bf2f(bf16_t v) { return u_as_f(((uint32_t)v) << 16); }
DEV bf16_t f2bf(float f) { uint32_t u = f_as_u(f); u += 0x7fffu + ((u >> 16) & 1u); return (bf16_t)(u >> 16); }
DEV us4 pack4(float a, float b, float c, float d) { us4 r; r[0] = f2bf(a); r[1] = f2bf(b); r[2] = f2bf(c); r[3] = f2bf(d); return r; }
DEV float silu_f(float v) { return v / (1.f + expf(-v)); }
DEV float wave_sum(float v) { v += __shfl_xor(v, 1); v += __shfl_xor(v, 2); v += __shfl_xor(v, 4); v += __shfl_xor(v, 8); v += __shfl_xor(v, 16); v += __shfl_xor(v, 32); return v; }
DEV float lg2_gamma(int h, bool bwd) { return log2f(1.f - exp2f(-((bwd ? 5.5f : 5.0f) + (float)h))); }

DEV int stage_chunk() { return ((threadIdx.x & 7) ^ ((threadIdx.x >> 4) & 7)) * 8; }
struct LdPlain {
    static constexpr bool kDirect = true;
    const bf16_t* rp[4];
    DEV LdPlain(const bf16_t* base, size_t row0, size_t ld) { const int lrow = threadIdx.x >> 3, lc = stage_chunk();
#pragma unroll
        for (int i = 0; i < 4; ++i) rp[i] = base + (row0 + lrow + 32 * i) * ld + lc; }
    DEV const bf16_t* src(int i, int kt) const { return rp[i] + kt * 64; }
    DEV bf16x8 ld(int i, int kt) const { return *(const bf16x8*)(rp[i] + kt * 64); }
};
struct LdGather {
    static constexpr bool kDirect = true;
    const bf16_t* rp[4];
    DEV const bf16_t* src(int i, int kt) const { return rp[i] + kt * 64; }
    DEV bf16x8 ld(int i, int kt) const { return *(const bf16x8*)(rp[i] + kt * 64); }
};
struct LdKScale {
    static constexpr bool kDirect = false;
    const bf16_t* rp[4]; float a, b; int lc;
    DEV LdKScale(const bf16_t* base, size_t row0, size_t ld, float a_, float b_) : a(a_), b(b_) { const int lrow = threadIdx.x >> 3; lc = stage_chunk();
#pragma unroll
        for (int i = 0; i < 4; ++i) rp[i] = base + (row0 + lrow + 32 * i) * ld + lc; }
    DEV const bf16_t* src(int i, int kt) const { return rp[i] + kt * 64; }
    DEV bf16x8 ld(int i, int kt) const { bf16x8 v = *(const bf16x8*)(rp[i] + kt * 64); const int k0 = kt * 64 + lc; bf16x8 o;
#pragma unroll
        for (int e = 0; e < 8; ++e) o[e] = (short)f2bf(bf2f((bf16_t)v[e]) * exp2f(a + b * (float)(k0 + e)));
        return o; }
};
struct LdRowScale {
    static constexpr bool kDirect = false;
    const bf16_t* rp[4]; float sc[4];
    DEV LdRowScale(const bf16_t* base, size_t row0, size_t ld, float a, float b) { const int lrow = threadIdx.x >> 3, lc = stage_chunk();
#pragma unroll
        for (int i = 0; i < 4; ++i) { rp[i] = base + (row0 + lrow + 32 * i) * ld + lc; sc[i] = exp2f(a + b * (float)(lrow + 32 * i)); } }
    DEV const bf16_t* src(int i, int kt) const { return rp[i] + kt * 64; }
    DEV bf16x8 ld(int i, int kt) const { bf16x8 v = *(const bf16x8*)(rp[i] + kt * 64); bf16x8 o;
#pragma unroll
        for (int e = 0; e < 8; ++e) o[e] = (short)f2bf(bf2f((bf16_t)v[e]) * sc[i]);
        return o; }
};
#ifdef CPU_EMU
DEV void glds16(const bf16_t* g, char* l) { memcpy(l, g, 16); }
DEV void wait_vm0() {}
#else
DEV void glds16(const bf16_t* g, char* l) { __builtin_amdgcn_global_load_lds((const __attribute__((address_space(1))) void*)g, (__attribute__((address_space(3))) void*)l, 16, 0, 0); }
DEV void wait_vm0() { asm volatile("s_waitcnt vmcnt(0)" ::: "memory"); }
#endif

struct NoHook { DEV void operator()(int, f32x4 (&)[4][4]) const {} };
template <class LX, class LY, class HK>
DEV void gemm_tile_h(f32x4 (&acc)[4][4], const LX& lx, const LY& ly, int nk, char* smem, const HK& hook) {
    int tid = threadIdx.x; OPAQUE(tid);
    const int lane = tid & 63, wid = tid >> 6, wr = wid >> 1, wc = wid & 1;
    const int fr = lane & 15, quad = lane >> 4;
    bf16x8 rx[4], ry[4];
    char* const sx = smem + tid * 16; char* const sy = smem + 32768 + tid * 16;
#pragma unroll
    for (int i = 0; i < 4; ++i) {
        if (LX::kDirect) glds16(lx.src(i, 0), sx + i * 4096); else rx[i] = lx.ld(i, 0);
        if (LY::kDirect) glds16(ly.src(i, 0), sy + i * 4096); else ry[i] = ly.ld(i, 0); }
#pragma unroll
    for (int i = 0; i < 4; ++i) { if (!LX::kDirect) *(bf16x8*)(sx + i * 4096) = rx[i]; if (!LY::kDirect) *(bf16x8*)(sy + i * 4096) = ry[i]; }
    wait_vm0();
    __syncthreads();
    const int sw = fr >> 1;
    for (int kt = 0; kt < nk; ++kt) {
        const char* bx = smem + (kt & 1) * 16384; const char* by = smem + 32768 + (kt & 1) * 16384;
        const int nb = ((kt + 1) & 1) * 16384;
        if (kt + 1 < nk) {
#pragma unroll
            for (int i = 0; i < 4; ++i) {
                if (LX::kDirect) glds16(lx.src(i, kt + 1), sx + nb + i * 4096); else rx[i] = lx.ld(i, kt + 1);
                if (LY::kDirect) glds16(ly.src(i, kt + 1), sy + nb + i * 4096); else ry[i] = ly.ld(i, kt + 1); }
        }
        hook(kt, acc);
        SCHED_FENCE();
#pragma unroll
        for (int kk = 0; kk < 2; ++kk) {
            bf16x8 xf[4], yf[4];
            const int ch = ((kk * 4 + quad) ^ sw) << 4;
#pragma unroll
            for (int mi = 0; mi < 4; ++mi) xf[mi] = *(const bf16x8*)(bx + (wr * 64 + mi * 16 + fr) * 128 + ch);
#pragma unroll
            for (int ni = 0; ni < 4; ++ni) yf[ni] = *(const bf16x8*)(by + (wc * 64 + ni * 16 + fr) * 128 + ch);
#pragma unroll
            for (int mi = 0; mi < 4; ++mi)
#pragma unroll
                for (int ni = 0; ni < 4; ++ni) acc[mi][ni] = __builtin_amdgcn_mfma_f32_16x16x32_bf16(xf[mi], yf[ni], acc[mi][ni], 0, 0, 0);
        }
        SCHED_FENCE();
        if (kt + 1 < nk) {
#pragma unroll
            for (int i = 0; i < 4; ++i) { if (!LX::kDirect) *(bf16x8*)(sx + nb + i * 4096) = rx[i]; if (!LY::kDirect) *(bf16x8*)(sy + nb + i * 4096) = ry[i]; }
        }
        wait_vm0();
        __syncthreads();
    }
}
template <class LX, class LY>
DEV void gemm_tile(f32x4 (&acc)[4][4], const LX& lx, const LY& ly, int nk, char* smem) { gemm_tile_h(acc, lx, ly, nk, smem, NoHook()); }
DEV void zero_acc(f32x4 (&acc)[4][4]) {
#pragma unroll
    for (int i = 0; i < 4; ++i)
#pragma unroll
        for (int j = 0; j < 4; ++j) acc[i][j] = (f32x4){0.f, 0.f, 0.f, 0.f};
}

DEV void task_ada(const Params& p, char* smem, int task) {
    float* sl = (float*)smem;
    float* red = sl + (NB + 1) * D;
    const int tid = threadIdx.x;
    for (int i = tid; i < (NB + 1) * D; i += NTHR) { const int r = i / D, k = i % D; const float v = r < NB ? p.c[r * D + k] : p.c_ctx[k]; sl[i] = silu_f(v); }
    __syncthreads();
    const int col = tid & 31, kq = tid >> 5, j = task * 32 + col;
    float acc[NB + 1];
#pragma unroll
    for (int r = 0; r <= NB; ++r) acc[r] = 0.f;
#pragma unroll 1
    for (int k = kq; k < D; k += 256) { float wv[32];
#pragma unroll
        for (int u = 0; u < 32; ++u) wv[u] = p.ada_w[(size_t)(k + 8 * u) * NMODC + j];
        SCHED_FENCE();
#pragma unroll
        for (int u = 0; u < 32; ++u) {
#pragma unroll
            for (int r = 0; r <= NB; ++r) acc[r] += sl[r * D + k + 8 * u] * wv[u];
            if ((u & 3) == 3) SCHED_FENCE(); } }
#pragma unroll
    for (int r = 0; r <= NB; ++r) red[(kq * (NB + 1) + r) * 32 + col] = acc[r];
    __syncthreads();
    for (int i = tid; i < (NB + 1) * 32; i += NTHR) { const int r = i / 32, cc = i % 32; float s = p.ada_b[task * 32 + cc];
        for (int q = 0; q < 8; ++q) s += red[(q * (NB + 1) + r) * 32 + cc];
        p.mod[r * NMODC + task * 32 + cc] = s; }
    __syncthreads();
}

DEV void transpose_tile(const float* src, int ldn, int k0, int n0, bf16_t* dst, size_t ldk, int mapmode, int which, const float* sc, int scsplit, const float* sc2, char* smem) {
    float* t = (float*)smem;
    const int tid = threadIdx.x;
    { const int r = tid >> 4, c4 = tid & 15;
#pragma unroll
      for (int i = 0; i < 4; ++i) { const int k = r + 16 * i; const f32x4 v = *(const f32x4*)(src + (size_t)(k0 + k) * ldn + n0 + c4 * 4);
          float s = 1.f; if (sc) { const int kk = k0 + k; s = kk < scsplit ? sc[kk] : sc2[kk - scsplit]; }
          t[k * 65 + c4 * 4 + 0] = v[0] * s; t[k * 65 + c4 * 4 + 1] = v[1] * s; t[k * 65 + c4 * 4 + 2] = v[2] * s; t[k * 65 + c4 * 4 + 3] = v[3] * s; } }
    __syncthreads();
    { const int n = tid >> 2, kc = tid & 3; const int nn = n0 + n;
      const int drow = mapmode == 0 ? nn : ((nn >> 6) * 128 + ((nn >> 5) & 1) * 64 + which * 32 + (nn & 31));
#pragma unroll
      for (int h = 0; h < 2; ++h) { bf16x8 o;
#pragma unroll
          for (int e = 0; e < 8; ++e) o[e] = (short)f2bf(t[(kc * 16 + h * 8 + e) * 65 + n]);
          *(bf16x8*)(dst + (size_t)drow * ldk + k0 + kc * 16 + h * 8) = o; } }
    __syncthreads();
}

DEV void task_filt(const Params& p, char* smem, int task) {
    float* z = (float*)smem;
    float* ha = z + 8 * 36;
    float* hb = ha + 8 * 64;
    float* w1 = hb + 8 * 64;
    float* w2 = w1 + 33 * 64;
    float* w3 = w2 + 64 * 64;
    const int tid = threadIdx.x, i0 = task * 8;
    {
        f32x4 a2[4], a3[4], a1[3];
#pragma unroll
        for (int u = 0; u < 4; ++u) { a2[u] = *(const f32x4*)(p.f_w2 + (u * 256 + tid) * 4); a3[u] = *(const f32x4*)(p.f_w3 + (u * 256 + tid) * 4); }
#pragma unroll
        for (int u = 0; u < 3; ++u) { const int i = u * 256 + tid; a1[u] = i < 528 ? *(const f32x4*)(p.f_w1 + i * 4) : (f32x4){0.f, 0.f, 0.f, 0.f}; }
#pragma unroll
        for (int u = 0; u < 4; ++u) { *(f32x4*)(w2 + (u * 256 + tid) * 4) = a2[u]; *(f32x4*)(w3 + (u * 256 + tid) * 4) = a3[u]; }
#pragma unroll
        for (int u = 0; u < 3; ++u) { const int i = u * 256 + tid; if (i < 528) *(f32x4*)(w1 + i * 4) = a1[u]; }
    }
    for (int i = tid; i < 8 * 33; i += NTHR) { const int pp = i / 33, f = i % 33, pos = i0 + pp; float v;
        if (f == 0) v = (float)pos / (float)(L - 1);
        else { const int bnd = (f - 1) & 15; const float band = 1e-4f + (float)bnd * ((15.f - 1e-4f) / 15.f);
               const float ang = (6.283185307179586f / (float)L) * (float)pos * band; v = f <= 16 ? cosf(ang) : -sinf(ang); }
        z[pp * 36 + f] = v; }
    __syncthreads();
    const int pp = tid >> 5, jq = tid & 31;
#pragma unroll 1
    for (int m = 0; m < 2; ++m) { const int j = jq + 32 * m; float s = p.f_b1[j];
#pragma unroll 3
        for (int k = 0; k < 33; ++k) s += z[pp * 36 + k] * w1[k * 64 + j];
        ha[pp * 64 + j] = sinf(p.f_freq[j] * s); }
    __syncthreads();
#pragma unroll 1
    for (int m = 0; m < 2; ++m) { const int j = jq + 32 * m; float s = p.f_b2[j];
#pragma unroll 4
        for (int k = 0; k < 64; ++k) s += ha[pp * 64 + k] * w2[k * 64 + j];
        hb[pp * 64 + j] = sinf(p.f_freq[j] * s); }
    __syncthreads();
#pragma unroll 1
    for (int m = 0; m < 2; ++m) { const int j = jq + 32 * m; float s = p.f_b3[j];
#pragma unroll 4
        for (int k = 0; k < 64; ++k) s += hb[pp * 64 + k] * w3[k * 64 + j];
        ha[pp * 64 + j] = sinf(p.f_freq[j] * s); }
    __syncthreads();
    const int cc4 = tid * 4;
    f32x4 acc[8];
#pragma unroll
    for (int q = 0; q < 8; ++q) acc[q] = (f32x4){0.f, 0.f, 0.f, 0.f};
    f32x4 wa[16];
#pragma unroll
    for (int kk = 0; kk < 16; ++kk) wa[kk] = *(const f32x4*)(p.f_wout + kk * 1024 + cc4);
#pragma unroll 1
    for (int k0 = 0; k0 < 64; k0 += 16) {
        f32x4 wb[16]; const int kn = k0 + 16 < 64 ? k0 + 16 : k0;
#pragma unroll
        for (int kk = 0; kk < 16; ++kk) wb[kk] = *(const f32x4*)(p.f_wout + (kn + kk) * 1024 + cc4);
#pragma unroll
        for (int kk = 0; kk < 16; ++kk)
#pragma unroll
            for (int q = 0; q < 8; ++q) acc[q] += wa[kk] * ha[q * 64 + k0 + kk];
#pragma unroll
        for (int kk = 0; kk < 16; ++kk) wa[kk] = wb[kk];
    }
    const float max_decay = logf(1e-2f) / 0.3f, min_decay = logf(1e-2f) / 1.5f;
    const bool isb = cc4 >= 512;
#pragma unroll
    for (int e = 0; e < 4; ++e) { const int c = (cc4 + e) & 511;
        const float delta = fabsf(min_decay + (float)c * ((max_decay - min_decay) / 511.f));
        const float sk = (!isb && task == 0) ? p.hy_skip[c] : 0.f;
#pragma unroll
        for (int q = 0; q < 8; ++q) { const int pos = i0 + q; const float tt = (float)pos / (float)(L - 1); const float win = expf(-tt * delta) + 0.05f; float val = acc[q][e] * win;
            if (!isb) { if (pos == 0) val += sk; p.gtap[(size_t)c * (2 * L) + (L - pos)] = f2bf(val); }
            else { if (pos == 0) p.gtap[(size_t)c * (2 * L)] = 0; else p.gtap[(size_t)c * (2 * L) + (L + pos)] = f2bf(val); } } }
    __syncthreads();
}

constexpr int NT_ADA = NMODC / 32;
constexpr int NT_WIN = 16 * 56, NT_WOUT = 16 * 16, NT_W13 = 16 * 2 * 16 * 8, NT_W2 = 16 * 8 * 16;
constexpr int NT_FILT = L / 8;
constexpr int NT_P0 = NT_ADA + NT_FILT + 1 + NT_WIN + NT_WOUT;

DEV void ph_prep(const Params& p, char* smem) {
    for (int task = blockIdx.x; task < NT_P0; task += gridDim.x) {
        int t = task;
        if (t < NT_ADA) { task_ada(p, smem, t); continue; } t -= NT_ADA;
        if (t < NT_FILT) { task_filt(p, smem, t); continue; } t -= NT_FILT;
        if (t < 1) {
            for (int i = threadIdx.x; i < 64 * 16; i += NTHR) { const int pos = i >> 4, f = i & 15; const float fr = powf(10000.f, -(float)f / 16.f); const float a = (float)pos * fr;
                p.rope[i * 2] = cosf(a); p.rope[i * 2 + 1] = sinf(a); }
            if (threadIdx.x < NEXP) p.cnt[threadIdx.x * 32] = 0;
            continue; } t -= 1;
        if (t < NT_WIN) { const int kt = t / 56, nt = t % 56; transpose_tile(p.w_in, PC, kt * 64, nt * 64, p.w_in_t, 1024, 0, 0, nullptr, 0, nullptr, smem); continue; } t -= NT_WIN;
        { const int kt = t / 16, nt = t % 16; transpose_tile(p.w_out, D, kt * 64, nt * 64, p.w_out_t, 1024, 0, 0, p.hy_out_norm, 512, p.ret_gn_w, smem); }
    }
}
DEV void expert_conv_task(const Params& p, char* smem, int t) {
    if (t < NT_W13) { const int e = t / 256, r = t % 256, which = r / 128, r2 = r % 128, kt = r2 / 8, nt = r2 % 8;
        transpose_tile((which ? p.exp_w3 : p.exp_w1) + (size_t)e * D * EH, EH, kt * 64, nt * 64, p.w13_t + (size_t)e * 1024 * 1024, 1024, 1, which, nullptr, 0, nullptr, smem); return; }
    t -= NT_W13;
    { const int e = t / 128, r = t % 128, kt = r / 16, nt = r % 16;
        transpose_tile(p.exp_w2 + (size_t)e * EH * D, D, kt * 64, nt * 64, p.w2_t + (size_t)e * 1024 * EH, EH, 0, 0, nullptr, 0, nullptr, smem); }
}

DEV void ph_norm1(const Params& p, char* smem) {
    const int tid = threadIdx.x, lane = tid & 63, wid = tid >> 6;
    {
        const int rstep = gridDim.x * 4; int row = blockIdx.x * 4 + wid;
        f32x4 w4[4];
#pragma unroll
        for (int i = 0; i < 4; ++i) w4[i] = *(const f32x4*)(p.norm1_w + i * 256 + lane * 4);
        f32x4 cur[4];
        if (row < TA) { const float* src = row < T ? p.x + (size_t)row * D : p.ctx + (size_t)(row - T) * D;
#pragma unroll
            for (int i = 0; i < 4; ++i) cur[i] = *(const f32x4*)(src + i * 256 + lane * 4); }
#pragma unroll 1
        for (; row < TA; row += rstep) {
            const int nrow = row + rstep < TA ? row + rstep : row;
            const float* nsrc = nrow < T ? p.x + (size_t)nrow * D : p.ctx + (size_t)(nrow - T) * D;
            f32x4 nxt[4];
#pragma unroll
            for (int i = 0; i < 4; ++i) nxt[i] = *(const f32x4*)(nsrc + i * 256 + lane * 4);
            const int mb = row < T ? row / L : NB;
            const float* sh = p.mod + (size_t)mb * NMODC; const float* sc = sh + D;
            f32x4 s1[4], s0[4];
#pragma unroll
            for (int i = 0; i < 4; ++i) { s1[i] = *(const f32x4*)(sc + i * 256 + lane * 4); s0[i] = *(const f32x4*)(sh + i * 256 + lane * 4); }
            float ss = 0.f;
#pragma unroll
            for (int i = 0; i < 4; ++i) ss += cur[i][0] * cur[i][0] + cur[i][1] * cur[i][1] + cur[i][2] * cur[i][2] + cur[i][3] * cur[i][3];
            ss = wave_sum(ss);
            const float rstd = rsqrtf(ss * (1.f / D) + 1e-6f);
#pragma unroll
            for (int i = 0; i < 4; ++i) { const int k = i * 256 + lane * 4; const f32x4 v = cur[i] * rstd * w4[i] * (1.f + s1[i]) + s0[i];
                *(us4*)(p.hbuf + (size_t)row * D + k) = pack4(v[0], v[1], v[2], v[3]); }
#pragma unroll
            for (int i = 0; i < 4; ++i) cur[i] = nxt[i];
        }
    }
    const int gtid = blockIdx.x * NTHR + tid, gn = gridDim.x * NTHR;
    for (int i = gtid; i < NB * D * 32; i += gn) { const int ii = i & 3, j = (i >> 2) & 31, k4 = (i >> 7) & 255, b = i >> 15; const int k = k4 * 4 + ii;
        const float r = j < 4 ? p.rg_w[k * 4 + j] : (j < 20 ? p.re_w[k * 16 + (j - 4)] : 0.f);
        p.RP[i] = p.norm2_w[k] * (1.f + p.mod[(size_t)b * NMODC + 4 * D + k]) * r; }
    for (int wt = blockIdx.x * 4 + wid; wt < NB * 32; wt += gridDim.x * 4) { const int b = wt >> 5, j = wt & 31; float s = 0.f;
        if (j < 20) for (int k = lane; k < D; k += 64) { const float r = j < 4 ? p.rg_w[k * 4 + j] : p.re_w[k * 16 + (j - 4)]; s += p.mod[(size_t)b * NMODC + 3 * D + k] * r; }
        s = wave_sum(s);
        if (lane == 0) p.cb[wt] = j < 4 ? s + p.rg_b[j] : (j < 20 ? s + p.re_b[j - 4] : 0.f); }
}

constexpr int NT_INP = (T / 128) * 28 + (TC / 128) * 8;
DEV void inproj_tile(const Params& p, char* smem, int mt, int nt) {
    int tid = threadIdx.x; OPAQUE(tid);
    const int lane = tid & 63, wid = tid >> 6, wr = wid >> 1, wc = wid & 1, fr = lane & 15, quad = lane >> 4;
    const size_t row0 = (size_t)mt * 128;
    const bool is_ctx = mt >= T / 128;
    const bool actX = (nt < 12) || (nt >= 16 && nt < 24);
    f32x4 acc[4][4]; zero_acc(acc);
    LdPlain la(p.hbuf, row0, D), lw(p.w_in_t, (size_t)nt * 128, D);
    if (actX) gemm_tile(acc, la, lw, D / 64, smem); else gemm_tile(acc, lw, la, D / 64, smem);
    if (nt < 12) {
#pragma unroll
        for (int mi = 0; mi < 4; ++mi)
#pragma unroll
            for (int ni = 0; ni < 4; ++ni) { const size_t tok = row0 + wr * 64 + mi * 16 + quad * 4; const int c = nt * 128 + wc * 64 + ni * 16 + fr;
                *(us4*)(p.pT + (size_t)c * T + tok) = pack4(acc[mi][ni][0], acc[mi][ni][1], acc[mi][ni][2], acc[mi][ni][3]); }
    } else if (nt >= 16 && nt < 24) {
        const bool isk = nt < 20; const int h = (nt - 16) & 3;
        if (!is_ctx) {
            const int b = (int)(row0 / L), tl0 = (int)(row0 % L);
            if (isk) {
                if (wc == 0) {
#pragma unroll
                    for (int mi = 0; mi < 4; ++mi)
#pragma unroll
                        for (int r = 0; r < 4; ++r) { const int tl = tl0 + wr * 64 + mi * 16 + quad * 4 + r;
                            { const float* cs = p.rope + ((tl >> 6) * 16 + fr) * 2; const float a = acc[mi][0][r], bq = acc[mi][1][r]; acc[mi][0][r] = a * cs[0] - bq * cs[1]; acc[mi][1][r] = a * cs[1] + bq * cs[0]; }
                            { const float* cs = p.rope + ((tl & 63) * 16 + fr) * 2; const float a = acc[mi][2][r], bq = acc[mi][3][r]; acc[mi][2][r] = a * cs[0] - bq * cs[1]; acc[mi][3][r] = a * cs[1] + bq * cs[0]; } }
                }
                const float scl = 0.08838834764831845f;
                const float lgf = lg2_gamma(h, false), lgb = lg2_gamma(h, true);
#pragma unroll
                for (int mi = 0; mi < 4; ++mi) { const int jl = wr * 64 + mi * 16 + quad * 4;
                    float zf[4], zb[4];
#pragma unroll
                    for (int r = 0; r < 4; ++r) { zf[r] = exp2f(lgf * (float)(127 - jl - r)); zb[r] = exp2f(lgb * (float)(jl + r)); }
#pragma unroll
                    for (int ni = 0; ni < 4; ++ni) { const int tl = tl0 + jl, d = wc * 64 + ni * 16 + fr; const size_t bh = (size_t)b * NH + h;
                        float kv[4];
#pragma unroll
                        for (int r = 0; r < 4; ++r) kv[r] = acc[mi][ni][r] * scl;
                        const us4 o = pack4(kv[0], kv[1], kv[2], kv[3]);
                        *(us4*)(p.kTf + (bh * 128 + d) * L + tl) = pack4(kv[0] * zf[0], kv[1] * zf[1], kv[2] * zf[2], kv[3] * zf[3]);
                        *(us4*)(p.kTb + (bh * 128 + d) * L + tl) = pack4(kv[0] * zb[0], kv[1] * zb[1], kv[2] * zb[2], kv[3] * zb[3]);
#pragma unroll
                        for (int r = 0; r < 4; ++r) p.kn[(bh * L + tl + r) * 128 + d] = o[r]; } }
            } else {
#pragma unroll
                for (int mi = 0; mi < 4; ++mi)
#pragma unroll
                    for (int ni = 0; ni < 4; ++ni) { const int tl = tl0 + wr * 64 + mi * 16 + quad * 4, d = wc * 64 + ni * 16 + fr; const size_t bh = (size_t)b * NH + h;
                        *(us4*)(p.vT + (bh * 128 + d) * L + tl) = pack4(acc[mi][ni][0], acc[mi][ni][1], acc[mi][ni][2], acc[mi][ni][3]); }
            }
        } else {
            const size_t cr0 = row0 - T; const int b = (int)(cr0 / LC), tl0 = (int)(cr0 % LC); const size_t bh = (size_t)b * NH + h;
            if (isk) {
                const float scl = 0.08838834764831845f; const float lgf = lg2_gamma(h, false), lgb = lg2_gamma(h, true);
#pragma unroll
                for (int mi = 0; mi < 4; ++mi) { const int jl = wr * 64 + mi * 16 + quad * 4; float zf[4], zb[4];
#pragma unroll
                    for (int r = 0; r < 4; ++r) { zf[r] = scl * exp2f(lgf * (float)(127 - jl - r)); zb[r] = scl * exp2f(lgb * (float)(jl + r)); }
#pragma unroll
                    for (int ni = 0; ni < 4; ++ni) { const int tl = tl0 + jl, d = wc * 64 + ni * 16 + fr;
                        *(us4*)(p.ckTf + (bh * 128 + d) * LC + tl) = pack4(acc[mi][ni][0] * zf[0], acc[mi][ni][1] * zf[1], acc[mi][ni][2] * zf[2], acc[mi][ni][3] * zf[3]);
                        *(us4*)(p.ckTb + (bh * 128 + d) * LC + tl) = pack4(acc[mi][ni][0] * zb[0], acc[mi][ni][1] * zb[1], acc[mi][ni][2] * zb[2], acc[mi][ni][3] * zb[3]); } }
            } else {
#pragma unroll
                for (int mi = 0; mi < 4; ++mi)
#pragma unroll
                    for (int ni = 0; ni < 4; ++ni) { const int tl = tl0 + wr * 64 + mi * 16 + quad * 4, d = wc * 64 + ni * 16 + fr;
                        *(us4*)(p.cvT + (bh * 128 + d) * LC + tl) = pack4(acc[mi][ni][0], acc[mi][ni][1], acc[mi][ni][2], acc[mi][ni][3]); }
            }
        }
    } else if (nt < 16) {
        const int h = nt - 12; const int b = (int)(row0 / L), tl0 = (int)(row0 % L);
        if (wr == 0) {
#pragma unroll
            for (int ni = 0; ni < 4; ++ni) { const int tl = tl0 + wc * 64 + ni * 16 + fr;
#pragma unroll
                for (int r = 0; r < 4; ++r) { const int j = quad * 4 + r;
                    { const float* cs = p.rope + ((tl >> 6) * 16 + j) * 2; const float a = acc[0][ni][r], bq = acc[1][ni][r]; acc[0][ni][r] = a * cs[0] - bq * cs[1]; acc[1][ni][r] = a * cs[1] + bq * cs[0]; }
                    { const float* cs = p.rope + ((tl & 63) * 16 + j) * 2; const float a = acc[2][ni][r], bq = acc[3][ni][r]; acc[2][ni][r] = a * cs[0] - bq * cs[1]; acc[3][ni][r] = a * cs[1] + bq * cs[0]; } } }
        }
#pragma unroll
        for (int mi = 0; mi < 4; ++mi)
#pragma unroll
            for (int ni = 0; ni < 4; ++ni) { const int tl = tl0 + wc * 64 + ni * 16 + fr, d = wr * 64 + mi * 16 + quad * 4; const size_t bh = (size_t)b * NH + h;
                *(us4*)(p.qn + (bh * L + tl) * 128 + d) = pack4(acc[mi][ni][0], acc[mi][ni][1], acc[mi][ni][2], acc[mi][ni][3]); }
    } else {
#pragma unroll
        for (int mi = 0; mi < 4; ++mi)
#pragma unroll
            for (int ni = 0; ni < 4; ++ni) { const size_t tok = row0 + wc * 64 + ni * 16 + fr; const int d = (nt - 24) * 128 + wr * 64 + mi * 16 + quad * 4;
                *(us4*)(p.gbuf + tok * 512 + d) = pack4(acc[mi][ni][0], acc[mi][ni][1], acc[mi][ni][2], acc[mi][ni][3]); }
    }
}
DEV void ph_inproj(const Params& p, char* smem) {
    constexpr int NMT = T / 128, NCM = TC / 128;
    const int G = gridDim.x, b = blockIdx.x;
    if ((G & 7) == 0 && NMT % 8 == 0) {
        constexpr int MX = NMT / 8;
        const int x = b & 7, li = b >> 3, nl = G >> 3;
        for (int q = li; q < MX * 28; q += nl) { const int ng = q / (MX * 4), rem = q % (MX * 4); inproj_tile(p, smem, x * MX + rem % MX, ng * 4 + rem / MX); }
        for (int t = b; t < NCM * 8; t += G) inproj_tile(p, smem, NMT + t / 8, 16 + t % 8);
        return;
    }
    for (int task = blockIdx.x; task < NT_INP; task += gridDim.x) {
        if (task < (T / 128) * 28) inproj_tile(p, smem, task / 28, task % 28);
        else { const int t = task - (T / 128) * 28; inproj_tile(p, smem, T / 128 + t / 8, 16 + t % 8); }
    }
}

constexpr int NU = L / 64, UPW = NU / 4;
typedef unsigned u32x2 __attribute__((ext_vector_type(2)));
typedef unsigned u32x4 __attribute__((ext_vector_type(4)));
constexpr int TAPC = 2 * L + 16;
DEV bf16x8 conv_afrag(const bf16_t* tcp, int m0a) {
    const u32x2 lo = *(const volatile LDS_AS u32x2*)(tcp + m0a), hi = *(const volatile LDS_AS u32x2*)(tcp + m0a + 4);
    const u32x4 v = {lo[0], lo[1], hi[0], hi[1]};
    return __builtin_bit_cast(bf16x8, v); }
DEV void conv3_w(const Params& p, int ch, float& w0, float& w1, float& w2, float& bs) { w0 = p.hy_conv_w[ch]; w1 = p.hy_conv_w[1536 + ch]; w2 = p.hy_conv_w[3072 + ch]; bs = p.hy_conv_b[ch]; }

DEV void conv_task(const Params& p, char* smem, int c) {
    bf16_t* taps = (bf16_t*)smem;
    bf16_t* U = taps + 4 * TAPC;
    int tid = threadIdx.x; OPAQUE(tid);
    const int lane = tid & 63, w = tid >> 6, fr = lane & 15, quad = lane >> 4;
    for (int i = tid; i < 2 * L / 8; i += NTHR) { const bf16x8 v = *(const bf16x8*)(p.gtap + (size_t)c * 2 * L + i * 8);
        *(bf16x8*)(taps + i * 8) = v;
#pragma unroll
        for (int a = 1; a < 4; ++a)
#pragma unroll
            for (int e = 0; e < 8; ++e) { const int q = i * 8 + e - a; if (q >= 0) taps[a * TAPC + q] = (bf16_t)v[e]; } }
    for (int i = tid; i < 8 * UP / 8; i += NTHR) *(bf16x8*)(U + i * 8) = (bf16x8){0, 0, 0, 0, 0, 0, 0, 0};
    __syncthreads();
    { float a0, a1, a2, ab, v0, v1, v2, vb; conv3_w(p, 512 + c, a0, a1, a2, ab); conv3_w(p, 1024 + c, v0, v1, v2, vb);
      constexpr int NGT = NB * (L / 8), NG = (NGT + NTHR - 1) / NTHR, GB = 4;
#pragma unroll 1
      for (int g0 = 0; g0 < NG; g0 += GB) {
          bf16x8 x1v[GB], vv[GB]; bf16_t hx0[GB], hx9[GB], hv0[GB], hv9[GB];
#pragma unroll
          for (int u = 0; u < GB; ++u) { int g = tid + (g0 + u) * NTHR; if (g >= NGT) g = NGT - 1; const int b = g / (L / 8), t8 = (g % (L / 8)) * 8;
              const bf16_t* r1 = p.pT + (size_t)(512 + c) * T + (size_t)b * L + t8; const bf16_t* rv = p.pT + (size_t)(1024 + c) * T + (size_t)b * L + t8;
              x1v[u] = *(const bf16x8*)r1; vv[u] = *(const bf16x8*)rv;
              hx0[u] = t8 > 0 ? r1[-1] : (bf16_t)0; hv0[u] = t8 > 0 ? rv[-1] : (bf16_t)0; hx9[u] = t8 + 8 < L ? r1[8] : (bf16_t)0; hv9[u] = t8 + 8 < L ? rv[8] : (bf16_t)0; }
#pragma unroll
          for (int u = 0; u < GB; ++u) { const int g = tid + (g0 + u) * NTHR; if (g >= NGT) continue; const int b = g / (L / 8), t8 = (g % (L / 8)) * 8;
              float px[10], pv[10];
              px[0] = bf2f(hx0[u]); pv[0] = bf2f(hv0[u]); px[9] = bf2f(hx9[u]); pv[9] = bf2f(hv9[u]);
#pragma unroll
              for (int e = 0; e < 8; ++e) { px[e + 1] = bf2f((bf16_t)x1v[u][e]); pv[e + 1] = bf2f((bf16_t)vv[u][e]); }
              bf16x8 o;
#pragma unroll
              for (int e = 0; e < 8; ++e) { const float x1 = a0 * px[e] + a1 * px[e + 1] + a2 * px[e + 2] + ab; const float vq = v0 * pv[e] + v1 * pv[e + 1] + v2 * pv[e + 2] + vb; o[e] = (short)f2bf(x1 * vq); }
              *(bf16x8*)(U + b * UP + 32 + t8) = o; } } }
    __syncthreads();
    f32x4 acc[2][UPW];
#pragma unroll
    for (int tp = 0; tp < 2; ++tp)
#pragma unroll
        for (int ui = 0; ui < UPW; ++ui) acc[tp][ui] = (f32x4){0.f, 0.f, 0.f, 0.f};
    const int bcol = fr & 7, i2 = fr >> 3;
    const bf16_t* Ub = U + bcol * UP + 32 + 32 * i2 + 8 * quad;
    const int al = (L - fr) & 3;
    const bf16_t* tcp = taps + al * TAPC;
    const int mbase = L - fr + 8 * quad - 64 * (UPW * w) - al;
#pragma unroll 1
    for (int jp = 1; jp >= 0; --jp) {
        bf16x8 af[2][UPW];
        int J0 = jp ? -1 : 0;
        if (jp) {
            const bf16x8 bfr = *(const bf16x8*)(Ub + 32 * J0);
#pragma unroll
            for (int tp = 0; tp < 2; ++tp)
#pragma unroll
                for (int ui = 0; ui < UPW; ++ui) { const bf16x8 a = conv_afrag(tcp, mbase - 64 * ui - 16 * tp + 32 * J0); acc[tp][ui] = __builtin_amdgcn_mfma_f32_16x16x32_bf16(a, bfr, acc[tp][ui], 0, 0, 0); }
            J0 = 1;
        }
#pragma unroll
        for (int tp = 0; tp < 2; ++tp)
#pragma unroll
            for (int ui = 0; ui < UPW; ++ui) af[tp][ui] = conv_afrag(tcp, mbase - 64 * ui - 16 * tp + 32 * J0);
#pragma unroll 1
        for (int grp = 0; grp < 4; ++grp) {
#pragma unroll
            for (int s = 0; s < UPW; ++s) {
                const bf16x8 bfr = *(const bf16x8*)(Ub + 32 * J0);
#pragma unroll
                for (int tp = 0; tp < 2; ++tp)
#pragma unroll
                    for (int ui = 0; ui < UPW; ++ui) acc[tp][ui] = __builtin_amdgcn_mfma_f32_16x16x32_bf16(af[tp][(ui - s + UPW) % UPW], bfr, acc[tp][ui], 0, 0, 0);
                J0 += 2;
                if (grp < 3 || s < UPW - 1) {
#pragma unroll
                    for (int tp = 0; tp < 2; ++tp) af[tp][(UPW - 1 - s) % UPW] = conv_afrag(tcp, mbase - 16 * tp + 32 * J0);
                }
            }
        }
    }
    float w0, w1, w2, wb; conv3_w(p, c, w0, w1, w2, wb);
    if (bcol < NB) {
        us4 cv[2][UPW]; bf16_t hl[2][UPW], hr[2][UPW];
#pragma unroll
        for (int tp = 0; tp < 2; ++tp)
#pragma unroll
            for (int ui = 0; ui < UPW; ++ui) { const int I0 = 4 * (UPW * w + ui) + tp; const int t = 16 * (I0 + 2 * i2) + 4 * quad;
                const bf16_t* r0 = p.pT + (size_t)c * T + (size_t)bcol * L + t; cv[tp][ui] = *(const us4*)r0;
                hl[tp][ui] = t > 0 ? r0[-1] : (bf16_t)0; hr[tp][ui] = t + 4 < L ? r0[4] : (bf16_t)0; }
#pragma unroll
        for (int tp = 0; tp < 2; ++tp)
#pragma unroll
            for (int ui = 0; ui < UPW; ++ui) { const int I0 = 4 * (UPW * w + ui) + tp; const int t = 16 * (I0 + 2 * i2) + 4 * quad;
                float pq[6]; pq[0] = bf2f(hl[tp][ui]); pq[5] = bf2f(hr[tp][ui]);
#pragma unroll
                for (int e = 0; e < 4; ++e) pq[e + 1] = bf2f(cv[tp][ui][e]);
                float y[4];
#pragma unroll
                for (int e = 0; e < 4; ++e) y[e] = (w0 * pq[e] + w1 * pq[e + 1] + w2 * pq[e + 2] + wb) * acc[tp][ui][e];
                *(us4*)(p.yhyT + (size_t)c * T + (size_t)bcol * L + t) = pack4(y[0], y[1], y[2], y[3]); }
    }
    __syncthreads();
}

struct LdSeq {
    static constexpr bool kDirect = true;
    const bf16_t *cb, *lb; int dir, lrow, lc;
    DEV LdSeq(const bf16_t* cb_, const bf16_t* lb_, int dir_) : cb(cb_), lb(lb_), dir(dir_) { lrow = threadIdx.x >> 3; lc = stage_chunk(); }
    DEV const bf16_t* src(int i, int kt) const { const int n = kt >> 1, half = (kt & 1) * 64;
        if (n < NCC) { const int J = dir ? NCC - 1 - n : n; return cb + (size_t)(lrow + 32 * i) * LC + J * 128 + half + lc; }
        const int I = dir ? NCH - 1 - (n - NCC) : n - NCC; return lb + (size_t)(lrow + 32 * i) * L + I * 128 + half + lc; }
    DEV bf16x8 ld(int i, int kt) const { return *(const bf16x8*)src(i, kt); }
};
struct RscanHook { bf16_t* so; int dir; float gch;
    DEV void store(int I, f32x4 (&acc)[4][4]) const {
#pragma unroll
        for (int mi = 0; mi < 4; ++mi)
#pragma unroll
            for (int ni = 0; ni < 4; ++ni) *(us4*)(so + (size_t)I * 16384 + (ni * 16) * 128 + mi * 16) = pack4(acc[mi][ni][0], acc[mi][ni][1], acc[mi][ni][2], acc[mi][ni][3]); }
    DEV void operator()(int kt, f32x4 (&acc)[4][4]) const {
        if (kt & 1) return; const int n = kt >> 1;
        if (n >= NCC) store(dir ? NCH - 1 - (n - NCC) : n - NCC, acc);
        if (n > 0) {
#pragma unroll
            for (int mi = 0; mi < 4; ++mi)
#pragma unroll
                for (int ni = 0; ni < 4; ++ni) acc[mi][ni] = acc[mi][ni] * gch; } }
};
DEV void rscan_task(const Params& p, char* smem, int task) {
    const int bh = task % (NB * NH), dir = task / (NB * NH), h = bh % NH;
    int tid = threadIdx.x; OPAQUE(tid);
    const int lane = tid & 63, wid = tid >> 6, wr = wid >> 1, wc = wid & 1, fr = lane & 15, quad = lane >> 4;
    LdSeq lk((dir ? p.ckTb : p.ckTf) + (size_t)bh * 128 * LC, (dir ? p.kTb : p.kTf) + (size_t)bh * 128 * L, dir);
    LdSeq lv(p.cvT + (size_t)bh * 128 * LC, p.vT + (size_t)bh * 128 * L, dir);
    RscanHook hk; hk.dir = dir; hk.gch = exp2f(128.f * lg2_gamma(h, dir == 1));
    hk.so = p.Sst + (((size_t)dir * NB * NH + bh) * NCH) * 16384 + (size_t)(wc * 64 + fr) * 128 + wr * 64 + quad * 4;
    f32x4 acc[4][4]; zero_acc(acc);
    gemm_tile_h(acc, lk, lv, 2 * (NCT - 1), smem, hk);
    hk.store(dir ? 0 : NCH - 1, acc);
}
constexpr int NT_RSC = 2 * NB * NH;
DEV void ph_conv_rscan(const Params& p, char* smem) {
    for (int task = blockIdx.x; task < NT_RSC + HW; task += gridDim.x) {
        if (task < NT_RSC) rscan_task(p, smem, task); else conv_task(p, smem, task - NT_RSC);
    }
}

DEV void hynorm_task(const Params& p, char* smem, int task) {
    bf16_t* tl = (bf16_t*)smem;
    const int tid = threadIdx.x; const size_t pos0 = (size_t)task * 64;
    for (int half = 0; half < 2; ++half) { const int c = tid + 256 * half; const bf16_t* src = p.yhyT + (size_t)c * T + pos0;
#pragma unroll
        for (int q = 0; q < 8; ++q) { const bf16x8 v = *(const bf16x8*)(src + q * 8);
#pragma unroll
            for (int e = 0; e < 8; ++e) tl[(q * 8 + e) * 520 + c] = (bf16_t)v[e]; } }
    __syncthreads();
    const int pos = tid >> 2, part = tid & 3;
    float ss = 0.f;
    for (int q = 0; q < 16; ++q) { const bf16x8 v = *(const bf16x8*)(tl + pos * 520 + part * 128 + q * 8);
#pragma unroll
        for (int e = 0; e < 8; ++e) { const float f = bf2f((bf16_t)v[e]); ss += f * f; } }
    ss += __shfl_xor(ss, 1); ss += __shfl_xor(ss, 2);
    const float rstd = rsqrtf(ss * (1.f / 512.f) + 1e-6f);
    for (int q = 0; q < 16; ++q) { const bf16x8 v = *(const bf16x8*)(tl + pos * 520 + part * 128 + q * 8); bf16x8 o;
#pragma unroll
        for (int e = 0; e < 8; ++e) o[e] = (short)f2bf(bf2f((bf16_t)v[e]) * rstd);
        *(bf16x8*)(p.ycat + (pos0 + pos) * 1024 + part * 128 + q * 8) = o; }
    __syncthreads();
}
DEV void rout_task(const Params& p, char* smem, int task) {
    const int bh = task / NCH, I = task % NCH, h = bh % NH, b = bh / NH;
    int tid = threadIdx.x; OPAQUE(tid);
    const int lane = tid & 63, wid = tid >> 6, wr = wid >> 1, wc = wid & 1, fr = lane & 15, quad = lane >> 4;
    const float lgf = lg2_gamma(h, false), lgb = lg2_gamma(h, true);
    bf16_t* P = p.Pscr + (size_t)blockIdx.x * 16384;
    const bf16_t* qb = p.qn + ((size_t)bh * L + I * 128) * 128; const bf16_t* kb = p.kn + ((size_t)bh * L + I * 128) * 128;
    {
        f32x4 acc[4][4]; zero_acc(acc);
        LdPlain lk(kb, 0, 128), lq(qb, 0, 128);
        gemm_tile(acc, lk, lq, 2, smem);
#pragma unroll
        for (int mi = 0; mi < 4; ++mi)
#pragma unroll
            for (int ni = 0; ni < 4; ++ni) { const int i = wc * 64 + ni * 16 + fr, j0 = wr * 64 + mi * 16 + quad * 4; float v[4];
#pragma unroll
                for (int r = 0; r < 4; ++r) { const int j = j0 + r; const float dcy = i > j ? exp2f(lgf * (float)(i - j)) : (i == j ? 2.f : exp2f(lgb * (float)(j - i))); v[r] = acc[mi][ni][r] * dcy; }
                *(us4*)(P + i * 128 + j0) = pack4(v[0], v[1], v[2], v[3]); }
    }
    __syncthreads();
    f32x4 acc[4][4]; zero_acc(acc);
    {
        LdPlain lv(p.vT + (size_t)bh * 128 * L + I * 128, 0, L), lp(P, 0, 128);
        gemm_tile(acc, lv, lp, 2, smem);
    }
    {
        LdPlain ls(p.Sst + (((size_t)0 * NB * NH + bh) * NCH + I) * 16384, 0, 128); LdRowScale lq(qb, 0, 128, lgf, lgf);
        gemm_tile(acc, ls, lq, 2, smem);
    }
    {
        LdPlain ls(p.Sst + (((size_t)1 * NB * NH + bh) * NCH + I) * 16384, 0, 128); LdRowScale lq(qb, 0, 128, 128.f * lgb, -lgb);
        gemm_tile(acc, ls, lq, 2, smem);
    }
    float* red = (float*)smem;
    float mean[4], rstd[4];
#pragma unroll
    for (int ni = 0; ni < 4; ++ni) { float s = 0.f, ss = 0.f;
#pragma unroll
        for (int mi = 0; mi < 4; ++mi)
#pragma unroll
            for (int r = 0; r < 4; ++r) { const float v = acc[mi][ni][r]; s += v; ss += v * v; }
        s += __shfl_xor(s, 16); s += __shfl_xor(s, 32); ss += __shfl_xor(ss, 16); ss += __shfl_xor(ss, 32);
        if (quad == 0) { const int i = wc * 64 + ni * 16 + fr; red[(wr * 128 + i) * 2] = s; red[(wr * 128 + i) * 2 + 1] = ss; } }
    __syncthreads();
#pragma unroll
    for (int ni = 0; ni < 4; ++ni) { const int i = wc * 64 + ni * 16 + fr; const float s = red[i * 2] + red[(128 + i) * 2], ss = red[i * 2 + 1] + red[(128 + i) * 2 + 1];
        mean[ni] = s * (1.f / 128.f); const float var = ss * (1.f / 128.f) - mean[ni] * mean[ni]; rstd[ni] = rsqrtf(fmaxf(var, 0.f) + 1e-6f); }
#pragma unroll
    for (int mi = 0; mi < 4; ++mi)
#pragma unroll
        for (int ni = 0; ni < 4; ++ni) { const int i = wc * 64 + ni * 16 + fr, e = wr * 64 + mi * 16 + quad * 4; const size_t tok = (size_t)b * L + I * 128 + i;
            const us4 gv = *(const us4*)(p.gbuf + tok * 512 + h * 128 + e); float y[4];
#pragma unroll
            for (int r = 0; r < 4; ++r) y[r] = (acc[mi][ni][r] - mean[ni]) * rstd[ni] * silu_f(bf2f(gv[r]));
            *(us4*)(p.ycat + tok * 1024 + 512 + h * 128 + e) = pack4(y[0], y[1], y[2], y[3]); }
    __syncthreads();
}
DEV void ph_rout_hynorm(const Params& p, char* smem) {
#pragma unroll 1
    for (int task = blockIdx.x; task < NB * NH * NCH + T / 64; task += gridDim.x) {
        if (task < NB * NH * NCH) rout_task(p, smem, task); else hynorm_task(p, smem, task - NB * NH * NCH); } }

DEV void outproj_tile(const Params& p, char* smem, int mt, int nt) {
    int tid = threadIdx.x; OPAQUE(tid);
    const int lane = tid & 63, wid = tid >> 6, wr = wid >> 1, wc = wid & 1, fr = lane & 15, quad = lane >> 4;
    f32x4 acc[4][4]; zero_acc(acc);
    LdPlain lw(p.w_out_t, (size_t)nt * 128, D), la(p.ycat, (size_t)mt * 128, D);
    gemm_tile(acc, lw, la, D / 64, smem);
    const int b = (mt * 128) / L; const float* g1 = p.mod + (size_t)b * NMODC + 2 * D;
#pragma unroll
    for (int mi = 0; mi < 4; ++mi)
#pragma unroll
        for (int ni = 0; ni < 4; ++ni) { const size_t tok = (size_t)mt * 128 + wc * 64 + ni * 16 + fr; const int col = nt * 128 + wr * 64 + mi * 16 + quad * 4;
            const f32x4 xv = *(const f32x4*)(p.x + tok * D + col), gv = *(const f32x4*)(g1 + col);
            *(f32x4*)(p.x1 + tok * D + col) = xv + gv * acc[mi][ni]; }
}
DEV void ph_outproj(const Params& p, char* smem) {
    constexpr int NMT = T / 128;
    const int G = gridDim.x, b = blockIdx.x;
    if ((G & 7) == 0 && NMT % 8 == 0) {
        constexpr int MX = NMT / 8, RB = MX < 8 ? MX : 8;
        const int x = b & 7, li = b >> 3, nl = G >> 3;
        for (int q = li; q < MX * 8; q += nl) { const int mg = q / (RB * 8), rem = q % (RB * 8); outproj_tile(p, smem, x * MX + mg * RB + rem % RB, rem / RB); }
    } else {
        for (int task = blockIdx.x; task < NMT * 8; task += gridDim.x) outproj_tile(p, smem, task / 8, task % 8);
    }
    for (int task = blockIdx.x; task < NT_W13 + NT_W2; task += gridDim.x) expert_conv_task(p, smem, task);
}

DEV void ph_norm2_router(const Params& p, char* smem) {
    const int tid = threadIdx.x, lane = tid & 63, wid = tid >> 6, fr = lane & 15, quad = lane >> 4;
    float* lgs = (float*)smem + wid * (16 * 33);
    float* rs = (float*)smem + 4 * 16 * 33 + wid * 16;
    int* lcnt = (int*)(smem + 16384); int* lbase = lcnt + NEXP;
    if (tid < NEXP) lcnt[tid] = 0;
    __syncthreads();
    for (int wt = blockIdx.x * 4 + wid; wt < T / 16; wt += gridDim.x * 4) {
        const size_t row0 = (size_t)wt * 16; const int b = (int)(row0 / L);
        const float* xr = p.x1 + (row0 + fr) * D + quad * 4;
        const float* rp = p.RP + (size_t)b * D * 32;
        f32x4 a0 = {0.f, 0.f, 0.f, 0.f}, a1 = a0; float ss = 0.f;
        const float* rpl = rp + ((size_t)quad * 32 + fr) * 4;
        f32x4 xv[4], b0[4], b1[4];
#pragma unroll
        for (int u = 0; u < 4; ++u) { xv[u] = *(const f32x4*)(xr + u * 16); b0[u] = *(const f32x4*)(rpl + (size_t)u * 512); b1[u] = *(const f32x4*)(rpl + (size_t)u * 512 + 64); }
#pragma unroll 1
        for (int k0 = 0; k0 < D; k0 += 64) {
            f32x4 xn[4], c0[4], c1[4];
            const int kn = k0 + 64 < D ? k0 + 64 : k0;
#pragma unroll
            for (int u = 0; u < 4; ++u) { xn[u] = *(const f32x4*)(xr + kn + u * 16); c0[u] = *(const f32x4*)(rpl + (size_t)(kn / 4 + u * 4) * 128); c1[u] = *(const f32x4*)(rpl + (size_t)(kn / 4 + u * 4) * 128 + 64); }
#pragma unroll
            for (int u = 0; u < 4; ++u) {
                ss += xv[u][0] * xv[u][0] + xv[u][1] * xv[u][1] + xv[u][2] * xv[u][2] + xv[u][3] * xv[u][3];
#pragma unroll
                for (int i = 0; i < 4; ++i) { a0 = __builtin_amdgcn_mfma_f32_16x16x4f32(xv[u][i], b0[u][i], a0, 0, 0, 0); a1 = __builtin_amdgcn_mfma_f32_16x16x4f32(xv[u][i], b1[u][i], a1, 0, 0, 0); }
            }
#pragma unroll
            for (int u = 0; u < 4; ++u) { xv[u] = xn[u]; b0[u] = c0[u]; b1[u] = c1[u]; }
        }
        ss += __shfl_xor(ss, 16); ss += __shfl_xor(ss, 32);
        const float rstd = rsqrtf(ss * (1.f / D) + 1e-6f);
        if (quad == 0) rs[fr] = rstd;
#pragma unroll
        for (int r = 0; r < 4; ++r) { lgs[(quad * 4 + r) * 33 + fr] = a0[r]; lgs[(quad * 4 + r) * 33 + 16 + fr] = a1[r]; }
        __syncthreads();
        int e0 = 0, e1 = 0, l0 = 0, l1 = 0; float w0 = 0.f, w1 = 0.f;
        if (lane < 16) {
            const float rsd = rs[lane]; float lg[20];
#pragma unroll
            for (int j = 0; j < 20; ++j) lg[j] = lgs[lane * 33 + j] * rsd + p.cb[b * 32 + j];
            int g = 0; float gm = lg[0];
#pragma unroll
            for (int j = 1; j < 4; ++j) if (lg[j] > gm) { gm = lg[j]; g = j; }
            float den = 0.f;
#pragma unroll
            for (int j = 0; j < 4; ++j) den += expf(lg[j] - gm);
            const float psel = 1.f / den;
            float le[4];
#pragma unroll
            for (int j = 0; j < 4; ++j) le[j] = g == 0 ? lg[4 + j] : (g == 1 ? lg[8 + j] : (g == 2 ? lg[12 + j] : lg[16 + j]));
            int i0 = 0; float m0 = le[0];
#pragma unroll
            for (int j = 1; j < 4; ++j) if (le[j] > m0) { m0 = le[j]; i0 = j; }
            int i1 = -1; float m1 = -3.0e38f;
#pragma unroll
            for (int j = 0; j < 4; ++j) if (j != i0 && le[j] > m1) { m1 = le[j]; i1 = j; }
            const float ex = expf(m1 - m0); w0 = psel / (1.f + ex); w1 = psel * ex / (1.f + ex);
            e0 = g * 4 + i0; e1 = g * 4 + i1;
            l0 = atomicAdd(lcnt + e0, 1); l1 = atomicAdd(lcnt + e1, 1);
        }
        __syncthreads();
        if (tid < NEXP) { const int c = lcnt[tid]; lbase[tid] = c ? atomicAdd(p.cnt + tid * 32, c) : 0; lcnt[tid] = 0; }
        __syncthreads();
        if (lane < 16) { const size_t tok = row0 + lane; const int p0 = lbase[e0] + l0, p1 = lbase[e1] + l1;
            p.elist[(size_t)e0 * T + p0] = (int)tok * 2; p.ewt[(size_t)e0 * T + p0] = w0;
            p.elist[(size_t)e1 * T + p1] = (int)tok * 2 + 1; p.ewt[(size_t)e1 * T + p1] = w1;
            p.tok_e[tok * 2] = e0; p.tok_e[tok * 2 + 1] = e1; p.tok_pos[tok * 2] = p0; p.tok_pos[tok * 2 + 1] = p1;
        }
        const float* sh = p.mod + (size_t)b * NMODC + 3 * D; const float* sc = sh + D;
        f32x4 wm[4], sa[4];
#pragma unroll
        for (int i = 0; i < 4; ++i) { const int k = i * 256 + lane * 4; const f32x4 w = *(const f32x4*)(p.norm2_w + k), s1 = *(const f32x4*)(sc + k); sa[i] = *(const f32x4*)(sh + k); wm[i] = w * (1.f + s1); }
        f32x4 cur[4];
#pragma unroll
        for (int i = 0; i < 4; ++i) cur[i] = *(const f32x4*)(p.x1 + row0 * D + i * 256 + lane * 4);
#pragma unroll 1
        for (int r = 0; r < 16; ++r) { const float rsd = rs[r]; f32x4 nxt[4]; const int rn = r < 15 ? r + 1 : r;
#pragma unroll
            for (int i = 0; i < 4; ++i) nxt[i] = *(const f32x4*)(p.x1 + (row0 + rn) * D + i * 256 + lane * 4);
#pragma unroll
            for (int i = 0; i < 4; ++i) { const int k = i * 256 + lane * 4; const f32x4 v = cur[i] * rsd * wm[i] + sa[i];
                *(us4*)(p.h2 + (row0 + r) * D + k) = pack4(v[0], v[1], v[2], v[3]); }
#pragma unroll
            for (int i = 0; i < 4; ++i) cur[i] = nxt[i];
        }
        __syncthreads();
    }
}

DEV bool moe_find_tile(const Params& p, int mtile, int& e, int& lt, int& rowoff, int& cnt) {
    int acc = 0;
    for (int q = 0; q < NEXP; ++q) { const int c = p.cnt[q * 32]; const int nt = (c + 127) >> 7; if (mtile < acc + nt) { e = q; lt = mtile - acc; rowoff = acc * 128; cnt = c; return true; } acc += nt; }
    return false;
}
DEV void ph_moe_up(const Params& p, char* smem) {
    const int tid = threadIdx.x, lane = tid & 63, wid = tid >> 6, wr = wid >> 1, wc = wid & 1, fr = lane & 15, quad = lane >> 4;
    const bool xcdmap = (gridDim.x & 7) == 0; const int xq = blockIdx.x & 7, qstep = xcdmap ? (int)(gridDim.x >> 3) : (int)gridDim.x;
    for (int q = xcdmap ? (int)(blockIdx.x >> 3) : (int)blockIdx.x; ; q += qstep) {
        const int mtile = xcdmap ? xq + 8 * (q >> 3) : (q >> 3), nt = q & 7;
        int e, lt, rowoff, cnt; if (!moe_find_tile(p, mtile, e, lt, rowoff, cnt)) break;
        LdGather la; const int lrow = tid >> 3, lc = stage_chunk();
#pragma unroll
        for (int i = 0; i < 4; ++i) { int li = lt * 128 + lrow + 32 * i; if (li >= cnt) li = cnt - 1; const int tok = p.elist[(size_t)e * T + li] >> 1; la.rp[i] = p.h2 + (size_t)tok * D + lc; }
        LdPlain lw(p.w13_t + (size_t)e * 1024 * 1024, (size_t)nt * 128, D);
        f32x4 acc[4][4]; zero_acc(acc);
        gemm_tile(acc, lw, la, D / 64, smem);
#pragma unroll
        for (int ni = 0; ni < 4; ++ni) { int li = lt * 128 + wc * 64 + ni * 16 + fr; const bool valid = li < cnt; if (!valid) li = cnt - 1; const float cw = p.ewt[(size_t)e * T + li];
#pragma unroll
            for (int mi = 0; mi < 2; ++mi) { float hv[4];
#pragma unroll
                for (int r = 0; r < 4; ++r) hv[r] = silu_f(acc[mi][ni][r]) * acc[mi + 2][ni][r] * cw;
                const int hidx = nt * 64 + wr * 32 + mi * 16 + quad * 4;
                if (valid) *(us4*)(p.hid + (size_t)(rowoff + lt * 128 + wc * 64 + ni * 16 + fr) * EH + hidx) = pack4(hv[0], hv[1], hv[2], hv[3]); } }
    }
}
DEV void ph_moe_down(const Params& p, char* smem) {
    const int tid = threadIdx.x, lane = tid & 63, wid = tid >> 6, wr = wid >> 1, wc = wid & 1, fr = lane & 15, quad = lane >> 4;
    const bool xcdmap = (gridDim.x & 7) == 0; const int xq = blockIdx.x & 7, qstep = xcdmap ? (int)(gridDim.x >> 3) : (int)gridDim.x;
    for (int q = xcdmap ? (int)(blockIdx.x >> 3) : (int)blockIdx.x; ; q += qstep) {
        const int mtile = xcdmap ? xq + 8 * (q >> 3) : (q >> 3), nt = q & 7;
        int e, lt, rowoff, cnt; if (!moe_find_tile(p, mtile, e, lt, rowoff, cnt)) break;
        LdGather la; const int lrow = tid >> 3, lc = stage_chunk();
#pragma unroll
        for (int i = 0; i < 4; ++i) { int li = lt * 128 + lrow + 32 * i; if (li >= cnt) li = cnt - 1; la.rp[i] = p.hid + (size_t)(rowoff + li) * EH + lc; }
        LdPlain lw(p.w2_t + (size_t)e * 1024 * EH, (size_t)nt * 128, EH);
        f32x4 acc[4][4]; zero_acc(acc);
        gemm_tile(acc, lw, la, EH / 64, smem);
#pragma unroll
        for (int ni = 0; ni < 4; ++ni) { const int li = lt * 128 + wc * 64 + ni * 16 + fr; if (li < cnt) { const int ts = p.elist[(size_t)e * T + li];
#pragma unroll
            for (int mi = 0; mi < 4; ++mi) *(us4*)(p.ymoe + (size_t)ts * D + nt * 128 + wr * 64 + mi * 16 + quad * 4) = pack4(acc[mi][ni][0], acc[mi][ni][1], acc[mi][ni][2], acc[mi][ni][3]); } }
    }
}
DEV void ph_final(const Params& p, char* smem) {
    const int lane = threadIdx.x & 63, wid = threadIdx.x >> 6;
    for (int row = blockIdx.x * 4 + wid; row < T; row += gridDim.x * 4) { const int b = row / L; const float* g2 = p.mod + (size_t)b * NMODC + 5 * D;
        f32x4 v[4]; float ss = 0.f;
#pragma unroll
        for (int i = 0; i < 4; ++i) { const int k = i * 256 + lane * 4; const f32x4 xv = *(const f32x4*)(p.x1 + (size_t)row * D + k), gv = *(const f32x4*)(g2 + k);
            const us4 y0 = *(const us4*)(p.ymoe + ((size_t)row * 2) * D + k), y1 = *(const us4*)(p.ymoe + ((size_t)row * 2 + 1) * D + k);
#pragma unroll
            for (int e = 0; e < 4; ++e) { v[i][e] = xv[e] + gv[e] * (bf2f(y0[e]) + bf2f(y1[e])); ss += v[i][e] * v[i][e]; } }
        ss = wave_sum(ss); const float rstd = rsqrtf(ss * (1.f / D) + 1e-6f);
#pragma unroll
        for (int i = 0; i < 4; ++i) { const int k = i * 256 + lane * 4; const f32x4 w = *(const f32x4*)(p.final_w + k); *(f32x4*)(p.out + (size_t)row * D + k) = v[i] * rstd * w; }
    }
}


#define XB_TMO      128
#define XB_XCNT(j)  (256  + 64 * (j))
#define XB_XSUB(j)  (1280 + 64 * (j))
#define XB_XGEN(j)  (2304 + 64 * (j))
#define XB_TOP      3328
#define XB_TOPGEN   3392
#define XCD_BAR_WORDS 3456
#ifndef CPU_EMU
#define XB_SPIN_CAP (1u << 22)
#define LAS __attribute__((address_space(3)))
__device__ __forceinline__ unsigned xb_ld(unsigned* p)              { return __hip_atomic_load(p, __ATOMIC_RELAXED, __HIP_MEMORY_SCOPE_AGENT); }
__device__ __forceinline__ unsigned xb_add(unsigned* p, unsigned v) { return __hip_atomic_fetch_add(p, v, __ATOMIC_RELAXED, __HIP_MEMORY_SCOPE_AGENT); }
__device__ __forceinline__ unsigned xb_xcc_id() { return (unsigned)__builtin_amdgcn_s_getreg((3 << 11) | 20) & 0xFu; }
#define XB_SPIN(cond, bar) do { unsigned _sp = 0; while (cond) { __builtin_amdgcn_s_sleep(1); \
    if ((++_sp & 255u) == 0u) { if (xb_ld(&(bar)[XB_TMO])) break; if (_sp > XB_SPIN_CAP) { atomicAdd(&(bar)[XB_TMO], 1u); break; } } } } while (0)
struct XcdBarrier { unsigned* bar; unsigned x; volatile LAS unsigned* st; };
__device__ __forceinline__ XcdBarrier xcd_barrier_post(unsigned* bar, volatile LAS unsigned* st) {
    XcdBarrier b; b.bar = bar; b.x = xb_xcc_id(); b.st = st;
    if (threadIdx.x == 0) (void)xb_add(&bar[XB_XCNT(b.x)], 1u);
    return b;
}
__device__ __forceinline__ void xcd_barrier_complete(unsigned* bar, unsigned x, unsigned& nloc, unsigned& nx) {
    const unsigned G = gridDim.x * gridDim.y * gridDim.z;
    unsigned sum, cnt, mine, sp = 0u;
    for (;;) {
        sum = 0u; cnt = 0u; mine = 0u;
#pragma unroll
        for (unsigned j = 0; j < 16; ++j) { const unsigned c = xb_ld(&bar[XB_XCNT(j)]); sum += c; cnt += (c > 0u) ? 1u : 0u; mine = (j == x) ? c : mine; }
        if (sum == G) break;
        __builtin_amdgcn_s_sleep(1);
        if ((++sp & 255u) == 0u) { if (xb_ld(&bar[XB_TMO])) break; if (sp > XB_SPIN_CAP) { atomicAdd(&bar[XB_TMO], 1u); break; } }
    }
    nloc = mine > 0u ? mine : 1u; nx = cnt > 0u ? cnt : 1u;
}
__device__ __forceinline__ void xcd_barrier(const XcdBarrier& b) {
    asm volatile("s_waitcnt vmcnt(0)" ::: "memory");
    __syncthreads();
    if (threadIdx.x == 0) {
        unsigned* bar = b.bar;
        __builtin_amdgcn_s_waitcnt(0);
        unsigned nloc = b.st[0], nx = b.st[1];
        if (nloc == 0u) { xcd_barrier_complete(bar, b.x, nloc, nx); b.st[0] = nloc; b.st[1] = nx; }
        const unsigned old = xb_add(&bar[XB_XSUB(b.x)], 1u);
        const unsigned gen = old / nloc;
        if (old + 1u == (gen + 1u) * nloc) {
            __builtin_amdgcn_fence(__ATOMIC_RELEASE, "agent");
            asm volatile("s_waitcnt vmcnt(0)" ::: "memory");
            const unsigned og = xb_add(&bar[XB_TOP], 1u);
            const unsigned tg = og / nx;
            if (og + 1u == (tg + 1u) * nx) xb_add(&bar[XB_TOPGEN], 1u);
            else XB_SPIN(xb_ld(&bar[XB_TOPGEN]) == tg, bar);
            __builtin_amdgcn_fence(__ATOMIC_ACQUIRE, "agent");
            xb_add(&bar[XB_XGEN(b.x)], 1u);
            asm volatile("s_waitcnt vmcnt(0)" ::: "memory");
        } else {
            XB_SPIN(xb_ld(&bar[XB_XGEN(b.x)]) == gen, bar);
            __builtin_amdgcn_fence(__ATOMIC_ACQUIRE, "agent");
            asm volatile("s_waitcnt vmcnt(0)" ::: "memory");
        }
    }
    __syncthreads();
}
#endif

#define PHASE_LIST(X) X(ph_prep) X(ph_norm1) X(ph_inproj) X(ph_conv_rscan) X(ph_rout_hynorm) X(ph_outproj) X(ph_norm2_router) X(ph_moe_up) X(ph_moe_down)

struct WsBuf { size_t size, off; int p0, p1; };
static size_t fill_params(Params& p, void* const* d_in, void* d_out, void* d_ws, int grid) {
    const float** in = (const float**)d_in;
    p.x = in[0]; p.c = in[1]; p.ctx = in[2]; p.c_ctx = in[3]; p.ada_w = in[4]; p.ada_b = in[5]; p.norm1_w = in[6]; p.w_in = in[7]; p.hy_conv_w = in[8]; p.hy_conv_b = in[9];
    p.f_w1 = in[10]; p.f_b1 = in[11]; p.f_w2 = in[12]; p.f_b2 = in[13]; p.f_w3 = in[14]; p.f_b3 = in[15]; p.f_wout = in[16]; p.f_freq = in[17]; p.hy_skip = in[18]; p.hy_out_norm = in[19];
    p.ret_gn_w = in[20]; p.w_out = in[21]; p.norm2_w = in[22]; p.rg_w = in[23]; p.rg_b = in[24]; p.re_w = in[25]; p.re_b = in[26]; p.exp_w1 = in[27]; p.exp_w3 = in[28]; p.exp_w2 = in[29]; p.final_w = in[30];
    p.out = (float*)d_out;
    char* ws = (char*)d_ws; WsBuf bufs[48]; void** slots[48]; int nb = 0; size_t total = 0;
#define WS(field, type, count, p0, p1) { slots[nb] = (void**)&p.field; bufs[nb] = WsBuf{((sizeof(type) * (size_t)(count)) + 255) & ~(size_t)255, 0, p0, p1}; ++nb; }
    WS(mod, float, (NB + 1) * NMODC, 0, 9); WS(cnt, int, NEXP * 32, 0, 9); WS(bar, unsigned, XCD_BAR_WORDS, 0, 9); WS(rope, float, 64 * 16 * 2, 0, 2); WS(w_in_t, bf16_t, PC * D, 0, 2); WS(w_out_t, bf16_t, D * D, 0, 5);
    WS(gtap, bf16_t, (size_t)HW * 2 * L, 0, 3);
    WS(hbuf, bf16_t, (size_t)TA * D, 1, 2); WS(RP, float, (size_t)NB * D * 32, 1, 6); WS(cb, float, NB * 32, 1, 6);
    WS(pT, bf16_t, (size_t)1536 * T, 2, 3); WS(qn, bf16_t, (size_t)T * 512, 2, 4); WS(kn, bf16_t, (size_t)T * 512, 2, 4); WS(kTf, bf16_t, (size_t)T * 512, 2, 3); WS(kTb, bf16_t, (size_t)T * 512, 2, 3); WS(vT, bf16_t, (size_t)T * 512, 2, 4);
    WS(ckTf, bf16_t, (size_t)TC * 512, 2, 3); WS(ckTb, bf16_t, (size_t)TC * 512, 2, 3); WS(cvT, bf16_t, (size_t)TC * 512, 2, 3); WS(gbuf, bf16_t, (size_t)T * 512, 2, 4);
    WS(yhyT, bf16_t, (size_t)HW * T, 3, 4); WS(Sst, bf16_t, (size_t)2 * NB * NH * NCH * 16384, 3, 4); WS(ycat, bf16_t, (size_t)T * D, 4, 5);
    WS(Pscr, bf16_t, (size_t)grid * 16384, 4, 4);
    WS(x1, float, (size_t)T * D, 5, 9); WS(w13_t, bf16_t, (size_t)NEXP * 1024 * 1024, 5, 7); WS(w2_t, bf16_t, (size_t)NEXP * 1024 * EH, 5, 8);
    WS(h2, bf16_t, (size_t)T * D, 6, 7); WS(elist, int, (size_t)NEXP * T, 6, 9); WS(ewt, float, (size_t)NEXP * T, 6, 9); WS(tok_e, int, (size_t)T * 2, 6, 9); WS(tok_pos, int, (size_t)T * 2, 6, 9);
    WS(hid, bf16_t, (size_t)(2 * T + NEXP * 128) * EH, 7, 8); WS(ymoe, bf16_t, (size_t)2 * T * D, 8, 9);
#undef WS
    int order[48]; for (int i = 0; i < nb; ++i) order[i] = i;
    for (int i = 1; i < nb; ++i) { const int v = order[i]; int j = i - 1; while (j >= 0 && bufs[order[j]].size < bufs[v].size) { order[j + 1] = order[j]; --j; } order[j + 1] = v; }
    bool placed[48]; for (int i = 0; i < nb; ++i) placed[i] = false;
    for (int oi = 0; oi < nb; ++oi) { WsBuf& nbuf = bufs[order[oi]]; size_t off = 0;
        for (bool moved = true; moved;) { moved = false;
            for (int i = 0; i < nb; ++i) { if (!placed[i]) continue; const WsBuf& b = bufs[i];
                if (b.p1 < nbuf.p0 || b.p0 > nbuf.p1) continue;
                if (off < b.off + b.size && b.off < off + nbuf.size) { off = b.off + b.size; moved = true; } } }
        nbuf.off = off; placed[order[oi]] = true; *slots[order[oi]] = (void*)(ws + off); if (off + nbuf.size > total) total = off + nbuf.size; }
    return total;
}

#ifndef CPU_EMU
__global__ void __launch_bounds__(NTHR, 2) mega_kernel(Params p) {
    extern __shared__ __attribute__((aligned(16))) char smem[];
    volatile LAS unsigned* st = (volatile LAS unsigned*)(smem + SMEM_BYTES - 16);
    if (threadIdx.x == 0) { st[0] = 0u; st[1] = 0u; }
    __syncthreads();
    const XcdBarrier xb = xcd_barrier_post(p.bar, st);
    if (p.out == nullptr) cg::this_grid().sync();
#define X(f) f(p, smem); xcd_barrier(xb);
    PHASE_LIST(X)
#undef X
    ph_final(p, smem);
}

extern "C" void kernel_launch(void* const* d_in, const int* in_sizes, int n_in, void* d_out, int out_size, void* d_ws, size_t ws_size, hipStream_t stream) {
    static int grid_blocks = 0;
    if (!grid_blocks) {
        int dev = 0, cus = 0, per_cu = 0;
        (void)hipGetDevice(&dev);
        (void)hipDeviceGetAttribute(&cus, hipDeviceAttributeMultiprocessorCount, dev);
        (void)hipFuncSetAttribute((const void*)mega_kernel, hipFuncAttributeMaxDynamicSharedMemorySize, SMEM_BYTES);
        (void)hipOccupancyMaxActiveBlocksPerMultiprocessor(&per_cu, mega_kernel, NTHR, SMEM_BYTES);
        if (per_cu > 2) per_cu = 2;
        if (per_cu < 1) per_cu = 1;
        grid_blocks = cus * per_cu;
    }
    Params p; memset(&p, 0, sizeof(p));
    const size_t need = fill_params(p, d_in, d_out, d_ws, grid_blocks);
    if (need > ws_size) { fprintf(stderr, "workspace too small: need %zu have %zu\n", need, ws_size); return; }
    (void)hipMemsetAsync(p.bar, 0, XCD_BAR_WORDS * sizeof(unsigned), stream);
    void* args[] = {&p};
    hipError_t e = hipLaunchCooperativeKernel((void*)mega_kernel, dim3(grid_blocks), dim3(NTHR), args, SMEM_BYTES, stream);
    if (e != hipSuccess) fprintf(stderr, "cooperative launch failed: %s (grid %d)\n", hipGetErrorString(e), grid_blocks);
}
#endif
```

```cpp
#ifdef CPU_EMU
#include "emu.h"
#else
#include <hip/hip_runtime.h>
#include <hip/hip_cooperative_groups.h>
#include <cstdio>
namespace cg = cooperative_groups;
#endif
#include <stdint.h>
#include <string.h>
#include <math.h>

#ifndef CFG_BATCH
#define CFG_BATCH 8
#endif
#ifndef CFG_SEQ
#define CFG_SEQ 2048
#endif
#ifndef CFG_CTX
#define CFG_CTX 256
#endif

#ifdef CPU_EMU
#define OPAQUE(x)
#define SCHED_FENCE()
#define LDS_AS
#else
#define LDS_AS __attribute__((address_space(3)))
#define OPAQUE(x) asm volatile("" : "+v"(x))
#define SCHED_FENCE() __builtin_amdgcn_sched_barrier(0)
#endif
#if defined(KPROBE_ID) && !defined(CPU_EMU)
#define KP_BEGIN(id) const unsigned long long kp_t0_##id = __builtin_amdgcn_s_memrealtime()
#define KP_END(id) do { if ((id) == KPROBE_ID && blockIdx.x == KPROBE_BLOCK && threadIdx.x == 0) *(unsigned long long*)(smem + SMEM_BYTES - 32) += __builtin_amdgcn_s_memrealtime() - kp_t0_##id; } while (0)
#else
#define KP_BEGIN(id)
#define KP_END(id)
#endif
#define DEV __device__ __forceinline__

typedef unsigned short bf16_t;
typedef short bf16x8 __attribute__((ext_vector_type(8)));
typedef float f32x4 __attribute__((ext_vector_type(4)));
typedef unsigned short us4 __attribute__((ext_vector_type(4)));

constexpr int NB = CFG_BATCH, L = CFG_SEQ, LC = CFG_CTX;
constexpr int D = 1024, T = NB * L, TC = NB * LC, TA = T + TC;
constexpr int HW = 512, NH = 4, DH = 128, CH = 128, PC = 3584, NMODC = 6 * D;
constexpr int NCH = L / CH, NCC = LC / CH, NCT = NCH + NCC;
constexpr int NEXP = 16, EH = 512;
constexpr int UP = L + 64;
constexpr int NTHR = 256;
constexpr int SMEM_BYTES = 77824;
constexpr int MAXTILES = T * 2 / 128 + NEXP;

struct Params {
    const float *x, *c, *ctx, *c_ctx, *ada_w, *ada_b, *norm1_w, *w_in, *hy_conv_w, *hy_conv_b, *f_w1, *f_b1, *f_w2, *f_b2, *f_w3, *f_b3,
        *f_wout, *f_freq, *hy_skip, *hy_out_norm, *ret_gn_w, *w_out, *norm2_w, *rg_w, *rg_b, *re_w, *re_b, *exp_w1, *exp_w3, *exp_w2, *final_w;
    float* out;
    float* mod;
    bf16_t* w_in_t;
    bf16_t* w_out_t;
    bf16_t* w13_t;
    bf16_t* w2_t;
    bf16_t* gtap;
    float* rope;
    bf16_t* hbuf;
    float* RP;
    float* cb;
    bf16_t* pT;
    bf16_t* qn;
    bf16_t* kn;
    bf16_t* kTf;
    bf16_t* kTb;
    bf16_t* vT;
    bf16_t* ckTf;
    bf16_t* ckTb;
    bf16_t* cvT;
    bf16_t* gbuf;
    bf16_t* Sst;
    bf16_t* yhyT;
    bf16_t* ycat;
    bf16_t* Pscr;
    bf16_t* Opart;
    float* x1;
    bf16_t* h2;
    unsigned* bar;
    int* cnt;
    int* elist;
    float* ewt;
    int* tok_e;
    int* tok_pos;
    bf16_t* hid;
    bf16_t* ymoe;
};

DEV uint32_t f_as_u(float f) { return __builtin_bit_cast(uint32_t, f); }
DEV float u_as_f(uint32_t u) { return __builtin_bit_cast(float, u); }
DEV float bf2f(bf16_t v) { return u_as_f(((uint32_t)v) << 16); }
#ifdef CPU_EMU
DEV bf16_t f2bf(float f) { uint32_t u = f_as_u(f); u += 0x7fffu + ((u >> 16) & 1u); return (bf16_t)(u >> 16); }
DEV us4 pack4(float a, float b, float c, float d) { us4 r; r[0] = f2bf(a); r[1] = f2bf(b); r[2] = f2bf(c); r[3] = f2bf(d); return r; }
#else
typedef __bf16 hwbf16x2 __attribute__((ext_vector_type(2)));
typedef __bf16 hwbf16x4 __attribute__((ext_vector_type(4)));
typedef float f32x2v __attribute__((ext_vector_type(2)));
DEV bf16_t f2bf(float f) { return __builtin_bit_cast(bf16_t, (__bf16)f); }
DEV us4 pack4(float a, float b, float c, float d) { const f32x4 v = {a, b, c, d}; return __builtin_bit_cast(us4, __builtin_convertvector(v, hwbf16x4)); }
#endif
DEV float silu_f(float v) { return v / (1.f + expf(-v)); }
DEV float wave_sum(float v) { v += __shfl_xor(v, 1); v += __shfl_xor(v, 2); v += __shfl_xor(v, 4); v += __shfl_xor(v, 8); v += __shfl_xor(v, 16); v += __shfl_xor(v, 32); return v; }
DEV float lg2_gamma(int h, bool bwd) { return log2f(1.f - exp2f(-((bwd ? 5.5f : 5.0f) + (float)h))); }

DEV int stage_chunk() { return ((threadIdx.x & 7) ^ ((threadIdx.x >> 4) & 7)) * 8; }
struct LdPlain {
    static constexpr bool kDirect = true;
    const bf16_t* rp[4];
    DEV LdPlain(const bf16_t* base, size_t row0, size_t ld) { const int lrow = threadIdx.x >> 3, lc = stage_chunk();
#pragma unroll
        for (int i = 0; i < 4; ++i) rp[i] = base + (row0 + lrow + 32 * i) * ld + lc; }
    DEV const bf16_t* src(int i, int kt) const { return rp[i] + kt * 64; }
    DEV bf16x8 ld(int i, int kt) const { return *(const bf16x8*)(rp[i] + kt * 64); }
};
struct LdGather {
    static constexpr bool kDirect = true;
    const bf16_t* rp[4];
    DEV const bf16_t* src(int i, int kt) const { return rp[i] + kt * 64; }
    DEV bf16x8 ld(int i, int kt) const { return *(const bf16x8*)(rp[i] + kt * 64); }
};
struct LdKScale {
    static constexpr bool kDirect = false;
    const bf16_t* rp[4]; float a, b; int lc;
    DEV LdKScale(const bf16_t* base, size_t row0, size_t ld, float a_, float b_) : a(a_), b(b_) { const int lrow = threadIdx.x >> 3; lc = stage_chunk();
#pragma unroll
        for (int i = 0; i < 4; ++i) rp[i] = base + (row0 + lrow + 32 * i) * ld + lc; }
    DEV const bf16_t* src(int i, int kt) const { return rp[i] + kt * 64; }
    DEV bf16x8 ld(int i, int kt) const { bf16x8 v = *(const bf16x8*)(rp[i] + kt * 64); const int k0 = kt * 64 + lc; bf16x8 o;
#pragma unroll
        for (int e = 0; e < 8; ++e) o[e] = (short)f2bf(bf2f((bf16_t)v[e]) * exp2f(a + b * (float)(k0 + e)));
        return o; }
};
struct LdRowScale {
    static constexpr bool kDirect = false;
    const bf16_t* rp[4]; float sc[4];
    DEV LdRowScale(const bf16_t* base, size_t row0, size_t ld, float a, float b) { const int lrow = threadIdx.x >> 3, lc = stage_chunk();
#pragma unroll
        for (int i = 0; i < 4; ++i) { rp[i] = base + (row0 + lrow + 32 * i) * ld + lc; sc[i] = exp2f(a + b * (float)(lrow + 32 * i)); } }
    DEV const bf16_t* src(int i, int kt) const { return rp[i] + kt * 64; }
    DEV bf16x8 ld(int i, int kt) const { bf16x8 v = *(const bf16x8*)(rp[i] + kt * 64); bf16x8 o;
#pragma unroll
        for (int e = 0; e < 8; ++e) o[e] = (short)f2bf(bf2f((bf16_t)v[e]) * sc[i]);
        return o; }
};
#ifdef CPU_EMU
DEV void glds16(const bf16_t* g, char* l) { memcpy(l, g, 16); }
DEV void wait_vm0() {}
#else
DEV void glds16(const bf16_t* g, char* l) { __builtin_amdgcn_global_load_lds((const __attribute__((address_space(1))) void*)g, (__attribute__((address_space(3))) void*)l, 16, 0, 0); }
DEV void wait_vm0() { asm volatile("s_waitcnt vmcnt(0)" ::: "memory"); }
#endif

struct NoHook { DEV void operator()(int, f32x4 (&)[4][4]) const {} };
template <class LX, class LY, class HK>
DEV void gemm_tile_h(f32x4 (&acc)[4][4], const LX& lx, const LY& ly, int nk, char* smem, const HK& hook) {
    int tid = threadIdx.x; OPAQUE(tid);
    const int lane = tid & 63, wid = tid >> 6, wr = wid >> 1, wc = wid & 1;
    const int fr = lane & 15, quad = lane >> 4;
    bf16x8 rx[4], ry[4];
    char* const sx = smem + tid * 16; char* const sy = smem + 32768 + tid * 16;
#pragma unroll
    for (int i = 0; i < 4; ++i) {
        if (LX::kDirect) glds16(lx.src(i, 0), sx + i * 4096); else rx[i] = lx.ld(i, 0);
        if (LY::kDirect) glds16(ly.src(i, 0), sy + i * 4096); else ry[i] = ly.ld(i, 0); }
#pragma unroll
    for (int i = 0; i < 4; ++i) { if (!LX::kDirect) *(bf16x8*)(sx + i * 4096) = rx[i]; if (!LY::kDirect) *(bf16x8*)(sy + i * 4096) = ry[i]; }
    wait_vm0();
    __syncthreads();
    const int sw = fr >> 1;
    for (int kt = 0; kt < nk; ++kt) {
        const char* bx = smem + (kt & 1) * 16384; const char* by = smem + 32768 + (kt & 1) * 16384;
        const int nb = ((kt + 1) & 1) * 16384;
        if (kt + 1 < nk) {
#pragma unroll
            for (int i = 0; i < 4; ++i) {
                if (LX::kDirect) glds16(lx.src(i, kt + 1), sx + nb + i * 4096); else rx[i] = lx.ld(i, kt + 1);
                if (LY::kDirect) glds16(ly.src(i, kt + 1), sy + nb + i * 4096); else ry[i] = ly.ld(i, kt + 1); }
        }
        hook(kt, acc);
        SCHED_FENCE();
#pragma unroll
        for (int kk = 0; kk < 2; ++kk) {
            bf16x8 xf[4], yf[4];
            const int ch = ((kk * 4 + quad) ^ sw) << 4;
#pragma unroll
            for (int mi = 0; mi < 4; ++mi) xf[mi] = *(const bf16x8*)(bx + (wr * 64 + mi * 16 + fr) * 128 + ch);
#pragma unroll
            for (int ni = 0; ni < 4; ++ni) yf[ni] = *(const bf16x8*)(by + (wc * 64 + ni * 16 + fr) * 128 + ch);
#pragma unroll
            for (int mi = 0; mi < 4; ++mi)
#pragma unroll
                for (int ni = 0; ni < 4; ++ni) acc[mi][ni] = __builtin_amdgcn_mfma_f32_16x16x32_bf16(xf[mi], yf[ni], acc[mi][ni], 0, 0, 0);
        }
        SCHED_FENCE();
        if (kt + 1 < nk) {
#pragma unroll
            for (int i = 0; i < 4; ++i) { if (!LX::kDirect) *(bf16x8*)(sx + nb + i * 4096) = rx[i]; if (!LY::kDirect) *(bf16x8*)(sy + nb + i * 4096) = ry[i]; }
        }
        wait_vm0();
        __syncthreads();
    }
}
template <class LX, class LY>
DEV void gemm_tile(f32x4 (&acc)[4][4], const LX& lx, const LY& ly, int nk, char* smem) { gemm_tile_h(acc, lx, ly, nk, smem, NoHook()); }

DEV int pipe_chunk() { return (int)(((threadIdx.x & 3) ^ ((0u - (threadIdx.x >> 4)) & 3u)) * 8); }
#ifdef CPU_EMU
#define PIPE_WAIT(n)
#define PIPE_BARRIER() __syncthreads()
#else
#define PIPE_WAIT(n) asm volatile("s_waitcnt vmcnt(" #n ")" ::: "memory")
#define PIPE_BARRIER() do { __builtin_amdgcn_sched_barrier(0); __builtin_amdgcn_s_barrier(); __builtin_amdgcn_sched_barrier(0); } while (0)
#endif
template <class LX, class LY, class HK>
DEV void gemm_pipe(f32x4 (&acc)[4][4], const LX& lx, const LY& ly, int nk, char* smem, const HK& hook) {
    int tid = threadIdx.x; OPAQUE(tid);
    const int lane = tid & 63, wid = tid >> 6, wr = wid >> 1, wc = wid & 1, fr = lane & 15, quad = lane >> 4;
    char* const sx = smem + tid * 16;
#pragma unroll
    for (int t = 0; t < 3; ++t) {
#pragma unroll
        for (int i = 0; i < 2; ++i) { glds16(lx.src(i, t), sx + t * 16384 + i * 4096); glds16(ly.src(i, t), sx + t * 16384 + 8192 + i * 4096); } }
    PIPE_WAIT(8);
    PIPE_BARRIER();
    const int rd = ((quad ^ ((0 - (fr >> 2)) & 3)) << 4) + fr * 64;
    for (int kt = 0; kt < nk; ++kt) {
        if (kt + 3 < nk) { const int sl = ((kt + 3) & 3) * 16384;
#pragma unroll
            for (int i = 0; i < 2; ++i) { glds16(lx.src(i, kt + 3), sx + sl + i * 4096); glds16(ly.src(i, kt + 3), sx + sl + 8192 + i * 4096); } }
        hook(kt, acc);
        SCHED_FENCE();
        const char* bx = smem + (kt & 3) * 16384; const char* by = bx + 8192;
        bf16x8 xf[4], yf[4];
#pragma unroll
        for (int mi = 0; mi < 4; ++mi) xf[mi] = *(const bf16x8*)(bx + (wr * 64 + mi * 16) * 64 + rd);
#pragma unroll
        for (int ni = 0; ni < 4; ++ni) yf[ni] = *(const bf16x8*)(by + (wc * 64 + ni * 16) * 64 + rd);
#pragma unroll
        for (int mi = 0; mi < 4; ++mi)
#pragma unroll
            for (int ni = 0; ni < 4; ++ni) acc[mi][ni] = __builtin_amdgcn_mfma_f32_16x16x32_bf16(xf[mi], yf[ni], acc[mi][ni], 0, 0, 0);
        SCHED_FENCE();
        if (kt + 3 < nk) PIPE_WAIT(8); else if (kt + 2 < nk) PIPE_WAIT(4); else PIPE_WAIT(0);
        PIPE_BARRIER();
    }
}
DEV void zero_acc(f32x4 (&acc)[4][4]) {
#pragma unroll
    for (int i = 0; i < 4; ++i)
#pragma unroll
        for (int j = 0; j < 4; ++j) acc[i][j] = (f32x4){0.f, 0.f, 0.f, 0.f};
}

DEV void task_ada(const Params& p, char* smem, int task) {
    float* sl = (float*)smem;
    float* red = sl + (NB + 1) * D;
    const int tid = threadIdx.x;
    for (int i = tid; i < (NB + 1) * D; i += NTHR) { const int r = i / D, k = i % D; const float v = r < NB ? p.c[r * D + k] : p.c_ctx[k]; sl[i] = silu_f(v); }
    __syncthreads();
    const int col = tid & 31, kq = tid >> 5, j = task * 32 + col;
    float acc[NB + 1];
#pragma unroll
    for (int r = 0; r <= NB; ++r) acc[r] = 0.f;
#pragma unroll 1
    for (int k = kq; k < D; k += 256) { float wv[32];
#pragma unroll
        for (int u = 0; u < 32; ++u) wv[u] = p.ada_w[(size_t)(k + 8 * u) * NMODC + j];
        SCHED_FENCE();
#pragma unroll
        for (int u = 0; u < 32; ++u) {
#pragma unroll
            for (int r = 0; r <= NB; ++r) acc[r] += sl[r * D + k + 8 * u] * wv[u];
            if ((u & 3) == 3) SCHED_FENCE(); } }
#pragma unroll
    for (int r = 0; r <= NB; ++r) red[(kq * (NB + 1) + r) * 32 + col] = acc[r];
    __syncthreads();
    for (int i = tid; i < (NB + 1) * 32; i += NTHR) { const int r = i / 32, cc = i % 32; float s = p.ada_b[task * 32 + cc];
        for (int q = 0; q < 8; ++q) s += red[(q * (NB + 1) + r) * 32 + cc];
        p.mod[r * NMODC + task * 32 + cc] = s; }
    __syncthreads();
}

DEV void transpose_tile(const float* src, int ldn, int k0, int n0, bf16_t* dst, size_t ldk, int mapmode, int which, const float* sc, int scsplit, const float* sc2, char* smem) {
    float* t = (float*)smem;
    const int tid = threadIdx.x;
    { const int r = tid >> 4, c4 = tid & 15;
#pragma unroll
      for (int i = 0; i < 4; ++i) { const int k = r + 16 * i; const f32x4 v = *(const f32x4*)(src + (size_t)(k0 + k) * ldn + n0 + c4 * 4);
          float s = 1.f; if (sc) { const int kk = k0 + k; s = kk < scsplit ? sc[kk] : sc2[kk - scsplit]; }
          t[k * 65 + c4 * 4 + 0] = v[0] * s; t[k * 65 + c4 * 4 + 1] = v[1] * s; t[k * 65 + c4 * 4 + 2] = v[2] * s; t[k * 65 + c4 * 4 + 3] = v[3] * s; } }
    __syncthreads();
    { const int n = tid >> 2, kc = tid & 3; const int nn = n0 + n;
      const int drow = mapmode == 0 ? nn : ((nn >> 6) * 128 + ((nn >> 5) & 1) * 64 + which * 32 + (nn & 31));
#pragma unroll
      for (int h = 0; h < 2; ++h) { bf16x8 o;
#pragma unroll
          for (int e = 0; e < 8; ++e) o[e] = (short)f2bf(t[(kc * 16 + h * 8 + e) * 65 + n]);
          *(bf16x8*)(dst + (size_t)drow * ldk + k0 + kc * 16 + h * 8) = o; } }
    __syncthreads();
}

DEV void task_filt(const Params& p, char* smem, int task) {
    float* z = (float*)smem;
    float* ha = z + 8 * 36;
    float* hb = ha + 8 * 64;
    float* w1 = hb + 8 * 64;
    float* w2 = w1 + 33 * 64;
    float* w3 = w2 + 64 * 64;
    const int tid = threadIdx.x, i0 = task * 8;
    {
        f32x4 a2[4], a3[4], a1[3];
#pragma unroll
        for (int u = 0; u < 4; ++u) { a2[u] = *(const f32x4*)(p.f_w2 + (u * 256 + tid) * 4); a3[u] = *(const f32x4*)(p.f_w3 + (u * 256 + tid) * 4); }
#pragma unroll
        for (int u = 0; u < 3; ++u) { const int i = u * 256 + tid; a1[u] = i < 528 ? *(const f32x4*)(p.f_w1 + i * 4) : (f32x4){0.f, 0.f, 0.f, 0.f}; }
#pragma unroll
        for (int u = 0; u < 4; ++u) { *(f32x4*)(w2 + (u * 256 + tid) * 4) = a2[u]; *(f32x4*)(w3 + (u * 256 + tid) * 4) = a3[u]; }
#pragma unroll
        for (int u = 0; u < 3; ++u) { const int i = u * 256 + tid; if (i < 528) *(f32x4*)(w1 + i * 4) = a1[u]; }
    }
    for (int i = tid; i < 8 * 33; i += NTHR) { const int pp = i / 33, f = i % 33, pos = i0 + pp; float v;
        if (f == 0) v = (float)pos / (float)(L - 1);
        else { const int bnd = (f - 1) & 15; const float band = 1e-4f + (float)bnd * ((15.f - 1e-4f) / 15.f);
               const float ang = (6.283185307179586f / (float)L) * (float)pos * band; v = f <= 16 ? cosf(ang) : -sinf(ang); }
        z[pp * 36 + f] = v; }
    __syncthreads();
    const int pp = tid >> 5, jq = tid & 31;
#pragma unroll 1
    for (int m = 0; m < 2; ++m) { const int j = jq + 32 * m; float s = p.f_b1[j];
#pragma unroll 3
        for (int k = 0; k < 33; ++k) s += z[pp * 36 + k] * w1[k * 64 + j];
        ha[pp * 64 + j] = sinf(p.f_freq[j] * s); }
    __syncthreads();
#pragma unroll 1
    for (int m = 0; m < 2; ++m) { const int j = jq + 32 * m; float s = p.f_b2[j];
#pragma unroll 4
        for (int k = 0; k < 64; ++k) s += ha[pp * 64 + k] * w2[k * 64 + j];
        hb[pp * 64 + j] = sinf(p.f_freq[j] * s); }
    __syncthreads();
#pragma unroll 1
    for (int m = 0; m < 2; ++m) { const int j = jq + 32 * m; float s = p.f_b3[j];
#pragma unroll 4
        for (int k = 0; k < 64; ++k) s += hb[pp * 64 + k] * w3[k * 64 + j];
        ha[pp * 64 + j] = sinf(p.f_freq[j] * s); }
    __syncthreads();
    const int cc4 = tid * 4;
    f32x4 acc[8];
#pragma unroll
    for (int q = 0; q < 8; ++q) acc[q] = (f32x4){0.f, 0.f, 0.f, 0.f};
    f32x4 wa[16];
#pragma unroll
    for (int kk = 0; kk < 16; ++kk) wa[kk] = *(const f32x4*)(p.f_wout + kk * 1024 + cc4);
#pragma unroll 1
    for (int k0 = 0; k0 < 64; k0 += 16) {
        f32x4 wb[16]; const int kn = k0 + 16 < 64 ? k0 + 16 : k0;
#pragma unroll
        for (int kk = 0; kk < 16; ++kk) wb[kk] = *(const f32x4*)(p.f_wout + (kn + kk) * 1024 + cc4);
#pragma unroll
        for (int kk = 0; kk < 16; ++kk)
#pragma unroll
            for (int q = 0; q < 8; ++q) acc[q] += wa[kk] * ha[q * 64 + k0 + kk];
#pragma unroll
        for (int kk = 0; kk < 16; ++kk) wa[kk] = wb[kk];
    }
    const float max_decay = logf(1e-2f) / 0.3f, min_decay = logf(1e-2f) / 1.5f;
    const bool isb = cc4 >= 512;
#pragma unroll
    for (int e = 0; e < 4; ++e) { const int c = (cc4 + e) & 511;
        const float delta = fabsf(min_decay + (float)c * ((max_decay - min_decay) / 511.f));
        const float sk = (!isb && task == 0) ? p.hy_skip[c] : 0.f;
#pragma unroll
        for (int q = 0; q < 8; ++q) { const int pos = i0 + q; const float tt = (float)pos / (float)(L - 1); const float win = expf(-tt * delta) + 0.05f; float val = acc[q][e] * win;
            if (!isb) { if (pos == 0) val += sk; p.gtap[(size_t)c * (2 * L) + (L - pos)] = f2bf(val); }
            else { if (pos == 0) p.gtap[(size_t)c * (2 * L)] = 0; else p.gtap[(size_t)c * (2 * L) + (L + pos)] = f2bf(val); } } }
    __syncthreads();
}

constexpr int NT_ADA = NMODC / 32;
constexpr int NT_WIN = 16 * 56, NT_WOUT = 16 * 16, NT_W13 = 16 * 2 * 16 * 8, NT_W2 = 16 * 8 * 16;
constexpr int NT_FILT = L / 8;
constexpr int NT_P0 = NT_ADA + NT_FILT + 1 + NT_WIN + NT_WOUT;

DEV void ph_prep(const Params& p, char* smem) {
    for (int task = blockIdx.x; task < NT_P0; task += gridDim.x) {
        int t = task;
        if (t < NT_ADA) { task_ada(p, smem, t); continue; } t -= NT_ADA;
        if (t < NT_FILT) { task_filt(p, smem, t); continue; } t -= NT_FILT;
        if (t < 1) {
            for (int i = threadIdx.x; i < 64 * 16; i += NTHR) { const int pos = i >> 4, f = i & 15; const float fr = powf(10000.f, -(float)f / 16.f); const float a = (float)pos * fr;
                p.rope[i * 2] = cosf(a); p.rope[i * 2 + 1] = sinf(a); }
            if (threadIdx.x < NEXP) p.cnt[threadIdx.x * 32] = 0;
            continue; } t -= 1;
        if (t < NT_WIN) { const int kt = t / 56, nt = t % 56; transpose_tile(p.w_in, PC, kt * 64, nt * 64, p.w_in_t, 1024, 0, 0, nullptr, 0, nullptr, smem); continue; } t -= NT_WIN;
        { const int kt = t / 16, nt = t % 16; transpose_tile(p.w_out, D, kt * 64, nt * 64, p.w_out_t, 1024, 0, 0, p.hy_out_norm, 512, p.ret_gn_w, smem); }
    }
}
DEV void expert_conv_task(const Params& p, char* smem, int t) {
    if (t < NT_W13) { const int e = t / 256, r = t % 256, which = r / 128, r2 = r % 128, kt = r2 / 8, nt = r2 % 8;
        transpose_tile((which ? p.exp_w3 : p.exp_w1) + (size_t)e * D * EH, EH, kt * 64, nt * 64, p.w13_t + (size_t)e * 1024 * 1024, 1024, 1, which, nullptr, 0, nullptr, smem); return; }
    t -= NT_W13;
    { const int e = t / 128, r = t % 128, kt = r / 16, nt = r % 16;
        transpose_tile(p.exp_w2 + (size_t)e * EH * D, D, kt * 64, nt * 64, p.w2_t + (size_t)e * 1024 * EH, EH, 0, 0, nullptr, 0, nullptr, smem); }
}

DEV void ph_norm1(const Params& p, char* smem) {
    const int tid = threadIdx.x, lane = tid & 63, wid = tid >> 6;
    {
        const int rstep = gridDim.x * 4; int row = blockIdx.x * 4 + wid;
        f32x4 w4[4];
#pragma unroll
        for (int i = 0; i < 4; ++i) w4[i] = *(const f32x4*)(p.norm1_w + i * 256 + lane * 4);
        f32x4 cur[4];
        if (row < TA) { const float* src = row < T ? p.x + (size_t)row * D : p.ctx + (size_t)(row - T) * D;
#pragma unroll
            for (int i = 0; i < 4; ++i) cur[i] = *(const f32x4*)(src + i * 256 + lane * 4); }
#pragma unroll 1
        for (; row < TA; row += rstep) {
            const int nrow = row + rstep < TA ? row + rstep : row;
            const float* nsrc = nrow < T ? p.x + (size_t)nrow * D : p.ctx + (size_t)(nrow - T) * D;
            f32x4 nxt[4];
#pragma unroll
            for (int i = 0; i < 4; ++i) nxt[i] = *(const f32x4*)(nsrc + i * 256 + lane * 4);
            const int mb = row < T ? row / L : NB;
            const float* sh = p.mod + (size_t)mb * NMODC; const float* sc = sh + D;
            f32x4 s1[4], s0[4];
#pragma unroll
            for (int i = 0; i < 4; ++i) { s1[i] = *(const f32x4*)(sc + i * 256 + lane * 4); s0[i] = *(const f32x4*)(sh + i * 256 + lane * 4); }
            float ss = 0.f;
#pragma unroll
            for (int i = 0; i < 4; ++i) ss += cur[i][0] * cur[i][0] + cur[i][1] * cur[i][1] + cur[i][2] * cur[i][2] + cur[i][3] * cur[i][3];
            ss = wave_sum(ss);
            const float rstd = rsqrtf(ss * (1.f / D) + 1e-6f);
#pragma unroll
            for (int i = 0; i < 4; ++i) { const int k = i * 256 + lane * 4; const f32x4 v = cur[i] * rstd * w4[i] * (1.f + s1[i]) + s0[i];
                *(us4*)(p.hbuf + (size_t)row * D + k) = pack4(v[0], v[1], v[2], v[3]); }
#pragma unroll
            for (int i = 0; i < 4; ++i) cur[i] = nxt[i];
        }
    }
    const int gtid = blockIdx.x * NTHR + tid, gn = gridDim.x * NTHR;
    for (int i = gtid; i < NB * D * 32; i += gn) { const int ii = i & 3, j = (i >> 2) & 31, k4 = (i >> 7) & 255, b = i >> 15; const int k = k4 * 4 + ii;
        const float r = j < 4 ? p.rg_w[k * 4 + j] : (j < 20 ? p.re_w[k * 16 + (j - 4)] : 0.f);
        p.RP[i] = p.norm2_w[k] * (1.f + p.mod[(size_t)b * NMODC + 4 * D + k]) * r; }
    for (int wt = blockIdx.x * 4 + wid; wt < NB * 32; wt += gridDim.x * 4) { const int b = wt >> 5, j = wt & 31; float s = 0.f;
        if (j < 20) for (int k = lane; k < D; k += 64) { const float r = j < 4 ? p.rg_w[k * 4 + j] : p.re_w[k * 16 + (j - 4)]; s += p.mod[(size_t)b * NMODC + 3 * D + k] * r; }
        s = wave_sum(s);
        if (lane == 0) p.cb[wt] = j < 4 ? s + p.rg_b[j] : (j < 20 ? s + p.re_b[j - 4] : 0.f); }
}

constexpr int NT_INP = (T / 128) * 28 + (TC / 128) * 8;
DEV void inproj_tile(const Params& p, char* smem, int mt, int nt) {
    int tid = threadIdx.x; OPAQUE(tid);
    const int lane = tid & 63, wid = tid >> 6, wr = wid >> 1, wc = wid & 1, fr = lane & 15, quad = lane >> 4;
    const size_t row0 = (size_t)mt * 128;
    const bool is_ctx = mt >= T / 128;
    const bool actX = (nt < 12) || (nt >= 16 && nt < 24);
    f32x4 acc[4][4]; zero_acc(acc);
    LdPlain la(p.hbuf, row0, D), lw(p.w_in_t, (size_t)nt * 128, D);
    if (actX) gemm_tile(acc, la, lw, D / 64, smem); else gemm_tile(acc, lw, la, D / 64, smem);
    if (nt < 12) {
#pragma unroll
        for (int mi = 0; mi < 4; ++mi)
#pragma unroll
            for (int ni = 0; ni < 4; ++ni) { const size_t tok = row0 + wr * 64 + mi * 16 + quad * 4; const int c = nt * 128 + wc * 64 + ni * 16 + fr;
                *(us4*)(p.pT + (size_t)c * T + tok) = pack4(acc[mi][ni][0], acc[mi][ni][1], acc[mi][ni][2], acc[mi][ni][3]); }
    } else if (nt >= 16 && nt < 24) {
        const bool isk = nt < 20; const int h = (nt - 16) & 3;
        if (!is_ctx) {
            const int b = (int)(row0 / L), tl0 = (int)(row0 % L);
            if (isk) {
                if (wc == 0) {
#pragma unroll
                    for (int mi = 0; mi < 4; ++mi)
#pragma unroll
                        for (int r = 0; r < 4; ++r) { const int tl = tl0 + wr * 64 + mi * 16 + quad * 4 + r;
                            { const float* cs = p.rope + ((tl >> 6) * 16 + fr) * 2; const float a = acc[mi][0][r], bq = acc[mi][1][r]; acc[mi][0][r] = a * cs[0] - bq * cs[1]; acc[mi][1][r] = a * cs[1] + bq * cs[0]; }
                            { const float* cs = p.rope + ((tl & 63) * 16 + fr) * 2; const float a = acc[mi][2][r], bq = acc[mi][3][r]; acc[mi][2][r] = a * cs[0] - bq * cs[1]; acc[mi][3][r] = a * cs[1] + bq * cs[0]; } }
                }
                const float scl = 0.08838834764831845f;
                const float lgf = lg2_gamma(h, false), lgb = lg2_gamma(h, true);
#pragma unroll
                for (int mi = 0; mi < 4; ++mi) { const int jl = wr * 64 + mi * 16 + quad * 4;
                    float zf[4], zb[4];
#pragma unroll
                    for (int r = 0; r < 4; ++r) { zf[r] = exp2f(lgf * (float)(127 - jl - r)); zb[r] = exp2f(lgb * (float)(jl + r)); }
#pragma unroll
                    for (int ni = 0; ni < 4; ++ni) { const int tl = tl0 + jl, d = wc * 64 + ni * 16 + fr; const size_t bh = (size_t)b * NH + h;
                        float kv[4];
#pragma unroll
                        for (int r = 0; r < 4; ++r) kv[r] = acc[mi][ni][r] * scl;
                        const us4 o = pack4(kv[0], kv[1], kv[2], kv[3]);
                        *(us4*)(p.kTf + (bh * 128 + d) * L + tl) = pack4(kv[0] * zf[0], kv[1] * zf[1], kv[2] * zf[2], kv[3] * zf[3]);
                        *(us4*)(p.kTb + (bh * 128 + d) * L + tl) = pack4(kv[0] * zb[0], kv[1] * zb[1], kv[2] * zb[2], kv[3] * zb[3]);
#pragma unroll
                        for (int r = 0; r < 4; ++r) p.kn[(bh * L + tl + r) * 128 + d] = o[r]; } }
            } else {
#pragma unroll
                for (int mi = 0; mi < 4; ++mi)
#pragma unroll
                    for (int ni = 0; ni < 4; ++ni) { const int tl = tl0 + wr * 64 + mi * 16 + quad * 4, d = wc * 64 + ni * 16 + fr; const size_t bh = (size_t)b * NH + h;
                        *(us4*)(p.vT + (bh * 128 + d) * L + tl) = pack4(acc[mi][ni][0], acc[mi][ni][1], acc[mi][ni][2], acc[mi][ni][3]); }
            }
        } else {
            const size_t cr0 = row0 - T; const int b = (int)(cr0 / LC), tl0 = (int)(cr0 % LC); const size_t bh = (size_t)b * NH + h;
            if (isk) {
                const float scl = 0.08838834764831845f; const float lgf = lg2_gamma(h, false), lgb = lg2_gamma(h, true);
#pragma unroll
                for (int mi = 0; mi < 4; ++mi) { const int jl = wr * 64 + mi * 16 + quad * 4; float zf[4], zb[4];
#pragma unroll
                    for (int r = 0; r < 4; ++r) { zf[r] = scl * exp2f(lgf * (float)(127 - jl - r)); zb[r] = scl * exp2f(lgb * (float)(jl + r)); }
#pragma unroll
                    for (int ni = 0; ni < 4; ++ni) { const int tl = tl0 + jl, d = wc * 64 + ni * 16 + fr;
                        *(us4*)(p.ckTf + (bh * 128 + d) * LC + tl) = pack4(acc[mi][ni][0] * zf[0], acc[mi][ni][1] * zf[1], acc[mi][ni][2] * zf[2], acc[mi][ni][3] * zf[3]);
                        *(us4*)(p.ckTb + (bh * 128 + d) * LC + tl) = pack4(acc[mi][ni][0] * zb[0], acc[mi][ni][1] * zb[1], acc[mi][ni][2] * zb[2], acc[mi][ni][3] * zb[3]); } }
            } else {
#pragma unroll
                for (int mi = 0; mi < 4; ++mi)
#pragma unroll
                    for (int ni = 0; ni < 4; ++ni) { const int tl = tl0 + wr * 64 + mi * 16 + quad * 4, d = wc * 64 + ni * 16 + fr;
                        *(us4*)(p.cvT + (bh * 128 + d) * LC + tl) = pack4(acc[mi][ni][0], acc[mi][ni][1], acc[mi][ni][2], acc[mi][ni][3]); }
            }
        }
    } else if (nt < 16) {
        const int h = nt - 12; const int b = (int)(row0 / L), tl0 = (int)(row0 % L);
        if (wr == 0) {
#pragma unroll
            for (int ni = 0; ni < 4; ++ni) { const int tl = tl0 + wc * 64 + ni * 16 + fr;
#pragma unroll
                for (int r = 0; r < 4; ++r) { const int j = quad * 4 + r;
                    { const float* cs = p.rope + ((tl >> 6) * 16 + j) * 2; const float a = acc[0][ni][r], bq = acc[1][ni][r]; acc[0][ni][r] = a * cs[0] - bq * cs[1]; acc[1][ni][r] = a * cs[1] + bq * cs[0]; }
                    { const float* cs = p.rope + ((tl & 63) * 16 + j) * 2; const float a = acc[2][ni][r], bq = acc[3][ni][r]; acc[2][ni][r] = a * cs[0] - bq * cs[1]; acc[3][ni][r] = a * cs[1] + bq * cs[0]; } } }
        }
#pragma unroll
        for (int mi = 0; mi < 4; ++mi)
#pragma unroll
            for (int ni = 0; ni < 4; ++ni) { const int tl = tl0 + wc * 64 + ni * 16 + fr, d = wr * 64 + mi * 16 + quad * 4; const size_t bh = (size_t)b * NH + h;
                *(us4*)(p.qn + (bh * L + tl) * 128 + d) = pack4(acc[mi][ni][0], acc[mi][ni][1], acc[mi][ni][2], acc[mi][ni][3]); }
    } else {
#pragma unroll
        for (int mi = 0; mi < 4; ++mi)
#pragma unroll
            for (int ni = 0; ni < 4; ++ni) { const size_t tok = row0 + wc * 64 + ni * 16 + fr; const int d = (nt - 24) * 128 + wr * 64 + mi * 16 + quad * 4;
                *(us4*)(p.gbuf + tok * 512 + d) = pack4(acc[mi][ni][0], acc[mi][ni][1], acc[mi][ni][2], acc[mi][ni][3]); }
    }
}
DEV void ph_inproj(const Params& p, char* smem) {
    constexpr int NMT = T / 128, NCM = TC / 128;
    const int G = gridDim.x, b = blockIdx.x;
    if ((G & 7) == 0 && NMT % 8 == 0) {
        constexpr int MX = NMT / 8;
        const int x = b & 7, li = b >> 3, nl = G >> 3;
        for (int q = li; q < MX * 28; q += nl) { const int ng = q / (MX * 4), rem = q % (MX * 4); inproj_tile(p, smem, x * MX + rem % MX, ng * 4 + rem / MX); }
        for (int t = b; t < NCM * 8; t += G) inproj_tile(p, smem, NMT + t / 8, 16 + t % 8);
        return;
    }
    for (int task = blockIdx.x; task < NT_INP; task += gridDim.x) {
        if (task < (T / 128) * 28) inproj_tile(p, smem, task / 28, task % 28);
        else { const int t = task - (T / 128) * 28; inproj_tile(p, smem, T / 128 + t / 8, 16 + t % 8); }
    }
}

constexpr int NU = L / 64, CSPLIT = 1, UPW = NU / (4 * CSPLIT), NGRP = NU / UPW;
typedef unsigned u32x2 __attribute__((ext_vector_type(2)));
typedef unsigned u32x4 __attribute__((ext_vector_type(4)));
constexpr int TAPC = 2 * L + 16;
DEV bf16x8 conv_afrag(const bf16_t* tcp, int m0a) {
    const u32x2 lo = *(const volatile LDS_AS u32x2*)(tcp + m0a), hi = *(const volatile LDS_AS u32x2*)(tcp + m0a + 4);
    const u32x4 v = {lo[0], lo[1], hi[0], hi[1]};
    return __builtin_bit_cast(bf16x8, v); }
DEV void conv3_w(const Params& p, int ch, float& w0, float& w1, float& w2, float& bs) { w0 = p.hy_conv_w[ch]; w1 = p.hy_conv_w[1536 + ch]; w2 = p.hy_conv_w[3072 + ch]; bs = p.hy_conv_b[ch]; }

DEV void conv_task(const Params& p, char* smem, int c, int half) {
    bf16_t* taps = (bf16_t*)smem;
    bf16_t* U = taps + 4 * TAPC;
    int tid = threadIdx.x; OPAQUE(tid);
    const int lane = tid & 63, w = tid >> 6, fr = lane & 15, quad = lane >> 4;
    {
        constexpr int NTC = (2 * L / 8 + NTHR - 1) / NTHR;
        constexpr int NGT = NB * (L / 8), NG = (NGT + NTHR - 1) / NTHR;
        float a0, a1, a2, ab, v0, v1, v2, vb; conv3_w(p, 512 + c, a0, a1, a2, ab); conv3_w(p, 1024 + c, v0, v1, v2, vb);
        bf16x8 tpv[NTC], x1v[NG], vv[NG]; bf16_t hx0[NG], hx9[NG], hv0[NG], hv9[NG];
#pragma unroll
        for (int u = 0; u < NTC; ++u) { int i = tid + u * NTHR; if (i >= 2 * L / 8) i = 2 * L / 8 - 1; tpv[u] = *(const bf16x8*)(p.gtap + (size_t)c * 2 * L + i * 8); }
#pragma unroll
        for (int u = 0; u < NG; ++u) { int g = tid + u * NTHR; if (g >= NGT) g = NGT - 1; const int b = g / (L / 8), t8 = (g % (L / 8)) * 8;
            const bf16_t* r1 = p.pT + (size_t)(512 + c) * T + (size_t)b * L + t8; const bf16_t* rv = p.pT + (size_t)(1024 + c) * T + (size_t)b * L + t8;
            x1v[u] = *(const bf16x8*)r1; vv[u] = *(const bf16x8*)rv;
            const int il = t8 > 0 ? -1 : 0, ir = t8 + 8 < L ? 8 : 7;
            hx0[u] = r1[il]; hv0[u] = rv[il]; hx9[u] = r1[ir]; hv9[u] = rv[ir]; }
        for (int i = tid; i < 8 * 8; i += NTHR) { const int b = i >> 3, q = i & 7; bf16_t* row = U + b * UP + (q < 4 ? q * 8 : 32 + L + (q - 4) * 8); *(bf16x8*)row = (bf16x8){0, 0, 0, 0, 0, 0, 0, 0}; }
        for (int i = tid; i < (8 - NB) * (L / 8); i += NTHR) *(bf16x8*)(U + (NB + i / (L / 8)) * UP + 32 + (i % (L / 8)) * 8) = (bf16x8){0, 0, 0, 0, 0, 0, 0, 0};
#pragma unroll
        for (int u = 0; u < NTC; ++u) { const int i = tid + u * NTHR; if (i >= 2 * L / 8) continue; const bf16x8 v = tpv[u];
            *(bf16x8*)(taps + i * 8) = v;
#pragma unroll
            for (int a = 1; a < 4; ++a)
#pragma unroll
                for (int e = 0; e < 8; ++e) { const int q = i * 8 + e - a; if (q >= 0) taps[a * TAPC + q] = (bf16_t)v[e]; } }
#pragma unroll
        for (int u = 0; u < NG; ++u) { const int g = tid + u * NTHR; if (g >= NGT) continue; const int b = g / (L / 8), t8 = (g % (L / 8)) * 8;
            float px[10], pv[10];
            px[0] = t8 > 0 ? bf2f(hx0[u]) : 0.f; pv[0] = t8 > 0 ? bf2f(hv0[u]) : 0.f; px[9] = t8 + 8 < L ? bf2f(hx9[u]) : 0.f; pv[9] = t8 + 8 < L ? bf2f(hv9[u]) : 0.f;
#pragma unroll
            for (int e = 0; e < 8; ++e) { px[e + 1] = bf2f((bf16_t)x1v[u][e]); pv[e + 1] = bf2f((bf16_t)vv[u][e]); }
            bf16x8 o;
#pragma unroll
            for (int e = 0; e < 8; ++e) { const float x1 = a0 * px[e] + a1 * px[e + 1] + a2 * px[e + 2] + ab; const float vq = v0 * pv[e] + v1 * pv[e + 1] + v2 * pv[e + 2] + vb; o[e] = (short)f2bf(x1 * vq); }
            *(bf16x8*)(U + b * UP + 32 + t8) = o; }
    }
    __syncthreads();
    f32x4 acc[2][UPW];
#pragma unroll
    for (int tp = 0; tp < 2; ++tp)
#pragma unroll
        for (int ui = 0; ui < UPW; ++ui) acc[tp][ui] = (f32x4){0.f, 0.f, 0.f, 0.f};
    const int bcol = fr & 7, i2 = fr >> 3;
    const bf16_t* Ub = U + bcol * UP + 32 + 32 * i2 + 8 * quad;
    const int al = (L - fr) & 3;
    const bf16_t* tcp = taps + al * TAPC;
    const int ub = UPW * (4 * half + w);
    const int mbase = L - fr + 8 * quad - 64 * ub - al;
#pragma unroll 1
    for (int jp = 1; jp >= 0; --jp) {
        bf16x8 af[2][UPW];
        int J0 = jp ? -1 : 0;
        if (jp) {
            const bf16x8 bfr = *(const bf16x8*)(Ub + 32 * J0);
#pragma unroll
            for (int tp = 0; tp < 2; ++tp)
#pragma unroll
                for (int ui = 0; ui < UPW; ++ui) { const bf16x8 a = conv_afrag(tcp, mbase - 64 * ui - 16 * tp + 32 * J0); acc[tp][ui] = __builtin_amdgcn_mfma_f32_16x16x32_bf16(a, bfr, acc[tp][ui], 0, 0, 0); }
            J0 = 1;
        }
#pragma unroll
        for (int tp = 0; tp < 2; ++tp)
#pragma unroll
            for (int ui = 0; ui < UPW; ++ui) af[tp][ui] = conv_afrag(tcp, mbase - 64 * ui - 16 * tp + 32 * J0);
        bf16x8 bnext = *(const bf16x8*)(Ub + 32 * J0);
#pragma unroll 1
        for (int grp = 0; grp < NGRP; ++grp) {
#pragma unroll
            for (int s = 0; s < UPW; ++s) {
                const bf16x8 bfr = bnext; { const int Jn = J0 + 2 < L / 32 ? J0 + 2 : J0; bnext = *(const bf16x8*)(Ub + 32 * Jn); }
#pragma unroll
                for (int tp = 0; tp < 2; ++tp)
#pragma unroll
                    for (int ui = 0; ui < UPW; ++ui) acc[tp][ui] = __builtin_amdgcn_mfma_f32_16x16x32_bf16(af[tp][(ui - s + UPW) % UPW], bfr, acc[tp][ui], 0, 0, 0);
                J0 += 2;
                if (grp < NGRP - 1 || s < UPW - 1) {
#pragma unroll
                    for (int tp = 0; tp < 2; ++tp) af[tp][(UPW - 1 - s) % UPW] = conv_afrag(tcp, mbase - 16 * tp + 32 * J0);
                }
            }
        }
    }
    if (bcol < NB) {
#pragma unroll
        for (int tp = 0; tp < 2; ++tp)
#pragma unroll
            for (int ui = 0; ui < UPW; ++ui) { const int I0 = 4 * (ub + ui) + tp; const int t = 16 * (I0 + 2 * i2) + 4 * quad;
                *(us4*)(p.yhyT + (size_t)c * T + (size_t)bcol * L + t) = pack4(acc[tp][ui][0], acc[tp][ui][1], acc[tp][ui][2], acc[tp][ui][3]); }
    }
    __syncthreads();
}

struct LdSeq64 {
    const bf16_t *cb, *lb; int dir;
    DEV LdSeq64(const bf16_t* cbase, const bf16_t* lbase, int row0, int dir_) : dir(dir_) { const int r = row0 + (threadIdx.x >> 2), lc = pipe_chunk(); cb = cbase + (size_t)r * LC + lc; lb = lbase + (size_t)r * L + lc; }
    DEV const bf16_t* src(int kt) const { const int n = kt >> 2, off = (kt & 3) * 32;
        if (n < NCC) { const int J = dir ? NCC - 1 - n : n; return cb + J * 128 + off; }
        const int I = dir ? NCH - 1 - (n - NCC) : n - NCC; return lb + I * 128 + off; }
};
struct RscanHook64 { bf16_t* so; int dir; float gch;
    DEV void store(int I, f32x4 (&acc)[2][2]) const {
#pragma unroll
        for (int mi = 0; mi < 2; ++mi)
#pragma unroll
            for (int ni = 0; ni < 2; ++ni) *(us4*)(so + (size_t)I * 16384 + (ni * 16) * 128 + mi * 16) = pack4(acc[mi][ni][0], acc[mi][ni][1], acc[mi][ni][2], acc[mi][ni][3]); }
    DEV void operator()(int kt, f32x4 (&acc)[2][2]) const {
        if (kt & 3) return; const int n = kt >> 2;
        if (n >= NCC) store(dir ? NCH - 1 - (n - NCC) : n - NCC, acc);
        if (n > 0) {
#pragma unroll
            for (int mi = 0; mi < 2; ++mi)
#pragma unroll
                for (int ni = 0; ni < 2; ++ni) acc[mi][ni] = acc[mi][ni] * gch; } }
};
DEV void rscan_task(const Params& p, char* smem, int task) {
    const int quadrant = task & 3, dh = quadrant >> 1, eh = quadrant & 1, bh = (task >> 2) % (NB * NH), dir = task / (4 * NB * NH), h = bh % NH;
    int tid = threadIdx.x; OPAQUE(tid);
    const int lane = tid & 63, wid = tid >> 6, wr = wid >> 1, wc = wid & 1, fr = lane & 15, quad = lane >> 4;
    const LdSeq64 lk((dir ? p.ckTb : p.ckTf) + (size_t)bh * 128 * LC, (dir ? p.kTb : p.kTf) + (size_t)bh * 128 * L, dh * 64, dir);
    const LdSeq64 lv(p.cvT + (size_t)bh * 128 * LC, p.vT + (size_t)bh * 128 * L, eh * 64, dir);
    RscanHook64 hk; hk.dir = dir; hk.gch = exp2f(128.f * lg2_gamma(h, dir == 1));
    hk.so = p.Sst + (((size_t)dir * NB * NH + bh) * NCH) * 16384 + (size_t)(eh * 64 + wc * 32 + fr) * 128 + dh * 64 + wr * 32 + quad * 4;
    f32x4 acc[2][2];
#pragma unroll
    for (int mi = 0; mi < 2; ++mi)
#pragma unroll
        for (int ni = 0; ni < 2; ++ni) acc[mi][ni] = (f32x4){0.f, 0.f, 0.f, 0.f};
    constexpr int nk = 4 * (NCT - 1);
    char* const sx = smem + tid * 16;
#pragma unroll
    for (int t = 0; t < 7; ++t) { if (t < nk) { glds16(lk.src(t), sx + t * 8192); glds16(lv.src(t), sx + t * 8192 + 4096); } }
    PIPE_WAIT(12);
    PIPE_BARRIER();
    const int rd = ((quad ^ ((0 - (fr >> 2)) & 3)) << 4) + fr * 64;
    for (int kt = 0; kt < nk; ++kt) {
        hk(kt, acc);
        SCHED_FENCE();
        if (kt + 7 < nk) { const int sl = ((kt + 7) & 7) * 8192; glds16(lk.src(kt + 7), sx + sl); glds16(lv.src(kt + 7), sx + sl + 4096); }
        SCHED_FENCE();
        const char* bx = smem + (kt & 7) * 8192; const char* by = bx + 4096;
        bf16x8 xf[2], yf[2];
#pragma unroll
        for (int mi = 0; mi < 2; ++mi) xf[mi] = *(const bf16x8*)(bx + (wr * 32 + mi * 16) * 64 + rd);
#pragma unroll
        for (int ni = 0; ni < 2; ++ni) yf[ni] = *(const bf16x8*)(by + (wc * 32 + ni * 16) * 64 + rd);
#pragma unroll
        for (int mi = 0; mi < 2; ++mi)
#pragma unroll
            for (int ni = 0; ni < 2; ++ni) acc[mi][ni] = __builtin_amdgcn_mfma_f32_16x16x32_bf16(xf[mi], yf[ni], acc[mi][ni], 0, 0, 0);
        SCHED_FENCE();
        const int rem = nk - 1 - kt;
        if (rem >= 7) PIPE_WAIT(12); else if (rem == 6) PIPE_WAIT(10); else if (rem == 5) PIPE_WAIT(8); else if (rem == 4) PIPE_WAIT(6); else if (rem == 3) PIPE_WAIT(4); else if (rem == 2) PIPE_WAIT(2); else PIPE_WAIT(0);
        PIPE_BARRIER();
    }
    hk.store(dir ? 0 : NCH - 1, acc);
}
constexpr int NT_RSC = 2 * NB * NH * 4;
constexpr int NT_CV = HW * CSPLIT, NT_RO = NB * NH * NCH;
DEV void rout_a_task(const Params& p, char* smem, int task);
DEV void ph_conv_rscan(const Params& p, char* smem) {
    const int G = gridDim.x, b = blockIdx.x;
    if (G == 2 * NT_RSC && NT_CV == 2 * NT_RSC && NT_RO == 2 * NT_RSC) {
        if (b < NT_RSC) { KP_BEGIN(0); rscan_task(p, smem, b); KP_END(0); KP_BEGIN(2); rout_a_task(p, smem, 2 * b); rout_a_task(p, smem, 2 * b + 1); KP_END(2); }
        else { KP_BEGIN(1); for (int k = 0; k < 2; ++k) { const int t = 2 * (b - NT_RSC) + k; conv_task(p, smem, t / CSPLIT, t % CSPLIT); } KP_END(1); }
        return;
    }
    for (int task = b; task < NT_RSC + NT_CV + NT_RO; task += G) {
        if (task < NT_RSC) rscan_task(p, smem, task); else if (task < NT_RSC + NT_CV) { const int t = task - NT_RSC; conv_task(p, smem, t / CSPLIT, t % CSPLIT); } else rout_a_task(p, smem, task - NT_RSC - NT_CV);
    }
}

DEV void hynorm_task(const Params& p, char* smem, int task) {
    bf16_t* tl = (bf16_t*)smem;
    const int tid = threadIdx.x; const size_t pos0 = (size_t)task * 64;
    const bool hasl = (pos0 % L) > 0, hasr = (pos0 % L) + 64 < L;
    for (int half = 0; half < 2; ++half) { const int c = tid + 256 * half; const bf16_t* src = p.yhyT + (size_t)c * T + pos0; const bf16_t* ps = p.pT + (size_t)c * T + pos0;
        float w0, w1, w2, wb; conv3_w(p, c, w0, w1, w2, wb);
        bf16x8 cv[8], pv[8];
#pragma unroll
        for (int q = 0; q < 8; ++q) { cv[q] = *(const bf16x8*)(src + q * 8); pv[q] = *(const bf16x8*)(ps + q * 8); }
        const bf16_t hl = ps[hasl ? -1 : 0], hr = ps[hasr ? 64 : 63];
        float prev = hasl ? bf2f(hl) : 0.f;
#pragma unroll
        for (int q = 0; q < 8; ++q)
#pragma unroll
            for (int e = 0; e < 8; ++e) { const float cur = bf2f((bf16_t)pv[q][e]);
                const float nxt = e < 7 ? bf2f((bf16_t)pv[q][e < 7 ? e + 1 : 7]) : (q < 7 ? bf2f((bf16_t)pv[q < 7 ? q + 1 : 7][0]) : (hasr ? bf2f(hr) : 0.f));
                const float x0 = w0 * prev + w1 * cur + w2 * nxt + wb;
                tl[(q * 8 + e) * 520 + c] = f2bf(x0 * bf2f((bf16_t)cv[q][e])); prev = cur; } }
    __syncthreads();
    const int pos = tid >> 2, part = tid & 3;
    float ss = 0.f;
    for (int q = 0; q < 16; ++q) { const bf16x8 v = *(const bf16x8*)(tl + pos * 520 + part * 128 + q * 8);
#pragma unroll
        for (int e = 0; e < 8; ++e) { const float f = bf2f((bf16_t)v[e]); ss += f * f; } }
    ss += __shfl_xor(ss, 1); ss += __shfl_xor(ss, 2);
    const float rstd = rsqrtf(ss * (1.f / 512.f) + 1e-6f);
    for (int q = 0; q < 16; ++q) { const bf16x8 v = *(const bf16x8*)(tl + pos * 520 + part * 128 + q * 8); bf16x8 o;
#pragma unroll
        for (int e = 0; e < 8; ++e) o[e] = (short)f2bf(bf2f((bf16_t)v[e]) * rstd);
        *(bf16x8*)(p.ycat + (pos0 + pos) * 1024 + part * 128 + q * 8) = o; }
    __syncthreads();
}
DEV void rout_a_task(const Params& p, char* smem, int task) {
    const int bh = task / NCH, I = task % NCH, h = bh % NH;
    int tid = threadIdx.x; OPAQUE(tid);
    const int lane = tid & 63, wid = tid >> 6, wr = wid >> 1, wc = wid & 1, fr = lane & 15, quad = lane >> 4;
    const float lgf = lg2_gamma(h, false), lgb = lg2_gamma(h, true);
    bf16_t* P = p.Pscr + (size_t)blockIdx.x * 16384;
    const bf16_t* qb = p.qn + ((size_t)bh * L + I * 128) * 128; const bf16_t* kb = p.kn + ((size_t)bh * L + I * 128) * 128;
    {
        f32x4 acc[4][4]; zero_acc(acc);
        LdPlain lk(kb, 0, 128), lq(qb, 0, 128);
        gemm_tile(acc, lk, lq, 2, smem);
#pragma unroll
        for (int mi = 0; mi < 4; ++mi)
#pragma unroll
            for (int ni = 0; ni < 4; ++ni) { const int i = wc * 64 + ni * 16 + fr, j0 = wr * 64 + mi * 16 + quad * 4; float v[4];
#pragma unroll
                for (int r = 0; r < 4; ++r) { const int j = j0 + r; const float dcy = i > j ? exp2f(lgf * (float)(i - j)) : (i == j ? 2.f : exp2f(lgb * (float)(j - i))); v[r] = acc[mi][ni][r] * dcy; }
                *(us4*)(P + i * 128 + j0) = pack4(v[0], v[1], v[2], v[3]); }
    }
    __syncthreads();
    f32x4 acc[4][4]; zero_acc(acc);
    {
        LdPlain lv(p.vT + (size_t)bh * 128 * L + I * 128, 0, L), lp(P, 0, 128);
        gemm_tile(acc, lv, lp, 2, smem);
    }
    bf16_t* op = p.Opart + (size_t)task * 16384;
#pragma unroll
    for (int mi = 0; mi < 4; ++mi)
#pragma unroll
        for (int ni = 0; ni < 4; ++ni) { const int i = wc * 64 + ni * 16 + fr, e = wr * 64 + mi * 16 + quad * 4; *(us4*)(op + i * 128 + e) = pack4(acc[mi][ni][0], acc[mi][ni][1], acc[mi][ni][2], acc[mi][ni][3]); }
}
DEV void rout_b_task(const Params& p, char* smem, int task) {
    const int bh = task / NCH, I = task % NCH, h = bh % NH, b = bh / NH;
    int tid = threadIdx.x; OPAQUE(tid);
    const int lane = tid & 63, wid = tid >> 6, wr = wid >> 1, wc = wid & 1, fr = lane & 15, quad = lane >> 4;
    const float lgf = lg2_gamma(h, false), lgb = lg2_gamma(h, true);
    const bf16_t* qb = p.qn + ((size_t)bh * L + I * 128) * 128;
    f32x4 acc[4][4];
    { const bf16_t* op = p.Opart + (size_t)task * 16384;
#pragma unroll
      for (int mi = 0; mi < 4; ++mi)
#pragma unroll
          for (int ni = 0; ni < 4; ++ni) { const int i = wc * 64 + ni * 16 + fr, e = wr * 64 + mi * 16 + quad * 4; const us4 v = *(const us4*)(op + i * 128 + e);
              acc[mi][ni] = (f32x4){bf2f(v[0]), bf2f(v[1]), bf2f(v[2]), bf2f(v[3])}; } }
    {
        LdPlain ls(p.Sst + (((size_t)0 * NB * NH + bh) * NCH + I) * 16384, 0, 128); LdRowScale lq(qb, 0, 128, lgf, lgf);
        gemm_tile(acc, ls, lq, 2, smem);
    }
    {
        LdPlain ls(p.Sst + (((size_t)1 * NB * NH + bh) * NCH + I) * 16384, 0, 128); LdRowScale lq(qb, 0, 128, 128.f * lgb, -lgb);
        gemm_tile(acc, ls, lq, 2, smem);
    }
    float* red = (float*)smem;
    float mean[4], rstd[4];
#pragma unroll
    for (int ni = 0; ni < 4; ++ni) { float s = 0.f, ss = 0.f;
#pragma unroll
        for (int mi = 0; mi < 4; ++mi)
#pragma unroll
            for (int r = 0; r < 4; ++r) { const float v = acc[mi][ni][r]; s += v; ss += v * v; }
        s += __shfl_xor(s, 16); s += __shfl_xor(s, 32); ss += __shfl_xor(ss, 16); ss += __shfl_xor(ss, 32);
        if (quad == 0) { const int i = wc * 64 + ni * 16 + fr; red[(wr * 128 + i) * 2] = s; red[(wr * 128 + i) * 2 + 1] = ss; } }
    __syncthreads();
#pragma unroll
    for (int ni = 0; ni < 4; ++ni) { const int i = wc * 64 + ni * 16 + fr; const float s = red[i * 2] + red[(128 + i) * 2], ss = red[i * 2 + 1] + red[(128 + i) * 2 + 1];
        mean[ni] = s * (1.f / 128.f); const float var = ss * (1.f / 128.f) - mean[ni] * mean[ni]; rstd[ni] = rsqrtf(fmaxf(var, 0.f) + 1e-6f); }
    us4 gv[4][4];
#pragma unroll
    for (int mi = 0; mi < 4; ++mi)
#pragma unroll
        for (int ni = 0; ni < 4; ++ni) { const int i = wc * 64 + ni * 16 + fr, e = wr * 64 + mi * 16 + quad * 4; const size_t tok = (size_t)b * L + I * 128 + i;
            gv[mi][ni] = *(const us4*)(p.gbuf + tok * 512 + h * 128 + e); }
#pragma unroll
    for (int mi = 0; mi < 4; ++mi)
#pragma unroll
        for (int ni = 0; ni < 4; ++ni) { const int i = wc * 64 + ni * 16 + fr, e = wr * 64 + mi * 16 + quad * 4; const size_t tok = (size_t)b * L + I * 128 + i; float y[4];
#pragma unroll
            for (int r = 0; r < 4; ++r) y[r] = (acc[mi][ni][r] - mean[ni]) * rstd[ni] * silu_f(bf2f(gv[mi][ni][r]));
            *(us4*)(p.ycat + tok * 1024 + 512 + h * 128 + e) = pack4(y[0], y[1], y[2], y[3]); }
    __syncthreads();
}
DEV void ph_rout_hynorm(const Params& p, char* smem) {
#pragma unroll 1
    for (int task = blockIdx.x; task < NB * NH * NCH + T / 64; task += gridDim.x) {
        if (task < NB * NH * NCH) { KP_BEGIN(3); rout_b_task(p, smem, task); KP_END(3); } else { KP_BEGIN(4); hynorm_task(p, smem, task - NB * NH * NCH); KP_END(4); } } }

DEV void outproj_tile(const Params& p, char* smem, int mt, int nt) {
    int tid = threadIdx.x; OPAQUE(tid);
    const int lane = tid & 63, wid = tid >> 6, wr = wid >> 1, wc = wid & 1, fr = lane & 15, quad = lane >> 4;
    f32x4 acc[4][4]; zero_acc(acc);
    LdPlain lw(p.w_out_t, (size_t)nt * 128, D), la(p.ycat, (size_t)mt * 128, D);
    gemm_tile(acc, lw, la, D / 64, smem);
    const int b = (mt * 128) / L; const float* g1 = p.mod + (size_t)b * NMODC + 2 * D;
#pragma unroll
    for (int mi = 0; mi < 4; ++mi)
#pragma unroll
        for (int ni = 0; ni < 4; ++ni) { const size_t tok = (size_t)mt * 128 + wc * 64 + ni * 16 + fr; const int col = nt * 128 + wr * 64 + mi * 16 + quad * 4;
            const f32x4 xv = *(const f32x4*)(p.x + tok * D + col), gv = *(const f32x4*)(g1 + col);
            *(f32x4*)(p.x1 + tok * D + col) = xv + gv * acc[mi][ni]; }
}
DEV void ph_outproj(const Params& p, char* smem) {
    constexpr int NMT = T / 128;
    const int G = gridDim.x, b = blockIdx.x;
    if ((G & 7) == 0 && NMT % 8 == 0) {
        constexpr int MX = NMT / 8, RB = MX < 8 ? MX : 8;
        const int x = b & 7, li = b >> 3, nl = G >> 3;
        for (int q = li; q < MX * 8; q += nl) { const int mg = q / (RB * 8), rem = q % (RB * 8); outproj_tile(p, smem, x * MX + mg * RB + rem % RB, rem / RB); }
    } else {
        for (int task = blockIdx.x; task < NMT * 8; task += gridDim.x) outproj_tile(p, smem, task / 8, task % 8);
    }
    for (int task = blockIdx.x; task < NT_W13 + NT_W2; task += gridDim.x) expert_conv_task(p, smem, task);
}

DEV void ph_norm2_router(const Params& p, char* smem) {
    const int tid = threadIdx.x, lane = tid & 63, wid = tid >> 6, fr = lane & 15, quad = lane >> 4;
    float* lgs = (float*)smem + wid * (16 * 33);
    float* rs = (float*)smem + 4 * 16 * 33 + wid * 16;
    int* lcnt = (int*)(smem + 16384); int* lbase = lcnt + NEXP;
    if (tid < NEXP) lcnt[tid] = 0;
    __syncthreads();
    for (int wt = blockIdx.x * 4 + wid; wt < T / 16; wt += gridDim.x * 4) {
        const size_t row0 = (size_t)wt * 16; const int b = (int)(row0 / L);
        const float* xr = p.x1 + (row0 + fr) * D + quad * 4;
        const float* rp = p.RP + (size_t)b * D * 32;
        f32x4 a0 = {0.f, 0.f, 0.f, 0.f}, a1 = a0; float ss = 0.f;
        const float* rpl = rp + ((size_t)quad * 32 + fr) * 4;
        f32x4 xv[4], b0[4], b1[4];
#pragma unroll
        for (int u = 0; u < 4; ++u) { xv[u] = *(const f32x4*)(xr + u * 16); b0[u] = *(const f32x4*)(rpl + (size_t)u * 512); b1[u] = *(const f32x4*)(rpl + (size_t)u * 512 + 64); }
#pragma unroll 1
        for (int k0 = 0; k0 < D; k0 += 64) {
            f32x4 xn[4], c0[4], c1[4];
            const int kn = k0 + 64 < D ? k0 + 64 : k0;
#pragma unroll
            for (int u = 0; u < 4; ++u) { xn[u] = *(const f32x4*)(xr + kn + u * 16); c0[u] = *(const f32x4*)(rpl + (size_t)(kn / 4 + u * 4) * 128); c1[u] = *(const f32x4*)(rpl + (size_t)(kn / 4 + u * 4) * 128 + 64); }
#pragma unroll
            for (int u = 0; u < 4; ++u) {
                ss += xv[u][0] * xv[u][0] + xv[u][1] * xv[u][1] + xv[u][2] * xv[u][2] + xv[u][3] * xv[u][3];
#pragma unroll
                for (int i = 0; i < 4; ++i) { a0 = __builtin_amdgcn_mfma_f32_16x16x4f32(xv[u][i], b0[u][i], a0, 0, 0, 0); a1 = __builtin_amdgcn_mfma_f32_16x16x4f32(xv[u][i], b1[u][i], a1, 0, 0, 0); }
            }
#pragma unroll
            for (int u = 0; u < 4; ++u) { xv[u] = xn[u]; b0[u] = c0[u]; b1[u] = c1[u]; }
        }
        ss += __shfl_xor(ss, 16); ss += __shfl_xor(ss, 32);
        const float rstd = rsqrtf(ss * (1.f / D) + 1e-6f);
        if (quad == 0) rs[fr] = rstd;
#pragma unroll
        for (int r = 0; r < 4; ++r) { lgs[(quad * 4 + r) * 33 + fr] = a0[r]; lgs[(quad * 4 + r) * 33 + 16 + fr] = a1[r]; }
        __syncthreads();
        int e0 = 0, e1 = 0, l0 = 0, l1 = 0; float w0 = 0.f, w1 = 0.f;
        if (lane < 16) {
            const float rsd = rs[lane]; float lg[20];
#pragma unroll
            for (int j = 0; j < 20; ++j) lg[j] = lgs[lane * 33 + j] * rsd + p.cb[b * 32 + j];
            int g = 0; float gm = lg[0];
#pragma unroll
            for (int j = 1; j < 4; ++j) if (lg[j] > gm) { gm = lg[j]; g = j; }
            float den = 0.f;
#pragma unroll
            for (int j = 0; j < 4; ++j) den += expf(lg[j] - gm);
            const float psel = 1.f / den;
            float le[4];
#pragma unroll
            for (int j = 0; j < 4; ++j) le[j] = g == 0 ? lg[4 + j] : (g == 1 ? lg[8 + j] : (g == 2 ? lg[12 + j] : lg[16 + j]));
            int i0 = 0; float m0 = le[0];
#pragma unroll
            for (int j = 1; j < 4; ++j) if (le[j] > m0) { m0 = le[j]; i0 = j; }
            int i1 = -1; float m1 = -3.0e38f;
#pragma unroll
            for (int j = 0; j < 4; ++j) if (j != i0 && le[j] > m1) { m1 = le[j]; i1 = j; }
            const float ex = expf(m1 - m0); w0 = psel / (1.f + ex); w1 = psel * ex / (1.f + ex);
            e0 = g * 4 + i0; e1 = g * 4 + i1;
            l0 = atomicAdd(lcnt + e0, 1); l1 = atomicAdd(lcnt + e1, 1);
        }
        __syncthreads();
        if (tid < NEXP) { const int c = lcnt[tid]; lbase[tid] = c ? atomicAdd(p.cnt + tid * 32, c) : 0; lcnt[tid] = 0; }
        __syncthreads();
        if (lane < 16) { const size_t tok = row0 + lane; const int p0 = lbase[e0] + l0, p1 = lbase[e1] + l1;
            p.elist[(size_t)e0 * T + p0] = (int)tok * 2; p.ewt[(size_t)e0 * T + p0] = w0;
            p.elist[(size_t)e1 * T + p1] = (int)tok * 2 + 1; p.ewt[(size_t)e1 * T + p1] = w1;
            p.tok_e[tok * 2] = e0; p.tok_e[tok * 2 + 1] = e1; p.tok_pos[tok * 2] = p0; p.tok_pos[tok * 2 + 1] = p1;
        }
        const float* sh = p.mod + (size_t)b * NMODC + 3 * D; const float* sc = sh + D;
        f32x4 wm[4], sa[4];
#pragma unroll
        for (int i = 0; i < 4; ++i) { const int k = i * 256 + lane * 4; const f32x4 w = *(const f32x4*)(p.norm2_w + k), s1 = *(const f32x4*)(sc + k); sa[i] = *(const f32x4*)(sh + k); wm[i] = w * (1.f + s1); }
        f32x4 cur[4];
#pragma unroll
        for (int i = 0; i < 4; ++i) cur[i] = *(const f32x4*)(p.x1 + row0 * D + i * 256 + lane * 4);
#pragma unroll 1
        for (int r = 0; r < 16; ++r) { const float rsd = rs[r]; f32x4 nxt[4]; const int rn = r < 15 ? r + 1 : r;
#pragma unroll
            for (int i = 0; i < 4; ++i) nxt[i] = *(const f32x4*)(p.x1 + (row0 + rn) * D + i * 256 + lane * 4);
#pragma unroll
            for (int i = 0; i < 4; ++i) { const int k = i * 256 + lane * 4; const f32x4 v = cur[i] * rsd * wm[i] + sa[i];
                *(us4*)(p.h2 + (row0 + r) * D + k) = pack4(v[0], v[1], v[2], v[3]); }
#pragma unroll
            for (int i = 0; i < 4; ++i) cur[i] = nxt[i];
        }
        __syncthreads();
    }
}

DEV bool moe_find_tile(const Params& p, int mtile, int& e, int& lt, int& rowoff, int& cnt) {
    int acc = 0;
    for (int q = 0; q < NEXP; ++q) { const int c = p.cnt[q * 32]; const int nt = (c + 127) >> 7; if (mtile < acc + nt) { e = q; lt = mtile - acc; rowoff = acc * 128; cnt = c; return true; } acc += nt; }
    return false;
}
DEV void ph_moe_up(const Params& p, char* smem) {
    const int tid = threadIdx.x, lane = tid & 63, wid = tid >> 6, wr = wid >> 1, wc = wid & 1, fr = lane & 15, quad = lane >> 4;
    const bool xcdmap = (gridDim.x & 7) == 0; const int xq = blockIdx.x & 7, qstep = xcdmap ? (int)(gridDim.x >> 3) : (int)gridDim.x;
    for (int q = xcdmap ? (int)(blockIdx.x >> 3) : (int)blockIdx.x; ; q += qstep) {
        const int mtile = xcdmap ? xq + 8 * (q >> 3) : (q >> 3), nt = q & 7;
        int e, lt, rowoff, cnt; if (!moe_find_tile(p, mtile, e, lt, rowoff, cnt)) break;
        LdGather la; const int lrow = tid >> 3, lc = stage_chunk();
#pragma unroll
        for (int i = 0; i < 4; ++i) { int li = lt * 128 + lrow + 32 * i; if (li >= cnt) li = cnt - 1; const int tok = p.elist[(size_t)e * T + li] >> 1; la.rp[i] = p.h2 + (size_t)tok * D + lc; }
        LdPlain lw(p.w13_t + (size_t)e * 1024 * 1024, (size_t)nt * 128, D);
        f32x4 acc[4][4]; zero_acc(acc);
        gemm_tile(acc, lw, la, D / 64, smem);
#pragma unroll
        for (int ni = 0; ni < 4; ++ni) { int li = lt * 128 + wc * 64 + ni * 16 + fr; const bool valid = li < cnt; if (!valid) li = cnt - 1; const float cw = p.ewt[(size_t)e * T + li];
#pragma unroll
            for (int mi = 0; mi < 2; ++mi) { float hv[4];
#pragma unroll
                for (int r = 0; r < 4; ++r) hv[r] = silu_f(acc[mi][ni][r]) * acc[mi + 2][ni][r] * cw;
                const int hidx = nt * 64 + wr * 32 + mi * 16 + quad * 4;
                if (valid) *(us4*)(p.hid + (size_t)(rowoff + lt * 128 + wc * 64 + ni * 16 + fr) * EH + hidx) = pack4(hv[0], hv[1], hv[2], hv[3]); } }
    }
}
DEV void ph_moe_down(const Params& p, char* smem) {
    const int tid = threadIdx.x, lane = tid & 63, wid = tid >> 6, wr = wid >> 1, wc = wid & 1, fr = lane & 15, quad = lane >> 4;
    const bool xcdmap = (gridDim.x & 7) == 0; const int xq = blockIdx.x & 7, qstep = xcdmap ? (int)(gridDim.x >> 3) : (int)gridDim.x;
    for (int q = xcdmap ? (int)(blockIdx.x >> 3) : (int)blockIdx.x; ; q += qstep) {
        const int mtile = xcdmap ? xq + 8 * (q >> 3) : (q >> 3), nt = q & 7;
        int e, lt, rowoff, cnt; if (!moe_find_tile(p, mtile, e, lt, rowoff, cnt)) break;
        LdGather la; const int lrow = tid >> 3, lc = stage_chunk();
#pragma unroll
        for (int i = 0; i < 4; ++i) { int li = lt * 128 + lrow + 32 * i; if (li >= cnt) li = cnt - 1; la.rp[i] = p.hid + (size_t)(rowoff + li) * EH + lc; }
        LdPlain lw(p.w2_t + (size_t)e * 1024 * EH, (size_t)nt * 128, EH);
        f32x4 acc[4][4]; zero_acc(acc);
        gemm_tile(acc, lw, la, EH / 64, smem);
#pragma unroll
        for (int ni = 0; ni < 4; ++ni) { const int li = lt * 128 + wc * 64 + ni * 16 + fr; if (li < cnt) { const int ts = p.elist[(size_t)e * T + li];
#pragma unroll
            for (int mi = 0; mi < 4; ++mi) *(us4*)(p.ymoe + (size_t)ts * D + nt * 128 + wr * 64 + mi * 16 + quad * 4) = pack4(acc[mi][ni][0], acc[mi][ni][1], acc[mi][ni][2], acc[mi][ni][3]); } }
    }
}
DEV void ph_final(const Params& p, char* smem) {
    const int lane = threadIdx.x & 63, wid = threadIdx.x >> 6;
    for (int row = blockIdx.x * 4 + wid; row < T; row += gridDim.x * 4) { const int b = row / L; const float* g2 = p.mod + (size_t)b * NMODC + 5 * D;
        f32x4 v[4]; float ss = 0.f;
#pragma unroll
        for (int i = 0; i < 4; ++i) { const int k = i * 256 + lane * 4; const f32x4 xv = *(const f32x4*)(p.x1 + (size_t)row * D + k), gv = *(const f32x4*)(g2 + k);
            const us4 y0 = *(const us4*)(p.ymoe + ((size_t)row * 2) * D + k), y1 = *(const us4*)(p.ymoe + ((size_t)row * 2 + 1) * D + k);
#pragma unroll
            for (int e = 0; e < 4; ++e) { v[i][e] = xv[e] + gv[e] * (bf2f(y0[e]) + bf2f(y1[e])); ss += v[i][e] * v[i][e]; } }
        ss = wave_sum(ss); const float rstd = rsqrtf(ss * (1.f / D) + 1e-6f);
#pragma unroll
        for (int i = 0; i < 4; ++i) { const int k = i * 256 + lane * 4; const f32x4 w = *(const f32x4*)(p.final_w + k); *(f32x4*)(p.out + (size_t)row * D + k) = v[i] * rstd * w; }
    }
}


#define XB_TMO      128
#define XB_XCNT(j)  (256  + 64 * (j))
#define XB_XSUB(j)  (1280 + 64 * (j))
#define XB_XGEN(j)  (2304 + 64 * (j))
#define XB_TOP      3328
#define XB_TOPGEN   3392
#define XCD_BAR_WORDS 3456
#ifndef CPU_EMU
#define XB_SPIN_CAP (1u << 22)
#define LAS __attribute__((address_space(3)))
__device__ __forceinline__ unsigned xb_ld(unsigned* p)              { return __hip_atomic_load(p, __ATOMIC_RELAXED, __HIP_MEMORY_SCOPE_AGENT); }
__device__ __forceinline__ unsigned xb_add(unsigned* p, unsigned v) { return __hip_atomic_fetch_add(p, v, __ATOMIC_RELAXED, __HIP_MEMORY_SCOPE_AGENT); }
__device__ __forceinline__ unsigned xb_xcc_id() { return (unsigned)__builtin_amdgcn_s_getreg((3 << 11) | 20) & 0xFu; }
#define XB_SPIN(cond, bar) do { unsigned _sp = 0; while (cond) { __builtin_amdgcn_s_sleep(1); \
    if ((++_sp & 255u) == 0u) { if (xb_ld(&(bar)[XB_TMO])) break; if (_sp > XB_SPIN_CAP) { atomicAdd(&(bar)[XB_TMO], 1u); break; } } } } while (0)
struct XcdBarrier { unsigned* bar; unsigned x; volatile LAS unsigned* st; };
__device__ __forceinline__ XcdBarrier xcd_barrier_post(unsigned* bar, volatile LAS unsigned* st) {
    XcdBarrier b; b.bar = bar; b.x = xb_xcc_id(); b.st = st;
    if (threadIdx.x == 0) (void)xb_add(&bar[XB_XCNT(b.x)], 1u);
    return b;
}
__device__ __forceinline__ void xcd_barrier_complete(unsigned* bar, unsigned x, unsigned& nloc, unsigned& nx) {
    const unsigned G = gridDim.x * gridDim.y * gridDim.z;
    unsigned sum, cnt, mine, sp = 0u;
    for (;;) {
        sum = 0u; cnt = 0u; mine = 0u;
#pragma unroll
        for (unsigned j = 0; j < 16; ++j) { const unsigned c = xb_ld(&bar[XB_XCNT(j)]); sum += c; cnt += (c > 0u) ? 1u : 0u; mine = (j == x) ? c : mine; }
        if (sum == G) break;
        __builtin_amdgcn_s_sleep(1);
        if ((++sp & 255u) == 0u) { if (xb_ld(&bar[XB_TMO])) break; if (sp > XB_SPIN_CAP) { atomicAdd(&bar[XB_TMO], 1u); break; } }
    }
    nloc = mine > 0u ? mine : 1u; nx = cnt > 0u ? cnt : 1u;
}
__device__ __forceinline__ void xcd_barrier(const XcdBarrier& b) {
    asm volatile("s_waitcnt vmcnt(0)" ::: "memory");
    __syncthreads();
    if (threadIdx.x == 0) {
        unsigned* bar = b.bar;
        __builtin_amdgcn_s_waitcnt(0);
        unsigned nloc = b.st[0], nx = b.st[1];
        if (nloc == 0u) { xcd_barrier_complete(bar, b.x, nloc, nx); b.st[0] = nloc; b.st[1] = nx; }
        const unsigned old = xb_add(&bar[XB_XSUB(b.x)], 1u);
        const unsigned gen = old / nloc;
        if (old + 1u == (gen + 1u) * nloc) {
            __builtin_amdgcn_fence(__ATOMIC_RELEASE, "agent");
            asm volatile("s_waitcnt vmcnt(0)" ::: "memory");
            const unsigned og = xb_add(&bar[XB_TOP], 1u);
            const unsigned tg = og / nx;
            if (og + 1u == (tg + 1u) * nx) xb_add(&bar[XB_TOPGEN], 1u);
            else XB_SPIN(xb_ld(&bar[XB_TOPGEN]) == tg, bar);
            __builtin_amdgcn_fence(__ATOMIC_ACQUIRE, "agent");
            xb_add(&bar[XB_XGEN(b.x)], 1u);
            asm volatile("s_waitcnt vmcnt(0)" ::: "memory");
        } else {
            XB_SPIN(xb_ld(&bar[XB_XGEN(b.x)]) == gen, bar);
            __builtin_amdgcn_fence(__ATOMIC_ACQUIRE, "agent");
            asm volatile("s_waitcnt vmcnt(0)" ::: "memory");
        }
    }
    __syncthreads();
}
#endif

#define PHASE_LIST(X) X(ph_prep) X(ph_norm1) X(ph_inproj) X(ph_conv_rscan) X(ph_rout_hynorm) X(ph_outproj) X(ph_norm2_router) X(ph_moe_up) X(ph_moe_down)

struct WsBuf { size_t size, off; int p0, p1; };
static size_t fill_params(Params& p, void* const* d_in, void* d_out, void* d_ws, int grid) {
    const float** in = (const float**)d_in;
    p.x = in[0]; p.c = in[1]; p.ctx = in[2]; p.c_ctx = in[3]; p.ada_w = in[4]; p.ada_b = in[5]; p.norm1_w = in[6]; p.w_in = in[7]; p.hy_conv_w = in[8]; p.hy_conv_b = in[9];
    p.f_w1 = in[10]; p.f_b1 = in[11]; p.f_w2 = in[12]; p.f_b2 = in[13]; p.f_w3 = in[14]; p.f_b3 = in[15]; p.f_wout = in[16]; p.f_freq = in[17]; p.hy_skip = in[18]; p.hy_out_norm = in[19];
    p.ret_gn_w = in[20]; p.w_out = in[21]; p.norm2_w = in[22]; p.rg_w = in[23]; p.rg_b = in[24]; p.re_w = in[25]; p.re_b = in[26]; p.exp_w1 = in[27]; p.exp_w3 = in[28]; p.exp_w2 = in[29]; p.final_w = in[30];
    p.out = (float*)d_out;
    char* ws = (char*)d_ws; WsBuf bufs[48]; void** slots[48]; int nb = 0; size_t total = 0;
#define WS(field, type, count, p0, p1) { slots[nb] = (void**)&p.field; bufs[nb] = WsBuf{((sizeof(type) * (size_t)(count)) + 255) & ~(size_t)255, 0, p0, p1}; ++nb; }
    WS(mod, float, (NB + 1) * NMODC, 0, 9); WS(cnt, int, NEXP * 32, 0, 9); WS(bar, unsigned, XCD_BAR_WORDS, 0, 9); WS(rope, float, 64 * 16 * 2, 0, 2); WS(w_in_t, bf16_t, PC * D, 0, 2); WS(w_out_t, bf16_t, D * D, 0, 5);
    WS(gtap, bf16_t, (size_t)HW * 2 * L, 0, 3);
    WS(hbuf, bf16_t, (size_t)TA * D, 1, 2); WS(RP, float, (size_t)NB * D * 32, 1, 6); WS(cb, float, NB * 32, 1, 6);
    WS(pT, bf16_t, (size_t)1536 * T, 2, 4); WS(qn, bf16_t, (size_t)T * 512, 2, 4); WS(kn, bf16_t, (size_t)T * 512, 2, 3); WS(kTf, bf16_t, (size_t)T * 512, 2, 3); WS(kTb, bf16_t, (size_t)T * 512, 2, 3); WS(vT, bf16_t, (size_t)T * 512, 2, 3);
    WS(ckTf, bf16_t, (size_t)TC * 512, 2, 3); WS(ckTb, bf16_t, (size_t)TC * 512, 2, 3); WS(cvT, bf16_t, (size_t)TC * 512, 2, 3); WS(gbuf, bf16_t, (size_t)T * 512, 2, 4);
    WS(yhyT, bf16_t, (size_t)HW * T, 3, 4); WS(Sst, bf16_t, (size_t)2 * NB * NH * NCH * 16384, 3, 4); WS(ycat, bf16_t, (size_t)T * D, 4, 5);
    WS(Pscr, bf16_t, (size_t)grid * 16384, 3, 3); WS(Opart, bf16_t, (size_t)NB * NH * NCH * 16384, 3, 4);
    WS(x1, float, (size_t)T * D, 5, 9); WS(w13_t, bf16_t, (size_t)NEXP * 1024 * 1024, 5, 7); WS(w2_t, bf16_t, (size_t)NEXP * 1024 * EH, 5, 8);
    WS(h2, bf16_t, (size_t)T * D, 6, 7); WS(elist, int, (size_t)NEXP * T, 6, 9); WS(ewt, float, (size_t)NEXP * T, 6, 9); WS(tok_e, int, (size_t)T * 2, 6, 9); WS(tok_pos, int, (size_t)T * 2, 6, 9);
    WS(hid, bf16_t, (size_t)(2 * T + NEXP * 128) * EH, 7, 8); WS(ymoe, bf16_t, (size_t)2 * T * D, 8, 9);
#undef WS
    int order[48]; for (int i = 0; i < nb; ++i) order[i] = i;
    for (int i = 1; i < nb; ++i) { const int v = order[i]; int j = i - 1; while (j >= 0 && bufs[order[j]].size < bufs[v].size) { order[j + 1] = order[j]; --j; } order[j + 1] = v; }
    bool placed[48]; for (int i = 0; i < nb; ++i) placed[i] = false;
    for (int oi = 0; oi < nb; ++oi) { WsBuf& nbuf = bufs[order[oi]]; size_t off = 0;
        for (bool moved = true; moved;) { moved = false;
            for (int i = 0; i < nb; ++i) { if (!placed[i]) continue; const WsBuf& b = bufs[i];
                if (b.p1 < nbuf.p0 || b.p0 > nbuf.p1) continue;
                if (off < b.off + b.size && b.off < off + nbuf.size) { off = b.off + b.size; moved = true; } } }
        nbuf.off = off; placed[order[oi]] = true; *slots[order[oi]] = (void*)(ws + off); if (off + nbuf.size > total) total = off + nbuf.size; }
    return total;
}

#ifndef CPU_EMU
__global__ void __launch_bounds__(NTHR, 2) mega_kernel(Params p) {
    extern __shared__ __attribute__((aligned(16))) char smem[];
    volatile LAS unsigned* st = (volatile LAS unsigned*)(smem + SMEM_BYTES - 16);
    if (threadIdx.x == 0) { st[0] = 0u; st[1] = 0u; *(unsigned long long*)(smem + SMEM_BYTES - 32) = 0ull; }
    __syncthreads();
    const XcdBarrier xb = xcd_barrier_post(p.bar, st);
    if (p.out == nullptr) cg::this_grid().sync();
#define X(f) f(p, smem); xcd_barrier(xb);
    PHASE_LIST(X)
#undef X
    ph_final(p, smem);
#ifdef KPROBE_ID
    if (blockIdx.x == KPROBE_BLOCK && threadIdx.x == 0) { const unsigned long long tn = __builtin_amdgcn_s_memrealtime(), wait = (unsigned long long)KPROBE_AMP * *(unsigned long long*)(smem + SMEM_BYTES - 32); while (__builtin_amdgcn_s_memrealtime() - tn < wait) __builtin_amdgcn_s_sleep(8); }
#endif
}

extern "C" void kernel_launch(void* const* d_in, const int* in_sizes, int n_in, void* d_out, int out_size, void* d_ws, size_t ws_size, hipStream_t stream) {
    static int grid_blocks = 0;
    if (!grid_blocks) {
        int dev = 0, cus = 0, per_cu = 0;
        (void)hipGetDevice(&dev);
        (void)hipDeviceGetAttribute(&cus, hipDeviceAttributeMultiprocessorCount, dev);
        (void)hipFuncSetAttribute((const void*)mega_kernel, hipFuncAttributeMaxDynamicSharedMemorySize, SMEM_BYTES);
        (void)hipOccupancyMaxActiveBlocksPerMultiprocessor(&per_cu, mega_kernel, NTHR, SMEM_BYTES);
        if (per_cu > 2) per_cu = 2;
        if (per_cu < 1) per_cu = 1;
        grid_blocks = cus * per_cu;
    }
    Params p; memset(&p, 0, sizeof(p));
    const size_t need = fill_params(p, d_in, d_out, d_ws, grid_blocks);
    if (need > ws_size) { fprintf(stderr, "workspace too small: need %zu have %zu\n", need, ws_size); return; }
    (void)hipMemsetAsync(p.bar, 0, XCD_BAR_WORDS * sizeof(unsigned), stream);
    void* args[] = {&p};
    hipError_t e = hipLaunchCooperativeKernel((void*)mega_kernel, dim3(grid_blocks), dim3(NTHR), args, SMEM_BYTES, stream);
    if (e != hipSuccess) fprintf(stderr, "cooperative launch failed: %s (grid %d)\n", hipGetErrorString(e), grid_blocks);
}
#endif
```

```cpp
#ifdef CPU_EMU
#include "emu.h"
#else
#include <hip/hip_runtime.h>
#include <hip/hip_cooperative_groups.h>
#include <cstdio>
namespace cg = cooperative_groups;
#endif
#include <stdint.h>
#include <string.h>
#include <math.h>

#ifndef CFG_BATCH
#define CFG_BATCH 8
#endif
#ifndef CFG_SEQ
#define CFG_SEQ 2048
#endif
#ifndef CFG_CTX
#define CFG_CTX 256
#endif

#ifdef CPU_EMU
#define OPAQUE(x)
#define SCHED_FENCE()
#define LDS_AS
#define WT_STORE(ptr, v) (*(ptr) = (v))
#else
#define WT_STORE(ptr, v) __hip_atomic_store((ptr), (v), __ATOMIC_RELAXED, __HIP_MEMORY_SCOPE_AGENT)
#define LDS_AS __attribute__((address_space(3)))
#define OPAQUE(x) asm volatile("" : "+v"(x))
#define SCHED_FENCE() __builtin_amdgcn_sched_barrier(0)
#endif
#if defined(KPROBE_ID) && !defined(CPU_EMU)
#define KP_BEGIN(id) const unsigned long long kp_t0_##id = __builtin_amdgcn_s_memrealtime()
#define KP_END(id) do { if ((id) == KPROBE_ID && blockIdx.x == KPROBE_BLOCK && threadIdx.x == 0) *(unsigned long long*)(smem + SMEM_BYTES - 32) += __builtin_amdgcn_s_memrealtime() - kp_t0_##id; } while (0)
#else
#define KP_BEGIN(id)
#define KP_END(id)
#endif
#define DEV __device__ __forceinline__

typedef unsigned short bf16_t;
typedef short bf16x8 __attribute__((ext_vector_type(8)));
typedef float f32x4 __attribute__((ext_vector_type(4)));
typedef unsigned short us4 __attribute__((ext_vector_type(4)));

constexpr int NB = CFG_BATCH, L = CFG_SEQ, LC = CFG_CTX;
constexpr int D = 1024, T = NB * L, TC = NB * LC, TA = T + TC;
constexpr int HW = 512, NH = 4, DH = 128, CH = 128, PC = 3584, NMODC = 6 * D;
constexpr int NCH = L / CH, NCC = LC / CH, NCT = NCH + NCC;
constexpr int NEXP = 16, EH = 512;
constexpr int UP = L + 64;
constexpr int NTHR = 256;
constexpr int SMEM_BYTES = 77824;
constexpr int MAXTILES = T * 2 / 128 + NEXP;

struct Params {
    const float *x, *c, *ctx, *c_ctx, *ada_w, *ada_b, *norm1_w, *w_in, *hy_conv_w, *hy_conv_b, *f_w1, *f_b1, *f_w2, *f_b2, *f_w3, *f_b3,
        *f_wout, *f_freq, *hy_skip, *hy_out_norm, *ret_gn_w, *w_out, *norm2_w, *rg_w, *rg_b, *re_w, *re_b, *exp_w1, *exp_w3, *exp_w2, *final_w;
    float* out;
    float* mod;
    bf16_t* w_in_t;
    bf16_t* w_out_t;
    bf16_t* w13_t;
    bf16_t* w2_t;
    bf16_t* gtap;
    float* rope;
    float* h3buf;
    bf16_t* hbuf;
    float* RP;
    float* cb;
    bf16_t* pT;
    bf16_t* qn;
    bf16_t* kn;
    bf16_t* kTf;
    bf16_t* kTb;
    bf16_t* vT;
    bf16_t* ckTf;
    bf16_t* ckTb;
    bf16_t* cvT;
    bf16_t* gbuf;
    bf16_t* Sst;
    bf16_t* yhyT;
    bf16_t* ycat;
    bf16_t* Pscr;
    bf16_t* Opart;
    float* x1;
    bf16_t* h2;
    unsigned* bar;
    int* cnt;
    int* elist;
    float* ewt;
    bf16_t* hid;
    bf16_t* ymoe;
};

DEV uint32_t f_as_u(float f) { return __builtin_bit_cast(uint32_t, f); }
DEV float u_as_f(uint32_t u) { return __builtin_bit_cast(float, u); }
DEV float bf2f(bf16_t v) { return u_as_f(((uint32_t)v) << 16); }
#ifdef CPU_EMU
DEV bf16_t f2bf(float f) { uint32_t u = f_as_u(f); u += 0x7fffu + ((u >> 16) & 1u); return (bf16_t)(u >> 16); }
DEV us4 pack4(float a, float b, float c, float d) { us4 r; r[0] = f2bf(a); r[1] = f2bf(b); r[2] = f2bf(c); r[3] = f2bf(d); return r; }
#else
typedef __bf16 hwbf16x2 __attribute__((ext_vector_type(2)));
typedef __bf16 hwbf16x4 __attribute__((ext_vector_type(4)));
typedef float f32x2v __attribute__((ext_vector_type(2)));
DEV bf16_t f2bf(float f) { return __builtin_bit_cast(bf16_t, (__bf16)f); }
DEV us4 pack4(float a, float b, float c, float d) { const f32x4 v = {a, b, c, d}; return __builtin_bit_cast(us4, __builtin_convertvector(v, hwbf16x4)); }
#endif
DEV float silu_f(float v) { return v / (1.f + expf(-v)); }
DEV float wave_sum(float v) { v += __shfl_xor(v, 1); v += __shfl_xor(v, 2); v += __shfl_xor(v, 4); v += __shfl_xor(v, 8); v += __shfl_xor(v, 16); v += __shfl_xor(v, 32); return v; }
DEV float lg2_gamma(int h, bool bwd) { return log2f(1.f - exp2f(-((bwd ? 5.5f : 5.0f) + (float)h))); }

DEV int stage_chunk() { return ((threadIdx.x & 7) ^ ((threadIdx.x >> 4) & 7)) * 8; }
struct LdPlain {
    static constexpr bool kDirect = true;
    const bf16_t* rp[4];
    DEV LdPlain(const bf16_t* base, size_t row0, size_t ld) { const int lrow = threadIdx.x >> 3, lc = stage_chunk();
#pragma unroll
        for (int i = 0; i < 4; ++i) rp[i] = base + (row0 + lrow + 32 * i) * ld + lc; }
    DEV const bf16_t* src(int i, int kt) const { return rp[i] + kt * 64; }
    DEV bf16x8 ld(int i, int kt) const { return *(const bf16x8*)(rp[i] + kt * 64); }
};
struct LdGather {
    static constexpr bool kDirect = true;
    const bf16_t* rp[4];
    DEV const bf16_t* src(int i, int kt) const { return rp[i] + kt * 64; }
    DEV bf16x8 ld(int i, int kt) const { return *(const bf16x8*)(rp[i] + kt * 64); }
};
struct LdKScale {
    static constexpr bool kDirect = false;
    const bf16_t* rp[4]; float a, b; int lc;
    DEV LdKScale(const bf16_t* base, size_t row0, size_t ld, float a_, float b_) : a(a_), b(b_) { const int lrow = threadIdx.x >> 3; lc = stage_chunk();
#pragma unroll
        for (int i = 0; i < 4; ++i) rp[i] = base + (row0 + lrow + 32 * i) * ld + lc; }
    DEV const bf16_t* src(int i, int kt) const { return rp[i] + kt * 64; }
    DEV bf16x8 ld(int i, int kt) const { bf16x8 v = *(const bf16x8*)(rp[i] + kt * 64); const int k0 = kt * 64 + lc; bf16x8 o;
#pragma unroll
        for (int e = 0; e < 8; ++e) o[e] = (short)f2bf(bf2f((bf16_t)v[e]) * exp2f(a + b * (float)(k0 + e)));
        return o; }
};
struct LdRowScale {
    static constexpr bool kDirect = false;
    const bf16_t* rp[4]; float sc[4];
    DEV LdRowScale(const bf16_t* base, size_t row0, size_t ld, float a, float b) { const int lrow = threadIdx.x >> 3, lc = stage_chunk();
#pragma unroll
        for (int i = 0; i < 4; ++i) { rp[i] = base + (row0 + lrow + 32 * i) * ld + lc; sc[i] = exp2f(a + b * (float)(lrow + 32 * i)); } }
    DEV const bf16_t* src(int i, int kt) const { return rp[i] + kt * 64; }
    DEV bf16x8 ld(int i, int kt) const { bf16x8 v = *(const bf16x8*)(rp[i] + kt * 64); bf16x8 o;
#pragma unroll
        for (int e = 0; e < 8; ++e) o[e] = (short)f2bf(bf2f((bf16_t)v[e]) * sc[i]);
        return o; }
};
#ifdef CPU_EMU
DEV void glds16(const bf16_t* g, char* l) { memcpy(l, g, 16); }
DEV void wait_vm0() {}
#else
DEV void glds16(const bf16_t* g, char* l) { __builtin_amdgcn_global_load_lds((const __attribute__((address_space(1))) void*)g, (__attribute__((address_space(3))) void*)l, 16, 0, 0); }
DEV void wait_vm0() { asm volatile("s_waitcnt vmcnt(0)" ::: "memory"); }
#endif

struct NoHook { DEV void operator()(int, f32x4 (&)[4][4]) const {} };
template <class LX, class LY, class HK>
DEV void gemm_tile_h(f32x4 (&acc)[4][4], const LX& lx, const LY& ly, int nk, char* smem, const HK& hook) {
    int tid = threadIdx.x; OPAQUE(tid);
    const int lane = tid & 63, wid = tid >> 6, wr = wid >> 1, wc = wid & 1;
    const int fr = lane & 15, quad = lane >> 4;
    bf16x8 rx[4], ry[4];
    char* const sx = smem + tid * 16; char* const sy = smem + 32768 + tid * 16;
#pragma unroll
    for (int i = 0; i < 4; ++i) {
        if (LX::kDirect) glds16(lx.src(i, 0), sx + i * 4096); else rx[i] = lx.ld(i, 0);
        if (LY::kDirect) glds16(ly.src(i, 0), sy + i * 4096); else ry[i] = ly.ld(i, 0); }
#pragma unroll
    for (int i = 0; i < 4; ++i) { if (!LX::kDirect) *(bf16x8*)(sx + i * 4096) = rx[i]; if (!LY::kDirect) *(bf16x8*)(sy + i * 4096) = ry[i]; }
    wait_vm0();
    __syncthreads();
    const int sw = fr >> 1;
    for (int kt = 0; kt < nk; ++kt) {
        const char* bx = smem + (kt & 1) * 16384; const char* by = smem + 32768 + (kt & 1) * 16384;
        const int nb = ((kt + 1) & 1) * 16384;
        if (kt + 1 < nk) {
#pragma unroll
            for (int i = 0; i < 4; ++i) {
                if (LX::kDirect) glds16(lx.src(i, kt + 1), sx + nb + i * 4096); else rx[i] = lx.ld(i, kt + 1);
                if (LY::kDirect) glds16(ly.src(i, kt + 1), sy + nb + i * 4096); else ry[i] = ly.ld(i, kt + 1); }
        }
        hook(kt, acc);
        SCHED_FENCE();
#pragma unroll
        for (int kk = 0; kk < 2; ++kk) {
            bf16x8 xf[4], yf[4];
            const int ch = ((kk * 4 + quad) ^ sw) << 4;
#pragma unroll
            for (int mi = 0; mi < 4; ++mi) xf[mi] = *(const bf16x8*)(bx + (wr * 64 + mi * 16 + fr) * 128 + ch);
#pragma unroll
            for (int ni = 0; ni < 4; ++ni) yf[ni] = *(const bf16x8*)(by + (wc * 64 + ni * 16 + fr) * 128 + ch);
#pragma unroll
            for (int mi = 0; mi < 4; ++mi)
#pragma unroll
                for (int ni = 0; ni < 4; ++ni) acc[mi][ni] = __builtin_amdgcn_mfma_f32_16x16x32_bf16(xf[mi], yf[ni], acc[mi][ni], 0, 0, 0);
        }
        SCHED_FENCE();
        if (kt + 1 < nk) {
#pragma unroll
            for (int i = 0; i < 4; ++i) { if (!LX::kDirect) *(bf16x8*)(sx + nb + i * 4096) = rx[i]; if (!LY::kDirect) *(bf16x8*)(sy + nb + i * 4096) = ry[i]; }
        }
        wait_vm0();
        __syncthreads();
    }
}
template <class LX, class LY>
DEV void gemm_tile(f32x4 (&acc)[4][4], const LX& lx, const LY& ly, int nk, char* smem) { gemm_tile_h(acc, lx, ly, nk, smem, NoHook()); }

DEV int pipe_chunk() { return (int)(((threadIdx.x & 3) ^ ((0u - (threadIdx.x >> 4)) & 3u)) * 8); }
#ifdef CPU_EMU
#define PIPE_WAIT(n)
#define PIPE_BARRIER() __syncthreads()
#else
#define PIPE_WAIT(n) asm volatile("s_waitcnt vmcnt(" #n ")" ::: "memory")
#define PIPE_BARRIER() do { __builtin_amdgcn_sched_barrier(0); __builtin_amdgcn_s_barrier(); __builtin_amdgcn_sched_barrier(0); } while (0)
#endif
template <class LX, class LY, class HK>
DEV void gemm_pipe(f32x4 (&acc)[4][4], const LX& lx, const LY& ly, int nk, char* smem, const HK& hook) {
    int tid = threadIdx.x; OPAQUE(tid);
    const int lane = tid & 63, wid = tid >> 6, wr = wid >> 1, wc = wid & 1, fr = lane & 15, quad = lane >> 4;
    char* const sx = smem + tid * 16;
#pragma unroll
    for (int t = 0; t < 3; ++t) {
#pragma unroll
        for (int i = 0; i < 2; ++i) { glds16(lx.src(i, t), sx + t * 16384 + i * 4096); glds16(ly.src(i, t), sx + t * 16384 + 8192 + i * 4096); } }
    PIPE_WAIT(8);
    PIPE_BARRIER();
    const int rd = ((quad ^ ((0 - (fr >> 2)) & 3)) << 4) + fr * 64;
    for (int kt = 0; kt < nk; ++kt) {
        if (kt + 3 < nk) { const int sl = ((kt + 3) & 3) * 16384;
#pragma unroll
            for (int i = 0; i < 2; ++i) { glds16(lx.src(i, kt + 3), sx + sl + i * 4096); glds16(ly.src(i, kt + 3), sx + sl + 8192 + i * 4096); } }
        hook(kt, acc);
        SCHED_FENCE();
        const char* bx = smem + (kt & 3) * 16384; const char* by = bx + 8192;
        bf16x8 xf[4], yf[4];
#pragma unroll
        for (int mi = 0; mi < 4; ++mi) xf[mi] = *(const bf16x8*)(bx + (wr * 64 + mi * 16) * 64 + rd);
#pragma unroll
        for (int ni = 0; ni < 4; ++ni) yf[ni] = *(const bf16x8*)(by + (wc * 64 + ni * 16) * 64 + rd);
#pragma unroll
        for (int mi = 0; mi < 4; ++mi)
#pragma unroll
            for (int ni = 0; ni < 4; ++ni) acc[mi][ni] = __builtin_amdgcn_mfma_f32_16x16x32_bf16(xf[mi], yf[ni], acc[mi][ni], 0, 0, 0);
        SCHED_FENCE();
        if (kt + 3 < nk) PIPE_WAIT(8); else if (kt + 2 < nk) PIPE_WAIT(4); else PIPE_WAIT(0);
        PIPE_BARRIER();
    }
}
DEV void zero_acc(f32x4 (&acc)[4][4]) {
#pragma unroll
    for (int i = 0; i < 4; ++i)
#pragma unroll
        for (int j = 0; j < 4; ++j) acc[i][j] = (f32x4){0.f, 0.f, 0.f, 0.f};
}

DEV void task_ada(const Params& p, char* smem, int task) {
    float* sl = (float*)smem;
    float* red = sl + (NB + 1) * D;
    const int tid = threadIdx.x;
    for (int i = tid; i < (NB + 1) * D; i += NTHR) { const int r = i / D, k = i % D; const float v = r < NB ? p.c[r * D + k] : p.c_ctx[k]; sl[i] = silu_f(v); }
    __syncthreads();
    const int col = tid & 31, kq = tid >> 5, j = task * 32 + col;
    float acc[NB + 1];
#pragma unroll
    for (int r = 0; r <= NB; ++r) acc[r] = 0.f;
#pragma unroll 1
    for (int k = kq; k < D; k += 256) { float wv[32];
#pragma unroll
        for (int u = 0; u < 32; ++u) wv[u] = p.ada_w[(size_t)(k + 8 * u) * NMODC + j];
        SCHED_FENCE();
#pragma unroll
        for (int u = 0; u < 32; ++u) {
#pragma unroll
            for (int r = 0; r <= NB; ++r) acc[r] += sl[r * D + k + 8 * u] * wv[u];
            if ((u & 3) == 3) SCHED_FENCE(); } }
#pragma unroll
    for (int r = 0; r <= NB; ++r) red[(kq * (NB + 1) + r) * 32 + col] = acc[r];
    __syncthreads();
    for (int i = tid; i < (NB + 1) * 32; i += NTHR) { const int r = i / 32, cc = i % 32; float s = p.ada_b[task * 32 + cc];
        for (int q = 0; q < 8; ++q) s += red[(q * (NB + 1) + r) * 32 + cc];
        p.mod[r * NMODC + task * 32 + cc] = s; }
    __syncthreads();
}

DEV void transpose_tile(const float* src, int ldn, int k0, int n0, bf16_t* dst, size_t ldk, int mapmode, int which, const float* sc, int scsplit, const float* sc2, char* smem) {
    float* t = (float*)smem;
    const int tid = threadIdx.x;
    { const int r = tid >> 4, c4 = tid & 15;
#pragma unroll
      for (int i = 0; i < 4; ++i) { const int k = r + 16 * i; const f32x4 v = *(const f32x4*)(src + (size_t)(k0 + k) * ldn + n0 + c4 * 4);
          float s = 1.f; if (sc) { const int kk = k0 + k; s = kk < scsplit ? sc[kk] : sc2[kk - scsplit]; }
          t[k * 65 + c4 * 4 + 0] = v[0] * s; t[k * 65 + c4 * 4 + 1] = v[1] * s; t[k * 65 + c4 * 4 + 2] = v[2] * s; t[k * 65 + c4 * 4 + 3] = v[3] * s; } }
    __syncthreads();
    { const int n = tid >> 2, kc = tid & 3; const int nn = n0 + n;
      const int drow = mapmode == 0 ? nn : ((nn >> 6) * 128 + ((nn >> 5) & 1) * 64 + which * 32 + (nn & 31));
#pragma unroll
      for (int h = 0; h < 2; ++h) { bf16x8 o;
#pragma unroll
          for (int e = 0; e < 8; ++e) o[e] = (short)f2bf(t[(kc * 16 + h * 8 + e) * 65 + n]);
          *(bf16x8*)(dst + (size_t)drow * ldk + k0 + kc * 16 + h * 8) = o; } }
    __syncthreads();
}

DEV void task_filt_mlp(const Params& p, char* smem, int task) {
    float* z = (float*)smem;
    float* ha = z + 8 * 36;
    float* hb = ha + 8 * 64;
    float* w1 = hb + 8 * 64;
    float* w2 = w1 + 33 * 64;
    float* w3 = w2 + 64 * 64;
    const int tid = threadIdx.x, i0 = task * 8;
    {   f32x4 a2[4], a3[4], a1[3];
#pragma unroll
        for (int u = 0; u < 4; ++u) { a2[u] = *(const f32x4*)(p.f_w2 + (u * 256 + tid) * 4); a3[u] = *(const f32x4*)(p.f_w3 + (u * 256 + tid) * 4); }
#pragma unroll
        for (int u = 0; u < 3; ++u) { const int i = u * 256 + tid; a1[u] = i < 528 ? *(const f32x4*)(p.f_w1 + i * 4) : (f32x4){0.f, 0.f, 0.f, 0.f}; }
#pragma unroll
        for (int u = 0; u < 4; ++u) { *(f32x4*)(w2 + (u * 256 + tid) * 4) = a2[u]; *(f32x4*)(w3 + (u * 256 + tid) * 4) = a3[u]; }
#pragma unroll
        for (int u = 0; u < 3; ++u) { const int i = u * 256 + tid; if (i < 528) *(f32x4*)(w1 + i * 4) = a1[u]; }
    }
    for (int i = tid; i < 8 * 33; i += NTHR) { const int pp = i / 33, f = i % 33, pos = i0 + pp; float v;
        if (f == 0) v = (float)pos / (float)(L - 1);
        else { const int bnd = (f - 1) & 15; const float band = 1e-4f + (float)bnd * ((15.f - 1e-4f) / 15.f);
               const float ang = (6.283185307179586f / (float)L) * (float)pos * band; v = f <= 16 ? cosf(ang) : -sinf(ang); }
        z[pp * 36 + f] = v; }
    __syncthreads();
    const int pp = tid >> 5, jq = tid & 31;
#pragma unroll 1
    for (int m = 0; m < 2; ++m) { const int j = jq + 32 * m; float s = p.f_b1[j];
#pragma unroll 3
        for (int k = 0; k < 33; ++k) s += z[pp * 36 + k] * w1[k * 64 + j];
        ha[pp * 64 + j] = sinf(p.f_freq[j] * s); }
    __syncthreads();
#pragma unroll 1
    for (int m = 0; m < 2; ++m) { const int j = jq + 32 * m; float s = p.f_b2[j];
#pragma unroll 4
        for (int k = 0; k < 64; ++k) s += ha[pp * 64 + k] * w2[k * 64 + j];
        hb[pp * 64 + j] = sinf(p.f_freq[j] * s); }
    __syncthreads();
#pragma unroll 1
    for (int m = 0; m < 2; ++m) { const int j = jq + 32 * m; float s = p.f_b3[j];
#pragma unroll 4
        for (int k = 0; k < 64; ++k) s += hb[pp * 64 + k] * w3[k * 64 + j];
        p.h3buf[(size_t)(i0 + pp) * 64 + j] = sinf(p.f_freq[j] * s); }
    __syncthreads();
}
DEV void task_filt_out(const Params& p, char* smem, int task) {
    float* hs = (float*)smem;
    const int tid = threadIdx.x, jb = task >> 2, cg = task & 3; const bool isb = jb >= L / 64;
    const int cl = tid & 127, mh = tid >> 7, c = cg * 128 + cl;
    float* wl = hs + 64 * 64;
    {   f32x4 hv[4], wq[8];
#pragma unroll
        for (int u = 0; u < 4; ++u) { const int i = u * 256 + tid, pp = i >> 4, q = i & 15; int pos = isb ? 64 * jb + pp - L : L - 64 * jb - pp; if (pos > L - 1) pos = L - 1;
            hv[u] = *(const f32x4*)(p.h3buf + (size_t)pos * 64 + q * 4); }
#pragma unroll
        for (int u = 0; u < 8; ++u) { const int i = u * 256 + tid, k = i >> 5, q = i & 31; wq[u] = *(const f32x4*)(p.f_wout + k * 1024 + (isb ? 512 : 0) + cg * 128 + q * 4); }
#pragma unroll
        for (int u = 0; u < 4; ++u) *(f32x4*)(hs + (u * 256 + tid) * 4) = hv[u];
#pragma unroll
        for (int u = 0; u < 8; ++u) *(f32x4*)(wl + (u * 256 + tid) * 4) = wq[u];
    }
    __syncthreads();
    float acc[32];
#pragma unroll
    for (int i = 0; i < 32; ++i) acc[i] = 0.f;
#pragma unroll 1
    for (int k0 = 0; k0 < 64; k0 += 4) {
        const float w0 = wl[(k0 + 0) * 128 + cl], w1 = wl[(k0 + 1) * 128 + cl], w2 = wl[(k0 + 2) * 128 + cl], w3 = wl[(k0 + 3) * 128 + cl];
#pragma unroll
        for (int i = 0; i < 32; ++i) { const f32x4 h0 = *(const f32x4*)(hs + (mh * 32 + i) * 64 + k0); acc[i] += h0[0] * w0 + h0[1] * w1 + h0[2] * w2 + h0[3] * w3; } }
    const float max_decay = logf(1e-2f) / 0.3f, min_decay = logf(1e-2f) / 1.5f;
    const float delta = fabsf(min_decay + (float)c * ((max_decay - min_decay) / 511.f));
    if (jb == L / 64 && mh == 0) {
        float af = 0.f;
        for (int k = 0; k < 64; ++k) af += hs[k] * p.f_wout[k * 1024 + c];
        acc[0] = af; }
    bf16_t* dst = p.gtap + (size_t)c * (2 * L) + 64 * jb + 32 * mh;
#pragma unroll
    for (int q = 0; q < 4; ++q) { bf16x8 o;
#pragma unroll
        for (int e = 0; e < 8; ++e) { const int i = q * 8 + e, m = 64 * jb + 32 * mh + i; const int pos = isb ? m - L : L - m;
            const float tt = (float)pos / (float)(L - 1); float val = acc[i] * (expf(-tt * delta) + 0.05f);
            if (m == L) val += p.hy_skip[c];
            if (m == 0) val = 0.f;
            o[e] = (short)f2bf(val); }
        *(bf16x8*)(dst + q * 8) = o; }
    __syncthreads();
}

constexpr int NT_ADA = NMODC / 32;
constexpr int NT_WIN = 16 * 56, NT_WOUT = 16 * 16, NT_W13 = 16 * 2 * 16 * 8, NT_W2 = 16 * 8 * 16;
constexpr int NT_FILT = (2 * L / 64) * 4, NT_FMLP = L / 8;
constexpr int NT_P0 = NT_ADA + NT_FMLP + 1 + NT_WIN;

DEV void ph_prep(const Params& p, char* smem) {
    for (int task = blockIdx.x; task < NT_P0; task += gridDim.x) {
        int t = task;
        if (t < NT_ADA) { task_ada(p, smem, t); continue; } t -= NT_ADA;
        if (t < NT_FMLP) { task_filt_mlp(p, smem, t); continue; } t -= NT_FMLP;
        if (t < 1) {
            for (int i = threadIdx.x; i < 64 * 16; i += NTHR) { const int pos = i >> 4, f = i & 15; const float fr = powf(10000.f, -(float)f / 16.f); const float a = (float)pos * fr;
                p.rope[i * 2] = cosf(a); p.rope[i * 2 + 1] = sinf(a); }
            if (threadIdx.x < NEXP) p.cnt[threadIdx.x * 32] = 0;
            continue; } t -= 1;
        { const int kt = t / 56, nt = t % 56; transpose_tile(p.w_in, PC, kt * 64, nt * 64, p.w_in_t, 1024, 0, 0, nullptr, 0, nullptr, smem); }
    }
}
DEV void prep_late_tasks(const Params& p, char* smem, int first_block) {
    const int nb = (int)gridDim.x - first_block, me = (int)blockIdx.x - first_block;
    if (nb <= 0) { for (int t = blockIdx.x; t < NT_FILT + NT_WOUT; t += gridDim.x) { if (t < NT_FILT) task_filt_out(p, smem, t); else { const int u = t - NT_FILT; transpose_tile(p.w_out, D, (u / 16) * 64, (u % 16) * 64, p.w_out_t, 1024, 0, 0, p.hy_out_norm, 512, p.ret_gn_w, smem); } } return; }
    if (me < 0) return;
    for (int t = me; t < NT_FILT + NT_WOUT; t += nb) {
        if (t < NT_FILT) task_filt_out(p, smem, t);
        else { const int u = t - NT_FILT, kt = u / 16, nt = u % 16; transpose_tile(p.w_out, D, kt * 64, nt * 64, p.w_out_t, 1024, 0, 0, p.hy_out_norm, 512, p.ret_gn_w, smem); }
    }
}
DEV void expert_conv_task(const Params& p, char* smem, int t) {
    if (t < NT_W13) { const int e = t / 256, r = t % 256, which = r / 128, r2 = r % 128, kt = r2 / 8, nt = r2 % 8;
        transpose_tile((which ? p.exp_w3 : p.exp_w1) + (size_t)e * D * EH, EH, kt * 64, nt * 64, p.w13_t + (size_t)e * 1024 * 1024, 1024, 1, which, nullptr, 0, nullptr, smem); return; }
    t -= NT_W13;
    { const int e = t / 128, r = t % 128, kt = r / 16, nt = r % 16;
        transpose_tile(p.exp_w2 + (size_t)e * EH * D, D, kt * 64, nt * 64, p.w2_t + (size_t)e * 1024 * EH, EH, 0, 0, nullptr, 0, nullptr, smem); }
}

DEV void ph_norm1(const Params& p, char* smem) {
    const int tid = threadIdx.x, lane = tid & 63, wid = tid >> 6;
    {
        const int rstep = gridDim.x * 4; int row = blockIdx.x * 4 + wid;
        f32x4 w4[4];
#pragma unroll
        for (int i = 0; i < 4; ++i) w4[i] = *(const f32x4*)(p.norm1_w + i * 256 + lane * 4);
        f32x4 cur[4];
        if (row < TA) { const float* src = row < T ? p.x + (size_t)row * D : p.ctx + (size_t)(row - T) * D;
#pragma unroll
            for (int i = 0; i < 4; ++i) cur[i] = *(const f32x4*)(src + i * 256 + lane * 4); }
#pragma unroll 1
        for (; row < TA; row += rstep) {
            const int nrow = row + rstep < TA ? row + rstep : row;
            const float* nsrc = nrow < T ? p.x + (size_t)nrow * D : p.ctx + (size_t)(nrow - T) * D;
            f32x4 nxt[4];
#pragma unroll
            for (int i = 0; i < 4; ++i) nxt[i] = *(const f32x4*)(nsrc + i * 256 + lane * 4);
            const int mb = row < T ? row / L : NB;
            const float* sh = p.mod + (size_t)mb * NMODC; const float* sc = sh + D;
            f32x4 s1[4], s0[4];
#pragma unroll
            for (int i = 0; i < 4; ++i) { s1[i] = *(const f32x4*)(sc + i * 256 + lane * 4); s0[i] = *(const f32x4*)(sh + i * 256 + lane * 4); }
            float ss = 0.f;
#pragma unroll
            for (int i = 0; i < 4; ++i) ss += cur[i][0] * cur[i][0] + cur[i][1] * cur[i][1] + cur[i][2] * cur[i][2] + cur[i][3] * cur[i][3];
            ss = wave_sum(ss);
            const float rstd = rsqrtf(ss * (1.f / D) + 1e-6f);
#pragma unroll
            for (int i = 0; i < 4; ++i) { const int k = i * 256 + lane * 4; const f32x4 v = cur[i] * rstd * w4[i] * (1.f + s1[i]) + s0[i];
                *(us4*)(p.hbuf + (size_t)row * D + k) = pack4(v[0], v[1], v[2], v[3]); }
#pragma unroll
            for (int i = 0; i < 4; ++i) cur[i] = nxt[i];
        }
    }
    const int gtid = blockIdx.x * NTHR + tid, gn = gridDim.x * NTHR;
    for (int i = gtid; i < NB * D * 32; i += gn) { const int ii = i & 3, j = (i >> 2) & 31, k4 = (i >> 7) & 255, b = i >> 15; const int k = k4 * 4 + ii;
        const float r = j < 4 ? p.rg_w[k * 4 + j] : (j < 20 ? p.re_w[k * 16 + (j - 4)] : 0.f);
        p.RP[i] = p.norm2_w[k] * (1.f + p.mod[(size_t)b * NMODC + 4 * D + k]) * r; }
    for (int wt = blockIdx.x * 4 + wid; wt < NB * 32; wt += gridDim.x * 4) { const int b = wt >> 5, j = wt & 31; float s = 0.f;
        if (j < 20) for (int k = lane; k < D; k += 64) { const float r = j < 4 ? p.rg_w[k * 4 + j] : p.re_w[k * 16 + (j - 4)]; s += p.mod[(size_t)b * NMODC + 3 * D + k] * r; }
        s = wave_sum(s);
        if (lane == 0) WT_STORE(p.cb + wt, j < 4 ? s + p.rg_b[j] : (j < 20 ? s + p.re_b[j - 4] : 0.f)); }
}

constexpr int NT_INP = (T / 128) * 28 + (TC / 128) * 8;
DEV void inproj_tile(const Params& p, char* smem, int mt, int nt) {
    int tid = threadIdx.x; OPAQUE(tid);
    const int lane = tid & 63, wid = tid >> 6, wr = wid >> 1, wc = wid & 1, fr = lane & 15, quad = lane >> 4;
    const size_t row0 = (size_t)mt * 128;
    const bool is_ctx = mt >= T / 128;
    const bool actX = (nt < 12) || (nt >= 16 && nt < 24);
    f32x4 acc[4][4]; zero_acc(acc);
    LdPlain la(p.hbuf, row0, D), lw(p.w_in_t, (size_t)nt * 128, D);
    if (actX) gemm_tile(acc, la, lw, D / 64, smem); else gemm_tile(acc, lw, la, D / 64, smem);
    if (nt < 12) {
#pragma unroll
        for (int mi = 0; mi < 4; ++mi)
#pragma unroll
            for (int ni = 0; ni < 4; ++ni) { const size_t tok = row0 + wr * 64 + mi * 16 + quad * 4; const int c = nt * 128 + wc * 64 + ni * 16 + fr;
                *(us4*)(p.pT + (size_t)c * T + tok) = pack4(acc[mi][ni][0], acc[mi][ni][1], acc[mi][ni][2], acc[mi][ni][3]); }
    } else if (nt >= 16 && nt < 24) {
        const bool isk = nt < 20; const int h = (nt - 16) & 3;
        if (!is_ctx) {
            const int b = (int)(row0 / L), tl0 = (int)(row0 % L);
            if (isk) {
                if (wc == 0) {
#pragma unroll
                    for (int mi = 0; mi < 4; ++mi)
#pragma unroll
                        for (int r = 0; r < 4; ++r) { const int tl = tl0 + wr * 64 + mi * 16 + quad * 4 + r;
                            { const float* cs = p.rope + ((tl >> 6) * 16 + fr) * 2; const float a = acc[mi][0][r], bq = acc[mi][1][r]; acc[mi][0][r] = a * cs[0] - bq * cs[1]; acc[mi][1][r] = a * cs[1] + bq * cs[0]; }
                            { const float* cs = p.rope + ((tl & 63) * 16 + fr) * 2; const float a = acc[mi][2][r], bq = acc[mi][3][r]; acc[mi][2][r] = a * cs[0] - bq * cs[1]; acc[mi][3][r] = a * cs[1] + bq * cs[0]; } }
                }
                const float scl = 0.08838834764831845f;
                const float lgf = lg2_gamma(h, false), lgb = lg2_gamma(h, true);
#pragma unroll
                for (int mi = 0; mi < 4; ++mi) { const int jl = wr * 64 + mi * 16 + quad * 4;
                    float zf[4], zb[4];
#pragma unroll
                    for (int r = 0; r < 4; ++r) { zf[r] = exp2f(lgf * (float)(127 - jl - r)); zb[r] = exp2f(lgb * (float)(jl + r)); }
#pragma unroll
                    for (int ni = 0; ni < 4; ++ni) { const int tl = tl0 + jl, d = wc * 64 + ni * 16 + fr; const size_t bh = (size_t)b * NH + h;
                        float kv[4];
#pragma unroll
                        for (int r = 0; r < 4; ++r) kv[r] = acc[mi][ni][r] * scl;
                        const us4 o = pack4(kv[0], kv[1], kv[2], kv[3]);
                        *(us4*)(p.kTf + (bh * 128 + d) * L + tl) = pack4(kv[0] * zf[0], kv[1] * zf[1], kv[2] * zf[2], kv[3] * zf[3]);
                        *(us4*)(p.kTb + (bh * 128 + d) * L + tl) = pack4(kv[0] * zb[0], kv[1] * zb[1], kv[2] * zb[2], kv[3] * zb[3]);
#pragma unroll
                        for (int r = 0; r < 4; ++r) p.kn[(bh * L + tl + r) * 128 + d] = o[r]; } }
            } else {
#pragma unroll
                for (int mi = 0; mi < 4; ++mi)
#pragma unroll
                    for (int ni = 0; ni < 4; ++ni) { const int tl = tl0 + wr * 64 + mi * 16 + quad * 4, d = wc * 64 + ni * 16 + fr; const size_t bh = (size_t)b * NH + h;
                        *(us4*)(p.vT + (bh * 128 + d) * L + tl) = pack4(acc[mi][ni][0], acc[mi][ni][1], acc[mi][ni][2], acc[mi][ni][3]); }
            }
        } else {
            const size_t cr0 = row0 - T; const int b = (int)(cr0 / LC), tl0 = (int)(cr0 % LC); const size_t bh = (size_t)b * NH + h;
            if (isk) {
                const float scl = 0.08838834764831845f; const float lgf = lg2_gamma(h, false), lgb = lg2_gamma(h, true);
#pragma unroll
                for (int mi = 0; mi < 4; ++mi) { const int jl = wr * 64 + mi * 16 + quad * 4; float zf[4], zb[4];
#pragma unroll
                    for (int r = 0; r < 4; ++r) { zf[r] = scl * exp2f(lgf * (float)(127 - jl - r)); zb[r] = scl * exp2f(lgb * (float)(jl + r)); }
#pragma unroll
                    for (int ni = 0; ni < 4; ++ni) { const int tl = tl0 + jl, d = wc * 64 + ni * 16 + fr;
                        *(us4*)(p.ckTf + (bh * 128 + d) * LC + tl) = pack4(acc[mi][ni][0] * zf[0], acc[mi][ni][1] * zf[1], acc[mi][ni][2] * zf[2], acc[mi][ni][3] * zf[3]);
                        *(us4*)(p.ckTb + (bh * 128 + d) * LC + tl) = pack4(acc[mi][ni][0] * zb[0], acc[mi][ni][1] * zb[1], acc[mi][ni][2] * zb[2], acc[mi][ni][3] * zb[3]); } }
            } else {
#pragma unroll
                for (int mi = 0; mi < 4; ++mi)
#pragma unroll
                    for (int ni = 0; ni < 4; ++ni) { const int tl = tl0 + wr * 64 + mi * 16 + quad * 4, d = wc * 64 + ni * 16 + fr;
                        *(us4*)(p.cvT + (bh * 128 + d) * LC + tl) = pack4(acc[mi][ni][0], acc[mi][ni][1], acc[mi][ni][2], acc[mi][ni][3]); }
            }
        }
    } else if (nt < 16) {
        const int h = nt - 12; const int b = (int)(row0 / L), tl0 = (int)(row0 % L);
        if (wr == 0) {
#pragma unroll
            for (int ni = 0; ni < 4; ++ni) { const int tl = tl0 + wc * 64 + ni * 16 + fr;
#pragma unroll
                for (int r = 0; r < 4; ++r) { const int j = quad * 4 + r;
                    { const float* cs = p.rope + ((tl >> 6) * 16 + j) * 2; const float a = acc[0][ni][r], bq = acc[1][ni][r]; acc[0][ni][r] = a * cs[0] - bq * cs[1]; acc[1][ni][r] = a * cs[1] + bq * cs[0]; }
                    { const float* cs = p.rope + ((tl & 63) * 16 + j) * 2; const float a = acc[2][ni][r], bq = acc[3][ni][r]; acc[2][ni][r] = a * cs[0] - bq * cs[1]; acc[3][ni][r] = a * cs[1] + bq * cs[0]; } } }
        }
#pragma unroll
        for (int mi = 0; mi < 4; ++mi)
#pragma unroll
            for (int ni = 0; ni < 4; ++ni) { const int tl = tl0 + wc * 64 + ni * 16 + fr, d = wr * 64 + mi * 16 + quad * 4; const size_t bh = (size_t)b * NH + h;
                *(us4*)(p.qn + (bh * L + tl) * 128 + d) = pack4(acc[mi][ni][0], acc[mi][ni][1], acc[mi][ni][2], acc[mi][ni][3]); }
    } else {
#pragma unroll
        for (int mi = 0; mi < 4; ++mi)
#pragma unroll
            for (int ni = 0; ni < 4; ++ni) { const size_t tok = row0 + wc * 64 + ni * 16 + fr; const int d = (nt - 24) * 128 + wr * 64 + mi * 16 + quad * 4;
                *(us4*)(p.gbuf + tok * 512 + d) = pack4(acc[mi][ni][0], acc[mi][ni][1], acc[mi][ni][2], acc[mi][ni][3]); }
    }
}
DEV void ph_inproj(const Params& p, char* smem) {
    constexpr int NMT = T / 128, NCM = TC / 128;
    const int G = gridDim.x, b = blockIdx.x;
    if ((G & 7) == 0 && NMT % 8 == 0) {
        constexpr int MX = NMT / 8;
        const int x = b & 7, li = b >> 3, nl = G >> 3;
        for (int q = li; q < MX * 28; q += nl) { const int ng = q / (MX * 4), rem = q % (MX * 4); inproj_tile(p, smem, x * MX + rem % MX, ng * 4 + rem / MX); }
        for (int t = b; t < NCM * 8; t += G) inproj_tile(p, smem, NMT + t / 8, 16 + t % 8);
        prep_late_tasks(p, smem, NCM * 8 < G ? NCM * 8 : 0);
        return;
    }
    for (int task = blockIdx.x; task < NT_INP; task += gridDim.x) {
        if (task < (T / 128) * 28) inproj_tile(p, smem, task / 28, task % 28);
        else { const int t = task - (T / 128) * 28; inproj_tile(p, smem, T / 128 + t / 8, 16 + t % 8); }
    }
    prep_late_tasks(p, smem, 0);
}

constexpr int NU = L / 64, CSPLIT = 1, UPW = NU / (4 * CSPLIT), NGRP = NU / UPW;
typedef unsigned u32x2 __attribute__((ext_vector_type(2)));
typedef unsigned u32x4 __attribute__((ext_vector_type(4)));
constexpr int TAPC = 2 * L + 16;
DEV bf16x8 conv_afrag(const bf16_t* tcp, int m0a) {
    const u32x2 lo = *(const volatile LDS_AS u32x2*)(tcp + m0a), hi = *(const volatile LDS_AS u32x2*)(tcp + m0a + 4);
    const u32x4 v = {lo[0], lo[1], hi[0], hi[1]};
    return __builtin_bit_cast(bf16x8, v); }
DEV void conv3_w(const Params& p, int ch, float& w0, float& w1, float& w2, float& bs) { w0 = p.hy_conv_w[ch]; w1 = p.hy_conv_w[1536 + ch]; w2 = p.hy_conv_w[3072 + ch]; bs = p.hy_conv_b[ch]; }

DEV void conv_task(const Params& p, char* smem, int c, int half) {
    bf16_t* taps = (bf16_t*)smem;
    bf16_t* U = taps + 4 * TAPC;
    int tid = threadIdx.x; OPAQUE(tid);
    const int lane = tid & 63, w = tid >> 6, fr = lane & 15, quad = lane >> 4;
    {
        constexpr int NTC = (2 * L / 8 + NTHR - 1) / NTHR;
        constexpr int NGT = NB * (L / 8), NG = (NGT + NTHR - 1) / NTHR;
        float a0, a1, a2, ab, v0, v1, v2, vb; conv3_w(p, 512 + c, a0, a1, a2, ab); conv3_w(p, 1024 + c, v0, v1, v2, vb);
        bf16x8 tpv[NTC], x1v[NG], vv[NG]; bf16_t hx0[NG], hx9[NG], hv0[NG], hv9[NG];
#pragma unroll
        for (int u = 0; u < NTC; ++u) { int i = tid + u * NTHR; if (i >= 2 * L / 8) i = 2 * L / 8 - 1; tpv[u] = *(const bf16x8*)(p.gtap + (size_t)c * 2 * L + i * 8); }
#pragma unroll
        for (int u = 0; u < NG; ++u) { int g = tid + u * NTHR; if (g >= NGT) g = NGT - 1; const int b = g / (L / 8), t8 = (g % (L / 8)) * 8;
            const bf16_t* r1 = p.pT + (size_t)(512 + c) * T + (size_t)b * L + t8; const bf16_t* rv = p.pT + (size_t)(1024 + c) * T + (size_t)b * L + t8;
            x1v[u] = *(const bf16x8*)r1; vv[u] = *(const bf16x8*)rv;
            const int il = t8 > 0 ? -1 : 0, ir = t8 + 8 < L ? 8 : 7;
            hx0[u] = r1[il]; hv0[u] = rv[il]; hx9[u] = r1[ir]; hv9[u] = rv[ir]; }
        for (int i = tid; i < 8 * 8; i += NTHR) { const int b = i >> 3, q = i & 7; bf16_t* row = U + b * UP + (q < 4 ? q * 8 : 32 + L + (q - 4) * 8); *(bf16x8*)row = (bf16x8){0, 0, 0, 0, 0, 0, 0, 0}; }
        for (int i = tid; i < (8 - NB) * (L / 8); i += NTHR) *(bf16x8*)(U + (NB + i / (L / 8)) * UP + 32 + (i % (L / 8)) * 8) = (bf16x8){0, 0, 0, 0, 0, 0, 0, 0};
#pragma unroll
        for (int u = 0; u < NTC; ++u) { const int i = tid + u * NTHR; if (i >= 2 * L / 8) continue; const bf16x8 v = tpv[u];
            *(bf16x8*)(taps + i * 8) = v;
#pragma unroll
            for (int a = 1; a < 4; ++a)
#pragma unroll
                for (int e = 0; e < 8; ++e) { const int q = i * 8 + e - a; if (q >= 0) taps[a * TAPC + q] = (bf16_t)v[e]; } }
#pragma unroll
        for (int u = 0; u < NG; ++u) { const int g = tid + u * NTHR; if (g >= NGT) continue; const int b = g / (L / 8), t8 = (g % (L / 8)) * 8;
            float px[10], pv[10];
            px[0] = t8 > 0 ? bf2f(hx0[u]) : 0.f; pv[0] = t8 > 0 ? bf2f(hv0[u]) : 0.f; px[9] = t8 + 8 < L ? bf2f(hx9[u]) : 0.f; pv[9] = t8 + 8 < L ? bf2f(hv9[u]) : 0.f;
#pragma unroll
            for (int e = 0; e < 8; ++e) { px[e + 1] = bf2f((bf16_t)x1v[u][e]); pv[e + 1] = bf2f((bf16_t)vv[u][e]); }
            bf16x8 o;
#pragma unroll
            for (int e = 0; e < 8; ++e) { const float x1 = a0 * px[e] + a1 * px[e + 1] + a2 * px[e + 2] + ab; const float vq = v0 * pv[e] + v1 * pv[e + 1] + v2 * pv[e + 2] + vb; o[e] = (short)f2bf(x1 * vq); }
            *(bf16x8*)(U + b * UP + 32 + t8) = o; }
    }
    __syncthreads();
    f32x4 acc[2][UPW];
#pragma unroll
    for (int tp = 0; tp < 2; ++tp)
#pragma unroll
        for (int ui = 0; ui < UPW; ++ui) acc[tp][ui] = (f32x4){0.f, 0.f, 0.f, 0.f};
    const int bcol = fr & 7, i2 = fr >> 3;
    const bf16_t* Ub = U + bcol * UP + 32 + 32 * i2 + 8 * quad;
    const int al = (L - fr) & 3;
    const bf16_t* tcp = taps + al * TAPC;
    const int ub = UPW * (4 * half + w);
    const int mbase = L - fr + 8 * quad - 64 * ub - al;
#pragma unroll 1
    for (int jp = 1; jp >= 0; --jp) {
        bf16x8 af[2][UPW];
        int J0 = jp ? -1 : 0;
        if (jp) {
            const bf16x8 bfr = *(const bf16x8*)(Ub + 32 * J0);
#pragma unroll
            for (int tp = 0; tp < 2; ++tp)
#pragma unroll
                for (int ui = 0; ui < UPW; ++ui) { const bf16x8 a = conv_afrag(tcp, mbase - 64 * ui - 16 * tp + 32 * J0); acc[tp][ui] = __builtin_amdgcn_mfma_f32_16x16x32_bf16(a, bfr, acc[tp][ui], 0, 0, 0); }
            J0 = 1;
        }
#pragma unroll
        for (int tp = 0; tp < 2; ++tp)
#pragma unroll
            for (int ui = 0; ui < UPW; ++ui) af[tp][ui] = conv_afrag(tcp, mbase - 64 * ui - 16 * tp + 32 * J0);
        bf16x8 bnext = *(const bf16x8*)(Ub + 32 * J0);
#pragma unroll 1
        for (int grp = 0; grp < NGRP; ++grp) {
#pragma unroll
            for (int s = 0; s < UPW; ++s) {
                const bf16x8 bfr = bnext; { const int Jn = J0 + 2 < L / 32 ? J0 + 2 : J0; bnext = *(const bf16x8*)(Ub + 32 * Jn); }
#pragma unroll
                for (int tp = 0; tp < 2; ++tp)
#pragma unroll
                    for (int ui = 0; ui < UPW; ++ui) acc[tp][ui] = __builtin_amdgcn_mfma_f32_16x16x32_bf16(af[tp][(ui - s + UPW) % UPW], bfr, acc[tp][ui], 0, 0, 0);
                J0 += 2;
                if (grp < NGRP - 1 || s < UPW - 1) {
#pragma unroll
                    for (int tp = 0; tp < 2; ++tp) af[tp][(UPW - 1 - s) % UPW] = conv_afrag(tcp, mbase - 16 * tp + 32 * J0);
                }
            }
        }
    }
    if (bcol < NB) {
#pragma unroll
        for (int tp = 0; tp < 2; ++tp)
#pragma unroll
            for (int ui = 0; ui < UPW; ++ui) { const int I0 = 4 * (ub + ui) + tp; const int t = 16 * (I0 + 2 * i2) + 4 * quad;
                *(us4*)(p.yhyT + (size_t)c * T + (size_t)bcol * L + t) = pack4(acc[tp][ui][0], acc[tp][ui][1], acc[tp][ui][2], acc[tp][ui][3]); }
    }
    __syncthreads();
}

struct LdSeq64 {
    const bf16_t *cb, *lb; int dir;
    DEV LdSeq64(const bf16_t* cbase, const bf16_t* lbase, int row0, int dir_) : dir(dir_) { const int r = row0 + (threadIdx.x >> 2), lc = pipe_chunk(); cb = cbase + (size_t)r * LC + lc; lb = lbase + (size_t)r * L + lc; }
    DEV const bf16_t* src(int kt) const { const int n = kt >> 2, off = (kt & 3) * 32;
        if (n < NCC) { const int J = dir ? NCC - 1 - n : n; return cb + J * 128 + off; }
        const int I = dir ? NCH - 1 - (n - NCC) : n - NCC; return lb + I * 128 + off; }
};
struct RscanHook64 { bf16_t* so; int dir; float gch;
    DEV void store(int I, f32x4 (&acc)[2][2]) const {
#pragma unroll
        for (int mi = 0; mi < 2; ++mi)
#pragma unroll
            for (int ni = 0; ni < 2; ++ni) *(us4*)(so + (size_t)I * 16384 + (ni * 16) * 128 + mi * 16) = pack4(acc[mi][ni][0], acc[mi][ni][1], acc[mi][ni][2], acc[mi][ni][3]); }
    DEV void operator()(int kt, f32x4 (&acc)[2][2]) const {
        if (kt & 3) return; const int n = kt >> 2;
        if (n >= NCC) store(dir ? NCH - 1 - (n - NCC) : n - NCC, acc);
        if (n > 0) {
#pragma unroll
            for (int mi = 0; mi < 2; ++mi)
#pragma unroll
                for (int ni = 0; ni < 2; ++ni) acc[mi][ni] = acc[mi][ni] * gch; } }
};
DEV void rscan_task(const Params& p, char* smem, int task) {
    const int quadrant = task & 3, dh = quadrant >> 1, eh = quadrant & 1, bh = (task >> 2) % (NB * NH), dir = task / (4 * NB * NH), h = bh % NH;
    int tid = threadIdx.x; OPAQUE(tid);
    const int lane = tid & 63, wid = tid >> 6, wr = wid >> 1, wc = wid & 1, fr = lane & 15, quad = lane >> 4;
    const LdSeq64 lk((dir ? p.ckTb : p.ckTf) + (size_t)bh * 128 * LC, (dir ? p.kTb : p.kTf) + (size_t)bh * 128 * L, dh * 64, dir);
    const LdSeq64 lv(p.cvT + (size_t)bh * 128 * LC, p.vT + (size_t)bh * 128 * L, eh * 64, dir);
    RscanHook64 hk; hk.dir = dir; hk.gch = exp2f(128.f * lg2_gamma(h, dir == 1));
    hk.so = p.Sst + (((size_t)dir * NB * NH + bh) * NCH) * 16384 + (size_t)(eh * 64 + wc * 32 + fr) * 128 + dh * 64 + wr * 32 + quad * 4;
    f32x4 acc[2][2];
#pragma unroll
    for (int mi = 0; mi < 2; ++mi)
#pragma unroll
        for (int ni = 0; ni < 2; ++ni) acc[mi][ni] = (f32x4){0.f, 0.f, 0.f, 0.f};
    constexpr int nk = 4 * (NCT - 1);
    char* const sx = smem + tid * 16;
#pragma unroll
    for (int t = 0; t < 7; ++t) { if (t < nk) { glds16(lk.src(t), sx + t * 8192); glds16(lv.src(t), sx + t * 8192 + 4096); } }
    PIPE_WAIT(12);
    PIPE_BARRIER();
    const int rd = ((quad ^ ((0 - (fr >> 2)) & 3)) << 4) + fr * 64;
    for (int kt = 0; kt < nk; ++kt) {
        hk(kt, acc);
        SCHED_FENCE();
        if (kt + 7 < nk) { const int sl = ((kt + 7) & 7) * 8192; glds16(lk.src(kt + 7), sx + sl); glds16(lv.src(kt + 7), sx + sl + 4096); }
        SCHED_FENCE();
        const char* bx = smem + (kt & 7) * 8192; const char* by = bx + 4096;
        bf16x8 xf[2], yf[2];
#pragma unroll
        for (int mi = 0; mi < 2; ++mi) xf[mi] = *(const bf16x8*)(bx + (wr * 32 + mi * 16) * 64 + rd);
#pragma unroll
        for (int ni = 0; ni < 2; ++ni) yf[ni] = *(const bf16x8*)(by + (wc * 32 + ni * 16) * 64 + rd);
#pragma unroll
        for (int mi = 0; mi < 2; ++mi)
#pragma unroll
            for (int ni = 0; ni < 2; ++ni) acc[mi][ni] = __builtin_amdgcn_mfma_f32_16x16x32_bf16(xf[mi], yf[ni], acc[mi][ni], 0, 0, 0);
        SCHED_FENCE();
        const int rem = nk - 1 - kt;
        if (rem >= 7) PIPE_WAIT(12); else if (rem == 6) PIPE_WAIT(10); else if (rem == 5) PIPE_WAIT(8); else if (rem == 4) PIPE_WAIT(6); else if (rem == 3) PIPE_WAIT(4); else if (rem == 2) PIPE_WAIT(2); else PIPE_WAIT(0);
        PIPE_BARRIER();
    }
    hk.store(dir ? 0 : NCH - 1, acc);
}
constexpr int NT_RSC = 2 * NB * NH * 4;
constexpr int NT_CV = HW * CSPLIT, NT_RO = NB * NH * NCH;
DEV void rout_a_task(const Params& p, char* smem, int task);
DEV void ph_conv_rscan(const Params& p, char* smem) {
    const int G = gridDim.x, b = blockIdx.x;
    if (G == 2 * NT_RSC && NT_CV == 2 * NT_RSC && NT_RO == 2 * NT_RSC) {
        if (b < NT_RSC) { KP_BEGIN(0); rscan_task(p, smem, b); KP_END(0); KP_BEGIN(2); rout_a_task(p, smem, 2 * b); rout_a_task(p, smem, 2 * b + 1); KP_END(2); }
        else { KP_BEGIN(1); for (int k = 0; k < 2; ++k) { const int t = 2 * (b - NT_RSC) + k; conv_task(p, smem, t / CSPLIT, t % CSPLIT); } KP_END(1); }
        return;
    }
    for (int task = b; task < NT_RSC + NT_CV + NT_RO; task += G) {
        if (task < NT_RSC) rscan_task(p, smem, task); else if (task < NT_RSC + NT_CV) { const int t = task - NT_RSC; conv_task(p, smem, t / CSPLIT, t % CSPLIT); } else rout_a_task(p, smem, task - NT_RSC - NT_CV);
    }
}

DEV void hynorm_task(const Params& p, char* smem, int task) {
    bf16_t* tl = (bf16_t*)smem;
    const int tid = threadIdx.x; const size_t pos0 = (size_t)task * 64;
    const bool hasl = (pos0 % L) > 0, hasr = (pos0 % L) + 64 < L;
    for (int half = 0; half < 2; ++half) { const int c = tid + 256 * half; const bf16_t* src = p.yhyT + (size_t)c * T + pos0; const bf16_t* ps = p.pT + (size_t)c * T + pos0;
        float w0, w1, w2, wb; conv3_w(p, c, w0, w1, w2, wb);
        bf16x8 cv[8], pv[8];
#pragma unroll
        for (int q = 0; q < 8; ++q) { cv[q] = *(const bf16x8*)(src + q * 8); pv[q] = *(const bf16x8*)(ps + q * 8); }
        const bf16_t hl = ps[hasl ? -1 : 0], hr = ps[hasr ? 64 : 63];
        float prev = hasl ? bf2f(hl) : 0.f;
#pragma unroll
        for (int q = 0; q < 8; ++q)
#pragma unroll
            for (int e = 0; e < 8; ++e) { const float cur = bf2f((bf16_t)pv[q][e]);
                const float nxt = e < 7 ? bf2f((bf16_t)pv[q][e < 7 ? e + 1 : 7]) : (q < 7 ? bf2f((bf16_t)pv[q < 7 ? q + 1 : 7][0]) : (hasr ? bf2f(hr) : 0.f));
                const float x0 = w0 * prev + w1 * cur + w2 * nxt + wb;
                tl[(q * 8 + e) * 520 + c] = f2bf(x0 * bf2f((bf16_t)cv[q][e])); prev = cur; } }
    __syncthreads();
    const int pos = tid >> 2, part = tid & 3;
    float ss = 0.f;
    for (int q = 0; q < 16; ++q) { const bf16x8 v = *(const bf16x8*)(tl + pos * 520 + part * 128 + q * 8);
#pragma unroll
        for (int e = 0; e < 8; ++e) { const float f = bf2f((bf16_t)v[e]); ss += f * f; } }
    ss += __shfl_xor(ss, 1); ss += __shfl_xor(ss, 2);
    const float rstd = rsqrtf(ss * (1.f / 512.f) + 1e-6f);
    for (int q = 0; q < 16; ++q) { const bf16x8 v = *(const bf16x8*)(tl + pos * 520 + part * 128 + q * 8); bf16x8 o;
#pragma unroll
        for (int e = 0; e < 8; ++e) o[e] = (short)f2bf(bf2f((bf16_t)v[e]) * rstd);
        *(bf16x8*)(p.ycat + (pos0 + pos) * 1024 + part * 128 + q * 8) = o; }
    __syncthreads();
}
DEV void rout_a_task(const Params& p, char* smem, int task) {
    const int bh = task / NCH, I = task % NCH, h = bh % NH;
    int tid = threadIdx.x; OPAQUE(tid);
    const int lane = tid & 63, wid = tid >> 6, wr = wid >> 1, wc = wid & 1, fr = lane & 15, quad = lane >> 4;
    const float lgf = lg2_gamma(h, false), lgb = lg2_gamma(h, true);
    bf16_t* P = p.Pscr + (size_t)blockIdx.x * 16384;
    const bf16_t* qb = p.qn + ((size_t)bh * L + I * 128) * 128; const bf16_t* kb = p.kn + ((size_t)bh * L + I * 128) * 128;
    {
        f32x4 acc[4][4]; zero_acc(acc);
        LdPlain lk(kb, 0, 128), lq(qb, 0, 128);
        gemm_tile(acc, lk, lq, 2, smem);
#pragma unroll
        for (int mi = 0; mi < 4; ++mi)
#pragma unroll
            for (int ni = 0; ni < 4; ++ni) { const int i = wc * 64 + ni * 16 + fr, j0 = wr * 64 + mi * 16 + quad * 4; float v[4];
#pragma unroll
                for (int r = 0; r < 4; ++r) { const int j = j0 + r; const float dcy = i > j ? exp2f(lgf * (float)(i - j)) : (i == j ? 2.f : exp2f(lgb * (float)(j - i))); v[r] = acc[mi][ni][r] * dcy; }
                *(us4*)(P + i * 128 + j0) = pack4(v[0], v[1], v[2], v[3]); }
    }
    __syncthreads();
    f32x4 acc[4][4]; zero_acc(acc);
    {
        LdPlain lv(p.vT + (size_t)bh * 128 * L + I * 128, 0, L), lp(P, 0, 128);
        gemm_tile(acc, lv, lp, 2, smem);
    }
    bf16_t* op = p.Opart + (size_t)task * 16384;
#pragma unroll
    for (int mi = 0; mi < 4; ++mi)
#pragma unroll
        for (int ni = 0; ni < 4; ++ni) { const int i = wc * 64 + ni * 16 + fr, e = wr * 64 + mi * 16 + quad * 4; *(us4*)(op + i * 128 + e) = pack4(acc[mi][ni][0], acc[mi][ni][1], acc[mi][ni][2], acc[mi][ni][3]); }
}
DEV void rout_b_task(const Params& p, char* smem, int task) {
    const int bh = task / NCH, I = task % NCH, h = bh % NH, b = bh / NH;
    int tid = threadIdx.x; OPAQUE(tid);
    const int lane = tid & 63, wid = tid >> 6, wr = wid >> 1, wc = wid & 1, fr = lane & 15, quad = lane >> 4;
    const float lgf = lg2_gamma(h, false), lgb = lg2_gamma(h, true);
    const bf16_t* qb = p.qn + ((size_t)bh * L + I * 128) * 128;
    f32x4 acc[4][4];
    { const bf16_t* op = p.Opart + (size_t)task * 16384;
#pragma unroll
      for (int mi = 0; mi < 4; ++mi)
#pragma unroll
          for (int ni = 0; ni < 4; ++ni) { const int i = wc * 64 + ni * 16 + fr, e = wr * 64 + mi * 16 + quad * 4; const us4 v = *(const us4*)(op + i * 128 + e);
              acc[mi][ni] = (f32x4){bf2f(v[0]), bf2f(v[1]), bf2f(v[2]), bf2f(v[3])}; } }
    {
        LdPlain ls(p.Sst + (((size_t)0 * NB * NH + bh) * NCH + I) * 16384, 0, 128); LdRowScale lq(qb, 0, 128, lgf, lgf);
        gemm_tile(acc, ls, lq, 2, smem);
    }
    {
        LdPlain ls(p.Sst + (((size_t)1 * NB * NH + bh) * NCH + I) * 16384, 0, 128); LdRowScale lq(qb, 0, 128, 128.f * lgb, -lgb);
        gemm_tile(acc, ls, lq, 2, smem);
    }
    float* red = (float*)smem;
    float mean[4], rstd[4];
#pragma unroll
    for (int ni = 0; ni < 4; ++ni) { float s = 0.f, ss = 0.f;
#pragma unroll
        for (int mi = 0; mi < 4; ++mi)
#pragma unroll
            for (int r = 0; r < 4; ++r) { const float v = acc[mi][ni][r]; s += v; ss += v * v; }
        s += __shfl_xor(s, 16); s += __shfl_xor(s, 32); ss += __shfl_xor(ss, 16); ss += __shfl_xor(ss, 32);
        if (quad == 0) { const int i = wc * 64 + ni * 16 + fr; red[(wr * 128 + i) * 2] = s; red[(wr * 128 + i) * 2 + 1] = ss; } }
    __syncthreads();
#pragma unroll
    for (int ni = 0; ni < 4; ++ni) { const int i = wc * 64 + ni * 16 + fr; const float s = red[i * 2] + red[(128 + i) * 2], ss = red[i * 2 + 1] + red[(128 + i) * 2 + 1];
        mean[ni] = s * (1.f / 128.f); const float var = ss * (1.f / 128.f) - mean[ni] * mean[ni]; rstd[ni] = rsqrtf(fmaxf(var, 0.f) + 1e-6f); }
    us4 gv[4][4];
#pragma unroll
    for (int mi = 0; mi < 4; ++mi)
#pragma unroll
        for (int ni = 0; ni < 4; ++ni) { const int i = wc * 64 + ni * 16 + fr, e = wr * 64 + mi * 16 + quad * 4; const size_t tok = (size_t)b * L + I * 128 + i;
            gv[mi][ni] = *(const us4*)(p.gbuf + tok * 512 + h * 128 + e); }
#pragma unroll
    for (int mi = 0; mi < 4; ++mi)
#pragma unroll
        for (int ni = 0; ni < 4; ++ni) { const int i = wc * 64 + ni * 16 + fr, e = wr * 64 + mi * 16 + quad * 4; const size_t tok = (size_t)b * L + I * 128 + i; float y[4];
#pragma unroll
            for (int r = 0; r < 4; ++r) y[r] = (acc[mi][ni][r] - mean[ni]) * rstd[ni] * silu_f(bf2f(gv[mi][ni][r]));
            *(us4*)(p.ycat + tok * 1024 + 512 + h * 128 + e) = pack4(y[0], y[1], y[2], y[3]); }
    __syncthreads();
}
DEV void ph_rout_hynorm(const Params& p, char* smem) {
#pragma unroll 1
    for (int task = blockIdx.x; task < NB * NH * NCH + T / 64; task += gridDim.x) {
        if (task < NB * NH * NCH) { KP_BEGIN(3); rout_b_task(p, smem, task); KP_END(3); } else { KP_BEGIN(4); hynorm_task(p, smem, task - NB * NH * NCH); KP_END(4); } } }

DEV void outproj_tile(const Params& p, char* smem, int mt, int nt) {
    int tid = threadIdx.x; OPAQUE(tid);
    const int lane = tid & 63, wid = tid >> 6, wr = wid >> 1, wc = wid & 1, fr = lane & 15, quad = lane >> 4;
    f32x4 acc[4][4]; zero_acc(acc);
    LdPlain lw(p.w_out_t, (size_t)nt * 128, D), la(p.ycat, (size_t)mt * 128, D);
    gemm_tile(acc, lw, la, D / 64, smem);
    const int b = (mt * 128) / L; const float* g1 = p.mod + (size_t)b * NMODC + 2 * D;
#pragma unroll
    for (int mi = 0; mi < 4; ++mi)
#pragma unroll
        for (int ni = 0; ni < 4; ++ni) { const size_t tok = (size_t)mt * 128 + wc * 64 + ni * 16 + fr; const int col = nt * 128 + wr * 64 + mi * 16 + quad * 4;
            const f32x4 xv = *(const f32x4*)(p.x + tok * D + col), gv = *(const f32x4*)(g1 + col);
            *(f32x4*)(p.x1 + tok * D + col) = xv + gv * acc[mi][ni]; }
}
DEV void ph_outproj(const Params& p, char* smem) {
    constexpr int NMT = T / 128;
    const int G = gridDim.x, b = blockIdx.x;
    if ((G & 7) == 0 && NMT % 8 == 0) {
        constexpr int MX = NMT / 8, RB = MX < 8 ? MX : 8;
        const int x = b & 7, li = b >> 3, nl = G >> 3;
        for (int q = li; q < MX * 8; q += nl) { const int mg = q / (RB * 8), rem = q % (RB * 8); outproj_tile(p, smem, x * MX + mg * RB + rem % RB, rem / RB); }
    } else {
        for (int task = blockIdx.x; task < NMT * 8; task += gridDim.x) outproj_tile(p, smem, task / 8, task % 8);
    }
    for (int task = blockIdx.x; task < NT_W13 + NT_W2; task += gridDim.x) expert_conv_task(p, smem, task);
}

DEV void ph_norm2_router(const Params& p, char* smem) {
    const int tid = threadIdx.x, lane = tid & 63, wid = tid >> 6, fr = lane & 15, quad = lane >> 4;
    float* lgs = (float*)smem + wid * (16 * 33);
    float* rs = (float*)smem + 4 * 16 * 33 + wid * 16;
    int* lcnt = (int*)(smem + 16384); int* lbase = lcnt + NEXP;
    if (tid < NEXP) lcnt[tid] = 0;
    __syncthreads();
    for (int wt = blockIdx.x * 4 + wid; wt < T / 16; wt += gridDim.x * 4) {
        const size_t row0 = (size_t)wt * 16; const int b = (int)(row0 / L);
        const float* xr = p.x1 + (row0 + fr) * D + quad * 4;
        const float* rp = p.RP + (size_t)b * D * 32;
        f32x4 a0 = {0.f, 0.f, 0.f, 0.f}, a1 = a0; float ss = 0.f;
        const float* rpl = rp + ((size_t)quad * 32 + fr) * 4;
        f32x4 xv[4], b0[4], b1[4];
#pragma unroll
        for (int u = 0; u < 4; ++u) { xv[u] = *(const f32x4*)(xr + u * 16); b0[u] = *(const f32x4*)(rpl + (size_t)u * 512); b1[u] = *(const f32x4*)(rpl + (size_t)u * 512 + 64); }
#pragma unroll 1
        for (int k0 = 0; k0 < D; k0 += 64) {
            f32x4 xn[4], c0[4], c1[4];
            const int kn = k0 + 64 < D ? k0 + 64 : k0;
#pragma unroll
            for (int u = 0; u < 4; ++u) { xn[u] = *(const f32x4*)(xr + kn + u * 16); c0[u] = *(const f32x4*)(rpl + (size_t)(kn / 4 + u * 4) * 128); c1[u] = *(const f32x4*)(rpl + (size_t)(kn / 4 + u * 4) * 128 + 64); }
#pragma unroll
            for (int u = 0; u < 4; ++u) {
                ss += xv[u][0] * xv[u][0] + xv[u][1] * xv[u][1] + xv[u][2] * xv[u][2] + xv[u][3] * xv[u][3];
#pragma unroll
                for (int i = 0; i < 4; ++i) { a0 = __builtin_amdgcn_mfma_f32_16x16x4f32(xv[u][i], b0[u][i], a0, 0, 0, 0); a1 = __builtin_amdgcn_mfma_f32_16x16x4f32(xv[u][i], b1[u][i], a1, 0, 0, 0); }
            }
#pragma unroll
            for (int u = 0; u < 4; ++u) { xv[u] = xn[u]; b0[u] = c0[u]; b1[u] = c1[u]; }
        }
        ss += __shfl_xor(ss, 16); ss += __shfl_xor(ss, 32);
        const float rstd = rsqrtf(ss * (1.f / D) + 1e-6f);
        if (quad == 0) rs[fr] = rstd;
#pragma unroll
        for (int r = 0; r < 4; ++r) { lgs[(quad * 4 + r) * 33 + fr] = a0[r]; lgs[(quad * 4 + r) * 33 + 16 + fr] = a1[r]; }
        __syncthreads();
        int e0 = 0, e1 = 0, l0 = 0, l1 = 0; float w0 = 0.f, w1 = 0.f;
        if (lane < 16) {
            const float rsd = rs[lane]; float lg[20];
#pragma unroll
            for (int j = 0; j < 20; ++j) lg[j] = lgs[lane * 33 + j] * rsd + p.cb[b * 32 + j];
            int g = 0; float gm = lg[0];
#pragma unroll
            for (int j = 1; j < 4; ++j) if (lg[j] > gm) { gm = lg[j]; g = j; }
            float den = 0.f;
#pragma unroll
            for (int j = 0; j < 4; ++j) den += expf(lg[j] - gm);
            const float psel = 1.f / den;
            float le[4];
#pragma unroll
            for (int j = 0; j < 4; ++j) le[j] = g == 0 ? lg[4 + j] : (g == 1 ? lg[8 + j] : (g == 2 ? lg[12 + j] : lg[16 + j]));
            int i0 = 0; float m0 = le[0];
#pragma unroll
            for (int j = 1; j < 4; ++j) if (le[j] > m0) { m0 = le[j]; i0 = j; }
            int i1 = -1; float m1 = -3.0e38f;
#pragma unroll
            for (int j = 0; j < 4; ++j) if (j != i0 && le[j] > m1) { m1 = le[j]; i1 = j; }
            const float ex = expf(m1 - m0); w0 = psel / (1.f + ex); w1 = psel * ex / (1.f + ex);
            e0 = g * 4 + i0; e1 = g * 4 + i1;
            l0 = atomicAdd(lcnt + e0, 1); l1 = atomicAdd(lcnt + e1, 1);
        }
        __syncthreads();
        if (tid < NEXP) { const int c = lcnt[tid]; lbase[tid] = c ? atomicAdd(p.cnt + tid * 32, c) : 0; lcnt[tid] = 0; }
        __syncthreads();
        if (lane < 16) { const size_t tok = row0 + lane; const int p0 = lbase[e0] + l0, p1 = lbase[e1] + l1;
            WT_STORE(p.elist + (size_t)e0 * T + p0, (int)tok * 2); WT_STORE(p.ewt + (size_t)e0 * T + p0, w0);
            WT_STORE(p.elist + (size_t)e1 * T + p1, (int)tok * 2 + 1); WT_STORE(p.ewt + (size_t)e1 * T + p1, w1);
        }
        const float* sh = p.mod + (size_t)b * NMODC + 3 * D; const float* sc = sh + D;
        f32x4 wm[4], sa[4];
#pragma unroll
        for (int i = 0; i < 4; ++i) { const int k = i * 256 + lane * 4; const f32x4 w = *(const f32x4*)(p.norm2_w + k), s1 = *(const f32x4*)(sc + k); sa[i] = *(const f32x4*)(sh + k); wm[i] = w * (1.f + s1); }
        f32x4 cur[4];
#pragma unroll
        for (int i = 0; i < 4; ++i) cur[i] = *(const f32x4*)(p.x1 + row0 * D + i * 256 + lane * 4);
#pragma unroll 1
        for (int r = 0; r < 16; ++r) { const float rsd = rs[r]; f32x4 nxt[4]; const int rn = r < 15 ? r + 1 : r;
#pragma unroll
            for (int i = 0; i < 4; ++i) nxt[i] = *(const f32x4*)(p.x1 + (row0 + rn) * D + i * 256 + lane * 4);
#pragma unroll
            for (int i = 0; i < 4; ++i) { const int k = i * 256 + lane * 4; const f32x4 v = cur[i] * rsd * wm[i] + sa[i];
                *(us4*)(p.h2 + (row0 + r) * D + k) = pack4(v[0], v[1], v[2], v[3]); }
#pragma unroll
            for (int i = 0; i < 4; ++i) cur[i] = nxt[i];
        }
        __syncthreads();
    }
}

DEV bool moe_find_tile(const Params& p, int mtile, int& e, int& lt, int& rowoff, int& cnt) {
    int acc = 0;
    for (int q = 0; q < NEXP; ++q) { const int c = p.cnt[q * 32]; const int nt = (c + 127) >> 7; if (mtile < acc + nt) { e = q; lt = mtile - acc; rowoff = acc * 128; cnt = c; return true; } acc += nt; }
    return false;
}
DEV void ph_moe_up(const Params& p, char* smem) {
    const int tid = threadIdx.x, lane = tid & 63, wid = tid >> 6, wr = wid >> 1, wc = wid & 1, fr = lane & 15, quad = lane >> 4;
    const bool xcdmap = (gridDim.x & 7) == 0; const int xq = blockIdx.x & 7, qstep = xcdmap ? (int)(gridDim.x >> 3) : (int)gridDim.x;
    for (int q = xcdmap ? (int)(blockIdx.x >> 3) : (int)blockIdx.x; ; q += qstep) {
        const int mtile = xcdmap ? xq + 8 * (q >> 3) : (q >> 3), nt = q & 7;
        int e, lt, rowoff, cnt; if (!moe_find_tile(p, mtile, e, lt, rowoff, cnt)) break;
        LdGather la; const int lrow = tid >> 3, lc = stage_chunk();
#pragma unroll
        for (int i = 0; i < 4; ++i) { int li = lt * 128 + lrow + 32 * i; if (li >= cnt) li = cnt - 1; const int tok = p.elist[(size_t)e * T + li] >> 1; la.rp[i] = p.h2 + (size_t)tok * D + lc; }
        LdPlain lw(p.w13_t + (size_t)e * 1024 * 1024, (size_t)nt * 128, D);
        f32x4 acc[4][4]; zero_acc(acc);
        gemm_tile(acc, lw, la, D / 64, smem);
#pragma unroll
        for (int ni = 0; ni < 4; ++ni) { int li = lt * 128 + wc * 64 + ni * 16 + fr; const bool valid = li < cnt; if (!valid) li = cnt - 1; const float cw = p.ewt[(size_t)e * T + li];
#pragma unroll
            for (int mi = 0; mi < 2; ++mi) { float hv[4];
#pragma unroll
                for (int r = 0; r < 4; ++r) hv[r] = silu_f(acc[mi][ni][r]) * acc[mi + 2][ni][r] * cw;
                const int hidx = nt * 64 + wr * 32 + mi * 16 + quad * 4;
                if (valid) *(us4*)(p.hid + (size_t)(rowoff + lt * 128 + wc * 64 + ni * 16 + fr) * EH + hidx) = pack4(hv[0], hv[1], hv[2], hv[3]); } }
    }
}
DEV void ph_moe_down(const Params& p, char* smem) {
    const int tid = threadIdx.x, lane = tid & 63, wid = tid >> 6, wr = wid >> 1, wc = wid & 1, fr = lane & 15, quad = lane >> 4;
    const bool xcdmap = (gridDim.x & 7) == 0; const int xq = blockIdx.x & 7, qstep = xcdmap ? (int)(gridDim.x >> 3) : (int)gridDim.x;
    for (int q = xcdmap ? (int)(blockIdx.x >> 3) : (int)blockIdx.x; ; q += qstep) {
        const int mtile = xcdmap ? xq + 8 * (q >> 3) : (q >> 3), nt = q & 7;
        int e, lt, rowoff, cnt; if (!moe_find_tile(p, mtile, e, lt, rowoff, cnt)) break;
        LdGather la; const int lrow = tid >> 3, lc = stage_chunk();
#pragma unroll
        for (int i = 0; i < 4; ++i) { int li = lt * 128 + lrow + 32 * i; if (li >= cnt) li = cnt - 1; la.rp[i] = p.hid + (size_t)(rowoff + li) * EH + lc; }
        LdPlain lw(p.w2_t + (size_t)e * 1024 * EH, (size_t)nt * 128, EH);
        f32x4 acc[4][4]; zero_acc(acc);
        gemm_tile(acc, lw, la, EH / 64, smem);
#pragma unroll
        for (int ni = 0; ni < 4; ++ni) { const int li = lt * 128 + wc * 64 + ni * 16 + fr; if (li < cnt) { const int ts = p.elist[(size_t)e * T + li];
#pragma unroll
            for (int mi = 0; mi < 4; ++mi) *(us4*)(p.ymoe + (size_t)ts * D + nt * 128 + wr * 64 + mi * 16 + quad * 4) = pack4(acc[mi][ni][0], acc[mi][ni][1], acc[mi][ni][2], acc[mi][ni][3]); } }
    }
}
DEV void ph_final(const Params& p, char* smem) {
    const int lane = threadIdx.x & 63, wid = threadIdx.x >> 6;
    for (int row = blockIdx.x * 4 + wid; row < T; row += gridDim.x * 4) { const int b = row / L; const float* g2 = p.mod + (size_t)b * NMODC + 5 * D;
        f32x4 v[4]; float ss = 0.f;
#pragma unroll
        for (int i = 0; i < 4; ++i) { const int k = i * 256 + lane * 4; const f32x4 xv = *(const f32x4*)(p.x1 + (size_t)row * D + k), gv = *(const f32x4*)(g2 + k);
            const us4 y0 = *(const us4*)(p.ymoe + ((size_t)row * 2) * D + k), y1 = *(const us4*)(p.ymoe + ((size_t)row * 2 + 1) * D + k);
#pragma unroll
            for (int e = 0; e < 4; ++e) { v[i][e] = xv[e] + gv[e] * (bf2f(y0[e]) + bf2f(y1[e])); ss += v[i][e] * v[i][e]; } }
        ss = wave_sum(ss); const float rstd = rsqrtf(ss * (1.f / D) + 1e-6f);
#pragma unroll
        for (int i = 0; i < 4; ++i) { const int k = i * 256 + lane * 4; const f32x4 w = *(const f32x4*)(p.final_w + k); *(f32x4*)(p.out + (size_t)row * D + k) = v[i] * rstd * w; }
    }
}


#define XB_TMO      128
#define XB_XCNT(j)  (256  + 64 * (j))
#define XB_XSUB(j)  (1280 + 64 * (j))
#define XB_XGEN(j)  (2304 + 64 * (j))
#define XB_TOP      3328
#define XB_TOPGEN   3392
#define XCD_BAR_WORDS 3456
#ifndef CPU_EMU
#define XB_SPIN_CAP (1u << 22)
#define LAS __attribute__((address_space(3)))
__device__ __forceinline__ unsigned xb_ld(unsigned* p)              { return __hip_atomic_load(p, __ATOMIC_RELAXED, __HIP_MEMORY_SCOPE_AGENT); }
__device__ __forceinline__ unsigned xb_add(unsigned* p, unsigned v) { return __hip_atomic_fetch_add(p, v, __ATOMIC_RELAXED, __HIP_MEMORY_SCOPE_AGENT); }
__device__ __forceinline__ unsigned xb_xcc_id() { return (unsigned)__builtin_amdgcn_s_getreg((3 << 11) | 20) & 0xFu; }
#define XB_SPIN(cond, bar) do { unsigned _sp = 0; while (cond) { __builtin_amdgcn_s_sleep(1); \
    if ((++_sp & 255u) == 0u) { if (xb_ld(&(bar)[XB_TMO])) break; if (_sp > XB_SPIN_CAP) { atomicAdd(&(bar)[XB_TMO], 1u); break; } } } } while (0)
struct XcdBarrier { unsigned* bar; unsigned x; volatile LAS unsigned* st; };
__device__ __forceinline__ XcdBarrier xcd_barrier_post(unsigned* bar, volatile LAS unsigned* st) {
    XcdBarrier b; b.bar = bar; b.x = xb_xcc_id(); b.st = st;
    if (threadIdx.x == 0) (void)xb_add(&bar[XB_XCNT(b.x)], 1u);
    return b;
}
__device__ __forceinline__ void xcd_barrier_complete(unsigned* bar, unsigned x, unsigned& nloc, unsigned& nx) {
    const unsigned G = gridDim.x * gridDim.y * gridDim.z;
    unsigned sum, cnt, mine, sp = 0u;
    for (;;) {
        sum = 0u; cnt = 0u; mine = 0u;
#pragma unroll
        for (unsigned j = 0; j < 16; ++j) { const unsigned c = xb_ld(&bar[XB_XCNT(j)]); sum += c; cnt += (c > 0u) ? 1u : 0u; mine = (j == x) ? c : mine; }
        if (sum == G) break;
        __builtin_amdgcn_s_sleep(1);
        if ((++sp & 255u) == 0u) { if (xb_ld(&bar[XB_TMO])) break; if (sp > XB_SPIN_CAP) { atomicAdd(&bar[XB_TMO], 1u); break; } }
    }
    nloc = mine > 0u ? mine : 1u; nx = cnt > 0u ? cnt : 1u;
}
__device__ __forceinline__ void xcd_barrier(const XcdBarrier& b) {
    asm volatile("s_waitcnt vmcnt(0)" ::: "memory");
    __syncthreads();
    if (threadIdx.x == 0) {
        unsigned* bar = b.bar;
        __builtin_amdgcn_s_waitcnt(0);
        unsigned nloc = b.st[0], nx = b.st[1];
        if (nloc == 0u) { xcd_barrier_complete(bar, b.x, nloc, nx); b.st[0] = nloc; b.st[1] = nx; }
        const unsigned old = xb_add(&bar[XB_XSUB(b.x)], 1u);
        const unsigned gen = old / nloc;
        if (old + 1u == (gen + 1u) * nloc) {
            __builtin_amdgcn_fence(__ATOMIC_RELEASE, "agent");
            asm volatile("s_waitcnt vmcnt(0)" ::: "memory");
            const unsigned og = xb_add(&bar[XB_TOP], 1u);
            const unsigned tg = og / nx;
            if (og + 1u == (tg + 1u) * nx) xb_add(&bar[XB_TOPGEN], 1u);
            else XB_SPIN(xb_ld(&bar[XB_TOPGEN]) == tg, bar);
            __builtin_amdgcn_fence(__ATOMIC_ACQUIRE, "agent");
            xb_add(&bar[XB_XGEN(b.x)], 1u);
            asm volatile("s_waitcnt vmcnt(0)" ::: "memory");
        } else {
            XB_SPIN(xb_ld(&bar[XB_XGEN(b.x)]) == gen, bar);
            __builtin_amdgcn_fence(__ATOMIC_ACQUIRE, "agent");
            asm volatile("s_waitcnt vmcnt(0)" ::: "memory");
        }
    }
    __syncthreads();
}
#endif

#define PHASE_LIST(X) X(ph_prep) X(ph_norm1) X(ph_inproj) X(ph_conv_rscan) X(ph_rout_hynorm) X(ph_outproj) X(ph_norm2_router) X(ph_moe_up) X(ph_moe_down)

struct WsBuf { size_t size, off; int p0, p1; };
static size_t fill_params(Params& p, void* const* d_in, void* d_out, void* d_ws, int grid) {
    const float** in = (const float**)d_in;
    p.x = in[0]; p.c = in[1]; p.ctx = in[2]; p.c_ctx = in[3]; p.ada_w = in[4]; p.ada_b = in[5]; p.norm1_w = in[6]; p.w_in = in[7]; p.hy_conv_w = in[8]; p.hy_conv_b = in[9];
    p.f_w1 = in[10]; p.f_b1 = in[11]; p.f_w2 = in[12]; p.f_b2 = in[13]; p.f_w3 = in[14]; p.f_b3 = in[15]; p.f_wout = in[16]; p.f_freq = in[17]; p.hy_skip = in[18]; p.hy_out_norm = in[19];
    p.ret_gn_w = in[20]; p.w_out = in[21]; p.norm2_w = in[22]; p.rg_w = in[23]; p.rg_b = in[24]; p.re_w = in[25]; p.re_b = in[26]; p.exp_w1 = in[27]; p.exp_w3 = in[28]; p.exp_w2 = in[29]; p.final_w = in[30];
    p.out = (float*)d_out;
    char* ws = (char*)d_ws; WsBuf bufs[48]; void** slots[48]; int nb = 0; size_t total = 0;
#define WS(field, type, count, p0, p1) { slots[nb] = (void**)&p.field; bufs[nb] = WsBuf{((sizeof(type) * (size_t)(count)) + 255) & ~(size_t)255, 0, p0, p1}; ++nb; }
    WS(mod, float, (NB + 1) * NMODC, 0, 9); WS(cnt, int, NEXP * 32, 0, 9); WS(bar, unsigned, XCD_BAR_WORDS, 0, 9); WS(rope, float, 64 * 16 * 2, 0, 2); WS(h3buf, float, (size_t)L * 64, 0, 2); WS(w_in_t, bf16_t, PC * D, 0, 2); WS(w_out_t, bf16_t, D * D, 2, 5);
    WS(gtap, bf16_t, (size_t)HW * 2 * L, 2, 3);
    WS(hbuf, bf16_t, (size_t)TA * D, 1, 2); WS(RP, float, (size_t)NB * D * 32, 1, 6); WS(cb, float, NB * 32, 1, 6);
    WS(pT, bf16_t, (size_t)1536 * T, 2, 4); WS(qn, bf16_t, (size_t)T * 512, 2, 4); WS(kn, bf16_t, (size_t)T * 512, 2, 3); WS(kTf, bf16_t, (size_t)T * 512, 2, 3); WS(kTb, bf16_t, (size_t)T * 512, 2, 3); WS(vT, bf16_t, (size_t)T * 512, 2, 3);
    WS(ckTf, bf16_t, (size_t)TC * 512, 2, 3); WS(ckTb, bf16_t, (size_t)TC * 512, 2, 3); WS(cvT, bf16_t, (size_t)TC * 512, 2, 3); WS(gbuf, bf16_t, (size_t)T * 512, 2, 4);
    WS(yhyT, bf16_t, (size_t)HW * T, 3, 4); WS(Sst, bf16_t, (size_t)2 * NB * NH * NCH * 16384, 3, 4); WS(ycat, bf16_t, (size_t)T * D, 4, 5);
    WS(Pscr, bf16_t, (size_t)grid * 16384, 3, 3); WS(Opart, bf16_t, (size_t)NB * NH * NCH * 16384, 3, 4);
    WS(x1, float, (size_t)T * D, 5, 9); WS(w13_t, bf16_t, (size_t)NEXP * 1024 * 1024, 5, 7); WS(w2_t, bf16_t, (size_t)NEXP * 1024 * EH, 5, 8);
    WS(h2, bf16_t, (size_t)T * D, 6, 7); WS(elist, int, (size_t)NEXP * T, 6, 9); WS(ewt, float, (size_t)NEXP * T, 6, 9);
    WS(hid, bf16_t, (size_t)(2 * T + NEXP * 128) * EH, 7, 8); WS(ymoe, bf16_t, (size_t)2 * T * D, 8, 9);
#undef WS
    int order[48]; for (int i = 0; i < nb; ++i) order[i] = i;
    for (int i = 1; i < nb; ++i) { const int v = order[i]; int j = i - 1; while (j >= 0 && bufs[order[j]].size < bufs[v].size) { order[j + 1] = order[j]; --j; } order[j + 1] = v; }
    bool placed[48]; for (int i = 0; i < nb; ++i) placed[i] = false;
    for (int oi = 0; oi < nb; ++oi) { WsBuf& nbuf = bufs[order[oi]]; size_t off = 0;
        for (bool moved = true; moved;) { moved = false;
            for (int i = 0; i < nb; ++i) { if (!placed[i]) continue; const WsBuf& b = bufs[i];
                if (b.p1 < nbuf.p0 || b.p0 > nbuf.p1) continue;
                if (off < b.off + b.size && b.off < off + nbuf.size) { off = b.off + b.size; moved = true; } } }
        nbuf.off = off; placed[order[oi]] = true; *slots[order[oi]] = (void*)(ws + off); if (off + nbuf.size > total) total = off + nbuf.size; }
    return total;
}

#ifndef CPU_EMU
__global__ void __launch_bounds__(NTHR, 2) mega_kernel(Params p) {
    extern __shared__ __attribute__((aligned(16))) char smem[];
    volatile LAS unsigned* st = (volatile LAS unsigned*)(smem + SMEM_BYTES - 16);
    if (threadIdx.x == 0) { st[0] = 0u; st[1] = 0u; *(unsigned long long*)(smem + SMEM_BYTES - 32) = 0ull; }
    __syncthreads();
    const XcdBarrier xb = xcd_barrier_post(p.bar, st);
    if (p.out == nullptr) cg::this_grid().sync();
#define X(f) f(p, smem); xcd_barrier(xb);
    PHASE_LIST(X)
#undef X
    ph_final(p, smem);
#ifdef KPROBE_ID
    if (blockIdx.x == KPROBE_BLOCK && threadIdx.x == 0) { const unsigned long long tn = __builtin_amdgcn_s_memrealtime(), wait = (unsigned long long)KPROBE_AMP * *(unsigned long long*)(smem + SMEM_BYTES - 32); while (__builtin_amdgcn_s_memrealtime() - tn < wait) __builtin_amdgcn_s_sleep(8); }
#endif
}

extern "C" void kernel_launch(void* const* d_in, const int* in_sizes, int n_in, void* d_out, int out_size, void* d_ws, size_t ws_size, hipStream_t stream) {
    static int grid_blocks = 0;
    if (!grid_blocks) {
        int dev = 0, cus = 0, per_cu = 0;
        (void)hipGetDevice(&dev);
        (void)hipDeviceGetAttribute(&cus, hipDeviceAttributeMultiprocessorCount, dev);
        (void)hipFuncSetAttribute((const void*)mega_kernel, hipFuncAttributeMaxDynamicSharedMemorySize, SMEM_BYTES);
        (void)hipOccupancyMaxActiveBlocksPerMultiprocessor(&per_cu, mega_kernel, NTHR, SMEM_BYTES);
        if (per_cu > 2) per_cu = 2;
        if (per_cu < 1) per_cu = 1;
        grid_blocks = cus * per_cu;
    }
    Params p; memset(&p, 0, sizeof(p));
    const size_t need = fill_params(p, d_in, d_out, d_ws, grid_blocks);
    if (need > ws_size) { fprintf(stderr, "workspace too small: need %zu have %zu\n", need, ws_size); return; }
    (void)hipMemsetAsync(p.bar, 0, XCD_BAR_WORDS * sizeof(unsigned), stream);
    void* args[] = {&p};
    hipError_t e = hipLaunchCooperativeKernel((void*)mega_kernel, dim3(grid_blocks), dim3(NTHR), args, SMEM_BYTES, stream);
    if (e != hipSuccess) fprintf(stderr, "cooperative launch failed: %s (grid %d)\n", hipGetErrorString(e), grid_blocks);
}
#endif
```

```cpp
#ifdef CPU_EMU
#include "emu.h"
#else
#include <hip/hip_runtime.h>
#include <hip/hip_cooperative_groups.h>
#include <cstdio>
namespace cg = cooperative_groups;
#endif
#include <stdint.h>
#include <string.h>
#include <math.h>

#ifndef CFG_BATCH
#define CFG_BATCH 8
#endif
#ifndef CFG_SEQ
#define CFG_SEQ 2048
#endif
#ifndef CFG_CTX
#define CFG_CTX 256
#endif

#ifdef CPU_EMU
#define OPAQUE(x)
#define SCHED_FENCE()
#define LDS_AS
#define WT_STORE(ptr, v) (*(ptr) = (v))
#define SETPRIO(n)
#else
#define SETPRIO(n) __builtin_amdgcn_s_setprio(n)
#define WT_STORE(ptr, v) __hip_atomic_store((ptr), (v), __ATOMIC_RELAXED, __HIP_MEMORY_SCOPE_AGENT)
#define LDS_AS __attribute__((address_space(3)))
#define OPAQUE(x) asm volatile("" : "+v"(x))
#define SCHED_FENCE() __builtin_amdgcn_sched_barrier(0)
#endif
#if defined(KPROBE_ID) && !defined(CPU_EMU)
#define KP_BEGIN(id) const unsigned long long kp_t0_##id = __builtin_amdgcn_s_memrealtime()
#define KP_END(id) do { if ((id) == KPROBE_ID && blockIdx.x == KPROBE_BLOCK && threadIdx.x == 0) *(unsigned long long*)(smem + SMEM_BYTES - 32) += __builtin_amdgcn_s_memrealtime() - kp_t0_##id; } while (0)
#else
#define KP_BEGIN(id)
#define KP_END(id)
#endif
#define DEV __device__ __forceinline__

typedef unsigned short bf16_t;
typedef short bf16x8 __attribute__((ext_vector_type(8)));
typedef float f32x4 __attribute__((ext_vector_type(4)));
typedef unsigned short us4 __attribute__((ext_vector_type(4)));

constexpr int NB = CFG_BATCH, L = CFG_SEQ, LC = CFG_CTX;
constexpr int D = 1024, T = NB * L, TC = NB * LC, TA = T + TC;
constexpr int HW = 512, NH = 4, DH = 128, CH = 128, PC = 3584, NMODC = 6 * D;
constexpr int NCH = L / CH, NCC = LC / CH, NCT = NCH + NCC;
constexpr int NEXP = 16, EH = 512;
constexpr int UP = L + 64;
constexpr int NTHR = 256;
constexpr int SMEM_BYTES = 77824;
constexpr int MAXTILES = T * 2 / 128 + NEXP;

struct Params {
    const float *x, *c, *ctx, *c_ctx, *ada_w, *ada_b, *norm1_w, *w_in, *hy_conv_w, *hy_conv_b, *f_w1, *f_b1, *f_w2, *f_b2, *f_w3, *f_b3,
        *f_wout, *f_freq, *hy_skip, *hy_out_norm, *ret_gn_w, *w_out, *norm2_w, *rg_w, *rg_b, *re_w, *re_b, *exp_w1, *exp_w3, *exp_w2, *final_w;
    float* out;
    float* mod;
    bf16_t* w_in_t;
    bf16_t* w_out_t;
    bf16_t* w13_t;
    bf16_t* w2_t;
    bf16_t* gtap;
    float* rope;
    float* h3buf;
    bf16_t* hbuf;
    float* RP;
    float* cb;
    bf16_t* pT;
    bf16_t* qn;
    bf16_t* kn;
    bf16_t* kTf;
    bf16_t* kTb;
    bf16_t* vT;
    bf16_t* ckTf;
    bf16_t* ckTb;
    bf16_t* cvT;
    bf16_t* gbuf;
    bf16_t* Sst;
    bf16_t* yhyT;
    bf16_t* ycat;
    bf16_t* Pscr;
    bf16_t* Opart;
    float* x1;
    bf16_t* h2;
    unsigned* bar;
    int* cnt;
    int* elist;
    float* ewt;
    bf16_t* hid;
    bf16_t* ymoe;
};

DEV uint32_t f_as_u(float f) { return __builtin_bit_cast(uint32_t, f); }
DEV float u_as_f(uint32_t u) { return __builtin_bit_cast(float, u); }
DEV float bf2f(bf16_t v) { return u_as_f(((uint32_t)v) << 16); }
#ifdef CPU_EMU
DEV bf16_t f2bf(float f) { uint32_t u = f_as_u(f); u += 0x7fffu + ((u >> 16) & 1u); return (bf16_t)(u >> 16); }
DEV us4 pack4(float a, float b, float c, float d) { us4 r; r[0] = f2bf(a); r[1] = f2bf(b); r[2] = f2bf(c); r[3] = f2bf(d); return r; }
#else
typedef __bf16 hwbf16x2 __attribute__((ext_vector_type(2)));
typedef __bf16 hwbf16x4 __attribute__((ext_vector_type(4)));
typedef float f32x2v __attribute__((ext_vector_type(2)));
DEV bf16_t f2bf(float f) { return __builtin_bit_cast(bf16_t, (__bf16)f); }
DEV us4 pack4(float a, float b, float c, float d) { const f32x4 v = {a, b, c, d}; return __builtin_bit_cast(us4, __builtin_convertvector(v, hwbf16x4)); }
#endif
DEV float silu_f(float v) { return v / (1.f + expf(-v)); }
DEV float wave_sum(float v) { v += __shfl_xor(v, 1); v += __shfl_xor(v, 2); v += __shfl_xor(v, 4); v += __shfl_xor(v, 8); v += __shfl_xor(v, 16); v += __shfl_xor(v, 32); return v; }
DEV float lg2_gamma(int h, bool bwd) { return log2f(1.f - exp2f(-((bwd ? 5.5f : 5.0f) + (float)h))); }

DEV int stage_chunk() { return ((threadIdx.x & 7) ^ ((threadIdx.x >> 4) & 7)) * 8; }
struct LdPlain {
    static constexpr bool kDirect = true;
    const bf16_t* rp[4];
    DEV LdPlain(const bf16_t* base, size_t row0, size_t ld) { const int lrow = threadIdx.x >> 3, lc = stage_chunk();
#pragma unroll
        for (int i = 0; i < 4; ++i) rp[i] = base + (row0 + lrow + 32 * i) * ld + lc; }
    DEV const bf16_t* src(int i, int kt) const { return rp[i] + kt * 64; }
    DEV bf16x8 ld(int i, int kt) const { return *(const bf16x8*)(rp[i] + kt * 64); }
};
struct LdGather {
    static constexpr bool kDirect = true;
    const bf16_t* rp[4];
    DEV const bf16_t* src(int i, int kt) const { return rp[i] + kt * 64; }
    DEV bf16x8 ld(int i, int kt) const { return *(const bf16x8*)(rp[i] + kt * 64); }
};
struct LdKScale {
    static constexpr bool kDirect = false;
    const bf16_t* rp[4]; float a, b; int lc;
    DEV LdKScale(const bf16_t* base, size_t row0, size_t ld, float a_, float b_) : a(a_), b(b_) { const int lrow = threadIdx.x >> 3; lc = stage_chunk();
#pragma unroll
        for (int i = 0; i < 4; ++i) rp[i] = base + (row0 + lrow + 32 * i) * ld + lc; }
    DEV const bf16_t* src(int i, int kt) const { return rp[i] + kt * 64; }
    DEV bf16x8 ld(int i, int kt) const { bf16x8 v = *(const bf16x8*)(rp[i] + kt * 64); const int k0 = kt * 64 + lc; bf16x8 o;
#pragma unroll
        for (int e = 0; e < 8; ++e) o[e] = (short)f2bf(bf2f((bf16_t)v[e]) * exp2f(a + b * (float)(k0 + e)));
        return o; }
};
struct LdRowScale {
    static constexpr bool kDirect = false;
    const bf16_t* rp[4]; float sc[4];
    DEV LdRowScale(const bf16_t* base, size_t row0, size_t ld, float a, float b) { const int lrow = threadIdx.x >> 3, lc = stage_chunk();
#pragma unroll
        for (int i = 0; i < 4; ++i) { rp[i] = base + (row0 + lrow + 32 * i) * ld + lc; sc[i] = exp2f(a + b * (float)(lrow + 32 * i)); } }
    DEV const bf16_t* src(int i, int kt) const { return rp[i] + kt * 64; }
    DEV bf16x8 ld(int i, int kt) const { bf16x8 v = *(const bf16x8*)(rp[i] + kt * 64); bf16x8 o;
#pragma unroll
        for (int e = 0; e < 8; ++e) o[e] = (short)f2bf(bf2f((bf16_t)v[e]) * sc[i]);
        return o; }
};
#ifdef CPU_EMU
DEV void glds16(const bf16_t* g, char* l) { memcpy(l, g, 16); }
DEV void wait_vm0() {}
#else
DEV void glds16(const bf16_t* g, char* l) { __builtin_amdgcn_global_load_lds((const __attribute__((address_space(1))) void*)g, (__attribute__((address_space(3))) void*)l, 16, 0, 0); }
DEV void wait_vm0() { asm volatile("s_waitcnt vmcnt(0)" ::: "memory"); }
#endif

struct NoHook { DEV void operator()(int, f32x4 (&)[4][4]) const {} };
template <class LX, class LY, class HK>
DEV void gemm_tile_h(f32x4 (&acc)[4][4], const LX& lx, const LY& ly, int nk, char* smem, const HK& hook) {
    int tid = threadIdx.x; OPAQUE(tid);
    const int lane = tid & 63, wid = tid >> 6, wr = wid >> 1, wc = wid & 1;
    const int fr = lane & 15, quad = lane >> 4;
    bf16x8 rx[4], ry[4];
    char* const sx = smem + tid * 16; char* const sy = smem + 32768 + tid * 16;
#pragma unroll
    for (int i = 0; i < 4; ++i) {
        if (LX::kDirect) glds16(lx.src(i, 0), sx + i * 4096); else rx[i] = lx.ld(i, 0);
        if (LY::kDirect) glds16(ly.src(i, 0), sy + i * 4096); else ry[i] = ly.ld(i, 0); }
#pragma unroll
    for (int i = 0; i < 4; ++i) { if (!LX::kDirect) *(bf16x8*)(sx + i * 4096) = rx[i]; if (!LY::kDirect) *(bf16x8*)(sy + i * 4096) = ry[i]; }
    wait_vm0();
    __syncthreads();
    const int sw = fr >> 1;
    for (int kt = 0; kt < nk; ++kt) {
        const char* bx = smem + (kt & 1) * 16384; const char* by = smem + 32768 + (kt & 1) * 16384;
        const int nb = ((kt + 1) & 1) * 16384;
        if (kt + 1 < nk) {
#pragma unroll
            for (int i = 0; i < 4; ++i) {
                if (LX::kDirect) glds16(lx.src(i, kt + 1), sx + nb + i * 4096); else rx[i] = lx.ld(i, kt + 1);
                if (LY::kDirect) glds16(ly.src(i, kt + 1), sy + nb + i * 4096); else ry[i] = ly.ld(i, kt + 1); }
        }
        hook(kt, acc);
        SCHED_FENCE();
#pragma unroll
        for (int kk = 0; kk < 2; ++kk) {
            bf16x8 xf[4], yf[4];
            const int ch = ((kk * 4 + quad) ^ sw) << 4;
#pragma unroll
            for (int mi = 0; mi < 4; ++mi) xf[mi] = *(const bf16x8*)(bx + (wr * 64 + mi * 16 + fr) * 128 + ch);
#pragma unroll
            for (int ni = 0; ni < 4; ++ni) yf[ni] = *(const bf16x8*)(by + (wc * 64 + ni * 16 + fr) * 128 + ch);
            SETPRIO(1);
#pragma unroll
            for (int mi = 0; mi < 4; ++mi)
#pragma unroll
                for (int ni = 0; ni < 4; ++ni) acc[mi][ni] = __builtin_amdgcn_mfma_f32_16x16x32_bf16(xf[mi], yf[ni], acc[mi][ni], 0, 0, 0);
            SETPRIO(0);
        }
        SCHED_FENCE();
        if (kt + 1 < nk) {
#pragma unroll
            for (int i = 0; i < 4; ++i) { if (!LX::kDirect) *(bf16x8*)(sx + nb + i * 4096) = rx[i]; if (!LY::kDirect) *(bf16x8*)(sy + nb + i * 4096) = ry[i]; }
        }
        wait_vm0();
        __syncthreads();
    }
}
template <class LX, class LY>
DEV void gemm_tile(f32x4 (&acc)[4][4], const LX& lx, const LY& ly, int nk, char* smem) { gemm_tile_h(acc, lx, ly, nk, smem, NoHook()); }

DEV int pipe_chunk() { return (int)(((threadIdx.x & 3) ^ ((0u - (threadIdx.x >> 4)) & 3u)) * 8); }
#ifdef CPU_EMU
#define PIPE_WAIT(n)
#define PIPE_BARRIER() __syncthreads()
#else
#define PIPE_WAIT(n) asm volatile("s_waitcnt vmcnt(" #n ")" ::: "memory")
#define PIPE_BARRIER() do { __builtin_amdgcn_sched_barrier(0); __builtin_amdgcn_s_barrier(); __builtin_amdgcn_sched_barrier(0); } while (0)
#endif
template <class LX, class LY, class HK>
DEV void gemm_pipe(f32x4 (&acc)[4][4], const LX& lx, const LY& ly, int nk, char* smem, const HK& hook) {
    int tid = threadIdx.x; OPAQUE(tid);
    const int lane = tid & 63, wid = tid >> 6, wr = wid >> 1, wc = wid & 1, fr = lane & 15, quad = lane >> 4;
    char* const sx = smem + tid * 16;
#pragma unroll
    for (int t = 0; t < 3; ++t) {
#pragma unroll
        for (int i = 0; i < 2; ++i) { glds16(lx.src(i, t), sx + t * 16384 + i * 4096); glds16(ly.src(i, t), sx + t * 16384 + 8192 + i * 4096); } }
    PIPE_WAIT(8);
    PIPE_BARRIER();
    const int rd = ((quad ^ ((0 - (fr >> 2)) & 3)) << 4) + fr * 64;
    for (int kt = 0; kt < nk; ++kt) {
        if (kt + 3 < nk) { const int sl = ((kt + 3) & 3) * 16384;
#pragma unroll
            for (int i = 0; i < 2; ++i) { glds16(lx.src(i, kt + 3), sx + sl + i * 4096); glds16(ly.src(i, kt + 3), sx + sl + 8192 + i * 4096); } }
        hook(kt, acc);
        SCHED_FENCE();
        const char* bx = smem + (kt & 3) * 16384; const char* by = bx + 8192;
        bf16x8 xf[4], yf[4];
#pragma unroll
        for (int mi = 0; mi < 4; ++mi) xf[mi] = *(const bf16x8*)(bx + (wr * 64 + mi * 16) * 64 + rd);
#pragma unroll
        for (int ni = 0; ni < 4; ++ni) yf[ni] = *(const bf16x8*)(by + (wc * 64 + ni * 16) * 64 + rd);
#pragma unroll
        for (int mi = 0; mi < 4; ++mi)
#pragma unroll
            for (int ni = 0; ni < 4; ++ni) acc[mi][ni] = __builtin_amdgcn_mfma_f32_16x16x32_bf16(xf[mi], yf[ni], acc[mi][ni], 0, 0, 0);
        SCHED_FENCE();
        if (kt + 3 < nk) PIPE_WAIT(8); else if (kt + 2 < nk) PIPE_WAIT(4); else PIPE_WAIT(0);
        PIPE_BARRIER();
    }
}
DEV void zero_acc(f32x4 (&acc)[4][4]) {
#pragma unroll
    for (int i = 0; i < 4; ++i)
#pragma unroll
        for (int j = 0; j < 4; ++j) acc[i][j] = (f32x4){0.f, 0.f, 0.f, 0.f};
}

DEV void task_ada(const Params& p, char* smem, int task) {
    float* sl = (float*)smem;
    float* red = sl + (NB + 1) * D;
    const int tid = threadIdx.x;
    for (int i = tid; i < (NB + 1) * D; i += NTHR) { const int r = i / D, k = i % D; const float v = r < NB ? p.c[r * D + k] : p.c_ctx[k]; sl[i] = silu_f(v); }
    __syncthreads();
    const int col = tid & 31, kq = tid >> 5, j = task * 32 + col;
    float acc[NB + 1];
#pragma unroll
    for (int r = 0; r <= NB; ++r) acc[r] = 0.f;
#pragma unroll 1
    for (int k = kq; k < D; k += 256) { float wv[32];
#pragma unroll
        for (int u = 0; u < 32; ++u) wv[u] = p.ada_w[(size_t)(k + 8 * u) * NMODC + j];
        SCHED_FENCE();
#pragma unroll
        for (int u = 0; u < 32; ++u) {
#pragma unroll
            for (int r = 0; r <= NB; ++r) acc[r] += sl[r * D + k + 8 * u] * wv[u];
            if ((u & 3) == 3) SCHED_FENCE(); } }
#pragma unroll
    for (int r = 0; r <= NB; ++r) red[(kq * (NB + 1) + r) * 32 + col] = acc[r];
    __syncthreads();
    for (int i = tid; i < (NB + 1) * 32; i += NTHR) { const int r = i / 32, cc = i % 32; float s = p.ada_b[task * 32 + cc];
        for (int q = 0; q < 8; ++q) s += red[(q * (NB + 1) + r) * 32 + cc];
        p.mod[r * NMODC + task * 32 + cc] = s; }
    __syncthreads();
}

DEV void transpose_tile(const float* src, int ldn, int k0, int n0, bf16_t* dst, size_t ldk, int mapmode, int which, const float* sc, int scsplit, const float* sc2, char* smem) {
    float* t = (float*)smem;
    const int tid = threadIdx.x;
    { const int r = tid >> 4, c4 = tid & 15;
#pragma unroll
      for (int i = 0; i < 4; ++i) { const int k = r + 16 * i; const f32x4 v = *(const f32x4*)(src + (size_t)(k0 + k) * ldn + n0 + c4 * 4);
          float s = 1.f; if (sc) { const int kk = k0 + k; s = kk < scsplit ? sc[kk] : sc2[kk - scsplit]; }
          t[k * 65 + c4 * 4 + 0] = v[0] * s; t[k * 65 + c4 * 4 + 1] = v[1] * s; t[k * 65 + c4 * 4 + 2] = v[2] * s; t[k * 65 + c4 * 4 + 3] = v[3] * s; } }
    __syncthreads();
    { const int n = tid >> 2, kc = tid & 3; const int nn = n0 + n;
      const int drow = mapmode == 0 ? nn : ((nn >> 6) * 128 + ((nn >> 5) & 1) * 64 + which * 32 + (nn & 31));
#pragma unroll
      for (int h = 0; h < 2; ++h) { bf16x8 o;
#pragma unroll
          for (int e = 0; e < 8; ++e) o[e] = (short)f2bf(t[(kc * 16 + h * 8 + e) * 65 + n]);
          *(bf16x8*)(dst + (size_t)drow * ldk + k0 + kc * 16 + h * 8) = o; } }
    __syncthreads();
}

DEV void task_filt_mlp(const Params& p, char* smem, int task) {
    float* z = (float*)smem;
    float* ha = z + 8 * 36;
    float* hb = ha + 8 * 64;
    float* w1 = hb + 8 * 64;
    float* w2 = w1 + 33 * 64;
    float* w3 = w2 + 64 * 64;
    const int tid = threadIdx.x, i0 = task * 8;
    {   f32x4 a2[4], a3[4], a1[3];
#pragma unroll
        for (int u = 0; u < 4; ++u) { a2[u] = *(const f32x4*)(p.f_w2 + (u * 256 + tid) * 4); a3[u] = *(const f32x4*)(p.f_w3 + (u * 256 + tid) * 4); }
#pragma unroll
        for (int u = 0; u < 3; ++u) { const int i = u * 256 + tid; a1[u] = i < 528 ? *(const f32x4*)(p.f_w1 + i * 4) : (f32x4){0.f, 0.f, 0.f, 0.f}; }
#pragma unroll
        for (int u = 0; u < 4; ++u) { *(f32x4*)(w2 + (u * 256 + tid) * 4) = a2[u]; *(f32x4*)(w3 + (u * 256 + tid) * 4) = a3[u]; }
#pragma unroll
        for (int u = 0; u < 3; ++u) { const int i = u * 256 + tid; if (i < 528) *(f32x4*)(w1 + i * 4) = a1[u]; }
    }
    for (int i = tid; i < 8 * 33; i += NTHR) { const int pp = i / 33, f = i % 33, pos = i0 + pp; float v;
        if (f == 0) v = (float)pos / (float)(L - 1);
        else { const int bnd = (f - 1) & 15; const float band = 1e-4f + (float)bnd * ((15.f - 1e-4f) / 15.f);
               const float ang = (6.283185307179586f / (float)L) * (float)pos * band; v = f <= 16 ? cosf(ang) : -sinf(ang); }
        z[pp * 36 + f] = v; }
    __syncthreads();
    const int pp = tid >> 5, jq = tid & 31;
#pragma unroll 1
    for (int m = 0; m < 2; ++m) { const int j = jq + 32 * m; float s = p.f_b1[j];
#pragma unroll 3
        for (int k = 0; k < 33; ++k) s += z[pp * 36 + k] * w1[k * 64 + j];
        ha[pp * 64 + j] = sinf(p.f_freq[j] * s); }
    __syncthreads();
#pragma unroll 1
    for (int m = 0; m < 2; ++m) { const int j = jq + 32 * m; float s = p.f_b2[j];
#pragma unroll 4
        for (int k = 0; k < 64; ++k) s += ha[pp * 64 + k] * w2[k * 64 + j];
        hb[pp * 64 + j] = sinf(p.f_freq[j] * s); }
    __syncthreads();
#pragma unroll 1
    for (int m = 0; m < 2; ++m) { const int j = jq + 32 * m; float s = p.f_b3[j];
#pragma unroll 4
        for (int k = 0; k < 64; ++k) s += hb[pp * 64 + k] * w3[k * 64 + j];
        p.h3buf[(size_t)(i0 + pp) * 64 + j] = sinf(p.f_freq[j] * s); }
    __syncthreads();
}
DEV void task_filt_out(const Params& p, char* smem, int task) {
    float* hs = (float*)smem;
    float* wl = hs + 64 * 64;
    const int tid = threadIdx.x, jb = task >> 3, cg = task & 7; const bool isb = jb >= L / 64;
    const int cl = tid & 63, mh = tid >> 6, c = cg * 64 + cl;
    {   f32x4 hv[4], wq[4];
#pragma unroll
        for (int u = 0; u < 4; ++u) { const int i = u * 256 + tid, pp = i >> 4, q = i & 15; int pos = isb ? 64 * jb + pp - L : L - 64 * jb - pp; if (pos > L - 1) pos = L - 1;
            hv[u] = *(const f32x4*)(p.h3buf + (size_t)pos * 64 + q * 4); }
#pragma unroll
        for (int u = 0; u < 4; ++u) { const int i = u * 256 + tid, k = i >> 4, q = i & 15; wq[u] = *(const f32x4*)(p.f_wout + k * 1024 + (isb ? 512 : 0) + cg * 64 + q * 4); }
#pragma unroll
        for (int u = 0; u < 4; ++u) { *(f32x4*)(hs + (u * 256 + tid) * 4) = hv[u]; *(f32x4*)(wl + (u * 256 + tid) * 4) = wq[u]; }
    }
    __syncthreads();
    float acc[16];
#pragma unroll
    for (int i = 0; i < 16; ++i) acc[i] = 0.f;
#pragma unroll 1
    for (int k0 = 0; k0 < 64; k0 += 4) {
        const float w0 = wl[(k0 + 0) * 64 + cl], w1 = wl[(k0 + 1) * 64 + cl], w2 = wl[(k0 + 2) * 64 + cl], w3 = wl[(k0 + 3) * 64 + cl];
#pragma unroll
        for (int i = 0; i < 16; ++i) { const f32x4 h0 = *(const f32x4*)(hs + (mh * 16 + i) * 64 + k0); acc[i] += h0[0] * w0 + h0[1] * w1 + h0[2] * w2 + h0[3] * w3; } }
    const float max_decay = logf(1e-2f) / 0.3f, min_decay = logf(1e-2f) / 1.5f;
    const float delta = fabsf(min_decay + (float)c * ((max_decay - min_decay) / 511.f));
    if (jb == L / 64 && mh == 0) {
        float af = 0.f;
        for (int k = 0; k < 64; ++k) af += hs[k] * p.f_wout[k * 1024 + c];
        acc[0] = af; }
    bf16_t* dst = p.gtap + (size_t)c * (2 * L) + 64 * jb + 16 * mh;
#pragma unroll
    for (int q = 0; q < 2; ++q) { bf16x8 o;
#pragma unroll
        for (int e = 0; e < 8; ++e) { const int i = q * 8 + e, m = 64 * jb + 16 * mh + i; const int pos = isb ? m - L : L - m;
            const float tt = (float)pos / (float)(L - 1); float val = acc[i] * (expf(-tt * delta) + 0.05f);
            if (m == L) val += p.hy_skip[c];
            if (m == 0) val = 0.f;
            o[e] = (short)f2bf(val); }
        *(bf16x8*)(dst + q * 8) = o; }
    __syncthreads();
}

constexpr int NT_ADA = NMODC / 32;
constexpr int NT_WIN = 16 * 56, NT_WOUT = 16 * 16, NT_W13 = 16 * 2 * 16 * 8, NT_W2 = 16 * 8 * 16;
constexpr int NT_FILT = (2 * L / 64) * 8, NT_FMLP = L / 8;
constexpr int NT_P0 = NT_ADA + NT_FMLP + 1 + NT_WIN;

DEV void ph_prep(const Params& p, char* smem) {
    for (int task = blockIdx.x; task < NT_P0; task += gridDim.x) {
        int t = task;
        if (t < NT_ADA) { task_ada(p, smem, t); continue; } t -= NT_ADA;
        if (t < NT_FMLP) { task_filt_mlp(p, smem, t); continue; } t -= NT_FMLP;
        if (t < 1) {
            for (int i = threadIdx.x; i < 64 * 16; i += NTHR) { const int pos = i >> 4, f = i & 15; const float fr = powf(10000.f, -(float)f / 16.f); const float a = (float)pos * fr;
                p.rope[i * 2] = cosf(a); p.rope[i * 2 + 1] = sinf(a); }
            if (threadIdx.x < NEXP) p.cnt[threadIdx.x * 32] = 0;
            continue; } t -= 1;
        { const int kt = t / 56, nt = t % 56; transpose_tile(p.w_in, PC, kt * 64, nt * 64, p.w_in_t, 1024, 0, 0, nullptr, 0, nullptr, smem); }
    }
}
DEV void wout_task(const Params& p, char* smem, int u) { transpose_tile(p.w_out, D, (u / 16) * 64, (u % 16) * 64, p.w_out_t, 1024, 0, 0, p.hy_out_norm, 512, p.ret_gn_w, smem); }
DEV void expert_conv_task(const Params& p, char* smem, int t) {
    if (t < NT_W13) { const int e = t / 256, r = t % 256, which = r / 128, r2 = r % 128, kt = r2 / 8, nt = r2 % 8;
        transpose_tile((which ? p.exp_w3 : p.exp_w1) + (size_t)e * D * EH, EH, kt * 64, nt * 64, p.w13_t + (size_t)e * 1024 * 1024, 1024, 1, which, nullptr, 0, nullptr, smem); return; }
    t -= NT_W13;
    { const int e = t / 128, r = t % 128, kt = r / 16, nt = r % 16;
        transpose_tile(p.exp_w2 + (size_t)e * EH * D, D, kt * 64, nt * 64, p.w2_t + (size_t)e * 1024 * EH, EH, 0, 0, nullptr, 0, nullptr, smem); }
}

DEV void ph_norm1(const Params& p, char* smem) {
    const int tid = threadIdx.x, lane = tid & 63, wid = tid >> 6;
    {
        const int rstep = gridDim.x * 4; int row = blockIdx.x * 4 + wid;
        f32x4 w4[4];
#pragma unroll
        for (int i = 0; i < 4; ++i) w4[i] = *(const f32x4*)(p.norm1_w + i * 256 + lane * 4);
        f32x4 cur[4];
        if (row < TA) { const float* src = row < T ? p.x + (size_t)row * D : p.ctx + (size_t)(row - T) * D;
#pragma unroll
            for (int i = 0; i < 4; ++i) cur[i] = *(const f32x4*)(src + i * 256 + lane * 4); }
#pragma unroll 1
        for (; row < TA; row += rstep) {
            const int nrow = row + rstep < TA ? row + rstep : row;
            const float* nsrc = nrow < T ? p.x + (size_t)nrow * D : p.ctx + (size_t)(nrow - T) * D;
            f32x4 nxt[4];
#pragma unroll
            for (int i = 0; i < 4; ++i) nxt[i] = *(const f32x4*)(nsrc + i * 256 + lane * 4);
            const int mb = row < T ? row / L : NB;
            const float* sh = p.mod + (size_t)mb * NMODC; const float* sc = sh + D;
            f32x4 s1[4], s0[4];
#pragma unroll
            for (int i = 0; i < 4; ++i) { s1[i] = *(const f32x4*)(sc + i * 256 + lane * 4); s0[i] = *(const f32x4*)(sh + i * 256 + lane * 4); }
            float ss = 0.f;
#pragma unroll
            for (int i = 0; i < 4; ++i) ss += cur[i][0] * cur[i][0] + cur[i][1] * cur[i][1] + cur[i][2] * cur[i][2] + cur[i][3] * cur[i][3];
            ss = wave_sum(ss);
            const float rstd = rsqrtf(ss * (1.f / D) + 1e-6f);
#pragma unroll
            for (int i = 0; i < 4; ++i) { const int k = i * 256 + lane * 4; const f32x4 v = cur[i] * rstd * w4[i] * (1.f + s1[i]) + s0[i];
                *(us4*)(p.hbuf + (size_t)row * D + k) = pack4(v[0], v[1], v[2], v[3]); }
#pragma unroll
            for (int i = 0; i < 4; ++i) cur[i] = nxt[i];
        }
    }
    const int gtid = blockIdx.x * NTHR + tid, gn = gridDim.x * NTHR;
    for (int i = gtid; i < NB * D * 32; i += gn) { const int ii = i & 3, j = (i >> 2) & 31, k4 = (i >> 7) & 255, b = i >> 15; const int k = k4 * 4 + ii;
        const float r = j < 4 ? p.rg_w[k * 4 + j] : (j < 20 ? p.re_w[k * 16 + (j - 4)] : 0.f);
        p.RP[i] = p.norm2_w[k] * (1.f + p.mod[(size_t)b * NMODC + 4 * D + k]) * r; }
    for (int wt = blockIdx.x * 4 + wid; wt < NB * 32; wt += gridDim.x * 4) { const int b = wt >> 5, j = wt & 31; float s = 0.f;
        if (j < 20) for (int k = lane; k < D; k += 64) { const float r = j < 4 ? p.rg_w[k * 4 + j] : p.re_w[k * 16 + (j - 4)]; s += p.mod[(size_t)b * NMODC + 3 * D + k] * r; }
        s = wave_sum(s);
        if (lane == 0) WT_STORE(p.cb + wt, j < 4 ? s + p.rg_b[j] : (j < 20 ? s + p.re_b[j - 4] : 0.f)); }
    for (int t = blockIdx.x; t < NT_FILT; t += gridDim.x) task_filt_out(p, smem, t);
}

constexpr int NT_INP = (T / 128) * 28 + (TC / 128) * 8;
DEV void inproj_tile(const Params& p, char* smem, int mt, int nt) {
    int tid = threadIdx.x; OPAQUE(tid);
    const int lane = tid & 63, wid = tid >> 6, wr = wid >> 1, wc = wid & 1, fr = lane & 15, quad = lane >> 4;
    const size_t row0 = (size_t)mt * 128;
    const bool is_ctx = mt >= T / 128;
    const bool actX = (nt < 12) || (nt >= 16 && nt < 24);
    f32x4 acc[4][4]; zero_acc(acc);
    LdPlain la(p.hbuf, row0, D), lw(p.w_in_t, (size_t)nt * 128, D);
    if (actX) gemm_tile(acc, la, lw, D / 64, smem); else gemm_tile(acc, lw, la, D / 64, smem);
    if (nt < 12) {
#pragma unroll
        for (int mi = 0; mi < 4; ++mi)
#pragma unroll
            for (int ni = 0; ni < 4; ++ni) { const size_t tok = row0 + wr * 64 + mi * 16 + quad * 4; const int c = nt * 128 + wc * 64 + ni * 16 + fr;
                *(us4*)(p.pT + (size_t)c * T + tok) = pack4(acc[mi][ni][0], acc[mi][ni][1], acc[mi][ni][2], acc[mi][ni][3]); }
    } else if (nt >= 16 && nt < 24) {
        const bool isk = nt < 20; const int h = (nt - 16) & 3;
        if (!is_ctx) {
            const int b = (int)(row0 / L), tl0 = (int)(row0 % L);
            if (isk) {
                if (wc == 0) {
#pragma unroll
                    for (int mi = 0; mi < 4; ++mi)
#pragma unroll
                        for (int r = 0; r < 4; ++r) { const int tl = tl0 + wr * 64 + mi * 16 + quad * 4 + r;
                            { const float* cs = p.rope + ((tl >> 6) * 16 + fr) * 2; const float a = acc[mi][0][r], bq = acc[mi][1][r]; acc[mi][0][r] = a * cs[0] - bq * cs[1]; acc[mi][1][r] = a * cs[1] + bq * cs[0]; }
                            { const float* cs = p.rope + ((tl & 63) * 16 + fr) * 2; const float a = acc[mi][2][r], bq = acc[mi][3][r]; acc[mi][2][r] = a * cs[0] - bq * cs[1]; acc[mi][3][r] = a * cs[1] + bq * cs[0]; } }
                }
                const float scl = 0.08838834764831845f;
                const float lgf = lg2_gamma(h, false), lgb = lg2_gamma(h, true);
#pragma unroll
                for (int mi = 0; mi < 4; ++mi) { const int jl = wr * 64 + mi * 16 + quad * 4;
                    float zf[4], zb[4];
#pragma unroll
                    for (int r = 0; r < 4; ++r) { zf[r] = exp2f(lgf * (float)(127 - jl - r)); zb[r] = exp2f(lgb * (float)(jl + r)); }
#pragma unroll
                    for (int ni = 0; ni < 4; ++ni) { const int tl = tl0 + jl, d = wc * 64 + ni * 16 + fr; const size_t bh = (size_t)b * NH + h;
                        float kv[4];
#pragma unroll
                        for (int r = 0; r < 4; ++r) kv[r] = acc[mi][ni][r] * scl;
                        const us4 o = pack4(kv[0], kv[1], kv[2], kv[3]);
                        *(us4*)(p.kTf + (bh * 128 + d) * L + tl) = pack4(kv[0] * zf[0], kv[1] * zf[1], kv[2] * zf[2], kv[3] * zf[3]);
                        *(us4*)(p.kTb + (bh * 128 + d) * L + tl) = pack4(kv[0] * zb[0], kv[1] * zb[1], kv[2] * zb[2], kv[3] * zb[3]);
#pragma unroll
                        for (int r = 0; r < 4; ++r) p.kn[(bh * L + tl + r) * 128 + d] = o[r]; } }
            } else {
#pragma unroll
                for (int mi = 0; mi < 4; ++mi)
#pragma unroll
                    for (int ni = 0; ni < 4; ++ni) { const int tl = tl0 + wr * 64 + mi * 16 + quad * 4, d = wc * 64 + ni * 16 + fr; const size_t bh = (size_t)b * NH + h;
                        *(us4*)(p.vT + (bh * 128 + d) * L + tl) = pack4(acc[mi][ni][0], acc[mi][ni][1], acc[mi][ni][2], acc[mi][ni][3]); }
            }
        } else {
            const size_t cr0 = row0 - T; const int b = (int)(cr0 / LC), tl0 = (int)(cr0 % LC); const size_t bh = (size_t)b * NH + h;
            if (isk) {
                const float scl = 0.08838834764831845f; const float lgf = lg2_gamma(h, false), lgb = lg2_gamma(h, true);
#pragma unroll
                for (int mi = 0; mi < 4; ++mi) { const int jl = wr * 64 + mi * 16 + quad * 4; float zf[4], zb[4];
#pragma unroll
                    for (int r = 0; r < 4; ++r) { zf[r] = scl * exp2f(lgf * (float)(127 - jl - r)); zb[r] = scl * exp2f(lgb * (float)(jl + r)); }
#pragma unroll
                    for (int ni = 0; ni < 4; ++ni) { const int tl = tl0 + jl, d = wc * 64 + ni * 16 + fr;
                        *(us4*)(p.ckTf + (bh * 128 + d) * LC + tl) = pack4(acc[mi][ni][0] * zf[0], acc[mi][ni][1] * zf[1], acc[mi][ni][2] * zf[2], acc[mi][ni][3] * zf[3]);
                        *(us4*)(p.ckTb + (bh * 128 + d) * LC + tl) = pack4(acc[mi][ni][0] * zb[0], acc[mi][ni][1] * zb[1], acc[mi][ni][2] * zb[2], acc[mi][ni][3] * zb[3]); } }
            } else {
#pragma unroll
                for (int mi = 0; mi < 4; ++mi)
#pragma unroll
                    for (int ni = 0; ni < 4; ++ni) { const int tl = tl0 + wr * 64 + mi * 16 + quad * 4, d = wc * 64 + ni * 16 + fr;
                        *(us4*)(p.cvT + (bh * 128 + d) * LC + tl) = pack4(acc[mi][ni][0], acc[mi][ni][1], acc[mi][ni][2], acc[mi][ni][3]); }
            }
        }
    } else if (nt < 16) {
        const int h = nt - 12; const int b = (int)(row0 / L), tl0 = (int)(row0 % L);
        if (wr == 0) {
#pragma unroll
            for (int ni = 0; ni < 4; ++ni) { const int tl = tl0 + wc * 64 + ni * 16 + fr;
#pragma unroll
                for (int r = 0; r < 4; ++r) { const int j = quad * 4 + r;
                    { const float* cs = p.rope + ((tl >> 6) * 16 + j) * 2; const float a = acc[0][ni][r], bq = acc[1][ni][r]; acc[0][ni][r] = a * cs[0] - bq * cs[1]; acc[1][ni][r] = a * cs[1] + bq * cs[0]; }
                    { const float* cs = p.rope + ((tl & 63) * 16 + j) * 2; const float a = acc[2][ni][r], bq = acc[3][ni][r]; acc[2][ni][r] = a * cs[0] - bq * cs[1]; acc[3][ni][r] = a * cs[1] + bq * cs[0]; } } }
        }
#pragma unroll
        for (int mi = 0; mi < 4; ++mi)
#pragma unroll
            for (int ni = 0; ni < 4; ++ni) { const int tl = tl0 + wc * 64 + ni * 16 + fr, d = wr * 64 + mi * 16 + quad * 4; const size_t bh = (size_t)b * NH + h;
                *(us4*)(p.qn + (bh * L + tl) * 128 + d) = pack4(acc[mi][ni][0], acc[mi][ni][1], acc[mi][ni][2], acc[mi][ni][3]); }
    } else {
#pragma unroll
        for (int mi = 0; mi < 4; ++mi)
#pragma unroll
            for (int ni = 0; ni < 4; ++ni) { const size_t tok = row0 + wc * 64 + ni * 16 + fr; const int d = (nt - 24) * 128 + wr * 64 + mi * 16 + quad * 4;
                *(us4*)(p.gbuf + tok * 512 + d) = pack4(acc[mi][ni][0], acc[mi][ni][1], acc[mi][ni][2], acc[mi][ni][3]); }
    }
}
DEV void ph_inproj(const Params& p, char* smem) {
    constexpr int NMT = T / 128, NCM = TC / 128;
    const int G = gridDim.x, b = blockIdx.x;
    if ((G & 7) == 0 && NMT % 8 == 0) {
        constexpr int MX = NMT / 8;
        const int x = b & 7, li = b >> 3, nl = G >> 3;
        for (int q = li; q < MX * 28; q += nl) { const int ng = q / (MX * 4), rem = q % (MX * 4); inproj_tile(p, smem, x * MX + rem % MX, ng * 4 + rem / MX); }
        for (int t = b; t < NCM * 8; t += G) inproj_tile(p, smem, NMT + t / 8, 16 + t % 8);
        return;
    }
    for (int task = blockIdx.x; task < NT_INP; task += gridDim.x) {
        if (task < (T / 128) * 28) inproj_tile(p, smem, task / 28, task % 28);
        else { const int t = task - (T / 128) * 28; inproj_tile(p, smem, T / 128 + t / 8, 16 + t % 8); }
    }
}

constexpr int NU = L / 64, CSPLIT = 1, UPW = NU / (4 * CSPLIT), NGRP = NU / UPW;
typedef unsigned u32x2 __attribute__((ext_vector_type(2)));
typedef unsigned u32x4 __attribute__((ext_vector_type(4)));
constexpr int TAPC = 2 * L + 16;
DEV bf16x8 conv_afrag(const bf16_t* tcp, int m0a) {
    const u32x2 lo = *(const volatile LDS_AS u32x2*)(tcp + m0a), hi = *(const volatile LDS_AS u32x2*)(tcp + m0a + 4);
    const u32x4 v = {lo[0], lo[1], hi[0], hi[1]};
    return __builtin_bit_cast(bf16x8, v); }
DEV void conv3_w(const Params& p, int ch, float& w0, float& w1, float& w2, float& bs) { w0 = p.hy_conv_w[ch]; w1 = p.hy_conv_w[1536 + ch]; w2 = p.hy_conv_w[3072 + ch]; bs = p.hy_conv_b[ch]; }

DEV void conv_task(const Params& p, char* smem, int c, int half) {
    bf16_t* taps = (bf16_t*)smem;
    bf16_t* U = taps + 4 * TAPC;
    int tid = threadIdx.x; OPAQUE(tid);
    const int lane = tid & 63, w = tid >> 6, fr = lane & 15, quad = lane >> 4;
    {
        constexpr int NTC = (2 * L / 8 + NTHR - 1) / NTHR;
        constexpr int NGT = NB * (L / 8), NG = (NGT + NTHR - 1) / NTHR;
        float a0, a1, a2, ab, v0, v1, v2, vb; conv3_w(p, 512 + c, a0, a1, a2, ab); conv3_w(p, 1024 + c, v0, v1, v2, vb);
        bf16x8 tpv[NTC], x1v[NG], vv[NG]; bf16_t hx0[NG], hx9[NG], hv0[NG], hv9[NG];
#pragma unroll
        for (int u = 0; u < NTC; ++u) { int i = tid + u * NTHR; if (i >= 2 * L / 8) i = 2 * L / 8 - 1; tpv[u] = *(const bf16x8*)(p.gtap + (size_t)c * 2 * L + i * 8); }
#pragma unroll
        for (int u = 0; u < NG; ++u) { int g = tid + u * NTHR; if (g >= NGT) g = NGT - 1; const int b = g / (L / 8), t8 = (g % (L / 8)) * 8;
            const bf16_t* r1 = p.pT + (size_t)(512 + c) * T + (size_t)b * L + t8; const bf16_t* rv = p.pT + (size_t)(1024 + c) * T + (size_t)b * L + t8;
            x1v[u] = *(const bf16x8*)r1; vv[u] = *(const bf16x8*)rv;
            const int il = t8 > 0 ? -1 : 0, ir = t8 + 8 < L ? 8 : 7;
            hx0[u] = r1[il]; hv0[u] = rv[il]; hx9[u] = r1[ir]; hv9[u] = rv[ir]; }
        for (int i = tid; i < 8 * 8; i += NTHR) { const int b = i >> 3, q = i & 7; bf16_t* row = U + b * UP + (q < 4 ? q * 8 : 32 + L + (q - 4) * 8); *(bf16x8*)row = (bf16x8){0, 0, 0, 0, 0, 0, 0, 0}; }
        for (int i = tid; i < (8 - NB) * (L / 8); i += NTHR) *(bf16x8*)(U + (NB + i / (L / 8)) * UP + 32 + (i % (L / 8)) * 8) = (bf16x8){0, 0, 0, 0, 0, 0, 0, 0};
#pragma unroll
        for (int u = 0; u < NTC; ++u) { const int i = tid + u * NTHR; if (i >= 2 * L / 8) continue; const bf16x8 v = tpv[u];
            *(bf16x8*)(taps + i * 8) = v;
#pragma unroll
            for (int a = 1; a < 4; ++a)
#pragma unroll
                for (int e = 0; e < 8; ++e) { const int q = i * 8 + e - a; if (q >= 0) taps[a * TAPC + q] = (bf16_t)v[e]; } }
#pragma unroll
        for (int u = 0; u < NG; ++u) { const int g = tid + u * NTHR; if (g >= NGT) continue; const int b = g / (L / 8), t8 = (g % (L / 8)) * 8;
            float px[10], pv[10];
            px[0] = t8 > 0 ? bf2f(hx0[u]) : 0.f; pv[0] = t8 > 0 ? bf2f(hv0[u]) : 0.f; px[9] = t8 + 8 < L ? bf2f(hx9[u]) : 0.f; pv[9] = t8 + 8 < L ? bf2f(hv9[u]) : 0.f;
#pragma unroll
            for (int e = 0; e < 8; ++e) { px[e + 1] = bf2f((bf16_t)x1v[u][e]); pv[e + 1] = bf2f((bf16_t)vv[u][e]); }
            bf16x8 o;
#pragma unroll
            for (int e = 0; e < 8; ++e) { const float x1 = a0 * px[e] + a1 * px[e + 1] + a2 * px[e + 2] + ab; const float vq = v0 * pv[e] + v1 * pv[e + 1] + v2 * pv[e + 2] + vb; o[e] = (short)f2bf(x1 * vq); }
            *(bf16x8*)(U + b * UP + 32 + t8) = o; }
    }
    __syncthreads();
    f32x4 acc[2][UPW];
#pragma unroll
    for (int tp = 0; tp < 2; ++tp)
#pragma unroll
        for (int ui = 0; ui < UPW; ++ui) acc[tp][ui] = (f32x4){0.f, 0.f, 0.f, 0.f};
    const int bcol = fr & 7, i2 = fr >> 3;
    const bf16_t* Ub = U + bcol * UP + 32 + 32 * i2 + 8 * quad;
    const int al = (L - fr) & 3;
    const bf16_t* tcp = taps + al * TAPC;
    const int ub = UPW * (4 * half + w);
    const int mbase = L - fr + 8 * quad - 64 * ub - al;
#pragma unroll 1
    for (int jp = 1; jp >= 0; --jp) {
        bf16x8 af[2][UPW];
        int J0 = jp ? -1 : 0;
        if (jp) {
            const bf16x8 bfr = *(const bf16x8*)(Ub + 32 * J0);
#pragma unroll
            for (int tp = 0; tp < 2; ++tp)
#pragma unroll
                for (int ui = 0; ui < UPW; ++ui) { const bf16x8 a = conv_afrag(tcp, mbase - 64 * ui - 16 * tp + 32 * J0); acc[tp][ui] = __builtin_amdgcn_mfma_f32_16x16x32_bf16(a, bfr, acc[tp][ui], 0, 0, 0); }
            J0 = 1;
        }
#pragma unroll
        for (int tp = 0; tp < 2; ++tp)
#pragma unroll
            for (int ui = 0; ui < UPW; ++ui) af[tp][ui] = conv_afrag(tcp, mbase - 64 * ui - 16 * tp + 32 * J0);
        bf16x8 bnext = *(const bf16x8*)(Ub + 32 * J0);
#pragma unroll 1
        for (int grp = 0; grp < NGRP; ++grp) {
#pragma unroll
            for (int s = 0; s < UPW; ++s) {
                const bf16x8 bfr = bnext; { const int Jn = J0 + 2 < L / 32 ? J0 + 2 : J0; bnext = *(const bf16x8*)(Ub + 32 * Jn); }
#pragma unroll
                for (int tp = 0; tp < 2; ++tp)
#pragma unroll
                    for (int ui = 0; ui < UPW; ++ui) acc[tp][ui] = __builtin_amdgcn_mfma_f32_16x16x32_bf16(af[tp][(ui - s + UPW) % UPW], bfr, acc[tp][ui], 0, 0, 0);
                J0 += 2;
                if (grp < NGRP - 1 || s < UPW - 1) {
#pragma unroll
                    for (int tp = 0; tp < 2; ++tp) af[tp][(UPW - 1 - s) % UPW] = conv_afrag(tcp, mbase - 16 * tp + 32 * J0);
                }
            }
        }
    }
    if (bcol < NB) {
#pragma unroll
        for (int tp = 0; tp < 2; ++tp)
#pragma unroll
            for (int ui = 0; ui < UPW; ++ui) { const int I0 = 4 * (ub + ui) + tp; const int t = 16 * (I0 + 2 * i2) + 4 * quad;
                *(us4*)(p.yhyT + (size_t)c * T + (size_t)bcol * L + t) = pack4(acc[tp][ui][0], acc[tp][ui][1], acc[tp][ui][2], acc[tp][ui][3]); }
    }
    __syncthreads();
}

struct LdSeq64 {
    const bf16_t *cb, *lb; int dir;
    DEV LdSeq64(const bf16_t* cbase, const bf16_t* lbase, int row0, int dir_) : dir(dir_) { const int r = row0 + (threadIdx.x >> 2), lc = pipe_chunk(); cb = cbase + (size_t)r * LC + lc; lb = lbase + (size_t)r * L + lc; }
    DEV const bf16_t* src(int kt) const { const int n = kt >> 2, off = (kt & 3) * 32;
        if (n < NCC) { const int J = dir ? NCC - 1 - n : n; return cb + J * 128 + off; }
        const int I = dir ? NCH - 1 - (n - NCC) : n - NCC; return lb + I * 128 + off; }
};
struct RscanHook64 { bf16_t* so; int dir; float gch;
    DEV void store(int I, f32x4 (&acc)[2][2]) const {
#pragma unroll
        for (int mi = 0; mi < 2; ++mi)
#pragma unroll
            for (int ni = 0; ni < 2; ++ni) *(us4*)(so + (size_t)I * 16384 + (ni * 16) * 128 + mi * 16) = pack4(acc[mi][ni][0], acc[mi][ni][1], acc[mi][ni][2], acc[mi][ni][3]); }
    DEV void operator()(int kt, f32x4 (&acc)[2][2]) const {
        if (kt & 3) return; const int n = kt >> 2;
        if (n >= NCC) store(dir ? NCH - 1 - (n - NCC) : n - NCC, acc);
        if (n > 0) {
#pragma unroll
            for (int mi = 0; mi < 2; ++mi)
#pragma unroll
                for (int ni = 0; ni < 2; ++ni) acc[mi][ni] = acc[mi][ni] * gch; } }
};
DEV void rscan_task(const Params& p, char* smem, int task) {
    const int quadrant = task & 3, dh = quadrant >> 1, eh = quadrant & 1, bh = (task >> 2) % (NB * NH), dir = task / (4 * NB * NH), h = bh % NH;
    int tid = threadIdx.x; OPAQUE(tid);
    const int lane = tid & 63, wid = tid >> 6, wr = wid >> 1, wc = wid & 1, fr = lane & 15, quad = lane >> 4;
    const LdSeq64 lk((dir ? p.ckTb : p.ckTf) + (size_t)bh * 128 * LC, (dir ? p.kTb : p.kTf) + (size_t)bh * 128 * L, dh * 64, dir);
    const LdSeq64 lv(p.cvT + (size_t)bh * 128 * LC, p.vT + (size_t)bh * 128 * L, eh * 64, dir);
    RscanHook64 hk; hk.dir = dir; hk.gch = exp2f(128.f * lg2_gamma(h, dir == 1));
    hk.so = p.Sst + (((size_t)dir * NB * NH + bh) * NCH) * 16384 + (size_t)(eh * 64 + wc * 32 + fr) * 128 + dh * 64 + wr * 32 + quad * 4;
    f32x4 acc[2][2];
#pragma unroll
    for (int mi = 0; mi < 2; ++mi)
#pragma unroll
        for (int ni = 0; ni < 2; ++ni) acc[mi][ni] = (f32x4){0.f, 0.f, 0.f, 0.f};
    constexpr int nk = 4 * (NCT - 1);
    char* const sx = smem + tid * 16;
#pragma unroll
    for (int t = 0; t < 7; ++t) { if (t < nk) { glds16(lk.src(t), sx + t * 8192); glds16(lv.src(t), sx + t * 8192 + 4096); } }
    PIPE_WAIT(12);
    PIPE_BARRIER();
    const int rd = ((quad ^ ((0 - (fr >> 2)) & 3)) << 4) + fr * 64;
    for (int kt = 0; kt < nk; ++kt) {
        hk(kt, acc);
        SCHED_FENCE();
        if (kt + 7 < nk) { const int sl = ((kt + 7) & 7) * 8192; glds16(lk.src(kt + 7), sx + sl); glds16(lv.src(kt + 7), sx + sl + 4096); }
        SCHED_FENCE();
        const char* bx = smem + (kt & 7) * 8192; const char* by = bx + 4096;
        bf16x8 xf[2], yf[2];
#pragma unroll
        for (int mi = 0; mi < 2; ++mi) xf[mi] = *(const bf16x8*)(bx + (wr * 32 + mi * 16) * 64 + rd);
#pragma unroll
        for (int ni = 0; ni < 2; ++ni) yf[ni] = *(const bf16x8*)(by + (wc * 32 + ni * 16) * 64 + rd);
#pragma unroll
        for (int mi = 0; mi < 2; ++mi)
#pragma unroll
            for (int ni = 0; ni < 2; ++ni) acc[mi][ni] = __builtin_amdgcn_mfma_f32_16x16x32_bf16(xf[mi], yf[ni], acc[mi][ni], 0, 0, 0);
        SCHED_FENCE();
        const int rem = nk - 1 - kt;
        if (rem >= 7) PIPE_WAIT(12); else if (rem == 6) PIPE_WAIT(10); else if (rem == 5) PIPE_WAIT(8); else if (rem == 4) PIPE_WAIT(6); else if (rem == 3) PIPE_WAIT(4); else if (rem == 2) PIPE_WAIT(2); else PIPE_WAIT(0);
        PIPE_BARRIER();
    }
    hk.store(dir ? 0 : NCH - 1, acc);
}
constexpr int NT_RSC = 2 * NB * NH * 4;
constexpr int NT_CV = HW * CSPLIT, NT_RO = NB * NH * NCH;
DEV void rout_a_task(const Params& p, char* smem, int task);
DEV void ph_conv_rscan(const Params& p, char* smem) {
    const int G = gridDim.x, b = blockIdx.x;
    if (G == 2 * NT_RSC && NT_CV == 2 * NT_RSC && NT_RO == 2 * NT_RSC) {
        if (b < NT_RSC) { KP_BEGIN(0); rscan_task(p, smem, b); KP_END(0); KP_BEGIN(2); rout_a_task(p, smem, 2 * b); rout_a_task(p, smem, 2 * b + 1); KP_END(2); }
        else { KP_BEGIN(1); for (int k = 0; k < 2; ++k) { const int t = 2 * (b - NT_RSC) + k; conv_task(p, smem, t / CSPLIT, t % CSPLIT); } KP_END(1); }
        return;
    }
    for (int task = b; task < NT_RSC + NT_CV + NT_RO; task += G) {
        if (task < NT_RSC) rscan_task(p, smem, task); else if (task < NT_RSC + NT_CV) { const int t = task - NT_RSC; conv_task(p, smem, t / CSPLIT, t % CSPLIT); } else rout_a_task(p, smem, task - NT_RSC - NT_CV);
    }
}

DEV void hynorm_task(const Params& p, char* smem, int task) {
    bf16_t* tl = (bf16_t*)smem;
    const int tid = threadIdx.x; const size_t pos0 = (size_t)task * 64;
    const bool hasl = (pos0 % L) > 0, hasr = (pos0 % L) + 64 < L;
    for (int half = 0; half < 2; ++half) { const int c = tid + 256 * half; const bf16_t* src = p.yhyT + (size_t)c * T + pos0; const bf16_t* ps = p.pT + (size_t)c * T + pos0;
        float w0, w1, w2, wb; conv3_w(p, c, w0, w1, w2, wb);
        bf16x8 cv[8], pv[8];
#pragma unroll
        for (int q = 0; q < 8; ++q) { cv[q] = *(const bf16x8*)(src + q * 8); pv[q] = *(const bf16x8*)(ps + q * 8); }
        const bf16_t hl = ps[hasl ? -1 : 0], hr = ps[hasr ? 64 : 63];
        float prev = hasl ? bf2f(hl) : 0.f;
#pragma unroll
        for (int q = 0; q < 8; ++q)
#pragma unroll
            for (int e = 0; e < 8; ++e) { const float cur = bf2f((bf16_t)pv[q][e]);
                const float nxt = e < 7 ? bf2f((bf16_t)pv[q][e < 7 ? e + 1 : 7]) : (q < 7 ? bf2f((bf16_t)pv[q < 7 ? q + 1 : 7][0]) : (hasr ? bf2f(hr) : 0.f));
                const float x0 = w0 * prev + w1 * cur + w2 * nxt + wb;
                tl[(q * 8 + e) * 520 + c] = f2bf(x0 * bf2f((bf16_t)cv[q][e])); prev = cur; } }
    __syncthreads();
    const int pos = tid >> 2, part = tid & 3;
    float ss = 0.f;
    for (int q = 0; q < 16; ++q) { const bf16x8 v = *(const bf16x8*)(tl + pos * 520 + part * 128 + q * 8);
#pragma unroll
        for (int e = 0; e < 8; ++e) { const float f = bf2f((bf16_t)v[e]); ss += f * f; } }
    ss += __shfl_xor(ss, 1); ss += __shfl_xor(ss, 2);
    const float rstd = rsqrtf(ss * (1.f / 512.f) + 1e-6f);
    for (int q = 0; q < 16; ++q) { const bf16x8 v = *(const bf16x8*)(tl + pos * 520 + part * 128 + q * 8); bf16x8 o;
#pragma unroll
        for (int e = 0; e < 8; ++e) o[e] = (short)f2bf(bf2f((bf16_t)v[e]) * rstd);
        *(bf16x8*)(p.ycat + (pos0 + pos) * 1024 + part * 128 + q * 8) = o; }
    __syncthreads();
}
DEV void rout_a_task(const Params& p, char* smem, int task) {
    const int bh = task / NCH, I = task % NCH, h = bh % NH;
    int tid = threadIdx.x; OPAQUE(tid);
    const int lane = tid & 63, wid = tid >> 6, wr = wid >> 1, wc = wid & 1, fr = lane & 15, quad = lane >> 4;
    const float lgf = lg2_gamma(h, false), lgb = lg2_gamma(h, true);
    bf16_t* P = p.Pscr + (size_t)blockIdx.x * 16384;
    const bf16_t* qb = p.qn + ((size_t)bh * L + I * 128) * 128; const bf16_t* kb = p.kn + ((size_t)bh * L + I * 128) * 128;
    {
        f32x4 acc[4][4]; zero_acc(acc);
        LdPlain lk(kb, 0, 128), lq(qb, 0, 128);
        gemm_tile(acc, lk, lq, 2, smem);
#pragma unroll
        for (int mi = 0; mi < 4; ++mi)
#pragma unroll
            for (int ni = 0; ni < 4; ++ni) { const int i = wc * 64 + ni * 16 + fr, j0 = wr * 64 + mi * 16 + quad * 4; float v[4];
#pragma unroll
                for (int r = 0; r < 4; ++r) { const int j = j0 + r; const float dcy = i > j ? exp2f(lgf * (float)(i - j)) : (i == j ? 2.f : exp2f(lgb * (float)(j - i))); v[r] = acc[mi][ni][r] * dcy; }
                *(us4*)(P + i * 128 + j0) = pack4(v[0], v[1], v[2], v[3]); }
    }
    __syncthreads();
    f32x4 acc[4][4]; zero_acc(acc);
    {
        LdPlain lv(p.vT + (size_t)bh * 128 * L + I * 128, 0, L), lp(P, 0, 128);
        gemm_tile(acc, lv, lp, 2, smem);
    }
    bf16_t* op = p.Opart + (size_t)task * 16384;
#pragma unroll
    for (int mi = 0; mi < 4; ++mi)
#pragma unroll
        for (int ni = 0; ni < 4; ++ni) { const int i = wc * 64 + ni * 16 + fr, e = wr * 64 + mi * 16 + quad * 4; *(us4*)(op + i * 128 + e) = pack4(acc[mi][ni][0], acc[mi][ni][1], acc[mi][ni][2], acc[mi][ni][3]); }
}
DEV void rout_b_task(const Params& p, char* smem, int task) {
    const int bh = task / NCH, I = task % NCH, h = bh % NH, b = bh / NH;
    int tid = threadIdx.x; OPAQUE(tid);
    const int lane = tid & 63, wid = tid >> 6, wr = wid >> 1, wc = wid & 1, fr = lane & 15, quad = lane >> 4;
    const float lgf = lg2_gamma(h, false), lgb = lg2_gamma(h, true);
    const bf16_t* qb = p.qn + ((size_t)bh * L + I * 128) * 128;
    f32x4 acc[4][4];
    { const bf16_t* op = p.Opart + (size_t)task * 16384;
#pragma unroll
      for (int mi = 0; mi < 4; ++mi)
#pragma unroll
          for (int ni = 0; ni < 4; ++ni) { const int i = wc * 64 + ni * 16 + fr, e = wr * 64 + mi * 16 + quad * 4; const us4 v = *(const us4*)(op + i * 128 + e);
              acc[mi][ni] = (f32x4){bf2f(v[0]), bf2f(v[1]), bf2f(v[2]), bf2f(v[3])}; } }
    {
        LdPlain ls(p.Sst + (((size_t)0 * NB * NH + bh) * NCH + I) * 16384, 0, 128); LdRowScale lq(qb, 0, 128, lgf, lgf);
        gemm_tile(acc, ls, lq, 2, smem);
    }
    {
        LdPlain ls(p.Sst + (((size_t)1 * NB * NH + bh) * NCH + I) * 16384, 0, 128); LdRowScale lq(qb, 0, 128, 128.f * lgb, -lgb);
        gemm_tile(acc, ls, lq, 2, smem);
    }
    float* red = (float*)smem;
    float mean[4], rstd[4];
#pragma unroll
    for (int ni = 0; ni < 4; ++ni) { float s = 0.f, ss = 0.f;
#pragma unroll
        for (int mi = 0; mi < 4; ++mi)
#pragma unroll
            for (int r = 0; r < 4; ++r) { const float v = acc[mi][ni][r]; s += v; ss += v * v; }
        s += __shfl_xor(s, 16); s += __shfl_xor(s, 32); ss += __shfl_xor(ss, 16); ss += __shfl_xor(ss, 32);
        if (quad == 0) { const int i = wc * 64 + ni * 16 + fr; red[(wr * 128 + i) * 2] = s; red[(wr * 128 + i) * 2 + 1] = ss; } }
    __syncthreads();
#pragma unroll
    for (int ni = 0; ni < 4; ++ni) { const int i = wc * 64 + ni * 16 + fr; const float s = red[i * 2] + red[(128 + i) * 2], ss = red[i * 2 + 1] + red[(128 + i) * 2 + 1];
        mean[ni] = s * (1.f / 128.f); const float var = ss * (1.f / 128.f) - mean[ni] * mean[ni]; rstd[ni] = rsqrtf(fmaxf(var, 0.f) + 1e-6f); }
    us4 gv[4][4];
#pragma unroll
    for (int mi = 0; mi < 4; ++mi)
#pragma unroll
        for (int ni = 0; ni < 4; ++ni) { const int i = wc * 64 + ni * 16 + fr, e = wr * 64 + mi * 16 + quad * 4; const size_t tok = (size_t)b * L + I * 128 + i;
            gv[mi][ni] = *(const us4*)(p.gbuf + tok * 512 + h * 128 + e); }
#pragma unroll
    for (int mi = 0; mi < 4; ++mi)
#pragma unroll
        for (int ni = 0; ni < 4; ++ni) { const int i = wc * 64 + ni * 16 + fr, e = wr * 64 + mi * 16 + quad * 4; const size_t tok = (size_t)b * L + I * 128 + i; float y[4];
#pragma unroll
            for (int r = 0; r < 4; ++r) y[r] = (acc[mi][ni][r] - mean[ni]) * rstd[ni] * silu_f(bf2f(gv[mi][ni][r]));
            *(us4*)(p.ycat + tok * 1024 + 512 + h * 128 + e) = pack4(y[0], y[1], y[2], y[3]); }
    __syncthreads();
}
DEV void ph_rout_hynorm(const Params& p, char* smem) {
#pragma unroll 1
    for (int task = blockIdx.x; task < NB * NH * NCH + T / 64 + NT_WOUT; task += gridDim.x) {
        if (task < NB * NH * NCH) { KP_BEGIN(3); rout_b_task(p, smem, task); KP_END(3); } else if (task < NB * NH * NCH + T / 64) { KP_BEGIN(4); hynorm_task(p, smem, task - NB * NH * NCH); KP_END(4); } else wout_task(p, smem, task - NB * NH * NCH - T / 64); } }

DEV void outproj_tile(const Params& p, char* smem, int mt, int nt) {
    int tid = threadIdx.x; OPAQUE(tid);
    const int lane = tid & 63, wid = tid >> 6, wr = wid >> 1, wc = wid & 1, fr = lane & 15, quad = lane >> 4;
    f32x4 acc[4][4]; zero_acc(acc);
    LdPlain lw(p.w_out_t, (size_t)nt * 128, D), la(p.ycat, (size_t)mt * 128, D);
    gemm_tile(acc, lw, la, D / 64, smem);
    const int b = (mt * 128) / L; const float* g1 = p.mod + (size_t)b * NMODC + 2 * D;
#pragma unroll
    for (int mi = 0; mi < 4; ++mi)
#pragma unroll
        for (int ni = 0; ni < 4; ++ni) { const size_t tok = (size_t)mt * 128 + wc * 64 + ni * 16 + fr; const int col = nt * 128 + wr * 64 + mi * 16 + quad * 4;
            const f32x4 xv = *(const f32x4*)(p.x + tok * D + col), gv = *(const f32x4*)(g1 + col);
            *(f32x4*)(p.x1 + tok * D + col) = xv + gv * acc[mi][ni]; }
}
DEV void ph_outproj(const Params& p, char* smem) {
    constexpr int NMT = T / 128;
    const int G = gridDim.x, b = blockIdx.x;
    if ((G & 7) == 0 && NMT % 8 == 0) {
        constexpr int MX = NMT / 8, RB = MX < 8 ? MX : 8;
        const int x = b & 7, li = b >> 3, nl = G >> 3;
        for (int q = li; q < MX * 8; q += nl) { const int mg = q / (RB * 8), rem = q % (RB * 8); outproj_tile(p, smem, x * MX + mg * RB + rem % RB, rem / RB); }
    } else {
        for (int task = blockIdx.x; task < NMT * 8; task += gridDim.x) outproj_tile(p, smem, task / 8, task % 8);
    }
}

DEV void ph_norm2_router(const Params& p, char* smem) {
    {
        const int nrb = (T / 16 + 3) / 4;
        const int G = gridDim.x, b = blockIdx.x;
        if (G > nrb) { if (b >= nrb) for (int t = b - nrb; t < NT_W13 + NT_W2; t += G - nrb) expert_conv_task(p, smem, t); }
        else for (int t = b; t < NT_W13 + NT_W2; t += G) expert_conv_task(p, smem, t);
    }
    const int tid = threadIdx.x, lane = tid & 63, wid = tid >> 6, fr = lane & 15, quad = lane >> 4;
    float* lgs = (float*)smem + wid * (16 * 33);
    float* rs = (float*)smem + 4 * 16 * 33 + wid * 16;
    int* lcnt = (int*)(smem + 16384); int* lbase = lcnt + NEXP;
    if (tid < NEXP) lcnt[tid] = 0;
    __syncthreads();
    for (int wt = blockIdx.x * 4 + wid; wt < T / 16; wt += gridDim.x * 4) {
        const size_t row0 = (size_t)wt * 16; const int b = (int)(row0 / L);
        const float* xr = p.x1 + (row0 + fr) * D + quad * 4;
        const float* rp = p.RP + (size_t)b * D * 32;
        f32x4 a0 = {0.f, 0.f, 0.f, 0.f}, a1 = a0; float ss = 0.f;
        const float* rpl = rp + ((size_t)quad * 32 + fr) * 4;
        f32x4 xv[4], b0[4], b1[4];
#pragma unroll
        for (int u = 0; u < 4; ++u) { xv[u] = *(const f32x4*)(xr + u * 16); b0[u] = *(const f32x4*)(rpl + (size_t)u * 512); b1[u] = *(const f32x4*)(rpl + (size_t)u * 512 + 64); }
#pragma unroll 1
        for (int k0 = 0; k0 < D; k0 += 64) {
            f32x4 xn[4], c0[4], c1[4];
            const int kn = k0 + 64 < D ? k0 + 64 : k0;
#pragma unroll
            for (int u = 0; u < 4; ++u) { xn[u] = *(const f32x4*)(xr + kn + u * 16); c0[u] = *(const f32x4*)(rpl + (size_t)(kn / 4 + u * 4) * 128); c1[u] = *(const f32x4*)(rpl + (size_t)(kn / 4 + u * 4) * 128 + 64); }
#pragma unroll
            for (int u = 0; u < 4; ++u) {
                ss += xv[u][0] * xv[u][0] + xv[u][1] * xv[u][1] + xv[u][2] * xv[u][2] + xv[u][3] * xv[u][3];
#pragma unroll
                for (int i = 0; i < 4; ++i) { a0 = __builtin_amdgcn_mfma_f32_16x16x4f32(xv[u][i], b0[u][i], a0, 0, 0, 0); a1 = __builtin_amdgcn_mfma_f32_16x16x4f32(xv[u][i], b1[u][i], a1, 0, 0, 0); }
            }
#pragma unroll
            for (int u = 0; u < 4; ++u) { xv[u] = xn[u]; b0[u] = c0[u]; b1[u] = c1[u]; }
        }
        ss += __shfl_xor(ss, 16); ss += __shfl_xor(ss, 32);
        const float rstd = rsqrtf(ss * (1.f / D) + 1e-6f);
        if (quad == 0) rs[fr] = rstd;
#pragma unroll
        for (int r = 0; r < 4; ++r) { lgs[(quad * 4 + r) * 33 + fr] = a0[r]; lgs[(quad * 4 + r) * 33 + 16 + fr] = a1[r]; }
        __syncthreads();
        int e0 = 0, e1 = 0, l0 = 0, l1 = 0; float w0 = 0.f, w1 = 0.f;
        if (lane < 16) {
            const float rsd = rs[lane]; float lg[20];
#pragma unroll
            for (int j = 0; j < 20; ++j) lg[j] = lgs[lane * 33 + j] * rsd + p.cb[b * 32 + j];
            int g = 0; float gm = lg[0];
#pragma unroll
            for (int j = 1; j < 4; ++j) if (lg[j] > gm) { gm = lg[j]; g = j; }
            float den = 0.f;
#pragma unroll
            for (int j = 0; j < 4; ++j) den += expf(lg[j] - gm);
            const float psel = 1.f / den;
            float le[4];
#pragma unroll
            for (int j = 0; j < 4; ++j) le[j] = g == 0 ? lg[4 + j] : (g == 1 ? lg[8 + j] : (g == 2 ? lg[12 + j] : lg[16 + j]));
            int i0 = 0; float m0 = le[0];
#pragma unroll
            for (int j = 1; j < 4; ++j) if (le[j] > m0) { m0 = le[j]; i0 = j; }
            int i1 = -1; float m1 = -3.0e38f;
#pragma unroll
            for (int j = 0; j < 4; ++j) if (j != i0 && le[j] > m1) { m1 = le[j]; i1 = j; }
            const float ex = expf(m1 - m0); w0 = psel / (1.f + ex); w1 = psel * ex / (1.f + ex);
            e0 = g * 4 + i0; e1 = g * 4 + i1;
            l0 = atomicAdd(lcnt + e0, 1); l1 = atomicAdd(lcnt + e1, 1);
        }
        __syncthreads();
        if (tid < NEXP) { const int c = lcnt[tid]; lbase[tid] = c ? atomicAdd(p.cnt + tid * 32, c) : 0; lcnt[tid] = 0; }
        __syncthreads();
        if (lane < 16) { const size_t tok = row0 + lane; const int p0 = lbase[e0] + l0, p1 = lbase[e1] + l1;
            WT_STORE(p.elist + (size_t)e0 * T + p0, (int)tok * 2); WT_STORE(p.ewt + (size_t)e0 * T + p0, w0);
            WT_STORE(p.elist + (size_t)e1 * T + p1, (int)tok * 2 + 1); WT_STORE(p.ewt + (size_t)e1 * T + p1, w1);
        }
        const float* sh = p.mod + (size_t)b * NMODC + 3 * D; const float* sc = sh + D;
        f32x4 wm[4], sa[4];
#pragma unroll
        for (int i = 0; i < 4; ++i) { const int k = i * 256 + lane * 4; const f32x4 w = *(const f32x4*)(p.norm2_w + k), s1 = *(const f32x4*)(sc + k); sa[i] = *(const f32x4*)(sh + k); wm[i] = w * (1.f + s1); }
        f32x4 cur[4];
#pragma unroll
        for (int i = 0; i < 4; ++i) cur[i] = *(const f32x4*)(p.x1 + row0 * D + i * 256 + lane * 4);
#pragma unroll 1
        for (int r = 0; r < 16; ++r) { const float rsd = rs[r]; f32x4 nxt[4]; const int rn = r < 15 ? r + 1 : r;
#pragma unroll
            for (int i = 0; i < 4; ++i) nxt[i] = *(const f32x4*)(p.x1 + (row0 + rn) * D + i * 256 + lane * 4);
#pragma unroll
            for (int i = 0; i < 4; ++i) { const int k = i * 256 + lane * 4; const f32x4 v = cur[i] * rsd * wm[i] + sa[i];
                *(us4*)(p.h2 + (row0 + r) * D + k) = pack4(v[0], v[1], v[2], v[3]); }
#pragma unroll
            for (int i = 0; i < 4; ++i) cur[i] = nxt[i];
        }
        __syncthreads();
    }
}

DEV bool moe_find_tile(const Params& p, int mtile, int& e, int& lt, int& rowoff, int& cnt) {
    int acc = 0;
    for (int q = 0; q < NEXP; ++q) { const int c = p.cnt[q * 32]; const int nt = (c + 127) >> 7; if (mtile < acc + nt) { e = q; lt = mtile - acc; rowoff = acc * 128; cnt = c; return true; } acc += nt; }
    return false;
}
DEV void ph_moe_up(const Params& p, char* smem) {
    const int tid = threadIdx.x, lane = tid & 63, wid = tid >> 6, wr = wid >> 1, wc = wid & 1, fr = lane & 15, quad = lane >> 4;
    const bool xcdmap = (gridDim.x & 7) == 0; const int xq = blockIdx.x & 7, qstep = xcdmap ? (int)(gridDim.x >> 3) : (int)gridDim.x;
    for (int q = xcdmap ? (int)(blockIdx.x >> 3) : (int)blockIdx.x; ; q += qstep) {
        const int mtile = xcdmap ? xq + 8 * (q >> 3) : (q >> 3), nt = q & 7;
        int e, lt, rowoff, cnt; if (!moe_find_tile(p, mtile, e, lt, rowoff, cnt)) break;
        LdGather la; const int lrow = tid >> 3, lc = stage_chunk();
#pragma unroll
        for (int i = 0; i < 4; ++i) { int li = lt * 128 + lrow + 32 * i; if (li >= cnt) li = cnt - 1; const int tok = p.elist[(size_t)e * T + li] >> 1; la.rp[i] = p.h2 + (size_t)tok * D + lc; }
        LdPlain lw(p.w13_t + (size_t)e * 1024 * 1024, (size_t)nt * 128, D);
        f32x4 acc[4][4]; zero_acc(acc);
        gemm_tile(acc, lw, la, D / 64, smem);
#pragma unroll
        for (int ni = 0; ni < 4; ++ni) { int li = lt * 128 + wc * 64 + ni * 16 + fr; const bool valid = li < cnt; if (!valid) li = cnt - 1; const float cw = p.ewt[(size_t)e * T + li];
#pragma unroll
            for (int mi = 0; mi < 2; ++mi) { float hv[4];
#pragma unroll
                for (int r = 0; r < 4; ++r) hv[r] = silu_f(acc[mi][ni][r]) * acc[mi + 2][ni][r] * cw;
                const int hidx = nt * 64 + wr * 32 + mi * 16 + quad * 4;
                if (valid) *(us4*)(p.hid + (size_t)(rowoff + lt * 128 + wc * 64 + ni * 16 + fr) * EH + hidx) = pack4(hv[0], hv[1], hv[2], hv[3]); } }
    }
}
DEV void ph_moe_down(const Params& p, char* smem) {
    const int tid = threadIdx.x, lane = tid & 63, wid = tid >> 6, wr = wid >> 1, wc = wid & 1, fr = lane & 15, quad = lane >> 4;
    const bool xcdmap = (gridDim.x & 7) == 0; const int xq = blockIdx.x & 7, qstep = xcdmap ? (int)(gridDim.x >> 3) : (int)gridDim.x;
    for (int q = xcdmap ? (int)(blockIdx.x >> 3) : (int)blockIdx.x; ; q += qstep) {
        const int mtile = xcdmap ? xq + 8 * (q >> 3) : (q >> 3), nt = q & 7;
        int e, lt, rowoff, cnt; if (!moe_find_tile(p, mtile, e, lt, rowoff, cnt)) break;
        LdGather la; const int lrow = tid >> 3, lc = stage_chunk();
#pragma unroll
        for (int i = 0; i < 4; ++i) { int li = lt * 128 + lrow + 32 * i; if (li >= cnt) li = cnt - 1; la.rp[i] = p.hid + (size_t)(rowoff + li) * EH + lc; }
        LdPlain lw(p.w2_t + (size_t)e * 1024 * EH, (size_t)nt * 128, EH);
        f32x4 acc[4][4]; zero_acc(acc);
        gemm_tile(acc, lw, la, EH / 64, smem);
#pragma unroll
        for (int ni = 0; ni < 4; ++ni) { const int li = lt * 128 + wc * 64 + ni * 16 + fr; if (li < cnt) { const int ts = p.elist[(size_t)e * T + li];
#pragma unroll
            for (int mi = 0; mi < 4; ++mi) *(us4*)(p.ymoe + (size_t)ts * D + nt * 128 + wr * 64 + mi * 16 + quad * 4) = pack4(acc[mi][ni][0], acc[mi][ni][1], acc[mi][ni][2], acc[mi][ni][3]); } }
    }
}
DEV void ph_final(const Params& p, char* smem) {
    const int lane = threadIdx.x & 63, wid = threadIdx.x >> 6;
    for (int row = blockIdx.x * 4 + wid; row < T; row += gridDim.x * 4) { const int b = row / L; const float* g2 = p.mod + (size_t)b * NMODC + 5 * D;
        f32x4 v[4]; float ss = 0.f;
#pragma unroll
        for (int i = 0; i < 4; ++i) { const int k = i * 256 + lane * 4; const f32x4 xv = *(const f32x4*)(p.x1 + (size_t)row * D + k), gv = *(const f32x4*)(g2 + k);
            const us4 y0 = *(const us4*)(p.ymoe + ((size_t)row * 2) * D + k), y1 = *(const us4*)(p.ymoe + ((size_t)row * 2 + 1) * D + k);
#pragma unroll
            for (int e = 0; e < 4; ++e) { v[i][e] = xv[e] + gv[e] * (bf2f(y0[e]) + bf2f(y1[e])); ss += v[i][e] * v[i][e]; } }
        ss = wave_sum(ss); const float rstd = rsqrtf(ss * (1.f / D) + 1e-6f);
#pragma unroll
        for (int i = 0; i < 4; ++i) { const int k = i * 256 + lane * 4; const f32x4 w = *(const f32x4*)(p.final_w + k); *(f32x4*)(p.out + (size_t)row * D + k) = v[i] * rstd * w; }
    }
}


#define XB_TMO      128
#define XB_XCNT(j)  (256  + 64 * (j))
#define XB_XSUB(j)  (1280 + 64 * (j))
#define XB_XGEN(j)  (2304 + 64 * (j))
#define XB_TOP      3328
#define XB_TOPGEN   3392
#define XCD_BAR_WORDS 3456
#ifndef CPU_EMU
#define XB_SPIN_CAP (1u << 22)
#define LAS __attribute__((address_space(3)))
__device__ __forceinline__ unsigned xb_ld(unsigned* p)              { return __hip_atomic_load(p, __ATOMIC_RELAXED, __HIP_MEMORY_SCOPE_AGENT); }
__device__ __forceinline__ unsigned xb_add(unsigned* p, unsigned v) { return __hip_atomic_fetch_add(p, v, __ATOMIC_RELAXED, __HIP_MEMORY_SCOPE_AGENT); }
__device__ __forceinline__ unsigned xb_xcc_id() { return (unsigned)__builtin_amdgcn_s_getreg((3 << 11) | 20) & 0xFu; }
#define XB_SPIN(cond, bar) do { unsigned _sp = 0; while (cond) { __builtin_amdgcn_s_sleep(1); \
    if ((++_sp & 255u) == 0u) { if (xb_ld(&(bar)[XB_TMO])) break; if (_sp > XB_SPIN_CAP) { atomicAdd(&(bar)[XB_TMO], 1u); break; } } } } while (0)
struct XcdBarrier { unsigned* bar; unsigned x; volatile LAS unsigned* st; };
__device__ __forceinline__ XcdBarrier xcd_barrier_post(unsigned* bar, volatile LAS unsigned* st) {
    XcdBarrier b; b.bar = bar; b.x = xb_xcc_id(); b.st = st;
    if (threadIdx.x == 0) (void)xb_add(&bar[XB_XCNT(b.x)], 1u);
    return b;
}
__device__ __forceinline__ void xcd_barrier_complete(unsigned* bar, unsigned x, unsigned& nloc, unsigned& nx) {
    const unsigned G = gridDim.x * gridDim.y * gridDim.z;
    unsigned sum, cnt, mine, sp = 0u;
    for (;;) {
        sum = 0u; cnt = 0u; mine = 0u;
#pragma unroll
        for (unsigned j = 0; j < 16; ++j) { const unsigned c = xb_ld(&bar[XB_XCNT(j)]); sum += c; cnt += (c > 0u) ? 1u : 0u; mine = (j == x) ? c : mine; }
        if (sum == G) break;
        __builtin_amdgcn_s_sleep(1);
        if ((++sp & 255u) == 0u) { if (xb_ld(&bar[XB_TMO])) break; if (sp > XB_SPIN_CAP) { atomicAdd(&bar[XB_TMO], 1u); break; } }
    }
    nloc = mine > 0u ? mine : 1u; nx = cnt > 0u ? cnt : 1u;
}
__device__ __forceinline__ void xcd_barrier(const XcdBarrier& b) {
    asm volatile("s_waitcnt vmcnt(0)" ::: "memory");
    __syncthreads();
    if (threadIdx.x == 0) {
        unsigned* bar = b.bar;
        __builtin_amdgcn_s_waitcnt(0);
        unsigned nloc = b.st[0], nx = b.st[1];
        if (nloc == 0u) { xcd_barrier_complete(bar, b.x, nloc, nx); b.st[0] = nloc; b.st[1] = nx; }
        const unsigned old = xb_add(&bar[XB_XSUB(b.x)], 1u);
        const unsigned gen = old / nloc;
        if (old + 1u == (gen + 1u) * nloc) {
            __builtin_amdgcn_fence(__ATOMIC_RELEASE, "agent");
            asm volatile("s_waitcnt vmcnt(0)" ::: "memory");
            const unsigned og = xb_add(&bar[XB_TOP], 1u);
            const unsigned tg = og / nx;
            if (og + 1u == (tg + 1u) * nx) xb_add(&bar[XB_TOPGEN], 1u);
            else XB_SPIN(xb_ld(&bar[XB_TOPGEN]) == tg, bar);
            __builtin_amdgcn_fence(__ATOMIC_ACQUIRE, "agent");
            xb_add(&bar[XB_XGEN(b.x)], 1u);
            asm volatile("s_waitcnt vmcnt(0)" ::: "memory");
        } else {
            XB_SPIN(xb_ld(&bar[XB_XGEN(b.x)]) == gen, bar);
            __builtin_amdgcn_fence(__ATOMIC_ACQUIRE, "agent");
            asm volatile("s_waitcnt vmcnt(0)" ::: "memory");
        }
    }
    __syncthreads();
}
#endif

#define PHASE_LIST(X) X(ph_prep) X(ph_norm1) X(ph_inproj) X(ph_conv_rscan) X(ph_rout_hynorm) X(ph_outproj) X(ph_norm2_router) X(ph_moe_up) X(ph_moe_down)

struct WsBuf { size_t size, off; int p0, p1; };
static size_t fill_params(Params& p, void* const* d_in, void* d_out, void* d_ws, int grid) {
    const float** in = (const float**)d_in;
    p.x = in[0]; p.c = in[1]; p.ctx = in[2]; p.c_ctx = in[3]; p.ada_w = in[4]; p.ada_b = in[5]; p.norm1_w = in[6]; p.w_in = in[7]; p.hy_conv_w = in[8]; p.hy_conv_b = in[9];
    p.f_w1 = in[10]; p.f_b1 = in[11]; p.f_w2 = in[12]; p.f_b2 = in[13]; p.f_w3 = in[14]; p.f_b3 = in[15]; p.f_wout = in[16]; p.f_freq = in[17]; p.hy_skip = in[18]; p.hy_out_norm = in[19];
    p.ret_gn_w = in[20]; p.w_out = in[21]; p.norm2_w = in[22]; p.rg_w = in[23]; p.rg_b = in[24]; p.re_w = in[25]; p.re_b = in[26]; p.exp_w1 = in[27]; p.exp_w3 = in[28]; p.exp_w2 = in[29]; p.final_w = in[30];
    p.out = (float*)d_out;
    char* ws = (char*)d_ws; WsBuf bufs[48]; void** slots[48]; int nb = 0; size_t total = 0;
#define WS(field, type, count, p0, p1) { slots[nb] = (void**)&p.field; bufs[nb] = WsBuf{((sizeof(type) * (size_t)(count)) + 255) & ~(size_t)255, 0, p0, p1}; ++nb; }
    WS(mod, float, (NB + 1) * NMODC, 0, 9); WS(cnt, int, NEXP * 32, 0, 9); WS(bar, unsigned, XCD_BAR_WORDS, 0, 9); WS(rope, float, 64 * 16 * 2, 0, 2); WS(h3buf, float, (size_t)L * 64, 0, 1); WS(w_in_t, bf16_t, PC * D, 0, 2); WS(w_out_t, bf16_t, D * D, 4, 5);
    WS(gtap, bf16_t, (size_t)HW * 2 * L, 1, 3);
    WS(hbuf, bf16_t, (size_t)TA * D, 1, 2); WS(RP, float, (size_t)NB * D * 32, 1, 6); WS(cb, float, NB * 32, 1, 6);
    WS(pT, bf16_t, (size_t)1536 * T, 2, 4); WS(qn, bf16_t, (size_t)T * 512, 2, 4); WS(kn, bf16_t, (size_t)T * 512, 2, 3); WS(kTf, bf16_t, (size_t)T * 512, 2, 3); WS(kTb, bf16_t, (size_t)T * 512, 2, 3); WS(vT, bf16_t, (size_t)T * 512, 2, 3);
    WS(ckTf, bf16_t, (size_t)TC * 512, 2, 3); WS(ckTb, bf16_t, (size_t)TC * 512, 2, 3); WS(cvT, bf16_t, (size_t)TC * 512, 2, 3); WS(gbuf, bf16_t, (size_t)T * 512, 2, 4);
    WS(yhyT, bf16_t, (size_t)HW * T, 3, 4); WS(Sst, bf16_t, (size_t)2 * NB * NH * NCH * 16384, 3, 4); WS(ycat, bf16_t, (size_t)T * D, 4, 5);
    WS(Pscr, bf16_t, (size_t)grid * 16384, 3, 3); WS(Opart, bf16_t, (size_t)NB * NH * NCH * 16384, 3, 4);
    WS(x1, float, (size_t)T * D, 5, 9); WS(w13_t, bf16_t, (size_t)NEXP * 1024 * 1024, 6, 7); WS(w2_t, bf16_t, (size_t)NEXP * 1024 * EH, 6, 8);
    WS(h2, bf16_t, (size_t)T * D, 6, 7); WS(elist, int, (size_t)NEXP * T, 6, 9); WS(ewt, float, (size_t)NEXP * T, 6, 9);
    WS(hid, bf16_t, (size_t)(2 * T + NEXP * 128) * EH, 7, 8); WS(ymoe, bf16_t, (size_t)2 * T * D, 8, 9);
#undef WS
    int order[48]; for (int i = 0; i < nb; ++i) order[i] = i;
    for (int i = 1; i < nb; ++i) { const int v = order[i]; int j = i - 1; while (j >= 0 && bufs[order[j]].size < bufs[v].size) { order[j + 1] = order[j]; --j; } order[j + 1] = v; }
    bool placed[48]; for (int i = 0; i < nb; ++i) placed[i] = false;
    for (int oi = 0; oi < nb; ++oi) { WsBuf& nbuf = bufs[order[oi]]; size_t off = 0;
        for (bool moved = true; moved;) { moved = false;
            for (int i = 0; i < nb; ++i) { if (!placed[i]) continue; const WsBuf& b = bufs[i];
                if (b.p1 < nbuf.p0 || b.p0 > nbuf.p1) continue;
                if (off < b.off + b.size && b.off < off + nbuf.size) { off = b.off + b.size; moved = true; } } }
        nbuf.off = off; placed[order[oi]] = true; *slots[order[oi]] = (void*)(ws + off); if (off + nbuf.size > total) total = off + nbuf.size; }
    return total;
}

#ifndef CPU_EMU
__global__ void __launch_bounds__(NTHR, 2) mega_kernel(Params p) {
    extern __shared__ __attribute__((aligned(16))) char smem[];
    volatile LAS unsigned* st = (volatile LAS unsigned*)(smem + SMEM_BYTES - 16);
    if (threadIdx.x == 0) { st[0] = 0u; st[1] = 0u; *(unsigned long long*)(smem + SMEM_BYTES - 32) = 0ull; }
    __syncthreads();
    const XcdBarrier xb = xcd_barrier_post(p.bar, st);
    if (p.out == nullptr) cg::this_grid().sync();
#define X(f) f(p, smem); xcd_barrier(xb);
    PHASE_LIST(X)
#undef X
    ph_final(p, smem);
#ifdef KPROBE_ID
    if (blockIdx.x == KPROBE_BLOCK && threadIdx.x == 0) { const unsigned long long tn = __builtin_amdgcn_s_memrealtime(), wait = (unsigned long long)KPROBE_AMP * *(unsigned long long*)(smem + SMEM_BYTES - 32); while (__builtin_amdgcn_s_memrealtime() - tn < wait) __builtin_amdgcn_s_sleep(8); }
#endif
}

extern "C" void kernel_launch(void* const* d_in, const int* in_sizes, int n_in, void* d_out, int out_size, void* d_ws, size_t ws_size, hipStream_t stream) {
    static int grid_blocks = 0;
    if (!grid_blocks) {
        int dev = 0, cus = 0, per_cu = 0;
        (void)hipGetDevice(&dev);
        (void)hipDeviceGetAttribute(&cus, hipDeviceAttributeMultiprocessorCount, dev);
        (void)hipFuncSetAttribute((const void*)mega_kernel, hipFuncAttributeMaxDynamicSharedMemorySize, SMEM_BYTES);
        (void)hipOccupancyMaxActiveBlocksPerMultiprocessor(&per_cu, mega_kernel, NTHR, SMEM_BYTES);
        if (per_cu > 2) per_cu = 2;
        if (per_cu < 1) per_cu = 1;
        grid_blocks = cus * per_cu;
    }
    Params p; memset(&p, 0, sizeof(p));
    const size_t need = fill_params(p, d_in, d_out, d_ws, grid_blocks);
    if (need > ws_size) { fprintf(stderr, "workspace too small: need %zu have %zu\n", need, ws_size); return; }
    (void)hipMemsetAsync(p.bar, 0, XCD_BAR_WORDS * sizeof(unsigned), stream);
    void* args[] = {&p};
    hipError_t e = hipLaunchCooperativeKernel((void*)mega_kernel, dim3(grid_blocks), dim3(NTHR), args, SMEM_BYTES, stream);
    if (e != hipSuccess) fprintf(stderr, "cooperative launch failed: %s (grid %d)\n", hipGetErrorString(e), grid_blocks);
}
#endif
```

```cpp
#ifdef CPU_EMU
#include "emu.h"
#else
#include <hip/hip_runtime.h>
#include <hip/hip_cooperative_groups.h>
#include <cstdio>
namespace cg = cooperative_groups;
#endif
#include <stdint.h>
#include <string.h>
#include <math.h>

#ifndef CFG_BATCH
#define CFG_BATCH 8
#endif
#ifndef CFG_SEQ
#define CFG_SEQ 2048
#endif
#ifndef CFG_CTX
#define CFG_CTX 256
#endif

#ifdef CPU_EMU
#define OPAQUE(x)
#define SCHED_FENCE()
#define LDS_AS
#define WT_STORE(ptr, v) (*(ptr) = (v))
#define SETPRIO(n)
#define WAVE_SYNC() emu_wave_sync()
#define NT_LD(T, ptr) (*(const T*)(ptr))
#else
#define NT_LD(T, ptr) __builtin_nontemporal_load((const T*)(ptr))
#define WAVE_SYNC() __builtin_amdgcn_wave_barrier()
#define SETPRIO(n) __builtin_amdgcn_s_setprio(n)
#define WT_STORE(ptr, v) __hip_atomic_store((ptr), (v), __ATOMIC_RELAXED, __HIP_MEMORY_SCOPE_AGENT)
#define LDS_AS __attribute__((address_space(3)))
#define OPAQUE(x) asm volatile("" : "+v"(x))
#define SCHED_FENCE() __builtin_amdgcn_sched_barrier(0)
#endif
#if defined(KPROBE_ID) && !defined(CPU_EMU)
#define KP_BEGIN(id) const unsigned long long kp_t0_##id = __builtin_amdgcn_s_memrealtime()
#define KP_END(id) do { if ((id) == KPROBE_ID && blockIdx.x == KPROBE_BLOCK && threadIdx.x == 0) *(unsigned long long*)(smem + SMEM_BYTES - 32) += __builtin_amdgcn_s_memrealtime() - kp_t0_##id; } while (0)
#else
#define KP_BEGIN(id)
#define KP_END(id)
#endif
#define DEV __device__ __forceinline__

typedef unsigned short bf16_t;
typedef short bf16x8 __attribute__((ext_vector_type(8)));
typedef float f32x4 __attribute__((ext_vector_type(4)));
typedef unsigned short us4 __attribute__((ext_vector_type(4)));

constexpr int NB = CFG_BATCH, L = CFG_SEQ, LC = CFG_CTX;
constexpr int D = 1024, T = NB * L, TC = NB * LC, TA = T + TC;
constexpr int HW = 512, NH = 4, DH = 128, CH = 128, PC = 3584, NMODC = 6 * D;
constexpr int NCH = L / CH, NCC = LC / CH, NCT = NCH + NCC;
constexpr int NEXP = 16, EH = 512;
constexpr int UP = L + 64;
constexpr int NTHR = 256;
constexpr int SMEM_BYTES = 77824;
constexpr int MAXTILES = T * 2 / 128 + NEXP;

struct Params {
    const float *x, *c, *ctx, *c_ctx, *ada_w, *ada_b, *norm1_w, *w_in, *hy_conv_w, *hy_conv_b, *f_w1, *f_b1, *f_w2, *f_b2, *f_w3, *f_b3,
        *f_wout, *f_freq, *hy_skip, *hy_out_norm, *ret_gn_w, *w_out, *norm2_w, *rg_w, *rg_b, *re_w, *re_b, *exp_w1, *exp_w3, *exp_w2, *final_w;
    float* out;
    float* mod;
    bf16_t* w_in_t;
    bf16_t* w_out_t;
    bf16_t* w13_t;
    bf16_t* w2_t;
    bf16_t* gtap;
    float* rope;
    float* h3buf;
    bf16_t* hbuf;
    float* RP;
    float* cb;
    bf16_t* pT;
    bf16_t* qn;
    bf16_t* kn;
    bf16_t* kTf;
    bf16_t* kTb;
    bf16_t* vT;
    bf16_t* ckTf;
    bf16_t* ckTb;
    bf16_t* cvT;
    bf16_t* gbuf;
    bf16_t* Sst;
    bf16_t* yhyT;
    bf16_t* ycat;
    bf16_t* Pscr;
    bf16_t* Opart;
    float* x1;
    bf16_t* h2;
    unsigned* bar;
    int* cnt;
    int* elist;
    float* ewt;
    bf16_t* hid;
    bf16_t* ymoe;
};

DEV uint32_t f_as_u(float f) { return __builtin_bit_cast(uint32_t, f); }
DEV float u_as_f(uint32_t u) { return __builtin_bit_cast(float, u); }
DEV float bf2f(bf16_t v) { return u_as_f(((uint32_t)v) << 16); }
#ifdef CPU_EMU
DEV bf16_t f2bf(float f) { uint32_t u = f_as_u(f); u += 0x7fffu + ((u >> 16) & 1u); return (bf16_t)(u >> 16); }
DEV us4 pack4(float a, float b, float c, float d) { us4 r; r[0] = f2bf(a); r[1] = f2bf(b); r[2] = f2bf(c); r[3] = f2bf(d); return r; }
#else
typedef __bf16 hwbf16x2 __attribute__((ext_vector_type(2)));
typedef __bf16 hwbf16x4 __attribute__((ext_vector_type(4)));
typedef float f32x2v __attribute__((ext_vector_type(2)));
DEV bf16_t f2bf(float f) { return __builtin_bit_cast(bf16_t, (__bf16)f); }
DEV us4 pack4(float a, float b, float c, float d) { const f32x4 v = {a, b, c, d}; return __builtin_bit_cast(us4, __builtin_convertvector(v, hwbf16x4)); }
#endif
DEV float silu_f(float v) { return v / (1.f + expf(-v)); }
DEV float wave_sum(float v) { v += __shfl_xor(v, 1); v += __shfl_xor(v, 2); v += __shfl_xor(v, 4); v += __shfl_xor(v, 8); v += __shfl_xor(v, 16); v += __shfl_xor(v, 32); return v; }
DEV float lg2_gamma(int h, bool bwd) { return log2f(1.f - exp2f(-((bwd ? 5.5f : 5.0f) + (float)h))); }

DEV int stage_chunk() { return ((threadIdx.x & 7) ^ ((threadIdx.x >> 4) & 7)) * 8; }
struct LdPlain {
    static constexpr bool kDirect = true;
    const bf16_t* rp[4];
    DEV LdPlain(const bf16_t* base, size_t row0, size_t ld) { const int lrow = threadIdx.x >> 3, lc = stage_chunk();
#pragma unroll
        for (int i = 0; i < 4; ++i) rp[i] = base + (row0 + lrow + 32 * i) * ld + lc; }
    DEV const bf16_t* src(int i, int kt) const { return rp[i] + kt * 64; }
    DEV bf16x8 ld(int i, int kt) const { return *(const bf16x8*)(rp[i] + kt * 64); }
};
struct LdGather {
    static constexpr bool kDirect = true;
    const bf16_t* rp[4];
    DEV const bf16_t* src(int i, int kt) const { return rp[i] + kt * 64; }
    DEV bf16x8 ld(int i, int kt) const { return *(const bf16x8*)(rp[i] + kt * 64); }
};
struct LdKScale {
    static constexpr bool kDirect = false;
    const bf16_t* rp[4]; float a, b; int lc;
    DEV LdKScale(const bf16_t* base, size_t row0, size_t ld, float a_, float b_) : a(a_), b(b_) { const int lrow = threadIdx.x >> 3; lc = stage_chunk();
#pragma unroll
        for (int i = 0; i < 4; ++i) rp[i] = base + (row0 + lrow + 32 * i) * ld + lc; }
    DEV const bf16_t* src(int i, int kt) const { return rp[i] + kt * 64; }
    DEV bf16x8 ld(int i, int kt) const { bf16x8 v = *(const bf16x8*)(rp[i] + kt * 64); const int k0 = kt * 64 + lc; bf16x8 o;
#pragma unroll
        for (int e = 0; e < 8; ++e) o[e] = (short)f2bf(bf2f((bf16_t)v[e]) * exp2f(a + b * (float)(k0 + e)));
        return o; }
};
struct LdRowScale {
    static constexpr bool kDirect = false;
    const bf16_t* rp[4]; float sc[4];
    DEV LdRowScale(const bf16_t* base, size_t row0, size_t ld, float a, float b) { const int lrow = threadIdx.x >> 3, lc = stage_chunk();
#pragma unroll
        for (int i = 0; i < 4; ++i) { rp[i] = base + (row0 + lrow + 32 * i) * ld + lc; sc[i] = exp2f(a + b * (float)(lrow + 32 * i)); } }
    DEV const bf16_t* src(int i, int kt) const { return rp[i] + kt * 64; }
    DEV bf16x8 ld(int i, int kt) const { bf16x8 v = *(const bf16x8*)(rp[i] + kt * 64); bf16x8 o;
#pragma unroll
        for (int e = 0; e < 8; ++e) o[e] = (short)f2bf(bf2f((bf16_t)v[e]) * sc[i]);
        return o; }
};
#ifdef CPU_EMU
DEV void glds16(const bf16_t* g, char* l) { memcpy(l, g, 16); }
DEV void wait_vm0() {}
#else
DEV void glds16(const bf16_t* g, char* l) { __builtin_amdgcn_global_load_lds((const __attribute__((address_space(1))) void*)g, (__attribute__((address_space(3))) void*)l, 16, 0, 0); }
DEV void wait_vm0() { asm volatile("s_waitcnt vmcnt(0)" ::: "memory"); }
#endif

struct NoHook { DEV void operator()(int, f32x4 (&)[4][4]) const {} };
template <class LX, class LY, class HK>
DEV void gemm_tile_h(f32x4 (&acc)[4][4], const LX& lx, const LY& ly, int nk, char* smem, const HK& hook) {
    int tid = threadIdx.x; OPAQUE(tid);
    const int lane = tid & 63, wid = tid >> 6, wr = wid >> 1, wc = wid & 1;
    const int fr = lane & 15, quad = lane >> 4;
    bf16x8 rx[4], ry[4];
    char* const sx = smem + tid * 16; char* const sy = smem + 32768 + tid * 16;
#pragma unroll
    for (int i = 0; i < 4; ++i) {
        if (LX::kDirect) glds16(lx.src(i, 0), sx + i * 4096); else rx[i] = lx.ld(i, 0);
        if (LY::kDirect) glds16(ly.src(i, 0), sy + i * 4096); else ry[i] = ly.ld(i, 0); }
#pragma unroll
    for (int i = 0; i < 4; ++i) { if (!LX::kDirect) *(bf16x8*)(sx + i * 4096) = rx[i]; if (!LY::kDirect) *(bf16x8*)(sy + i * 4096) = ry[i]; }
    wait_vm0();
    __syncthreads();
    const int sw = fr >> 1;
    for (int kt = 0; kt < nk; ++kt) {
        const char* bx = smem + (kt & 1) * 16384; const char* by = smem + 32768 + (kt & 1) * 16384;
        const int nb = ((kt + 1) & 1) * 16384;
        if (kt + 1 < nk) {
#pragma unroll
            for (int i = 0; i < 4; ++i) {
                if (LX::kDirect) glds16(lx.src(i, kt + 1), sx + nb + i * 4096); else rx[i] = lx.ld(i, kt + 1);
                if (LY::kDirect) glds16(ly.src(i, kt + 1), sy + nb + i * 4096); else ry[i] = ly.ld(i, kt + 1); }
        }
        hook(kt, acc);
        SCHED_FENCE();
        {
            bf16x8 xf[2][4], yf[2][4];
#pragma unroll
            for (int kk = 0; kk < 2; ++kk) { const int ch = ((kk * 4 + quad) ^ sw) << 4;
#pragma unroll
                for (int mi = 0; mi < 4; ++mi) xf[kk][mi] = *(const bf16x8*)(bx + (wr * 64 + mi * 16 + fr) * 128 + ch);
#pragma unroll
                for (int ni = 0; ni < 4; ++ni) yf[kk][ni] = *(const bf16x8*)(by + (wc * 64 + ni * 16 + fr) * 128 + ch); }
            SETPRIO(1);
#pragma unroll
            for (int kk = 0; kk < 2; ++kk)
#pragma unroll
                for (int mi = 0; mi < 4; ++mi)
#pragma unroll
                    for (int ni = 0; ni < 4; ++ni) acc[mi][ni] = __builtin_amdgcn_mfma_f32_16x16x32_bf16(xf[kk][mi], yf[kk][ni], acc[mi][ni], 0, 0, 0);
            SETPRIO(0);
        }
        SCHED_FENCE();
        if (kt + 1 < nk) {
#pragma unroll
            for (int i = 0; i < 4; ++i) { if (!LX::kDirect) *(bf16x8*)(sx + nb + i * 4096) = rx[i]; if (!LY::kDirect) *(bf16x8*)(sy + nb + i * 4096) = ry[i]; }
        }
        wait_vm0();
        __syncthreads();
    }
}
template <class LX, class LY>
DEV void gemm_tile(f32x4 (&acc)[4][4], const LX& lx, const LY& ly, int nk, char* smem) { gemm_tile_h(acc, lx, ly, nk, smem, NoHook()); }

DEV int pipe_chunk() { return (int)(((threadIdx.x & 3) ^ ((0u - (threadIdx.x >> 4)) & 3u)) * 8); }
#ifdef CPU_EMU
#define PIPE_WAIT(n)
#define PIPE_BARRIER() __syncthreads()
#else
#define PIPE_WAIT(n) asm volatile("s_waitcnt vmcnt(" #n ")" ::: "memory")
#define PIPE_BARRIER() do { __builtin_amdgcn_sched_barrier(0); __builtin_amdgcn_s_barrier(); __builtin_amdgcn_sched_barrier(0); } while (0)
#endif
template <class LX, class LY, class HK>
DEV void gemm_pipe(f32x4 (&acc)[4][4], const LX& lx, const LY& ly, int nk, char* smem, const HK& hook) {
    int tid = threadIdx.x; OPAQUE(tid);
    const int lane = tid & 63, wid = tid >> 6, wr = wid >> 1, wc = wid & 1, fr = lane & 15, quad = lane >> 4;
    char* const sx = smem + tid * 16;
#pragma unroll
    for (int t = 0; t < 3; ++t) {
#pragma unroll
        for (int i = 0; i < 2; ++i) { glds16(lx.src(i, t), sx + t * 16384 + i * 4096); glds16(ly.src(i, t), sx + t * 16384 + 8192 + i * 4096); } }
    PIPE_WAIT(8);
    PIPE_BARRIER();
    const int rd = ((quad ^ ((0 - (fr >> 2)) & 3)) << 4) + fr * 64;
    for (int kt = 0; kt < nk; ++kt) {
        if (kt + 3 < nk) { const int sl = ((kt + 3) & 3) * 16384;
#pragma unroll
            for (int i = 0; i < 2; ++i) { glds16(lx.src(i, kt + 3), sx + sl + i * 4096); glds16(ly.src(i, kt + 3), sx + sl + 8192 + i * 4096); } }
        hook(kt, acc);
        SCHED_FENCE();
        const char* bx = smem + (kt & 3) * 16384; const char* by = bx + 8192;
        bf16x8 xf[4], yf[4];
#pragma unroll
        for (int mi = 0; mi < 4; ++mi) xf[mi] = *(const bf16x8*)(bx + (wr * 64 + mi * 16) * 64 + rd);
#pragma unroll
        for (int ni = 0; ni < 4; ++ni) yf[ni] = *(const bf16x8*)(by + (wc * 64 + ni * 16) * 64 + rd);
#pragma unroll
        for (int mi = 0; mi < 4; ++mi)
#pragma unroll
            for (int ni = 0; ni < 4; ++ni) acc[mi][ni] = __builtin_amdgcn_mfma_f32_16x16x32_bf16(xf[mi], yf[ni], acc[mi][ni], 0, 0, 0);
        SCHED_FENCE();
        if (kt + 3 < nk) PIPE_WAIT(8); else if (kt + 2 < nk) PIPE_WAIT(4); else PIPE_WAIT(0);
        PIPE_BARRIER();
    }
}
DEV void zero_acc(f32x4 (&acc)[4][4]) {
#pragma unroll
    for (int i = 0; i < 4; ++i)
#pragma unroll
        for (int j = 0; j < 4; ++j) acc[i][j] = (f32x4){0.f, 0.f, 0.f, 0.f};
}

struct Topo { int x, rk, nl; bool local; };
DEV Topo topo_get(char* smem) {
#ifdef CPU_EMU
    (void)smem; Topo t; t.x = blockIdx.x & 7; t.rk = blockIdx.x >> 3; t.nl = gridDim.x >> 3; t.local = NB == 8 && (T / 128) % 8 == 0 && (TC / 128) % 8 == 0 && (gridDim.x & 7) == 0 && gridDim.x >= 8; return t;
#else
    const volatile LDS_AS unsigned* st = (const volatile LDS_AS unsigned*)(smem + SMEM_BYTES - 64);
    Topo t; t.x = blockIdx.x & 7; t.rk = blockIdx.x >> 3; t.nl = gridDim.x >> 3;
    t.local = NB == 8 && (T / 128) % 8 == 0 && (TC / 128) % 8 == 0 && st[1] == 8u && st[4] == 0xFFu && st[5] == 0u && (gridDim.x & 7) == 0 && st[0] == (gridDim.x >> 3); return t;
#endif
}
constexpr int XB_FLAG_BASE = 5504, NFLAG_RT = T / 128, NFLAG_MT = 2 * T / 128 + NEXP;
DEV unsigned* flag_rt(const Params& p, int mt) { return p.bar + XB_FLAG_BASE + mt * 32; }
DEV unsigned* flag_mt(const Params& p, int m) { return p.bar + XB_FLAG_BASE + (NFLAG_RT + m) * 32; }
DEV unsigned* flag_n1(const Params& p, int x, int half) { return p.bar + XB_FLAG_BASE + (NFLAG_RT + NFLAG_MT + x * 2 + half) * 32; }
DEV bool df1_mode(const Topo& tp) { return tp.local && tp.nl == 64 && (T / 128 / 8) % 2 == 0 && (TC / 128 / 8) == 2; }
DEV void flag_post(unsigned* w) {
#ifndef CPU_EMU
    asm volatile("s_waitcnt vmcnt(0)" ::: "memory");
    __syncthreads();
    if (threadIdx.x == 0) (void)__hip_atomic_fetch_add(w, 1u, __ATOMIC_RELAXED, __HIP_MEMORY_SCOPE_AGENT);
#else
    (void)w; __syncthreads();
#endif
}
DEV void flag_wait(unsigned* w, unsigned need) {
#ifndef CPU_EMU
    if (threadIdx.x == 0) { unsigned sp = 0u; while (__hip_atomic_load(w, __ATOMIC_RELAXED, __HIP_MEMORY_SCOPE_AGENT) < need) { __builtin_amdgcn_s_sleep(1); if (++sp > (1u << 22)) break; } }
    __syncthreads();
#else
    (void)w; (void)need;
#endif
}
DEV void flag_acquire() {
#ifndef CPU_EMU
    if (threadIdx.x == 0) { __builtin_amdgcn_fence(__ATOMIC_ACQUIRE, "agent"); asm volatile("s_waitcnt vmcnt(0)" ::: "memory"); }
    __syncthreads();
#endif
}
DEV void task_ada(const Params& p, char* smem, int task) {
    float* sl = (float*)smem;
    float* red = sl + (NB + 1) * D;
    const int tid = threadIdx.x;
    for (int i = tid; i < (NB + 1) * D; i += NTHR) { const int r = i / D, k = i % D; const float v = r < NB ? p.c[r * D + k] : p.c_ctx[k]; sl[i] = silu_f(v); }
    __syncthreads();
    const int col = tid & 31, kq = tid >> 5, j = task * 32 + col;
    float acc[NB + 1];
#pragma unroll
    for (int r = 0; r <= NB; ++r) acc[r] = 0.f;
#pragma unroll 1
    for (int k = kq; k < D; k += 256) { float wv[32];
#pragma unroll
        for (int u = 0; u < 32; ++u) wv[u] = NT_LD(float, p.ada_w + (size_t)(k + 8 * u) * NMODC + j);
        SCHED_FENCE();
#pragma unroll
        for (int u = 0; u < 32; ++u) {
#pragma unroll
            for (int r = 0; r <= NB; ++r) acc[r] += sl[r * D + k + 8 * u] * wv[u];
            if ((u & 3) == 3) SCHED_FENCE(); } }
#pragma unroll
    for (int r = 0; r <= NB; ++r) red[(kq * (NB + 1) + r) * 32 + col] = acc[r];
    __syncthreads();
    for (int i = tid; i < (NB + 1) * 32; i += NTHR) { const int r = i / 32, cc = i % 32; float s = p.ada_b[task * 32 + cc];
        for (int q = 0; q < 8; ++q) s += red[(q * (NB + 1) + r) * 32 + cc];
        p.mod[r * NMODC + task * 32 + cc] = s; }
    __syncthreads();
}

template <int NW>
DEV void transpose_tile(const float* src, int ldn, int k0, int n0, bf16_t* dst, size_t ldk, int mapmode, int which, const float* sc, int scsplit, const float* sc2, char* smem) {
    float* t = (float*)smem;
    const int tid = threadIdx.x;
    { const int r = tid >> 4, c4 = tid & 15;
      f32x4 v[NW][4];
#pragma unroll
      for (int w = 0; w < NW; ++w)
#pragma unroll
          for (int i = 0; i < 4; ++i) v[w][i] = NT_LD(f32x4, src + (size_t)(k0 + r + 16 * i) * ldn + n0 + w * 64 + c4 * 4);
#pragma unroll
      for (int i = 0; i < 4; ++i) { const int k = r + 16 * i;
          float s = 1.f; if (sc) { const int kk = k0 + k; s = kk < scsplit ? sc[kk] : sc2[kk - scsplit]; }
#pragma unroll
          for (int w = 0; w < NW; ++w) { float* tw = t + w * (64 * 65) + k * 65 + c4 * 4; tw[0] = v[w][i][0] * s; tw[1] = v[w][i][1] * s; tw[2] = v[w][i][2] * s; tw[3] = v[w][i][3] * s; } } }
    __syncthreads();
    { const int nl = tid >> 3, kc = tid & 7;
#pragma unroll
      for (int w = 0; w < NW; ++w)
#pragma unroll
          for (int h = 0; h < 2; ++h) { const int n = nl + 32 * h, nn = n0 + w * 64 + n;
              const int drow = mapmode == 0 ? nn : ((nn >> 6) * 128 + ((nn >> 5) & 1) * 64 + which * 32 + (nn & 31));
              bf16x8 o;
#pragma unroll
              for (int e = 0; e < 8; ++e) o[e] = (short)f2bf(t[w * (64 * 65) + (kc * 8 + e) * 65 + n]);
              *(bf16x8*)(dst + (size_t)drow * ldk + k0 + kc * 8) = o; } }
    __syncthreads();
}

DEV void task_filt_mlp(const Params& p, char* smem, int task) {
    float* z = (float*)smem;
    float* ha = z + 8 * 36;
    float* hb = ha + 8 * 64;
    float* w1 = hb + 8 * 64;
    float* w2 = w1 + 33 * 64;
    float* w3 = w2 + 64 * 64;
    const int tid = threadIdx.x, i0 = task * 8;
    {   f32x4 a2[4], a3[4], a1[3];
#pragma unroll
        for (int u = 0; u < 4; ++u) { a2[u] = *(const f32x4*)(p.f_w2 + (u * 256 + tid) * 4); a3[u] = *(const f32x4*)(p.f_w3 + (u * 256 + tid) * 4); }
#pragma unroll
        for (int u = 0; u < 3; ++u) { const int i = u * 256 + tid; a1[u] = i < 528 ? *(const f32x4*)(p.f_w1 + i * 4) : (f32x4){0.f, 0.f, 0.f, 0.f}; }
#pragma unroll
        for (int u = 0; u < 4; ++u) { *(f32x4*)(w2 + (u * 256 + tid) * 4) = a2[u]; *(f32x4*)(w3 + (u * 256 + tid) * 4) = a3[u]; }
#pragma unroll
        for (int u = 0; u < 3; ++u) { const int i = u * 256 + tid; if (i < 528) *(f32x4*)(w1 + i * 4) = a1[u]; }
    }
    for (int i = tid; i < 8 * 33; i += NTHR) { const int pp = i / 33, f = i % 33, pos = i0 + pp; float v;
        if (f == 0) v = (float)pos / (float)(L - 1);
        else { const int bnd = (f - 1) & 15; const float band = 1e-4f + (float)bnd * ((15.f - 1e-4f) / 15.f);
               const float ang = (6.283185307179586f / (float)L) * (float)pos * band; v = f <= 16 ? cosf(ang) : -sinf(ang); }
        z[pp * 36 + f] = v; }
    __syncthreads();
    const int pp = tid >> 5, jq = tid & 31;
#pragma unroll 1
    for (int m = 0; m < 2; ++m) { const int j = jq + 32 * m; float s = p.f_b1[j];
#pragma unroll 3
        for (int k = 0; k < 33; ++k) s += z[pp * 36 + k] * w1[k * 64 + j];
        ha[pp * 64 + j] = sinf(p.f_freq[j] * s); }
    __syncthreads();
#pragma unroll 1
    for (int m = 0; m < 2; ++m) { const int j = jq + 32 * m; float s = p.f_b2[j];
#pragma unroll 4
        for (int k = 0; k < 64; ++k) s += ha[pp * 64 + k] * w2[k * 64 + j];
        hb[pp * 64 + j] = sinf(p.f_freq[j] * s); }
    __syncthreads();
#pragma unroll 1
    for (int m = 0; m < 2; ++m) { const int j = jq + 32 * m; float s = p.f_b3[j];
#pragma unroll 4
        for (int k = 0; k < 64; ++k) s += hb[pp * 64 + k] * w3[k * 64 + j];
        p.h3buf[(size_t)(i0 + pp) * 64 + j] = sinf(p.f_freq[j] * s); }
    __syncthreads();
}
DEV void task_filt_out(const Params& p, char* smem, int task) {
    float* hs = (float*)smem;
    float* wl = hs + 64 * 64;
    const int tid = threadIdx.x, jb = task >> 3, cg = task & 7; const bool isb = jb >= L / 64;
    const int cl = tid & 63, mh = tid >> 6, c = cg * 64 + cl;
    {   f32x4 hv[4], wq[4];
#pragma unroll
        for (int u = 0; u < 4; ++u) { const int i = u * 256 + tid, pp = i >> 4, q = i & 15; int pos = isb ? 64 * jb + pp - L : L - 64 * jb - pp; if (pos > L - 1) pos = L - 1;
            hv[u] = *(const f32x4*)(p.h3buf + (size_t)pos * 64 + q * 4); }
#pragma unroll
        for (int u = 0; u < 4; ++u) { const int i = u * 256 + tid, k = i >> 4, q = i & 15; wq[u] = *(const f32x4*)(p.f_wout + k * 1024 + (isb ? 512 : 0) + cg * 64 + q * 4); }
#pragma unroll
        for (int u = 0; u < 4; ++u) { *(f32x4*)(hs + (u * 256 + tid) * 4) = hv[u]; *(f32x4*)(wl + (u * 256 + tid) * 4) = wq[u]; }
    }
    __syncthreads();
    float acc[16];
#pragma unroll
    for (int i = 0; i < 16; ++i) acc[i] = 0.f;
#pragma unroll 1
    for (int k0 = 0; k0 < 64; k0 += 4) {
        const float w0 = wl[(k0 + 0) * 64 + cl], w1 = wl[(k0 + 1) * 64 + cl], w2 = wl[(k0 + 2) * 64 + cl], w3 = wl[(k0 + 3) * 64 + cl];
#pragma unroll
        for (int i = 0; i < 16; ++i) { const f32x4 h0 = *(const f32x4*)(hs + (mh * 16 + i) * 64 + k0); acc[i] += h0[0] * w0 + h0[1] * w1 + h0[2] * w2 + h0[3] * w3; } }
    const float max_decay = logf(1e-2f) / 0.3f, min_decay = logf(1e-2f) / 1.5f;
    const float delta = fabsf(min_decay + (float)c * ((max_decay - min_decay) / 511.f));
    if (jb == L / 64 && mh == 0) {
        float af = 0.f, fw[64];
#pragma unroll
        for (int k = 0; k < 64; ++k) fw[k] = p.f_wout[k * 1024 + c];
#pragma unroll
        for (int k = 0; k < 64; ++k) af += hs[k] * fw[k];
        acc[0] = af; }
    bf16_t* dst = p.gtap + (size_t)c * (2 * L) + 64 * jb + 16 * mh;
#pragma unroll
    for (int q = 0; q < 2; ++q) { bf16x8 o;
#pragma unroll
        for (int e = 0; e < 8; ++e) { const int i = q * 8 + e, m = 64 * jb + 16 * mh + i; const int pos = isb ? m - L : L - m;
            const float tt = (float)pos / (float)(L - 1); float val = acc[i] * (expf(-tt * delta) + 0.05f);
            if (m == L) val += p.hy_skip[c];
            if (m == 0) val = 0.f;
            o[e] = (short)f2bf(val); }
        *(bf16x8*)(dst + q * 8) = o; }
    __syncthreads();
}

constexpr int NT_ADA = NMODC / 32;
constexpr int NT_WIN = 16 * 14, NT_WOUT = 16 * 16, NT_W13 = 16 * 2 * 16 * 2, NT_W2 = 16 * 8 * 4;
constexpr int NT_FILT = (2 * L / 64) * 8, NT_FMLP = L / 8;
constexpr int NT_WOUT4 = 16 * 4;
constexpr int NT_P0 = NT_ADA + NT_WIN + NT_WOUT4 + NT_FMLP + 1;

DEV void prep_task(const Params& p, char* smem, int t) {
    if (t < NT_ADA) { task_ada(p, smem, t); return; } t -= NT_ADA;
    if (t < NT_WIN) { const int kt = t / 14, nq = t % 14; transpose_tile<4>(p.w_in, PC, kt * 64, nq * 256, p.w_in_t, 1024, 0, 0, nullptr, 0, nullptr, smem); return; } t -= NT_WIN;
    if (t < NT_WOUT4) { transpose_tile<4>(p.w_out, D, (t / 4) * 64, (t % 4) * 256, p.w_out_t, 1024, 0, 0, p.hy_out_norm, 512, p.ret_gn_w, smem); return; } t -= NT_WOUT4;
    if (t < NT_FMLP) { task_filt_mlp(p, smem, t); return; }
    for (int i = threadIdx.x; i < 64 * 16; i += NTHR) { const int pos = i >> 4, f = i & 15; const float fr = powf(10000.f, -(float)f / 16.f); const float a = (float)pos * fr;
        p.rope[i * 2] = cosf(a); p.rope[i * 2 + 1] = sinf(a); }
    if (threadIdx.x < NEXP) p.cnt[threadIdx.x * 32] = 0;
}
DEV void ph_prep(const Params& p, char* smem) {
    const int G = gridDim.x, b = blockIdx.x;
    if (G >= NT_ADA + NT_FMLP + 1) {
        if (b < NT_ADA) { task_ada(p, smem, b); return; }
        const int o = b - NT_ADA, no = G - NT_ADA;
        for (int t = o; t < NT_WIN + NT_WOUT4; t += no) prep_task(p, smem, NT_ADA + t);
        for (int t = o; t < NT_FMLP + 1; t += no) prep_task(p, smem, NT_ADA + NT_WIN + NT_WOUT4 + t);
        return;
    }
    for (int task = b; task < NT_P0; task += G) prep_task(p, smem, task);
}
DEV void wout_task(const Params& p, char* smem, int u) { transpose_tile<1>(p.w_out, D, (u / 16) * 64, (u % 16) * 64, p.w_out_t, 1024, 0, 0, p.hy_out_norm, 512, p.ret_gn_w, smem); }
DEV void expert_conv_task(const Params& p, char* smem, int t) {
    if (t < NT_W13) { const int e = t / 64, r = t % 64, which = r / 32, r2 = r % 32, kt = r2 / 2, nq = r2 % 2;
        transpose_tile<4>((which ? p.exp_w3 : p.exp_w1) + (size_t)e * D * EH, EH, kt * 64, nq * 256, p.w13_t + (size_t)e * 1024 * 1024, 1024, 1, which, nullptr, 0, nullptr, smem); return; }
    t -= NT_W13;
    { const int e = t / 32, r = t % 32, kt = r / 4, nq = r % 4;
        transpose_tile<4>(p.exp_w2 + (size_t)e * EH * D, D, kt * 64, nq * 256, p.w2_t + (size_t)e * 1024 * EH, EH, 0, 0, nullptr, 0, nullptr, smem); }
}

DEV void ph_norm1(const Params& p, char* smem) {
    const int tid = threadIdx.x, lane = tid & 63, wid = tid >> 6;
    const bool latefirst = (int)(blockIdx.x >> 3) >= (int)(gridDim.x >> 4);
#pragma unroll 1
    for (int pass = 0; pass < 2; ++pass) {
    if ((pass == 0) != latefirst) {
    {
        const Topo tp = topo_get(smem);
        const int rstep = tp.local ? tp.nl * 4 : (int)gridDim.x * 4, rlim = tp.local ? (T + TC) / 8 : TA; int rr = tp.local ? tp.rk * 4 + wid : (int)blockIdx.x * 4 + wid;
        auto rowof = [&](int r) -> int { return tp.local ? (r < T / 8 ? tp.x * (T / 8) + r : T + tp.x * (TC / 8) + (r - T / 8)) : r; };
        int row = rowof(rr < rlim ? rr : 0);
        f32x4 w4[4];
#pragma unroll
        for (int i = 0; i < 4; ++i) w4[i] = *(const f32x4*)(p.norm1_w + (i >> 1) * 512 + lane * 8 + (i & 1) * 4);
        f32x4 cur[4];
        if (rr < rlim) { const float* src = row < T ? p.x + (size_t)row * D : p.ctx + (size_t)(row - T) * D;
#pragma unroll
            for (int i = 0; i < 4; ++i) cur[i] = NT_LD(f32x4, src + (i >> 1) * 512 + lane * 8 + (i & 1) * 4); }
#pragma unroll 1
        for (; rr < rlim; rr += rstep, row = rowof(rr < rlim ? rr : 0)) {
            const int mb = row < T ? row / L : NB;
            const float* sh = p.mod + (size_t)mb * NMODC; const float* sc = sh + D;
            f32x4 s1[4], s0[4];
#pragma unroll
            for (int i = 0; i < 4; ++i) { const int k = (i >> 1) * 512 + lane * 8 + (i & 1) * 4; s1[i] = *(const f32x4*)(sc + k); s0[i] = *(const f32x4*)(sh + k); }
            const int nrow = rr + rstep < rlim ? rowof(rr + rstep) : row;
            const float* nsrc = nrow < T ? p.x + (size_t)nrow * D : p.ctx + (size_t)(nrow - T) * D;
            f32x4 nxt[4];
#pragma unroll
            for (int i = 0; i < 4; ++i) nxt[i] = NT_LD(f32x4, nsrc + (i >> 1) * 512 + lane * 8 + (i & 1) * 4);
            float ss = 0.f;
#pragma unroll
            for (int i = 0; i < 4; ++i) ss += cur[i][0] * cur[i][0] + cur[i][1] * cur[i][1] + cur[i][2] * cur[i][2] + cur[i][3] * cur[i][3];
            ss = wave_sum(ss);
            const float rstd = rsqrtf(ss * (1.f / D) + 1e-6f);
#pragma unroll
            for (int h = 0; h < 2; ++h) { const f32x4 va = cur[2 * h] * rstd * w4[2 * h] * (1.f + s1[2 * h]) + s0[2 * h], vb = cur[2 * h + 1] * rstd * w4[2 * h + 1] * (1.f + s1[2 * h + 1]) + s0[2 * h + 1];
                const us4 pa = pack4(va[0], va[1], va[2], va[3]), pb = pack4(vb[0], vb[1], vb[2], vb[3]);
                bf16x8 o = {(short)pa[0], (short)pa[1], (short)pa[2], (short)pa[3], (short)pb[0], (short)pb[1], (short)pb[2], (short)pb[3]};
                *(bf16x8*)(p.hbuf + (size_t)row * D + h * 512 + lane * 8) = o; }
#pragma unroll
            for (int i = 0; i < 4; ++i) cur[i] = nxt[i];
        }
    }
    { const Topo tq = topo_get(smem); if (df1_mode(tq)) flag_post(flag_n1(p, tq.x, latefirst ? 1 : 0)); }
    } else {
    const int gtid = blockIdx.x * NTHR + tid, gn = gridDim.x * NTHR;
    for (int i = gtid; i < NB * D * 32; i += gn) { const int ii = i & 3, j = (i >> 2) & 31, k4 = (i >> 7) & 255, b = i >> 15; const int k = k4 * 4 + ii;
        const float r = j < 4 ? p.rg_w[k * 4 + j] : (j < 20 ? p.re_w[k * 16 + (j - 4)] : 0.f);
        p.RP[i] = p.norm2_w[k] * (1.f + p.mod[(size_t)b * NMODC + 4 * D + k]) * r; }
    if (wid == 0) for (int wt = blockIdx.x; wt < NB * 32; wt += gridDim.x) { const int b = wt >> 5, j = wt & 31; float s = 0.f;
        if (j < 20) { float mv[D / 64], rv[D / 64];
#pragma unroll
            for (int u = 0; u < D / 64; ++u) { const int k = lane + 64 * u; mv[u] = p.mod[(size_t)b * NMODC + 3 * D + k]; rv[u] = j < 4 ? p.rg_w[k * 4 + j] : p.re_w[k * 16 + (j - 4)]; }
#pragma unroll
            for (int u = 0; u < D / 64; ++u) s += mv[u] * rv[u]; }
        s = wave_sum(s);
        if (lane == 0) WT_STORE(p.cb + wt, j < 4 ? s + p.rg_b[j] : (j < 20 ? s + p.re_b[j - 4] : 0.f)); }
    for (int t = blockIdx.x; t < NT_FILT; t += gridDim.x) task_filt_out(p, smem, t);
    }
    }
}

constexpr int OPITCH = 136;
template <bool NMAJOR>
DEV void staged_store(const f32x4 (&acc)[4][4], float scale, char* smem, bf16_t* base, size_t stride) {
    int tid = threadIdx.x; OPAQUE(tid);
    const int lane = tid & 63, wid = tid >> 6, wr = wid >> 1, wc = wid & 1, fr = lane & 15, quad = lane >> 4;
    bf16_t* ost = (bf16_t*)smem;
#pragma unroll
    for (int mi = 0; mi < 4; ++mi)
#pragma unroll
        for (int ni = 0; ni < 4; ++ni) { const int n = wc * 64 + ni * 16 + fr, m = wr * 64 + mi * 16 + quad * 4;
            const us4 o = pack4(acc[mi][ni][0] * scale, acc[mi][ni][1] * scale, acc[mi][ni][2] * scale, acc[mi][ni][3] * scale);
            if (NMAJOR) *(us4*)(ost + n * OPITCH + m) = o;
            else {
#pragma unroll
                for (int r = 0; r < 4; ++r) ost[(m + r) * OPITCH + n] = o[r]; } }
    __syncthreads();
#pragma unroll
    for (int i = 0; i < 8; ++i) { const int q = tid + 256 * i, row = q >> 4, ch = q & 15;
        *(bf16x8*)(base + (size_t)row * stride + ch * 8) = *(const bf16x8*)(ost + row * OPITCH + ch * 8); }
    __syncthreads();
}

constexpr int NT_INP = (T / 128) * 28 + (TC / 128) * 8;
DEV void inproj_tile(const Params& p, char* smem, int mt, int nt) {
    int tid = threadIdx.x; OPAQUE(tid);
    const int lane = tid & 63, wid = tid >> 6, wr = wid >> 1, wc = wid & 1, fr = lane & 15, quad = lane >> 4;
    const size_t row0 = (size_t)mt * 128;
    const bool is_ctx = mt >= T / 128;
    const bool actX = (nt < 12) || (nt >= 16 && nt < 24);
    f32x4 acc[4][4]; zero_acc(acc);
    LdPlain la(p.hbuf, row0, D), lw(p.w_in_t, (size_t)nt * 128, D);
    if (actX) gemm_tile(acc, la, lw, D / 64, smem); else gemm_tile(acc, lw, la, D / 64, smem);
    if (nt < 12) {
        staged_store<true>(acc, 1.f, smem, p.pT + (size_t)(nt * 128) * T + row0, T);
    } else if (nt >= 16 && nt < 24) {
        const bool isk = nt < 20; const int h = (nt - 16) & 3;
        if (!is_ctx) {
            const int b = (int)(row0 / L), tl0 = (int)(row0 % L); const size_t bh = (size_t)b * NH + h;
            if (isk) {
                if (wc == 0) {
#pragma unroll
                    for (int mi = 0; mi < 4; ++mi)
#pragma unroll
                        for (int r = 0; r < 4; ++r) { const int tl = tl0 + wr * 64 + mi * 16 + quad * 4 + r;
                            { const float* cs = p.rope + ((tl >> 6) * 16 + fr) * 2; const float a = acc[mi][0][r], bq = acc[mi][1][r]; acc[mi][0][r] = a * cs[0] - bq * cs[1]; acc[mi][1][r] = a * cs[1] + bq * cs[0]; }
                            { const float* cs = p.rope + ((tl & 63) * 16 + fr) * 2; const float a = acc[mi][2][r], bq = acc[mi][3][r]; acc[mi][2][r] = a * cs[0] - bq * cs[1]; acc[mi][3][r] = a * cs[1] + bq * cs[0]; } }
                }
                const float scl = 0.08838834764831845f;
                staged_store<false>(acc, scl, smem, p.kn + (bh * L + tl0) * 128, 128);
                const float lgf = lg2_gamma(h, false), lgb = lg2_gamma(h, true);
                f32x4 t[4][4];
#pragma unroll
                for (int mi = 0; mi < 4; ++mi) { const int jl = wr * 64 + mi * 16 + quad * 4;
#pragma unroll
                    for (int ni = 0; ni < 4; ++ni)
#pragma unroll
                        for (int r = 0; r < 4; ++r) t[mi][ni][r] = acc[mi][ni][r] * exp2f(lgf * (float)(127 - jl - r)); }
                staged_store<true>(t, scl, smem, p.kTf + (bh * 128) * L + tl0, L);
#pragma unroll
                for (int mi = 0; mi < 4; ++mi) { const int jl = wr * 64 + mi * 16 + quad * 4;
#pragma unroll
                    for (int ni = 0; ni < 4; ++ni)
#pragma unroll
                        for (int r = 0; r < 4; ++r) t[mi][ni][r] = acc[mi][ni][r] * exp2f(lgb * (float)(jl + r)); }
                staged_store<true>(t, scl, smem, p.kTb + (bh * 128) * L + tl0, L);
            } else staged_store<true>(acc, 1.f, smem, p.vT + (bh * 128) * L + tl0, L);
        } else {
            const size_t cr0 = row0 - T; const int b = (int)(cr0 / LC), tl0 = (int)(cr0 % LC); const size_t bh = (size_t)b * NH + h;
            if (isk) {
                const float scl = 0.08838834764831845f; const float lgf = lg2_gamma(h, false), lgb = lg2_gamma(h, true);
                f32x4 t[4][4];
#pragma unroll
                for (int mi = 0; mi < 4; ++mi) { const int jl = wr * 64 + mi * 16 + quad * 4;
#pragma unroll
                    for (int ni = 0; ni < 4; ++ni)
#pragma unroll
                        for (int r = 0; r < 4; ++r) t[mi][ni][r] = acc[mi][ni][r] * exp2f(lgf * (float)(127 - jl - r)); }
                staged_store<true>(t, scl, smem, p.ckTf + (bh * 128) * LC + tl0, LC);
#pragma unroll
                for (int mi = 0; mi < 4; ++mi) { const int jl = wr * 64 + mi * 16 + quad * 4;
#pragma unroll
                    for (int ni = 0; ni < 4; ++ni)
#pragma unroll
                        for (int r = 0; r < 4; ++r) t[mi][ni][r] = acc[mi][ni][r] * exp2f(lgb * (float)(jl + r)); }
                staged_store<true>(t, scl, smem, p.ckTb + (bh * 128) * LC + tl0, LC);
            } else staged_store<true>(acc, 1.f, smem, p.cvT + (bh * 128) * LC + tl0, LC);
        }
    } else if (nt < 16) {
        const int h = nt - 12; const int b = (int)(row0 / L), tl0 = (int)(row0 % L);
        if (wr == 0) {
#pragma unroll
            for (int ni = 0; ni < 4; ++ni) { const int tl = tl0 + wc * 64 + ni * 16 + fr;
#pragma unroll
                for (int r = 0; r < 4; ++r) { const int j = quad * 4 + r;
                    { const float* cs = p.rope + ((tl >> 6) * 16 + j) * 2; const float a = acc[0][ni][r], bq = acc[1][ni][r]; acc[0][ni][r] = a * cs[0] - bq * cs[1]; acc[1][ni][r] = a * cs[1] + bq * cs[0]; }
                    { const float* cs = p.rope + ((tl & 63) * 16 + j) * 2; const float a = acc[2][ni][r], bq = acc[3][ni][r]; acc[2][ni][r] = a * cs[0] - bq * cs[1]; acc[3][ni][r] = a * cs[1] + bq * cs[0]; } } }
        }
        staged_store<true>(acc, 1.f, smem, p.qn + (((size_t)b * NH + h) * L + tl0) * 128, 128);
    } else {
        staged_store<true>(acc, 1.f, smem, p.gbuf + row0 * 512 + (nt - 24) * 128, 512);
    }
}
DEV void ph_inproj(const Params& p, char* smem) {
    constexpr int NMT = T / 128, NCM = TC / 128;
    const int G = gridDim.x, b = blockIdx.x;
    if ((G & 7) == 0 && NMT % 8 == 0) {
        constexpr int MX = NMT / 8;
        const int x = b & 7, li = b >> 3, nl = G >> 3;
        const Topo tp = topo_get(smem);
        if (df1_mode(tp)) {
            flag_acquire();
            int curh = -1;
            for (int q = li; q < MX * 28; q += nl) { const int half = q / (MX * 14), r2 = q % (MX * 14);
                if (half != curh) { curh = half; flag_wait(flag_n1(p, x, half), (unsigned)(nl / 2)); }
                inproj_tile(p, smem, x * MX + 2 * (r2 % (MX / 2)) + half, r2 / (MX / 2)); }
            for (int t = li; t < (NCM / 8) * 8; t += nl) { const int half = t / 8; if (half != curh) { curh = half; flag_wait(flag_n1(p, x, half), (unsigned)(nl / 2)); }
                inproj_tile(p, smem, NMT + x * (NCM / 8) + half, 16 + t % 8); }
            return;
        }
        for (int q = li; q < MX * 28; q += nl) { const int ng = q / (MX * 4), rem = q % (MX * 4); inproj_tile(p, smem, x * MX + rem % MX, ng * 4 + rem / MX); }
        if (topo_get(smem).local) { for (int t = li; t < (NCM / 8) * 8; t += nl) inproj_tile(p, smem, NMT + x * (NCM / 8) + t / 8, 16 + t % 8); }
        else for (int t = b; t < NCM * 8; t += G) inproj_tile(p, smem, NMT + t / 8, 16 + t % 8);
        return;
    }
    for (int task = blockIdx.x; task < NT_INP; task += gridDim.x) {
        if (task < (T / 128) * 28) inproj_tile(p, smem, task / 28, task % 28);
        else { const int t = task - (T / 128) * 28; inproj_tile(p, smem, T / 128 + t / 8, 16 + t % 8); }
    }
}

constexpr int NU = L / 64, CSPLIT = 1, UPW = NU / (4 * CSPLIT), NGRP = NU / UPW;
typedef unsigned u32x2 __attribute__((ext_vector_type(2)));
typedef unsigned u32x4 __attribute__((ext_vector_type(4)));
constexpr int TAPC = 2 * L + 16;
DEV bf16x8 conv_afrag(const bf16_t* tcp, int m0a) {
    const u32x2 lo = *(const volatile LDS_AS u32x2*)(tcp + m0a), hi = *(const volatile LDS_AS u32x2*)(tcp + m0a + 4);
    const u32x4 v = {lo[0], lo[1], hi[0], hi[1]};
    return __builtin_bit_cast(bf16x8, v); }
DEV void conv3_w(const Params& p, int ch, float& w0, float& w1, float& w2, float& bs) { w0 = p.hy_conv_w[ch]; w1 = p.hy_conv_w[1536 + ch]; w2 = p.hy_conv_w[3072 + ch]; bs = p.hy_conv_b[ch]; }

DEV void conv_task(const Params& p, char* smem, int c, int half) {
    bf16_t* taps = (bf16_t*)smem;
    bf16_t* U = taps + 4 * TAPC;
    int tid = threadIdx.x; OPAQUE(tid);
    const int lane = tid & 63, w = tid >> 6, fr = lane & 15, quad = lane >> 4;
    {
        constexpr int NTC = (2 * L / 8 + NTHR - 1) / NTHR;
        constexpr int NGT = NB * (L / 8), NG = (NGT + NTHR - 1) / NTHR;
        float a0, a1, a2, ab, v0, v1, v2, vb; conv3_w(p, 512 + c, a0, a1, a2, ab); conv3_w(p, 1024 + c, v0, v1, v2, vb);
        bf16x8 tpv[NTC], x1v[NG], vv[NG]; bf16_t hx0[NG], hx9[NG], hv0[NG], hv9[NG];
#pragma unroll
        for (int u = 0; u < NTC; ++u) { int i = tid + u * NTHR; if (i >= 2 * L / 8) i = 2 * L / 8 - 1; tpv[u] = *(const bf16x8*)(p.gtap + (size_t)c * 2 * L + i * 8); }
#pragma unroll
        for (int u = 0; u < NG; ++u) { int g = tid + u * NTHR; if (g >= NGT) g = NGT - 1; const int b = g / (L / 8), t8 = (g % (L / 8)) * 8;
            const bf16_t* r1 = p.pT + (size_t)(512 + c) * T + (size_t)b * L + t8; const bf16_t* rv = p.pT + (size_t)(1024 + c) * T + (size_t)b * L + t8;
            x1v[u] = *(const bf16x8*)r1; vv[u] = *(const bf16x8*)rv;
            const int il = t8 > 0 ? -1 : 0, ir = t8 + 8 < L ? 8 : 7;
            hx0[u] = r1[il]; hv0[u] = rv[il]; hx9[u] = r1[ir]; hv9[u] = rv[ir]; }
        for (int i = tid; i < 8 * 8; i += NTHR) { const int b = i >> 3, q = i & 7; bf16_t* row = U + b * UP + (q < 4 ? q * 8 : 32 + L + (q - 4) * 8); *(bf16x8*)row = (bf16x8){0, 0, 0, 0, 0, 0, 0, 0}; }
        for (int i = tid; i < (8 - NB) * (L / 8); i += NTHR) *(bf16x8*)(U + (NB + i / (L / 8)) * UP + 32 + (i % (L / 8)) * 8) = (bf16x8){0, 0, 0, 0, 0, 0, 0, 0};
#pragma unroll
        for (int u = 0; u < NTC; ++u) { const int i = tid + u * NTHR; if (i >= 2 * L / 8) continue; const bf16x8 v = tpv[u];
            *(bf16x8*)(taps + i * 8) = v;
#pragma unroll
            for (int a = 1; a < 4; ++a)
#pragma unroll
                for (int e = 0; e < 8; ++e) { const int q = i * 8 + e - a; if (q >= 0) taps[a * TAPC + q] = (bf16_t)v[e]; } }
#pragma unroll
        for (int u = 0; u < NG; ++u) { const int g = tid + u * NTHR; if (g >= NGT) continue; const int b = g / (L / 8), t8 = (g % (L / 8)) * 8;
            float px[10], pv[10];
            px[0] = t8 > 0 ? bf2f(hx0[u]) : 0.f; pv[0] = t8 > 0 ? bf2f(hv0[u]) : 0.f; px[9] = t8 + 8 < L ? bf2f(hx9[u]) : 0.f; pv[9] = t8 + 8 < L ? bf2f(hv9[u]) : 0.f;
#pragma unroll
            for (int e = 0; e < 8; ++e) { px[e + 1] = bf2f((bf16_t)x1v[u][e]); pv[e + 1] = bf2f((bf16_t)vv[u][e]); }
            bf16x8 o;
#pragma unroll
            for (int e = 0; e < 8; ++e) { const float x1 = a0 * px[e] + a1 * px[e + 1] + a2 * px[e + 2] + ab; const float vq = v0 * pv[e] + v1 * pv[e + 1] + v2 * pv[e + 2] + vb; o[e] = (short)f2bf(x1 * vq); }
            *(bf16x8*)(U + b * UP + 32 + t8) = o; }
    }
    __syncthreads();
    f32x4 acc[2][UPW];
#pragma unroll
    for (int tp = 0; tp < 2; ++tp)
#pragma unroll
        for (int ui = 0; ui < UPW; ++ui) acc[tp][ui] = (f32x4){0.f, 0.f, 0.f, 0.f};
    const int bcol = fr & 7, i2 = fr >> 3;
    const bf16_t* Ub = U + bcol * UP + 32 + 32 * i2 + 8 * quad;
    const int al = (L - fr) & 3;
    const bf16_t* tcp = taps + al * TAPC;
    const int ub = UPW * (4 * half + w);
    const int mbase = L - fr + 8 * quad - 64 * ub - al;
#pragma unroll 1
    for (int jp = 1; jp >= 0; --jp) {
        bf16x8 af[2][UPW];
        int J0 = jp ? -1 : 0;
        if (jp) {
            const bf16x8 bfr = *(const bf16x8*)(Ub + 32 * J0);
#pragma unroll
            for (int tp = 0; tp < 2; ++tp)
#pragma unroll
                for (int ui = 0; ui < UPW; ++ui) { const bf16x8 a = conv_afrag(tcp, mbase - 64 * ui - 16 * tp + 32 * J0); acc[tp][ui] = __builtin_amdgcn_mfma_f32_16x16x32_bf16(a, bfr, acc[tp][ui], 0, 0, 0); }
            J0 = 1;
        }
#pragma unroll
        for (int tp = 0; tp < 2; ++tp)
#pragma unroll
            for (int ui = 0; ui < UPW; ++ui) af[tp][ui] = conv_afrag(tcp, mbase - 64 * ui - 16 * tp + 32 * J0);
        bf16x8 bnext = *(const bf16x8*)(Ub + 32 * J0);
#pragma unroll 1
        for (int grp = 0; grp < NGRP; ++grp) {
#pragma unroll
            for (int s = 0; s < UPW; ++s) {
                const bf16x8 bfr = bnext; { const int Jn = J0 + 2 < L / 32 ? J0 + 2 : J0; bnext = *(const bf16x8*)(Ub + 32 * Jn); }
#pragma unroll
                for (int tp = 0; tp < 2; ++tp)
#pragma unroll
                    for (int ui = 0; ui < UPW; ++ui) acc[tp][ui] = __builtin_amdgcn_mfma_f32_16x16x32_bf16(af[tp][(ui - s + UPW) % UPW], bfr, acc[tp][ui], 0, 0, 0);
                J0 += 2;
                if (grp < NGRP - 1 || s < UPW - 1) {
#pragma unroll
                    for (int tp = 0; tp < 2; ++tp) af[tp][(UPW - 1 - s) % UPW] = conv_afrag(tcp, mbase - 16 * tp + 32 * J0);
                }
            }
        }
    }
    __syncthreads();
    {   bf16_t* ost = (bf16_t*)smem; constexpr int OP = L + 8;
        if (bcol < NB) {
#pragma unroll
            for (int tp = 0; tp < 2; ++tp)
#pragma unroll
                for (int ui = 0; ui < UPW; ++ui) { const int I0 = 4 * (ub + ui) + tp; const int t = 16 * (I0 + 2 * i2) + 4 * quad;
                    *(us4*)(ost + bcol * OP + t) = pack4(acc[tp][ui][0], acc[tp][ui][1], acc[tp][ui][2], acc[tp][ui][3]); }
        }
        __syncthreads();
        constexpr int NCHK = NB * L / 8;
        for (int q0 = tid; q0 < NCHK; q0 += NTHR) { const int row = q0 / (L / 8), ch = q0 % (L / 8);
            *(bf16x8*)(p.yhyT + (size_t)c * T + (size_t)row * L + ch * 8) = *(const bf16x8*)(ost + row * OP + ch * 8); }
    }
    __syncthreads();
}

struct LdSeq64 {
    const bf16_t *cb, *lb; int dir;
    DEV LdSeq64(const bf16_t* cbase, const bf16_t* lbase, int row0, int dir_) : dir(dir_) { const int r = row0 + (threadIdx.x >> 3), lc = stage_chunk(); cb = cbase + (size_t)r * LC + lc; lb = lbase + (size_t)r * L + lc; }
    DEV const bf16_t* src(int i, int kt) const { const int n = kt >> 1, off = (kt & 1) * 64;
        if (n < NCC) { const int J = dir ? NCC - 1 - n : n; return cb + (size_t)(32 * i) * LC + J * 128 + off; }
        const int I = dir ? NCH - 1 - (n - NCC) : n - NCC; return lb + (size_t)(32 * i) * L + I * 128 + off; }
};
struct RscanHook64 { bf16_t* so; int dir; float gch;
    DEV void store(int I, f32x4 (&acc)[2][2]) const {
#pragma unroll
        for (int mi = 0; mi < 2; ++mi)
#pragma unroll
            for (int ni = 0; ni < 2; ++ni) *(us4*)(so + (size_t)I * 16384 + (ni * 16) * 128 + mi * 16) = pack4(acc[mi][ni][0], acc[mi][ni][1], acc[mi][ni][2], acc[mi][ni][3]); }
    DEV void operator()(int kt, f32x4 (&acc)[2][2]) const {
        if (kt & 1) return; const int n = kt >> 1;
        if (n >= NCC) store(dir ? NCH - 1 - (n - NCC) : n - NCC, acc);
        if (n > 0) {
#pragma unroll
            for (int mi = 0; mi < 2; ++mi)
#pragma unroll
                for (int ni = 0; ni < 2; ++ni) acc[mi][ni] = acc[mi][ni] * gch; } }
};
DEV void rscan_task(const Params& p, char* smem, int task) {
    const int quadrant = task & 3, dh = quadrant >> 1, eh = quadrant & 1, bh = (task >> 2) % (NB * NH), dir = task / (4 * NB * NH), h = bh % NH;
    int tid = threadIdx.x; OPAQUE(tid);
    const int lane = tid & 63, wid = tid >> 6, wr = wid >> 1, wc = wid & 1, fr = lane & 15, quad = lane >> 4;
    const LdSeq64 lk((dir ? p.ckTb : p.ckTf) + (size_t)bh * 128 * LC, (dir ? p.kTb : p.kTf) + (size_t)bh * 128 * L, dh * 64, dir);
    const LdSeq64 lv(p.cvT + (size_t)bh * 128 * LC, p.vT + (size_t)bh * 128 * L, eh * 64, dir);
    RscanHook64 hk; hk.dir = dir; hk.gch = exp2f(128.f * lg2_gamma(h, dir == 1));
    hk.so = p.Sst + (((size_t)dir * NB * NH + bh) * NCH) * 16384 + (size_t)(eh * 64 + wc * 32 + fr) * 128 + dh * 64 + wr * 32 + quad * 4;
    f32x4 acc[2][2];
#pragma unroll
    for (int mi = 0; mi < 2; ++mi)
#pragma unroll
        for (int ni = 0; ni < 2; ++ni) acc[mi][ni] = (f32x4){0.f, 0.f, 0.f, 0.f};
    constexpr int nk = 2 * (NCT - 1);
    char* const sx = smem + tid * 16;
#pragma unroll
    for (int t = 0; t < 3; ++t) { if (t < nk) {
#pragma unroll
        for (int i = 0; i < 2; ++i) { glds16(lk.src(i, t), sx + t * 16384 + i * 4096); glds16(lv.src(i, t), sx + t * 16384 + 8192 + i * 4096); } } }
    PIPE_WAIT(8);
    PIPE_BARRIER();
    const int sw = fr >> 1;
    for (int kt = 0; kt < nk; ++kt) {
        hk(kt, acc);
        SCHED_FENCE();
        if (kt + 3 < nk) { char* const d = sx + ((kt + 3) & 3) * 16384;
#pragma unroll
            for (int i = 0; i < 2; ++i) { glds16(lk.src(i, kt + 3), d + i * 4096); glds16(lv.src(i, kt + 3), d + 8192 + i * 4096); } }
        SCHED_FENCE();
        const char* bx = smem + (kt & 3) * 16384; const char* by = bx + 8192;
#pragma unroll
        for (int kk = 0; kk < 2; ++kk) {
            bf16x8 xf[2], yf[2]; const int ch = ((kk * 4 + quad) ^ sw) << 4;
#pragma unroll
            for (int mi = 0; mi < 2; ++mi) xf[mi] = *(const bf16x8*)(bx + (wr * 32 + mi * 16 + fr) * 128 + ch);
#pragma unroll
            for (int ni = 0; ni < 2; ++ni) yf[ni] = *(const bf16x8*)(by + (wc * 32 + ni * 16 + fr) * 128 + ch);
#pragma unroll
            for (int mi = 0; mi < 2; ++mi)
#pragma unroll
                for (int ni = 0; ni < 2; ++ni) acc[mi][ni] = __builtin_amdgcn_mfma_f32_16x16x32_bf16(xf[mi], yf[ni], acc[mi][ni], 0, 0, 0);
        }
        SCHED_FENCE();
        const int rem = nk - 1 - kt;
        if (rem >= 3) PIPE_WAIT(8); else if (rem == 2) PIPE_WAIT(4); else PIPE_WAIT(0);
        PIPE_BARRIER();
    }
    hk.store(dir ? 0 : NCH - 1, acc);
}
constexpr int NT_RSC = 2 * NB * NH * 4;
constexpr int NT_CV = HW * CSPLIT, NT_RO = NB * NH * NCH;
DEV void rout_a_task(const Params& p, char* smem, int task);
DEV void ph_conv_rscan(const Params& p, char* smem) {
    const int G = gridDim.x, b = blockIdx.x;
    if (G == 2 * NT_RSC && NT_CV == 2 * NT_RSC && NT_RO == 2 * NT_RSC) {
        if (b < NT_RSC) { KP_BEGIN(0); rscan_task(p, smem, b); KP_END(0); KP_BEGIN(2); rout_a_task(p, smem, 2 * b); rout_a_task(p, smem, 2 * b + 1); KP_END(2); }
        else { KP_BEGIN(1); for (int k = 0; k < 2; ++k) { const int t = 2 * (b - NT_RSC) + k; conv_task(p, smem, t / CSPLIT, t % CSPLIT); } KP_END(1); }
        return;
    }
    for (int task = b; task < NT_RSC + NT_CV + NT_RO; task += G) {
        if (task < NT_RSC) rscan_task(p, smem, task); else if (task < NT_RSC + NT_CV) { const int t = task - NT_RSC; conv_task(p, smem, t / CSPLIT, t % CSPLIT); } else rout_a_task(p, smem, task - NT_RSC - NT_CV);
    }
}

DEV void hynorm_task(const Params& p, char* smem, int task) {
    bf16_t* tl = (bf16_t*)smem;
    float* cw = (float*)(smem + 64 * 520 * 2);
    const int tid = threadIdx.x, lane = tid & 63, wid = tid >> 6; const size_t pos0 = (size_t)task * 64;
    const bool hasl = (pos0 % L) > 0, hasr = (pos0 % L) + 64 < L;
    {   float w0[2], w1[2], w2[2], wb[2];
#pragma unroll
        for (int h = 0; h < 2; ++h) conv3_w(p, tid + 256 * h, w0[h], w1[h], w2[h], wb[h]);
#pragma unroll
        for (int h = 0; h < 2; ++h) *(f32x4*)(cw + (tid + 256 * h) * 4) = (f32x4){w0[h], w1[h], w2[h], wb[h]}; }
    const int q = tid & 7, cq = tid >> 3;
    const int eoff = q == 0 ? (hasl ? -1 : 0) : (q == 7 ? (hasr ? 64 : 63) : q * 8);
#pragma unroll 1
    for (int j0 = 0; j0 < 16; j0 += 8) {
        bf16x8 cv[8], pv[8]; bf16_t he[8];
#pragma unroll
        for (int j = 0; j < 8; ++j) { const int c = cq + 32 * (j0 + j); const bf16_t* src = p.yhyT + (size_t)c * T + pos0; const bf16_t* ps = p.pT + (size_t)c * T + pos0;
            cv[j] = *(const bf16x8*)(src + q * 8); pv[j] = *(const bf16x8*)(ps + q * 8); he[j] = ps[eoff]; }
        if (j0 == 0) __syncthreads();
#pragma unroll
        for (int j = 0; j < 8; ++j) { const int c = cq + 32 * (j0 + j);
            const f32x4 w = *(const f32x4*)(cw + c * 4);
            const float edge = bf2f(he[j]);
            const float lft = __shfl(bf2f((bf16_t)pv[j][7]), lane - 1), rgt = __shfl(bf2f((bf16_t)pv[j][0]), lane + 1);
            float prev = q == 0 ? (hasl ? edge : 0.f) : lft; const float last = q == 7 ? (hasr ? edge : 0.f) : rgt;
#pragma unroll
            for (int e = 0; e < 8; ++e) { const float cur = bf2f((bf16_t)pv[j][e]); const float nxt = e < 7 ? bf2f((bf16_t)pv[j][e < 7 ? e + 1 : 7]) : last;
                const float x0 = w[0] * prev + w[1] * cur + w[2] * nxt + w[3];
                tl[(q * 8 + e) * 520 + c] = f2bf(x0 * bf2f((bf16_t)cv[j][e])); prev = cur; } }
    }
    __syncthreads();
#pragma unroll 4
    for (int i = 0; i < 16; ++i) { const int pos = wid * 16 + i; const bf16x8 v = *(const bf16x8*)(tl + pos * 520 + lane * 8);
        float f[8], ss = 0.f;
#pragma unroll
        for (int e = 0; e < 8; ++e) { f[e] = bf2f((bf16_t)v[e]); ss += f[e] * f[e]; }
        ss = wave_sum(ss);
        const float rstd = rsqrtf(ss * (1.f / 512.f) + 1e-6f); bf16x8 o;
#pragma unroll
        for (int e = 0; e < 8; ++e) o[e] = (short)f2bf(f[e] * rstd);
        *(bf16x8*)(p.ycat + (pos0 + pos) * 1024 + lane * 8) = o; }
    __syncthreads();
}
DEV void rout_a_task(const Params& p, char* smem, int task) {
    const int bh = task / NCH, I = task % NCH, h = bh % NH;
    int tid = threadIdx.x; OPAQUE(tid);
    const int lane = tid & 63, wid = tid >> 6, wr = wid >> 1, wc = wid & 1, fr = lane & 15, quad = lane >> 4;
    const float lgf = lg2_gamma(h, false), lgb = lg2_gamma(h, true);
    const bf16_t* qb = p.qn + ((size_t)bh * L + I * 128) * 128; const bf16_t* kb = p.kn + ((size_t)bh * L + I * 128) * 128;
    f32x4 acc[4][4]; zero_acc(acc);
    {
        LdPlain lk(kb, 0, 128), lq(qb, 0, 128);
        gemm_tile(acc, lk, lq, 2, smem);
    }
    {   const LdPlain lv(p.vT + (size_t)bh * 128 * L + I * 128, 0, L);
        char* const sx = smem + tid * 16;
#pragma unroll
        for (int kt = 0; kt < 2; ++kt)
#pragma unroll
            for (int i = 0; i < 4; ++i) glds16(lv.src(i, kt), sx + kt * 16384 + i * 4096);
    }
#pragma unroll
    for (int mi = 0; mi < 4; ++mi)
#pragma unroll
        for (int ni = 0; ni < 4; ++ni) { const int i = wc * 64 + ni * 16 + fr, j0 = wr * 64 + mi * 16 + quad * 4; float v[4];
#pragma unroll
            for (int r = 0; r < 4; ++r) { const int j = j0 + r; const float dcy = i > j ? exp2f(lgf * (float)(i - j)) : (i == j ? 2.f : exp2f(lgb * (float)(j - i))); v[r] = acc[mi][ni][r] * dcy; }
            const int chunk = mi * 2 + (quad >> 1);
            *(us4*)(smem + 32768 + wr * 16384 + i * 128 + ((chunk ^ ((i >> 1) & 7)) << 4) + (quad & 1) * 8) = pack4(v[0], v[1], v[2], v[3]); }
    wait_vm0();
    __syncthreads();
    zero_acc(acc);
    {
        const int sw = fr >> 1;
#pragma unroll
        for (int kt = 0; kt < 2; ++kt) { const char* bx = smem + kt * 16384; const char* by = smem + 32768 + kt * 16384;
#pragma unroll
            for (int kk = 0; kk < 2; ++kk) { bf16x8 xf[4], yf[4]; const int ch = ((kk * 4 + quad) ^ sw) << 4;
#pragma unroll
                for (int mi = 0; mi < 4; ++mi) xf[mi] = *(const bf16x8*)(bx + (wr * 64 + mi * 16 + fr) * 128 + ch);
#pragma unroll
                for (int ni = 0; ni < 4; ++ni) yf[ni] = *(const bf16x8*)(by + (wc * 64 + ni * 16 + fr) * 128 + ch);
#pragma unroll
                for (int mi = 0; mi < 4; ++mi)
#pragma unroll
                    for (int ni = 0; ni < 4; ++ni) acc[mi][ni] = __builtin_amdgcn_mfma_f32_16x16x32_bf16(xf[mi], yf[ni], acc[mi][ni], 0, 0, 0); } }
    }
    bf16_t* op = p.Opart + (size_t)task * 16384;
#pragma unroll
    for (int mi = 0; mi < 4; ++mi)
#pragma unroll
        for (int ni = 0; ni < 4; ++ni) *(us4*)(op + ((mi * 4 + ni) * NTHR + tid) * 4) = pack4(acc[mi][ni][0], acc[mi][ni][1], acc[mi][ni][2], acc[mi][ni][3]);
    __syncthreads();
}
DEV void rout_b_task(const Params& p, char* smem, int task) {
    const int bh = task / NCH, I = task % NCH, h = bh % NH, b = bh / NH;
    int tid = threadIdx.x; OPAQUE(tid);
    const int lane = tid & 63, wid = tid >> 6, wr = wid >> 1, wc = wid & 1, fr = lane & 15, quad = lane >> 4;
    const float lgf = lg2_gamma(h, false), lgb = lg2_gamma(h, true);
    const bf16_t* qb = p.qn + ((size_t)bh * L + I * 128) * 128;
    f32x4 acc[4][4];
    { const bf16_t* op = p.Opart + (size_t)task * 16384;
#pragma unroll
      for (int mi = 0; mi < 4; ++mi)
#pragma unroll
          for (int ni = 0; ni < 4; ++ni) { const us4 v = *(const us4*)(op + ((mi * 4 + ni) * NTHR + tid) * 4);
              acc[mi][ni] = (f32x4){bf2f(v[0]), bf2f(v[1]), bf2f(v[2]), bf2f(v[3])}; } }
    {
        LdPlain ls(p.Sst + (((size_t)0 * NB * NH + bh) * NCH + I) * 16384, 0, 128); LdRowScale lq(qb, 0, 128, lgf, lgf);
        gemm_tile(acc, ls, lq, 2, smem);
    }
    {
        LdPlain ls(p.Sst + (((size_t)1 * NB * NH + bh) * NCH + I) * 16384, 0, 128); LdRowScale lq(qb, 0, 128, 128.f * lgb, -lgb);
        gemm_tile(acc, ls, lq, 2, smem);
    }
    float* red = (float*)smem;
    float mean[4], rstd[4];
#pragma unroll
    for (int ni = 0; ni < 4; ++ni) { float s = 0.f, ss = 0.f;
#pragma unroll
        for (int mi = 0; mi < 4; ++mi)
#pragma unroll
            for (int r = 0; r < 4; ++r) { const float v = acc[mi][ni][r]; s += v; ss += v * v; }
        s += __shfl_xor(s, 16); s += __shfl_xor(s, 32); ss += __shfl_xor(ss, 16); ss += __shfl_xor(ss, 32);
        if (quad == 0) { const int i = wc * 64 + ni * 16 + fr; red[(wr * 128 + i) * 2] = s; red[(wr * 128 + i) * 2 + 1] = ss; } }
    __syncthreads();
#pragma unroll
    for (int ni = 0; ni < 4; ++ni) { const int i = wc * 64 + ni * 16 + fr; const float s = red[i * 2] + red[(128 + i) * 2], ss = red[i * 2 + 1] + red[(128 + i) * 2 + 1];
        mean[ni] = s * (1.f / 128.f); const float var = ss * (1.f / 128.f) - mean[ni] * mean[ni]; rstd[ni] = rsqrtf(fmaxf(var, 0.f) + 1e-6f); }
    __syncthreads();
    float* ost = (float*)smem;
#pragma unroll
    for (int mi = 0; mi < 4; ++mi)
#pragma unroll
        for (int ni = 0; ni < 4; ++ni) { const int i = wc * 64 + ni * 16 + fr, e = wr * 64 + mi * 16 + quad * 4;
            *(f32x4*)(ost + i * 132 + e) = (acc[mi][ni] - mean[ni]) * rstd[ni]; }
    __syncthreads();
    bf16x8 gv[8];
#pragma unroll
    for (int k = 0; k < 8; ++k) { const int i = (tid >> 4) + 16 * k; const size_t tok = (size_t)b * L + I * 128 + i; gv[k] = *(const bf16x8*)(p.gbuf + tok * 512 + h * 128 + (tid & 15) * 8); }
#pragma unroll
    for (int k = 0; k < 8; ++k) { const int i = (tid >> 4) + 16 * k; const size_t tok = (size_t)b * L + I * 128 + i;
        const f32x4 v0 = *(const f32x4*)(ost + i * 132 + (tid & 15) * 8), v1 = *(const f32x4*)(ost + i * 132 + (tid & 15) * 8 + 4);
        const us4 pa = pack4(v0[0] * silu_f(bf2f((bf16_t)gv[k][0])), v0[1] * silu_f(bf2f((bf16_t)gv[k][1])), v0[2] * silu_f(bf2f((bf16_t)gv[k][2])), v0[3] * silu_f(bf2f((bf16_t)gv[k][3])));
        const us4 pb = pack4(v1[0] * silu_f(bf2f((bf16_t)gv[k][4])), v1[1] * silu_f(bf2f((bf16_t)gv[k][5])), v1[2] * silu_f(bf2f((bf16_t)gv[k][6])), v1[3] * silu_f(bf2f((bf16_t)gv[k][7])));
        const bf16x8 o = {(short)pa[0], (short)pa[1], (short)pa[2], (short)pa[3], (short)pb[0], (short)pb[1], (short)pb[2], (short)pb[3]};
        *(bf16x8*)(p.ycat + tok * 1024 + 512 + h * 128 + (tid & 15) * 8) = o; }
    __syncthreads();
}
DEV void ph_rout_hynorm(const Params& p, char* smem) {
    const Topo tp = topo_get(smem);
    if (tp.local) {
#pragma unroll 1
        for (int t = tp.rk; t < NH * NCH; t += tp.nl) { KP_BEGIN(3); rout_b_task(p, smem, tp.x * NH * NCH + t); KP_END(3); }
#pragma unroll 1
        for (int t = tp.rk; t < L / 64; t += tp.nl) { KP_BEGIN(4); hynorm_task(p, smem, tp.x * (L / 64) + t); KP_END(4); }
        return;
    }
#pragma unroll 1
    for (int task = blockIdx.x; task < NB * NH * NCH + T / 64; task += gridDim.x) {
        if (task < NB * NH * NCH) rout_b_task(p, smem, task); else hynorm_task(p, smem, task - NB * NH * NCH); } }

DEV void outproj_tile(const Params& p, char* smem, int mt, int nt, bool post) {
    int tid = threadIdx.x; OPAQUE(tid);
    const int lane = tid & 63, wid = tid >> 6, wr = wid >> 1, wc = wid & 1, fr = lane & 15, quad = lane >> 4;
    f32x4 acc[4][4]; zero_acc(acc);
    LdPlain lw(p.w_out_t, (size_t)nt * 128, D), la(p.ycat, (size_t)mt * 128, D);
    gemm_tile(acc, lw, la, D / 64, smem);
    const int b = (mt * 128) / L; const float* g1 = p.mod + (size_t)b * NMODC + 2 * D;
    float* ost = (float*)smem;
#pragma unroll
    for (int mi = 0; mi < 4; ++mi)
#pragma unroll
        for (int ni = 0; ni < 4; ++ni) *(f32x4*)(ost + (wc * 64 + ni * 16 + fr) * 132 + wr * 64 + mi * 16 + quad * 4) = acc[mi][ni];
    __syncthreads();
    const f32x4 gv = *(const f32x4*)(g1 + nt * 128 + (tid & 31) * 4);
    f32x4 xv[16];
#pragma unroll
    for (int i = 0; i < 16; ++i) xv[i] = NT_LD(f32x4, p.x + ((size_t)mt * 128 + (tid >> 5) + 8 * i) * D + nt * 128 + (tid & 31) * 4);
#pragma unroll
    for (int i = 0; i < 16; ++i) { const int row = (tid >> 5) + 8 * i;
        *(f32x4*)(p.x1 + ((size_t)mt * 128 + row) * D + nt * 128 + (tid & 31) * 4) = xv[i] + gv * *(const f32x4*)(ost + row * 132 + (tid & 31) * 4); }
    if (post) flag_post(flag_rt(p, mt)); else __syncthreads();
}
DEV void ph_outproj(const Params& p, char* smem) {
    constexpr int NMT = T / 128;
    const int G = gridDim.x, b = blockIdx.x;
    if ((G & 7) == 0 && NMT % 8 == 0) {
        constexpr int MX = NMT / 8, RB = MX < 8 ? MX : 8;
        const int x = b & 7, li = b >> 3, nl = G >> 3;
        const bool convfirst = li >= nl / 2;
        if (convfirst) for (int t = b; t < NT_W13 + NT_W2; t += G) expert_conv_task(p, smem, t);
        for (int q = li; q < MX * 8; q += nl) { const int mg = q / (RB * 8), rem = q % (RB * 8); outproj_tile(p, smem, x * MX + mg * RB + rem % RB, rem / RB, topo_get(smem).local); }
        if (!convfirst) for (int t = b; t < NT_W13 + NT_W2; t += G) expert_conv_task(p, smem, t);
    } else {
        for (int task = blockIdx.x; task < NMT * 8; task += gridDim.x) outproj_tile(p, smem, task / 8, task % 8, false);
        for (int t = b; t < NT_W13 + NT_W2; t += G) expert_conv_task(p, smem, t);
    }
}

constexpr int RT_RSTR = D + 4;
struct RouterW { f32x4 b0[4][4], b1[4][4]; };
DEV void router_load_w(const Params& p, int b, RouterW& w) {
    const int lane = threadIdx.x & 63, wid = threadIdx.x >> 6, fr = lane & 15, quad = lane >> 4;
    const float* rpl = p.RP + (size_t)b * D * 32 + ((size_t)(wid * 64 + quad) * 32 + fr) * 4;
#pragma unroll
    for (int it = 0; it < 4; ++it)
#pragma unroll
        for (int u = 0; u < 4; ++u) { w.b0[it][u] = *(const f32x4*)(rpl + (size_t)(it * 16 + u * 4) * 128); w.b1[it][u] = *(const f32x4*)(rpl + (size_t)(it * 16 + u * 4) * 128 + 64); }
}
DEV void router_task(const Params& p, char* smem, int rt, int slot) {
    const int tid = threadIdx.x, lane = tid & 63, wid = tid >> 6, fr = lane & 15, quad = lane >> 4;
    float* x1s = (float*)smem;
    float* lgs = x1s + 16 * RT_RSTR;
    float* rsp = lgs + 4 * 16 * 33;
    int* lcnt = (int*)(rsp + 64); int* dec = lcnt + 2 * NEXP;
    const size_t row0 = (size_t)rt * 16; const int b = (int)(row0 / L);
    KP_BEGIN(11);
    RouterW w; router_load_w(p, b, w);
    {
        const float* xg = p.x1 + row0 * D + wid * 256 + lane * 4; char* xl = (char*)(x1s + wid * 256) + lane * 16;
#pragma unroll
        for (int r = 0; r < 16; ++r) glds16((const bf16_t*)(xg + (size_t)r * D), xl + r * (RT_RSTR * 4));
        wait_vm0();
        WAVE_SYNC();
    }
    f32x4 a0 = {0.f, 0.f, 0.f, 0.f}, a1 = a0; float ss = 0.f;
    const float* xq = x1s + fr * RT_RSTR + wid * 256 + quad * 4;
#pragma unroll
    for (int it = 0; it < 4; ++it) {
#pragma unroll
        for (int u = 0; u < 4; ++u) { const f32x4 xv = *(const f32x4*)(xq + it * 64 + u * 16);
            ss += xv[0] * xv[0] + xv[1] * xv[1] + xv[2] * xv[2] + xv[3] * xv[3];
#pragma unroll
            for (int i = 0; i < 4; ++i) { a0 = __builtin_amdgcn_mfma_f32_16x16x4f32(xv[i], w.b0[it][u][i], a0, 0, 0, 0); a1 = __builtin_amdgcn_mfma_f32_16x16x4f32(xv[i], w.b1[it][u][i], a1, 0, 0, 0); }
        }
    }
    ss += __shfl_xor(ss, 16); ss += __shfl_xor(ss, 32);
    if (quad == 0) rsp[wid * 16 + fr] = ss;
#pragma unroll
    for (int r = 0; r < 4; ++r) { lgs[(wid * 16 + quad * 4 + r) * 33 + fr] = a0[r]; lgs[(wid * 16 + quad * 4 + r) * 33 + 16 + fr] = a1[r]; }
    __syncthreads();
    KP_END(11); KP_BEGIN(10);
    if (wid == 0) {
        int e0 = 0, e1 = 0, l0 = 0, l1 = 0; float w0 = 0.f, w1 = 0.f;
        if (lane < 16) {
            const float rsd = rsqrtf((rsp[lane] + rsp[16 + lane] + rsp[32 + lane] + rsp[48 + lane]) * (1.f / D) + 1e-6f); float lg[20];
#pragma unroll
            for (int j = 0; j < 20; ++j) lg[j] = (lgs[lane * 33 + j] + lgs[(16 + lane) * 33 + j] + lgs[(32 + lane) * 33 + j] + lgs[(48 + lane) * 33 + j]) * rsd + p.cb[b * 32 + j];
            int g = 0; float gm = lg[0];
#pragma unroll
            for (int j = 1; j < 4; ++j) if (lg[j] > gm) { gm = lg[j]; g = j; }
            float den = 0.f;
#pragma unroll
            for (int j = 0; j < 4; ++j) den += expf(lg[j] - gm);
            const float psel = 1.f / den;
            float le[4];
#pragma unroll
            for (int j = 0; j < 4; ++j) le[j] = g == 0 ? lg[4 + j] : (g == 1 ? lg[8 + j] : (g == 2 ? lg[12 + j] : lg[16 + j]));
            int i0 = 0; float m0 = le[0];
#pragma unroll
            for (int j = 1; j < 4; ++j) if (le[j] > m0) { m0 = le[j]; i0 = j; }
            int i1 = -1; float m1 = -3.0e38f;
#pragma unroll
            for (int j = 0; j < 4; ++j) if (j != i0 && le[j] > m1) { m1 = le[j]; i1 = j; }
            const float ex = expf(m1 - m0); w0 = psel / (1.f + ex); w1 = psel * ex / (1.f + ex);
            e0 = g * 4 + i0; e1 = g * 4 + i1;
            l0 = atomicAdd(lcnt + e0, 1); l1 = atomicAdd(lcnt + e1, 1);
            int* d = dec + (slot * 16 + lane) * 6; d[0] = e0; d[1] = e1; d[2] = l0; d[3] = l1; d[4] = (int)f_as_u(w0); d[5] = (int)f_as_u(w1);
        }
    }
    KP_END(10); KP_BEGIN(12);
    {
        const int c = tid & 127, hf = tid >> 7, k = c * 8;
        const float* sh = p.mod + (size_t)b * NMODC + 3 * D; const float* sc = sh + D;
        f32x4 wm[2], sa[2];
#pragma unroll
        for (int i = 0; i < 2; ++i) { const f32x4 w = *(const f32x4*)(p.norm2_w + k + i * 4), s1 = *(const f32x4*)(sc + k + i * 4); sa[i] = *(const f32x4*)(sh + k + i * 4); wm[i] = w * (1.f + s1); }
#pragma unroll
        for (int r = 0; r < 8; ++r) { const int row = hf * 8 + r;
            const float rsd = rsqrtf((rsp[row] + rsp[16 + row] + rsp[32 + row] + rsp[48 + row]) * (1.f / D) + 1e-6f);
            const f32x4 v0 = *(const f32x4*)(x1s + row * RT_RSTR + k) * rsd * wm[0] + sa[0], v1 = *(const f32x4*)(x1s + row * RT_RSTR + k + 4) * rsd * wm[1] + sa[1];
            const us4 pa = pack4(v0[0], v0[1], v0[2], v0[3]), pb = pack4(v1[0], v1[1], v1[2], v1[3]);
            const bf16x8 o = {(short)pa[0], (short)pa[1], (short)pa[2], (short)pa[3], (short)pb[0], (short)pb[1], (short)pb[2], (short)pb[3]};
            *(bf16x8*)(p.h2 + (row0 + row) * D + k) = o; }
    }
    __syncthreads();
    KP_END(12);
}
DEV void router_flush(const Params& p, char* smem, int rt0, int stride, int nslots) {
    const int tid = threadIdx.x, lane = tid & 63;
    int* lcnt = (int*)((float*)smem + 16 * RT_RSTR + 4 * 16 * 33 + 64); int* lbase = lcnt + NEXP; int* dec = lcnt + 2 * NEXP;
    if (tid < 64) {
        if (lane < NEXP) { const int c = lcnt[lane]; lbase[lane] = c ? atomicAdd(p.cnt + lane * 32, c) : 0; lcnt[lane] = 0; }
        WAVE_SYNC();
        for (int i = lane; i < nslots * 16; i += 64) { const int sl = i >> 4, r = i & 15; const int* d = dec + i * 6; const size_t tok = (size_t)(rt0 + sl * stride) * 16 + r;
            const int e0 = d[0], e1 = d[1]; const int p0 = lbase[e0] + d[2], p1 = lbase[e1] + d[3];
            WT_STORE(p.elist + (size_t)e0 * T + p0, (int)tok * 2); WT_STORE(p.ewt + (size_t)e0 * T + p0, u_as_f((uint32_t)d[4]));
            WT_STORE(p.elist + (size_t)e1 * T + p1, (int)tok * 2 + 1); WT_STORE(p.ewt + (size_t)e1 * T + p1, u_as_f((uint32_t)d[5])); }
    }
    __syncthreads();
}
DEV void ph_norm2_router(const Params& p, char* smem) {
    const int G = gridDim.x, b = blockIdx.x;
    {   int* lcnt = (int*)((float*)smem + 16 * RT_RSTR + 4 * 16 * 33 + 64);
        if (threadIdx.x < NEXP) lcnt[threadIdx.x] = 0;
        __syncthreads(); }
    const Topo tp = topo_get(smem);
    int tpb = (T / 16 + G - 1) / G, rbeg = b * tpb, rend = rbeg + tpb < T / 16 ? rbeg + tpb : T / 16;
    if (tp.local) { tpb = (T / 128 + tp.nl - 1) / tp.nl; rbeg = tp.x * (T / 128) + tp.rk * tpb; const int re = (tp.x + 1) * (T / 128); rend = rbeg + tpb < re ? rbeg + tpb : re; }
    int slot = 0, rt0 = rbeg, curmt = -1;
    if (tp.local) flag_acquire();
    for (int rt = rbeg; rt < rend; ++rt) { if (tp.local && (rt >> 3) != curmt) { curmt = rt >> 3; flag_wait(flag_rt(p, curmt), 8u); }
        router_task(p, smem, rt, slot); if (++slot == 8) { router_flush(p, smem, rt0, 1, 8); slot = 0; rt0 = rt + 1; } }
    if (slot) router_flush(p, smem, rt0, 1, slot);
}

struct MoeCnt { int c[NEXP]; };
DEV void moe_load_cnt(const Params& p, MoeCnt& m) {
#pragma unroll
    for (int q = 0; q < NEXP; ++q) m.c[q] = p.cnt[q * 32];
}
DEV bool moe_find_tile(const MoeCnt& m, int mtile, int& e, int& lt, int& rowoff, int& cnt) {
    int acc = 0; bool found = false; e = 0; lt = 0; rowoff = 0; cnt = 0;
#pragma unroll
    for (int q = 0; q < NEXP; ++q) { const int c = m.c[q]; const int nt = (c + 127) >> 7; if (!found && mtile < acc + nt) { e = q; lt = mtile - acc; rowoff = acc * 128; cnt = c; found = true; } acc += nt; }
    return found;
}
DEV void ph_moe_up(const Params& p, char* smem) {
    const int tid = threadIdx.x, lane = tid & 63, wid = tid >> 6, wr = wid >> 1, wc = wid & 1, fr = lane & 15, quad = lane >> 4;
    const Topo tp = topo_get(smem); const bool xcdmap = (gridDim.x & 7) == 0; const int xq = tp.x, qstep = xcdmap ? tp.nl : (int)gridDim.x;
    MoeCnt mc; moe_load_cnt(p, mc);
    const int lrow = tid >> 3, lc = stage_chunk();
    int q = xcdmap ? tp.rk : (int)blockIdx.x;
    int e, lt, rowoff, cnt; bool valid = moe_find_tile(mc, xcdmap ? xq + 8 * (q >> 3) : (q >> 3), e, lt, rowoff, cnt);
    int tokc[4];
#pragma unroll
    for (int i = 0; i < 4; ++i) { int li = lt * 128 + lrow + 32 * i; if (li >= cnt) li = cnt - 1; if (li < 0) li = 0; tokc[i] = p.elist[(size_t)e * T + li]; }
    while (valid) {
        const int nt = q & 7;
        LdGather la;
#pragma unroll
        for (int i = 0; i < 4; ++i) la.rp[i] = p.h2 + (size_t)(tokc[i] >> 1) * D + lc;
        float cw[4];
#pragma unroll
        for (int ni = 0; ni < 4; ++ni) { int li = lt * 128 + wc * 64 + ni * 16 + fr; if (li >= cnt) li = cnt - 1; cw[ni] = p.ewt[(size_t)e * T + li]; }
        const int qn = q + qstep; int en, ltn, rowoffn, cntn; const bool validn = moe_find_tile(mc, xcdmap ? xq + 8 * (qn >> 3) : (qn >> 3), en, ltn, rowoffn, cntn);
        int tokn[4];
#pragma unroll
        for (int i = 0; i < 4; ++i) { int li = ltn * 128 + lrow + 32 * i; if (li >= cntn) li = cntn - 1; if (li < 0) li = 0; tokn[i] = p.elist[(size_t)en * T + li]; }
        LdPlain lw(p.w13_t + (size_t)e * 1024 * 1024, (size_t)nt * 128, D);
        f32x4 acc[4][4]; zero_acc(acc);
        gemm_tile(acc, lw, la, D / 64, smem);
        bf16_t* ost = (bf16_t*)smem;
#pragma unroll
        for (int ni = 0; ni < 4; ++ni) {
#pragma unroll
            for (int mi = 0; mi < 2; ++mi) { float hv[4];
#pragma unroll
                for (int r = 0; r < 4; ++r) hv[r] = silu_f(acc[mi][ni][r]) * acc[mi + 2][ni][r] * cw[ni];
                *(us4*)(ost + (wc * 64 + ni * 16 + fr) * 72 + wr * 32 + mi * 16 + quad * 4) = pack4(hv[0], hv[1], hv[2], hv[3]); } }
        __syncthreads();
#pragma unroll
        for (int i = 0; i < 4; ++i) { const int row = (tid >> 3) + 32 * i, ch = tid & 7;
            if (lt * 128 + row < cnt) *(bf16x8*)(p.hid + (size_t)(rowoff + lt * 128 + row) * EH + nt * 64 + ch * 8) = *(const bf16x8*)(ost + row * 72 + ch * 8); }
        if (tp.local) flag_post(flag_mt(p, xcdmap ? xq + 8 * (q >> 3) : (q >> 3))); else __syncthreads();
        q = qn; e = en; lt = ltn; rowoff = rowoffn; cnt = cntn; valid = validn;
#pragma unroll
        for (int i = 0; i < 4; ++i) tokc[i] = tokn[i];
    }
}
DEV void ph_moe_down(const Params& p, char* smem) {
    const int tid = threadIdx.x, lane = tid & 63, wid = tid >> 6, wr = wid >> 1, wc = wid & 1, fr = lane & 15, quad = lane >> 4;
    const Topo tp = topo_get(smem); const bool xcdmap = (gridDim.x & 7) == 0; const int xq = tp.x, qstep = xcdmap ? tp.nl : (int)gridDim.x;
    MoeCnt mc; moe_load_cnt(p, mc);
    if (tp.local) flag_acquire();
    for (int q = xcdmap ? tp.rk : (int)blockIdx.x; ; q += qstep) {
        const int mtile = xcdmap ? xq + 8 * (q >> 3) : (q >> 3), nt = q & 7;
        int e, lt, rowoff, cnt; if (!moe_find_tile(mc, mtile, e, lt, rowoff, cnt)) break;
        if (tp.local) flag_wait(flag_mt(p, mtile), 8u);
        LdGather la; const int lrow = tid >> 3, lc = stage_chunk();
#pragma unroll
        for (int i = 0; i < 4; ++i) { int li = lt * 128 + lrow + 32 * i; if (li >= cnt) li = cnt - 1; la.rp[i] = p.hid + (size_t)(rowoff + li) * EH + lc; }
        int ts[8];
#pragma unroll
        for (int i = 0; i < 8; ++i) { int li = lt * 128 + (tid >> 4) + 16 * i; if (li >= cnt) li = cnt - 1; ts[i] = p.elist[(size_t)e * T + li]; }
        LdPlain lw(p.w2_t + (size_t)e * 1024 * EH, (size_t)nt * 128, EH);
        f32x4 acc[4][4]; zero_acc(acc);
        gemm_tile(acc, lw, la, EH / 64, smem);
        bf16_t* ost = (bf16_t*)smem;
#pragma unroll
        for (int mi = 0; mi < 4; ++mi)
#pragma unroll
            for (int ni = 0; ni < 4; ++ni) *(us4*)(ost + (wc * 64 + ni * 16 + fr) * OPITCH + wr * 64 + mi * 16 + quad * 4) = pack4(acc[mi][ni][0], acc[mi][ni][1], acc[mi][ni][2], acc[mi][ni][3]);
        __syncthreads();
#pragma unroll
        for (int i = 0; i < 8; ++i) { const int row = (tid >> 4) + 16 * i, ch = tid & 15;
            if (lt * 128 + row < cnt) *(bf16x8*)(p.ymoe + (size_t)ts[i] * D + nt * 128 + ch * 8) = *(const bf16x8*)(ost + row * OPITCH + ch * 8); }
        __syncthreads();
    }
}
DEV void ph_final(const Params& p, char* smem) {
    const int lane = threadIdx.x & 63, wid = threadIdx.x >> 6;
    for (int row = blockIdx.x * 4 + wid; row < T; row += gridDim.x * 4) { const int b = row / L; const float* g2 = p.mod + (size_t)b * NMODC + 5 * D;
        f32x4 v[4]; float ss = 0.f;
#pragma unroll
        for (int i = 0; i < 4; ++i) { const int k = i * 256 + lane * 4; const f32x4 xv = NT_LD(f32x4, p.x1 + (size_t)row * D + k), gv = *(const f32x4*)(g2 + k);
            const us4 y0 = NT_LD(us4, p.ymoe + ((size_t)row * 2) * D + k), y1 = NT_LD(us4, p.ymoe + ((size_t)row * 2 + 1) * D + k);
#pragma unroll
            for (int e = 0; e < 4; ++e) { v[i][e] = xv[e] + gv[e] * (bf2f(y0[e]) + bf2f(y1[e])); ss += v[i][e] * v[i][e]; } }
        ss = wave_sum(ss); const float rstd = rsqrtf(ss * (1.f / D) + 1e-6f);
#pragma unroll
        for (int i = 0; i < 4; ++i) { const int k = i * 256 + lane * 4; const f32x4 w = *(const f32x4*)(p.final_w + k); *(f32x4*)(p.out + (size_t)row * D + k) = v[i] * rstd * w; }
    }
}


#define XB_TMO      128
#define XB_CLS(c)   (192 + (c))
#define XB_XCNT(j)  (256  + 64 * (j))
#define XB_XSUB(j)  (1280 + 64 * (j))
#define XB_XGEN(j)  (2304 + 64 * (j))
#define XB_TOP      3328
#define XB_TOPGEN   3392
#define XB_LSUB(j)  (3456 + 64 * (j))
#define XB_LGEN(j)  (4480 + 64 * (j))
#define XCD_BAR_WORDS (5504 + (T / 128 + 2 * T / 128 + NEXP + 16) * 32)
#ifndef CPU_EMU
#define XB_SPIN_CAP (1u << 22)
#define LAS __attribute__((address_space(3)))
__device__ __forceinline__ unsigned xb_ld(unsigned* p)              { return __hip_atomic_load(p, __ATOMIC_RELAXED, __HIP_MEMORY_SCOPE_AGENT); }
__device__ __forceinline__ unsigned xb_add(unsigned* p, unsigned v) { return __hip_atomic_fetch_add(p, v, __ATOMIC_RELAXED, __HIP_MEMORY_SCOPE_AGENT); }
__device__ __forceinline__ unsigned xb_xcc_id() { return (unsigned)__builtin_amdgcn_s_getreg((3 << 11) | 20) & 0xFu; }
#define XB_SPIN(cond, bar) do { unsigned _sp = 0; while (cond) { __builtin_amdgcn_s_sleep(1); \
    if ((++_sp & 255u) == 0u) { if (xb_ld(&(bar)[XB_TMO])) break; if (_sp > XB_SPIN_CAP) { atomicAdd(&(bar)[XB_TMO], 1u); break; } } } } while (0)
struct XcdBarrier { unsigned* bar; unsigned x; volatile LAS unsigned* st; };
__device__ __forceinline__ XcdBarrier xcd_barrier_post(unsigned* bar, volatile LAS unsigned* st) {
    XcdBarrier b; b.bar = bar; b.x = xb_xcc_id(); b.st = st;
    if (threadIdx.x == 0) { (void)__hip_atomic_fetch_or(&bar[XB_CLS(blockIdx.x & 7u)], 1u << b.x, __ATOMIC_RELAXED, __HIP_MEMORY_SCOPE_AGENT);
        st[2] = xb_add(&bar[XB_XCNT(b.x)], 1u); st[3] = b.x; }
    return b;
}
__device__ __forceinline__ void xcd_barrier_complete(unsigned* bar, unsigned x, unsigned& nloc, unsigned& nx, unsigned& idmask) {
    const unsigned G = gridDim.x * gridDim.y * gridDim.z;
    unsigned sum, cnt, mine, msk, sp = 0u;
    for (;;) {
        sum = 0u; cnt = 0u; mine = 0u; msk = 0u;
#pragma unroll
        for (unsigned j = 0; j < 16; ++j) { const unsigned c = xb_ld(&bar[XB_XCNT(j)]); sum += c; cnt += (c > 0u) ? 1u : 0u; msk |= (c > 0u) ? (1u << j) : 0u; mine = (j == x) ? c : mine; }
        if (sum == G) break;
        __builtin_amdgcn_s_sleep(1);
        if ((++sp & 255u) == 0u) { if (xb_ld(&bar[XB_TMO])) break; if (sp > XB_SPIN_CAP) { atomicAdd(&bar[XB_TMO], 1u); break; } }
    }
    nloc = mine > 0u ? mine : 1u; nx = cnt > 0u ? cnt : 1u; idmask = msk;
}
__device__ __forceinline__ void xcd_barrier(const XcdBarrier& b) {
    asm volatile("s_waitcnt vmcnt(0)" ::: "memory");
    __syncthreads();
    if (threadIdx.x == 0) {
        unsigned* bar = b.bar;
        __builtin_amdgcn_s_waitcnt(0);
        unsigned nloc = b.st[0], nx = b.st[1];
        if (nloc == 0u) { unsigned idmask; xcd_barrier_complete(bar, b.x, nloc, nx, idmask); b.st[0] = nloc; b.st[1] = nx; b.st[4] = idmask; unsigned bad = 0u; for (unsigned c = 0; c < 8u; ++c) { const unsigned m = xb_ld(&bar[XB_CLS(c)]); bad |= (m == 0u || (m & (m - 1u)) != 0u) ? 1u : 0u; } b.st[5] = bad; }
        const unsigned old = xb_add(&bar[XB_XSUB(b.x)], 1u);
        const unsigned gen = old / nloc;
        if (old + 1u == (gen + 1u) * nloc) {
            __builtin_amdgcn_fence(__ATOMIC_RELEASE, "agent");
            asm volatile("s_waitcnt vmcnt(0)" ::: "memory");
            const unsigned og = xb_add(&bar[XB_TOP], 1u);
            const unsigned tg = og / nx;
            if (og + 1u == (tg + 1u) * nx) xb_add(&bar[XB_TOPGEN], 1u);
            else XB_SPIN(xb_ld(&bar[XB_TOPGEN]) == tg, bar);
            __builtin_amdgcn_fence(__ATOMIC_ACQUIRE, "agent");
            xb_add(&bar[XB_XGEN(b.x)], 1u);
            asm volatile("s_waitcnt vmcnt(0)" ::: "memory");
        } else {
            __builtin_amdgcn_fence(__ATOMIC_ACQUIRE, "agent");
            XB_SPIN(xb_ld(&bar[XB_XGEN(b.x)]) == gen, bar);
            asm volatile("s_waitcnt vmcnt(0)" ::: "memory");
        }
    }
    __syncthreads();
}
__device__ __forceinline__ void xcd_barrier_local(const XcdBarrier& b) {
    asm volatile("s_waitcnt vmcnt(0)" ::: "memory");
    __syncthreads();
    if (threadIdx.x == 0) {
        unsigned* bar = b.bar;
        __builtin_amdgcn_s_waitcnt(0);
        const unsigned nloc = b.st[0];
        const unsigned old = xb_add(&bar[XB_LSUB(b.x)], 1u);
        const unsigned gen = old / nloc;
        if (old + 1u == (gen + 1u) * nloc) xb_add(&bar[XB_LGEN(b.x)], 1u);
        else XB_SPIN(xb_ld(&bar[XB_LGEN(b.x)]) == gen, bar);
        __builtin_amdgcn_fence(__ATOMIC_ACQUIRE, "agent");
        asm volatile("s_waitcnt vmcnt(0)" ::: "memory");
    }
    __syncthreads();
}
#endif

#define PHASE_LIST(X) X(ph_prep) X(ph_norm1) X(ph_inproj) X(ph_conv_rscan) X(ph_rout_hynorm) X(ph_outproj) X(ph_norm2_router) X(ph_moe_up) X(ph_moe_down)

struct WsBuf { size_t size, off; int p0, p1; };
static size_t fill_params(Params& p, void* const* d_in, void* d_out, void* d_ws, int grid) {
    const float** in = (const float**)d_in;
    p.x = in[0]; p.c = in[1]; p.ctx = in[2]; p.c_ctx = in[3]; p.ada_w = in[4]; p.ada_b = in[5]; p.norm1_w = in[6]; p.w_in = in[7]; p.hy_conv_w = in[8]; p.hy_conv_b = in[9];
    p.f_w1 = in[10]; p.f_b1 = in[11]; p.f_w2 = in[12]; p.f_b2 = in[13]; p.f_w3 = in[14]; p.f_b3 = in[15]; p.f_wout = in[16]; p.f_freq = in[17]; p.hy_skip = in[18]; p.hy_out_norm = in[19];
    p.ret_gn_w = in[20]; p.w_out = in[21]; p.norm2_w = in[22]; p.rg_w = in[23]; p.rg_b = in[24]; p.re_w = in[25]; p.re_b = in[26]; p.exp_w1 = in[27]; p.exp_w3 = in[28]; p.exp_w2 = in[29]; p.final_w = in[30];
    p.out = (float*)d_out;
    char* ws = (char*)d_ws; WsBuf bufs[48]; void** slots[48]; int nb = 0; size_t total = 0;
#define WS(field, type, count, p0, p1) { slots[nb] = (void**)&p.field; bufs[nb] = WsBuf{((sizeof(type) * (size_t)(count)) + 255) & ~(size_t)255, 0, p0, p1}; ++nb; }
    WS(mod, float, (NB + 1) * NMODC, 0, 9); WS(cnt, int, NEXP * 32, 0, 9); WS(bar, unsigned, XCD_BAR_WORDS, 0, 9); WS(rope, float, 64 * 16 * 2, 0, 2); WS(h3buf, float, (size_t)L * 64, 0, 2); WS(w_in_t, bf16_t, PC * D, 0, 2); WS(w_out_t, bf16_t, D * D, 0, 5);
    WS(gtap, bf16_t, (size_t)HW * 2 * L, 1, 3);
    WS(hbuf, bf16_t, (size_t)TA * D, 1, 2); WS(RP, float, (size_t)NB * D * 32, 1, 6); WS(cb, float, NB * 32, 1, 6);
    WS(pT, bf16_t, (size_t)1536 * T, 2, 4); WS(qn, bf16_t, (size_t)T * 512, 2, 4); WS(kn, bf16_t, (size_t)T * 512, 2, 3); WS(kTf, bf16_t, (size_t)T * 512, 2, 3); WS(kTb, bf16_t, (size_t)T * 512, 2, 3); WS(vT, bf16_t, (size_t)T * 512, 2, 3);
    WS(ckTf, bf16_t, (size_t)TC * 512, 2, 3); WS(ckTb, bf16_t, (size_t)TC * 512, 2, 3); WS(cvT, bf16_t, (size_t)TC * 512, 2, 3); WS(gbuf, bf16_t, (size_t)T * 512, 2, 4);
    WS(yhyT, bf16_t, (size_t)HW * T, 3, 4); WS(Sst, bf16_t, (size_t)2 * NB * NH * NCH * 16384, 3, 4); WS(ycat, bf16_t, (size_t)T * D, 4, 5);
    WS(Opart, bf16_t, (size_t)NB * NH * NCH * 16384, 3, 4);
    WS(x1, float, (size_t)T * D, 5, 9); WS(w13_t, bf16_t, (size_t)NEXP * 1024 * 1024, 5, 7); WS(w2_t, bf16_t, (size_t)NEXP * 1024 * EH, 5, 8);
    WS(h2, bf16_t, (size_t)T * D, 5, 7); WS(elist, int, (size_t)NEXP * T, 5, 9); WS(ewt, float, (size_t)NEXP * T, 5, 9);
    WS(hid, bf16_t, (size_t)(2 * T + NEXP * 128) * EH, 7, 8); WS(ymoe, bf16_t, (size_t)2 * T * D, 7, 9);
#undef WS
    int order[48]; for (int i = 0; i < nb; ++i) order[i] = i;
    for (int i = 1; i < nb; ++i) { const int v = order[i]; int j = i - 1; while (j >= 0 && bufs[order[j]].size < bufs[v].size) { order[j + 1] = order[j]; --j; } order[j + 1] = v; }
    bool placed[48]; for (int i = 0; i < nb; ++i) placed[i] = false;
    for (int oi = 0; oi < nb; ++oi) { WsBuf& nbuf = bufs[order[oi]]; size_t off = 0;
        for (bool moved = true; moved;) { moved = false;
            for (int i = 0; i < nb; ++i) { if (!placed[i]) continue; const WsBuf& b = bufs[i];
                if (b.p1 < nbuf.p0 || b.p0 > nbuf.p1) continue;
                if (off < b.off + b.size && b.off < off + nbuf.size) { off = b.off + b.size; moved = true; } } }
        nbuf.off = off; placed[order[oi]] = true; *slots[order[oi]] = (void*)(ws + off); if (off + nbuf.size > total) total = off + nbuf.size; }
    return total;
}

#ifndef CPU_EMU
__global__ void __launch_bounds__(NTHR, 2) mega_kernel(Params p) {
    extern __shared__ __attribute__((aligned(16))) char smem[];
    volatile LAS unsigned* st = (volatile LAS unsigned*)(smem + SMEM_BYTES - 64);
    if (threadIdx.x == 0) { st[0] = 0u; st[1] = 0u; st[4] = 0u; st[5] = 1u; *(unsigned long long*)(smem + SMEM_BYTES - 32) = 0ull; }
    __syncthreads();
    const XcdBarrier xb = xcd_barrier_post(p.bar, st);
    if (p.out == nullptr) cg::this_grid().sync();
    ph_prep(p, smem); xcd_barrier(xb);
    const bool loc = topo_get(smem).local;
    ph_norm1(p, smem); if (df1_mode(topo_get(smem))) {} else if (loc) xcd_barrier_local(xb); else xcd_barrier(xb);
    ph_inproj(p, smem); xcd_barrier(xb);
    ph_conv_rscan(p, smem); xcd_barrier(xb);
    ph_rout_hynorm(p, smem); xcd_barrier(xb);
    ph_outproj(p, smem); if (!loc) xcd_barrier(xb);
    ph_norm2_router(p, smem); xcd_barrier(xb);
    ph_moe_up(p, smem); if (!loc) xcd_barrier(xb);
    ph_moe_down(p, smem); xcd_barrier(xb);
    ph_final(p, smem);
#ifdef KPROBE_ID
    if (blockIdx.x == KPROBE_BLOCK && threadIdx.x == 0) { const unsigned long long tn = __builtin_amdgcn_s_memrealtime(), wait = (unsigned long long)KPROBE_AMP * *(unsigned long long*)(smem + SMEM_BYTES - 32); while (__builtin_amdgcn_s_memrealtime() - tn < wait) __builtin_amdgcn_s_sleep(8); }
#endif
}

extern "C" void kernel_launch(void* const* d_in, const int* in_sizes, int n_in, void* d_out, int out_size, void* d_ws, size_t ws_size, hipStream_t stream) {
    static int grid_blocks = 0;
    if (!grid_blocks) {
        int dev = 0, cus = 0, per_cu = 0;
        (void)hipGetDevice(&dev);
        (void)hipDeviceGetAttribute(&cus, hipDeviceAttributeMultiprocessorCount, dev);
        (void)hipFuncSetAttribute((const void*)mega_kernel, hipFuncAttributeMaxDynamicSharedMemorySize, SMEM_BYTES);
        (void)hipOccupancyMaxActiveBlocksPerMultiprocessor(&per_cu, mega_kernel, NTHR, SMEM_BYTES);
        if (per_cu > 2) per_cu = 2;
        if (per_cu < 1) per_cu = 1;
        grid_blocks = cus * per_cu;
    }
    Params p; memset(&p, 0, sizeof(p));
    const size_t need = fill_params(p, d_in, d_out, d_ws, grid_blocks);
    if (need > ws_size) { fprintf(stderr, "workspace too small: need %zu have %zu\n", need, ws_size); return; }
    (void)hipMemsetAsync(p.bar, 0, XCD_BAR_WORDS * sizeof(unsigned), stream);
    void* args[] = {&p};
    hipError_t e = hipLaunchCooperativeKernel((void*)mega_kernel, dim3(grid_blocks), dim3(NTHR), args, SMEM_BYTES, stream);
    if (e != hipSuccess) fprintf(stderr, "cooperative launch failed: %s (grid %d)\n", hipGetErrorString(e), grid_blocks);
}
#endif
```
